# Optimizing an MI355X kernel written in HIP

```python
import jax
import jax.numpy as jnp
from jax import lax
import numpy as np

D_MODEL = 1024
BATCH = 8
SEQ = 4096
DEPTH = 4

GRID_W = 64
CTX_LEN = 256
N_MIXERS = 2
EXPAND = 2
D_INNER = EXPAND * D_MODEL
RW_HEAD = 64
RW_HEADS = D_INNER // RW_HEAD
R_DECAY = 64
R_AAA = 64
R_MV = 32
HG_DK = 128
HG_HEADS = D_INNER // HG_DK
HG_DV = D_INNER // HG_HEADS
CHUNK = 64
N_RW = (DEPTH + 1) // 2
N_HG = DEPTH // 2
NORM_EPS = 1e-6
LN_X_EPS = 64e-5

kernel_name = "hybrid_rwkv7_hgrn2_dit_trunk"


def _rmsnorm(x, g):
    xf = x.astype(jnp.float32)
    y = xf * lax.rsqrt(jnp.mean(xf * xf, axis=-1, keepdims=True) + NORM_EPS)
    return (y * g.astype(jnp.float32)).astype(x.dtype)


def _heads(t, n_heads):
    return t.reshape(t.shape[0], t.shape[1], n_heads, t.shape[2] // n_heads)


def _qshift_grid(h, rows):
    b, s, d = h.shape
    q = d // 4
    g = jnp.pad(h.reshape(b, rows, GRID_W, d), ((0, 0), (1, 1), (1, 1), (0, 0)))
    left = g[:, 1:-1, :-2, :q]
    right = g[:, 1:-1, 2:, q:2 * q]
    up = g[:, :-2, 1:-1, 2 * q:3 * q]
    down = g[:, 2:, 1:-1, 3 * q:]
    return jnp.concatenate([left, right, up, down], axis=-1).reshape(b, s, d)


def _shift_seq(h):
    half = h.shape[-1] // 2
    prev = jnp.pad(h[:, :-1, :half], ((0, 0), (1, 0), (0, 0)))
    nxt = jnp.pad(h[:, 1:, half:], ((0, 0), (0, 1), (0, 0)))
    return jnp.concatenate([prev, nxt], axis=-1)


def _rwkv7_features(h, hs, mix, proj, w0, w1, w2, a0, a1, a2, k_k, k_a, v_res, v_first):
    f32 = jnp.float32
    xx = hs - h
    xr, xw, xk, xv, xa, xg = [h + xx * mix[n] for n in range(6)]
    r = xr @ proj[0]
    k = xk @ proj[1]
    v = xv @ proj[2]
    z = jax.nn.silu(xg @ proj[3])
    v_raw = v
    if v_res is not None:
        v0, v1, v2 = v_res
        v = v + (v_first - v) * jax.nn.sigmoid(v0 + (xv @ v1) @ v2)
    kk = _heads(k * k_k, RW_HEADS).astype(f32)
    kk = kk * lax.rsqrt(jnp.maximum(jnp.sum(kk * kk, axis=-1, keepdims=True), 1e-24))
    dirs = []
    for d in range(2):
        u = (w0[d] + jnp.tanh(xw @ w1[d]) @ w2[d]).astype(f32)
        log_w = -jnp.exp(-jax.nn.softplus(-u) - 0.5)
        a = jax.nn.sigmoid((a0[d] + (xa @ a1[d]) @ a2[d]).astype(f32))
        k_d = k.astype(f32) * (1.0 + (a - 1.0) * k_a.astype(f32))
        dirs.append((_heads(log_w, RW_HEADS), _heads(a, RW_HEADS), _heads(k_d, RW_HEADS)))
    return (_heads(r, RW_HEADS).astype(f32), _heads(v, RW_HEADS).astype(f32), z, kk, dirs, v_raw)


def _rwkv7_scan(r, log_w, k, v, kk, a, s0, reverse, emit):
    def step(s, xs):
        w_t, k_t, v_t, kk_t, a_t = xs[:5]
        sa = jnp.einsum('bhvk,bhk->bhv', s, -kk_t)
        s = (s * jnp.exp(w_t)[:, :, None, :] + sa[..., None] * (kk_t * a_t)[:, :, None, :]
             + v_t[..., None] * k_t[:, :, None, :])
        y = jnp.einsum('bhvk,bhk->bhv', s, xs[5]) if emit else None
        return s, y
    xs = (log_w, k, v, kk, a) + ((r,) if emit else ())
    s_last, ys = lax.scan(step, s0, tuple(jnp.moveaxis(t, 1, 0) for t in xs), reverse=reverse)
    return (jnp.moveaxis(ys, 0, 1) if emit else None), s_last


def _rwkv7_out(ys, feats, r_k, ln_w, ln_b, w_o):
    r, v, z, _, dirs, _ = feats
    y = ys[0] + ys[1]
    mu = jnp.mean(y, axis=-1, keepdims=True)
    var = jnp.mean(jnp.square(y - mu), axis=-1, keepdims=True)
    y = (y - mu) * lax.rsqrt(var + LN_X_EPS)
    rk = r_k.astype(jnp.float32).reshape(RW_HEADS, RW_HEAD)
    bonus = sum(jnp.sum(r * kd * rk, axis=-1, keepdims=True) for (_, _, kd) in dirs) * v
    b, t = y.shape[:2]
    y = (y.reshape(b, t, D_INNER) * ln_w.astype(jnp.float32) + ln_b.astype(jnp.float32)
         + bonus.reshape(b, t, D_INNER))
    return (y.astype(z.dtype) * z) @ w_o


def _rwkv7_mixer(h_lat, h_ctx, rows, p, v_res, vf_lat, vf_ctx, ctx_out):
    mix, proj, w_o, w0, w1, w2, a0, a1, a2, k_k, k_a, r_k, ln_w, ln_b = p
    shared = (mix, proj, w0, w1, w2, a0, a1, a2, k_k, k_a, v_res)
    f_ctx = _rwkv7_features(h_ctx, _shift_seq(h_ctx), *shared, vf_ctx)
    f_lat = _rwkv7_features(h_lat, _qshift_grid(h_lat, rows), *shared, vf_lat)
    s0 = jnp.zeros((h_lat.shape[0], RW_HEADS, RW_HEAD, RW_HEAD), jnp.float32)

    def run(f, s_init, emit):
        r, v, _, kk, dirs, _ = f
        outs = [_rwkv7_scan(r, lw, kd, v, kk, a, s_init[d], d == 1, emit)
                for d, (lw, a, kd) in enumerate(dirs)]
        return [o[0] for o in outs], [o[1] for o in outs]

    ys_ctx, s_ctx = run(f_ctx, (s0, s0), ctx_out)
    ys_lat, _ = run(f_lat, s_ctx, True)
    y_lat = _rwkv7_out(ys_lat, f_lat, r_k, ln_w, ln_b, w_o)
    y_ctx = _rwkv7_out(ys_ctx, f_ctx, r_k, ln_w, ln_b, w_o) if ctx_out else None
    return y_lat, y_ctx, f_lat[5], f_ctx[5]


def _hgrn2_features(h, w_in, lb):
    f32 = jnp.float32
    q, f_fwd, f_bwd, i, g = jnp.split(h @ w_in, 5, axis=-1)
    lb = lb.astype(f32)
    dirs = []
    for fl in (f_fwd, f_bwd):
        f = lb + (1.0 - lb) * jax.nn.sigmoid(fl.astype(f32))
        dirs.append((_heads(1.0 - f, HG_HEADS), _heads(jnp.log(f), HG_HEADS)))
    return (_heads(jax.nn.silu(q), HG_HEADS).astype(f32), _heads(i, HG_HEADS).astype(f32), g, dirs)


def _to_chunks(t):
    b, s, h, d = t.shape
    return t.reshape(b, s // CHUNK, CHUNK, h, d).transpose(1, 0, 3, 2, 4)


def _hgrn2_chunk_scan(q, k, v, log_f, s0):
    mask = jnp.tril(jnp.ones((CHUNK, CHUNK), dtype=bool))[:, :, None]

    def step(s, xs):
        q_c, k_c, v_c, lf_c = xs
        cum = jnp.cumsum(lf_c, axis=2)
        diff = jnp.where(mask, cum[:, :, :, None, :] - cum[:, :, None, :, :], -jnp.inf)
        att = jnp.einsum('bhtk,bhsk,bhtsk->bhts', q_c, k_c, jnp.exp(diff))
        y = (jnp.einsum('bhts,bhsv->bhtv', att, v_c)
             + jnp.einsum('bhtk,bhkv->bhtv', q_c * jnp.exp(cum), s))
        last = cum[:, :, -1:, :]
        s = (jnp.exp(last[:, :, 0, :])[..., None] * s
             + jnp.einsum('bhsk,bhsv->bhkv', k_c * jnp.exp(last - cum), v_c))
        return s, y

    s_last, ys = lax.scan(step, s0, tuple(_to_chunks(t) for t in (q, k, v, log_f)))
    nc, b, h, c, d = ys.shape
    return ys.transpose(1, 0, 3, 2, 4).reshape(b, nc * c, h, d), s_last


def _hgrn2_final_state(k, v, log_f):
    cum = jnp.cumsum(log_f, axis=1)
    return jnp.einsum('bthk,bthv->bhkv', k * jnp.exp(cum[:, -1:] - cum), v)


def _hgrn2_out(y, g, gn, w_o):
    y = y * lax.rsqrt(jnp.mean(y * y, axis=-1, keepdims=True) + NORM_EPS) * gn.astype(jnp.float32)
    b, t = y.shape[:2]
    return (y.reshape(b, t, D_INNER).astype(g.dtype) * jax.nn.silu(g)) @ w_o


def _hgrn2_mixer(h_lat, h_ctx, w_in, w_o, gn, lb, ctx_out):
    rev = lambda t: t[:, ::-1]
    q_c, i_c, g_c, dirs_c = _hgrn2_features(h_ctx, w_in, lb)
    q_l, i_l, g_l, dirs_l = _hgrn2_features(h_lat, w_in, lb)
    (k_cf, lf_cf), (k_cb, lf_cb) = dirs_c
    (k_lf, lf_lf), (k_lb, lf_lb) = dirs_l
    if ctx_out:
        s0 = jnp.zeros((h_ctx.shape[0], HG_HEADS, HG_DK, HG_DV), jnp.float32)
        yc_f, s_f = _hgrn2_chunk_scan(q_c, k_cf, i_c, lf_cf, s0)
        yc_b, s_b = _hgrn2_chunk_scan(rev(q_c), rev(k_cb), rev(i_c), rev(lf_cb), s0)
        y_ctx = _hgrn2_out(yc_f + rev(yc_b), g_c, gn, w_o)
    else:
        s_f = _hgrn2_final_state(k_cf, i_c, lf_cf)
        s_b = _hgrn2_final_state(rev(k_cb), rev(i_c), rev(lf_cb))
        y_ctx = None
    yl_f, _ = _hgrn2_chunk_scan(q_l, k_lf, i_l, lf_lf, s_f)
    yl_b, _ = _hgrn2_chunk_scan(rev(q_l), rev(k_lb), rev(i_l), rev(lf_lb), s_b)
    y_lat = _hgrn2_out(yl_f + rev(yl_b), g_l, gn, w_o)
    return y_lat, y_ctx


def setup_inputs(seed: int = 0) -> dict:
    key = jax.random.key(seed)
    ks = iter(jax.random.split(key, 40))
    nrm = lambda shape, scale: scale * jax.random.normal(next(ks), shape, jnp.float32)
    D, DI = D_MODEL, D_INNER
    ramp = (jnp.arange(DI, dtype=jnp.float32) / (DI - 1)) ** 0.9
    return {
        "x": nrm((BATCH, SEQ, D), 1.0),
        "c": nrm((BATCH, D), 1.0),
        "ctx": nrm((BATCH, CTX_LEN, D), 1.0),
        "c_ctx": nrm((D,), 1.0),
        "mod_w": nrm((DEPTH, D, 3 * D), D ** -0.5),
        "mod_b": nrm((DEPTH, 3 * D), 0.01),
        "pre_g": 1.0 + nrm((DEPTH, D), 0.05),
        "post_g": 1.0 + nrm((DEPTH, D), 0.05),
        "rw_mix": jax.random.uniform(next(ks), (N_RW, 6, D), jnp.float32),
        "rw_proj": nrm((N_RW, 4, D, DI), D ** -0.5),
        "rw_wo": nrm((N_RW, DI, D), DI ** -0.5),
        "rw_w0": -6.0 + 5.0 * ramp + nrm((N_RW, 2, DI), 0.1),
        "rw_w1": nrm((N_RW, 2, D, R_DECAY), D ** -0.5),
        "rw_w2": nrm((N_RW, 2, R_DECAY, DI), 0.5 * R_DECAY ** -0.5),
        "rw_a0": nrm((N_RW, 2, DI), 0.1),
        "rw_a1": nrm((N_RW, 2, D, R_AAA), D ** -0.5),
        "rw_a2": nrm((N_RW, 2, R_AAA, DI), R_AAA ** -0.5),
        "rw_v0": nrm((N_RW - 1, DI), 0.1),
        "rw_v1": nrm((N_RW - 1, D, R_MV), D ** -0.5),
        "rw_v2": nrm((N_RW - 1, R_MV, DI), R_MV ** -0.5),
        "rw_kk": 0.85 + nrm((N_RW, DI), 0.05),
        "rw_ka": 1.0 + nrm((N_RW, DI), 0.05),
        "rw_rk": nrm((N_RW, DI), 0.1),
        "rw_lnw": 1.0 + nrm((N_RW, DI), 0.05),
        "rw_lnb": nrm((N_RW, DI), 0.01),
        "hg_win": nrm((N_HG, D, 5 * DI), D ** -0.5),
        "hg_wo": nrm((N_HG, DI, D), DI ** -0.5),
        "hg_gn": 1.0 + nrm((N_HG, HG_DV), 0.05),
        "hg_lb": nrm((DEPTH, DI), 0.1),
    }


def reference(x, c, ctx, c_ctx, mod_w, mod_b, pre_g, post_g, rw_mix, rw_proj, rw_wo, rw_w0, rw_w1,
              rw_w2, rw_a0, rw_a1, rw_a2, rw_v0, rw_v1, rw_v2, rw_kk, rw_ka, rw_rk, rw_lnw, rw_lnb,
              hg_win, hg_wo, hg_gn, hg_lb):
    rows = x.shape[1] // GRID_W
    sc = jax.nn.silu(c)
    scc = jax.nn.silu(c_ctx)
    p_lb = jax.nn.softmax(hg_lb.astype(jnp.float32), axis=0)
    lb_all = jnp.cumsum(p_lb, axis=0) - p_lb[0]
    vf_lat = None
    vf_ctx = None
    for i in range(DEPTH):
        ctx_out = i < DEPTH - 1
        shift, scale, gate = jnp.split(sc @ mod_w[i] + mod_b[i], 3, axis=-1)
        shift_c, scale_c, gate_c = jnp.split(scc @ mod_w[i] + mod_b[i], 3, axis=-1)
        h_lat = _rmsnorm(x, pre_g[i]) * (1.0 + scale[:, None]) + shift[:, None]
        h_ctx = _rmsnorm(ctx, pre_g[i]) * (1.0 + scale_c) + shift_c
        j = i // N_MIXERS
        if i % N_MIXERS == 0:
            p = (rw_mix[j], rw_proj[j], rw_wo[j], rw_w0[j], rw_w1[j], rw_w2[j], rw_a0[j], rw_a1[j],
                 rw_a2[j], rw_kk[j], rw_ka[j], rw_rk[j], rw_lnw[j], rw_lnb[j])
            v_res = None if j == 0 else (rw_v0[j - 1], rw_v1[j - 1], rw_v2[j - 1])
            y_lat, y_ctx, vfl, vfc = _rwkv7_mixer(h_lat, h_ctx, rows, p, v_res, vf_lat, vf_ctx, ctx_out)
            if j == 0:
                vf_lat, vf_ctx = vfl, vfc
        else:
            y_lat, y_ctx = _hgrn2_mixer(h_lat, h_ctx, hg_win[j], hg_wo[j], hg_gn[j], lb_all[i], ctx_out)
        x = x + gate[:, None] * _rmsnorm(y_lat, post_g[i])
        if ctx_out:
            ctx = ctx + gate_c * _rmsnorm(y_ctx, post_g[i])
    return x
```

```cpp
#include <hip/hip_runtime.h>
#include <hip/hip_cooperative_groups.h>
#include <cstdio>
#include <cstdint>
namespace cg = cooperative_groups;

typedef unsigned short bf16_t;
using bf16x8 = __attribute__((ext_vector_type(8))) short;
using f32x16 = __attribute__((ext_vector_type(16))) float;
using f32x4 = __attribute__((ext_vector_type(4))) float;

constexpr int NB = 8, SEQ = 4096, CTX = 256, TT = 4352, DM = 1024, DI = 2048;
constexpr int GB = 2, NG = NB / GB, NTG = GB * TT;
constexpr int MT = NTG / 128;
constexpr float EPS = 1e-6f;

struct Params {
  const float *x, *c, *ctx, *c_ctx, *mod_w, *mod_b, *pre_g, *post_g, *rw_mix, *rw_proj, *rw_wo, *rw_w0, *rw_w1,
      *rw_w2, *rw_a0, *rw_a1, *rw_a2, *rw_v0, *rw_v1, *rw_v2, *rw_kk, *rw_ka, *rw_rk, *rw_lnw, *rw_lnb, *hg_win,
      *hg_wo, *hg_gn, *hg_lb;
  float* out;
  bf16_t *R, *K, *V, *Z, *WF, *WB, *AF, *AB, *YF, *YB, *VF, *H, *H0, *LRW, *LRA, *LRV;
  float *O, *BN, *CTXB, *MODV, *LB;
};

__device__ __forceinline__ bf16_t f2bf(float f) {
  unsigned u = __float_as_uint(f);
  u += 0x7fffu + ((u >> 16) & 1u);
  return (bf16_t)(u >> 16);
}
__device__ __forceinline__ float bf2f(bf16_t h) { return __uint_as_float(((unsigned)h) << 16); }
__device__ __forceinline__ unsigned pack2(float a, float b) { return (unsigned)f2bf(a) | ((unsigned)f2bf(b) << 16); }
__device__ __forceinline__ float lo2f(unsigned u) { return __uint_as_float(u << 16); }
__device__ __forceinline__ float hi2f(unsigned u) { return __uint_as_float(u & 0xffff0000u); }
__device__ __forceinline__ float sigmoidf_(float x) { return 1.f / (1.f + __expf(-x)); }
__device__ __forceinline__ float siluf_(float x) { return x / (1.f + __expf(-x)); }

template <int CTRL>
__device__ __forceinline__ float dppf(float v) {
  return __int_as_float(__builtin_amdgcn_update_dpp(0, __float_as_int(v), CTRL, 0xf, 0xf, true));
}
__device__ __forceinline__ float red4(float v) { v += dppf<0xB1>(v); v += dppf<0x4E>(v); return v; }
__device__ __forceinline__ float red8(float v) { v = red4(v); v += dppf<0x141>(v); return v; }
__device__ __forceinline__ float red16(float v) { v = red8(v); v += dppf<0x140>(v); return v; }
__device__ __forceinline__ float red64(float v) {
  v = red16(v);
  v += __shfl_xor(v, 16);
  v += __shfl_xor(v, 32);
  return v;
}

__device__ __forceinline__ void unpack8(const uint4& u, float* f) {
  f[0] = lo2f(u.x); f[1] = hi2f(u.x); f[2] = lo2f(u.y); f[3] = hi2f(u.y);
  f[4] = lo2f(u.z); f[5] = hi2f(u.z); f[6] = lo2f(u.w); f[7] = hi2f(u.w);
}
__device__ __forceinline__ uint4 pack8(const float* f) {
  uint4 u; u.x = pack2(f[0], f[1]); u.y = pack2(f[2], f[3]); u.z = pack2(f[4], f[5]); u.w = pack2(f[6], f[7]);
  return u;
}

__device__ __forceinline__ const float* row_in(const Params& p, int b, int t) {
  return t < CTX ? p.ctx + ((size_t)b * CTX + t) * DM : p.x + ((size_t)b * SEQ + (t - CTX)) * DM;
}
__device__ __forceinline__ float* row_cur(const Params& p, int b, int t) {
  return t < CTX ? p.CTXB + ((size_t)b * CTX + t) * DM : p.out + ((size_t)b * SEQ + (t - CTX)) * DM;
}

__device__ void phase_mod(const Params& p, char* smem) {
  float* red = (float*)smem;
  const int tid = threadIdx.x, cl = tid & 63, kp = tid >> 6;
  for (int task = blockIdx.x; task < 4 * 48; task += gridDim.x) {
    const int l = task / 48, col = (task % 48) * 64 + cl;
    float acc[9];
#pragma unroll
    for (int r = 0; r < 9; ++r) acc[r] = 0.f;
    const float* W = p.mod_w + (size_t)l * DM * 3 * DM + col;
    for (int k = kp * 256; k < kp * 256 + 256; ++k) {
      const float w = W[(size_t)k * 3 * DM];
#pragma unroll
      for (int r = 0; r < 9; ++r) {
        const float cv = r < 8 ? p.c[r * DM + k] : p.c_ctx[k];
        acc[r] += siluf_(cv) * w;
      }
    }
    __syncthreads();
#pragma unroll
    for (int r = 0; r < 9; ++r) red[(kp * 9 + r) * 64 + cl] = acc[r];
    __syncthreads();
    for (int idx = tid; idx < 9 * 64; idx += 256) {
      const int r = idx >> 6, c2 = idx & 63;
      float s = 0.f;
      for (int q = 0; q < 4; ++q) s += red[(q * 9 + r) * 64 + c2];
      const int cc = (task % 48) * 64 + c2;
      p.MODV[((size_t)l * 9 + r) * 3 * DM + cc] = s + p.mod_b[l * 3 * DM + cc];
    }
  }
  for (int cidx = blockIdx.x * 256 + tid; cidx < DI; cidx += gridDim.x * 256) {
    float v[4], m = -1e30f;
    for (int l = 0; l < 4; ++l) { v[l] = p.hg_lb[l * DI + cidx]; m = fmaxf(m, v[l]); }
    float s = 0.f;
    for (int l = 0; l < 4; ++l) { v[l] = __expf(v[l] - m); s += v[l]; }
    float cum = 0.f;
    for (int l = 0; l < 4; ++l) { cum += v[l] / s; p.LB[l * DI + cidx] = cum - v[0] / s; }
  }
}

__device__ void phase_resnorm(const Params& p, int g, int lu, int ln) {
  const int lane = threadIdx.x & 63;
  const int wv = blockIdx.x * 4 + (threadIdx.x >> 6), nw = gridDim.x * 4;
  for (int tg = wv; tg < NTG; tg += nw) {
    const int bl = tg / TT, t = tg % TT, b = g * GB + bl;
    const bool isctx = t < CTX;
    const int mrow = isctx ? 8 : b;
    float xv[16];
    const float* src = (lu <= 0) ? row_in(p, b, t) : row_cur(p, b, t);
#pragma unroll
    for (int j = 0; j < 4; ++j) {
      const float4 v4 = *(const float4*)(src + j * 256 + lane * 4);
      xv[j * 4 + 0] = v4.x; xv[j * 4 + 1] = v4.y; xv[j * 4 + 2] = v4.z; xv[j * 4 + 3] = v4.w;
    }
    if (lu >= 0 && !(isctx && lu == 3)) {
      float ov[16], ss = 0.f;
      const float* orow = p.O + (size_t)tg * DM;
#pragma unroll
      for (int j = 0; j < 4; ++j) {
        const float4 v4 = *(const float4*)(orow + j * 256 + lane * 4);
        ov[j * 4 + 0] = v4.x; ov[j * 4 + 1] = v4.y; ov[j * 4 + 2] = v4.z; ov[j * 4 + 3] = v4.w;
      }
#pragma unroll
      for (int e = 0; e < 16; ++e) ss += ov[e] * ov[e];
      ss = red64(ss);
      const float rstd = rsqrtf(ss * (1.f / DM) + EPS);
      const float* gate = p.MODV + ((size_t)lu * 9 + mrow) * 3 * DM + 2 * DM;
      const float* pg = p.post_g + lu * DM;
      float* dst = row_cur(p, b, t);
#pragma unroll
      for (int j = 0; j < 4; ++j) {
        const int cc = j * 256 + lane * 4;
        const float4 g4 = *(const float4*)(gate + cc);
        const float4 p4 = *(const float4*)(pg + cc);
        xv[j * 4 + 0] += g4.x * (ov[j * 4 + 0] * rstd * p4.x);
        xv[j * 4 + 1] += g4.y * (ov[j * 4 + 1] * rstd * p4.y);
        xv[j * 4 + 2] += g4.z * (ov[j * 4 + 2] * rstd * p4.z);
        xv[j * 4 + 3] += g4.w * (ov[j * 4 + 3] * rstd * p4.w);
        *(float4*)(dst + cc) = make_float4(xv[j * 4 + 0], xv[j * 4 + 1], xv[j * 4 + 2], xv[j * 4 + 3]);
      }
    }
    if (ln >= 0) {
      for (int pass = 0; pass < (ln == 2 ? 2 : 1); ++pass) {
        const int lp = pass == 0 ? ln : 0;
        bf16_t* hdst = (pass == 0 ? p.H : p.H0) + (size_t)tg * DM;
        if (pass == 1) {
          const float* s0 = row_in(p, b, t);
#pragma unroll
          for (int j = 0; j < 4; ++j) {
            const float4 v4 = *(const float4*)(s0 + j * 256 + lane * 4);
            xv[j * 4 + 0] = v4.x; xv[j * 4 + 1] = v4.y; xv[j * 4 + 2] = v4.z; xv[j * 4 + 3] = v4.w;
          }
        }
        float ss = 0.f;
#pragma unroll
        for (int e = 0; e < 16; ++e) ss += xv[e] * xv[e];
        ss = red64(ss);
        const float rstd = rsqrtf(ss * (1.f / DM) + EPS);
        const float* mv = p.MODV + ((size_t)lp * 9 + mrow) * 3 * DM;
        const float* pg = p.pre_g + lp * DM;
#pragma unroll
        for (int j = 0; j < 4; ++j) {
          const int cc = j * 256 + lane * 4;
          const float4 sh = *(const float4*)(mv + cc);
          const float4 sc = *(const float4*)(mv + DM + cc);
          const float4 p4 = *(const float4*)(pg + cc);
          const float h0 = xv[j * 4 + 0] * rstd * p4.x * (1.f + sc.x) + sh.x;
          const float h1 = xv[j * 4 + 1] * rstd * p4.y * (1.f + sc.y) + sh.y;
          const float h2 = xv[j * 4 + 2] * rstd * p4.z * (1.f + sc.z) + sh.z;
          const float h3 = xv[j * 4 + 3] * rstd * p4.w * (1.f + sc.w) + sh.w;
          uint2 u; u.x = pack2(h0, h1); u.y = pack2(h2, h3);
          *(uint2*)(hdst + cc) = u;
        }
      }
    }
  }
}

constexpr int LDT = 40;

template <int AMODE, class Epi>
__device__ __forceinline__ void gemm_tile(const bf16_t* __restrict__ A, int lda, const float* __restrict__ mix, int m0,
                                          int K, const float* __restrict__ B0, const float* __restrict__ B1, int ldb,
                                          int nvalid, char* smem, Epi epi) {
  bf16_t* As = (bf16_t*)smem;
  bf16_t* Bs = As + 128 * LDT;
  const int tid = threadIdx.x, lane = tid & 63, w = tid >> 6, wm = w >> 1, wn = w & 1;
  const int arow = tid >> 1, akh = tid & 1;
  const int bn = tid & 127, bkh = tid >> 7;
  const float* Bp = bn < 64 ? B0 + bn : B1 + (bn - 64);
  const bool bvalid = bn < nvalid;
  const int tg = m0 + arow;
  const int t = tg % TT;
  const bf16_t* Arow = A + (size_t)tg * lda + akh * 16;

  f32x16 acc[2][2];
#pragma unroll
  for (int i = 0; i < 2; ++i)
#pragma unroll
    for (int j = 0; j < 2; ++j)
#pragma unroll
      for (int r = 0; r < 16; ++r) acc[i][j][r] = 0.f;

  uint4 ra0, ra1, rn0, rn1;
  float rb[16];
  auto load_regs = [&](int k0) {
    ra0 = *(const uint4*)(Arow + k0);
    ra1 = *(const uint4*)(Arow + k0 + 8);
    if (AMODE == 1) {
      int nb; bool valid;
      if (t < CTX) {
        const bool half = k0 >= 512;
        nb = half ? 1 : -1;
        valid = half ? (t + 1 < CTX) : (t >= 1);
      } else {
        const int tl = t - CTX, row = tl >> 6, col = tl & 63, q = k0 >> 8;
        if (q == 0) { nb = -1; valid = col > 0; }
        else if (q == 1) { nb = 1; valid = col < 63; }
        else if (q == 2) { nb = -64; valid = row > 0; }
        else { nb = 64; valid = row < 63; }
      }
      if (valid) {
        const bf16_t* Nrow = Arow + (ptrdiff_t)nb * lda;
        rn0 = *(const uint4*)(Nrow + k0);
        rn1 = *(const uint4*)(Nrow + k0 + 8);
      } else {
        rn0 = make_uint4(0, 0, 0, 0); rn1 = rn0;
      }
    }
#pragma unroll
    for (int j = 0; j < 16; ++j) rb[j] = bvalid ? Bp[(size_t)(k0 + bkh * 16 + j) * ldb] : 0.f;
  };
  auto store_lds = [&](int k0) {
    uint4 o0 = ra0, o1 = ra1;
    if (AMODE == 1) {
      float h[16], n[16];
      unpack8(ra0, h); unpack8(ra1, h + 8); unpack8(rn0, n); unpack8(rn1, n + 8);
      const float* mp = mix + k0 + akh * 16;
#pragma unroll
      for (int e = 0; e < 16; e += 4) {
        const float4 m4 = *(const float4*)(mp + e);
        h[e + 0] += (n[e + 0] - h[e + 0]) * m4.x;
        h[e + 1] += (n[e + 1] - h[e + 1]) * m4.y;
        h[e + 2] += (n[e + 2] - h[e + 2]) * m4.z;
        h[e + 3] += (n[e + 3] - h[e + 3]) * m4.w;
      }
      o0 = pack8(h); o1 = pack8(h + 8);
    }
    *(uint4*)(As + arow * LDT + akh * 16) = o0;
    *(uint4*)(As + arow * LDT + akh * 16 + 8) = o1;
    *(uint4*)(Bs + bn * LDT + bkh * 16) = pack8(rb);
    *(uint4*)(Bs + bn * LDT + bkh * 16 + 8) = pack8(rb + 8);
  };

  load_regs(0);
  for (int k0 = 0; k0 < K; k0 += 32) {
    __syncthreads();
    store_lds(k0);
    __syncthreads();
    if (k0 + 32 < K) load_regs(k0 + 32);
#pragma unroll
    for (int kk = 0; kk < 2; ++kk) {
      bf16x8 af[2], bf[2];
#pragma unroll
      for (int i = 0; i < 2; ++i)
        af[i] = *(const bf16x8*)(As + (wm * 64 + i * 32 + (lane & 31)) * LDT + kk * 16 + (lane >> 5) * 8);
#pragma unroll
      for (int j = 0; j < 2; ++j)
        bf[j] = *(const bf16x8*)(Bs + (wn * 64 + j * 32 + (lane & 31)) * LDT + kk * 16 + (lane >> 5) * 8);
#pragma unroll
      for (int i = 0; i < 2; ++i)
#pragma unroll
        for (int j = 0; j < 2; ++j) acc[i][j] = __builtin_amdgcn_mfma_f32_32x32x16_bf16(af[i], bf[j], acc[i][j], 0, 0, 0);
    }
  }
#pragma unroll
  for (int i = 0; i < 2; ++i)
#pragma unroll
    for (int j = 0; j < 2; ++j)
#pragma unroll
      for (int r = 0; r < 16; ++r) {
        const int row = m0 + wm * 64 + i * 32 + (r & 3) + 8 * (r >> 2) + 4 * (lane >> 5);
        const int col = wn * 64 + j * 32 + (lane & 31);
        epi(row, col, acc[i][j][r]);
      }
}

__device__ void phase_rw_proj(const Params& p, int j, char* smem) {
  const int ntn = j == 0 ? 66 : 83;
  const float* mixb = p.rw_mix + (size_t)j * 6 * DM;
  const float* proj = p.rw_proj + (size_t)j * 4 * DM * DI;
  for (int tile = blockIdx.x; tile < MT * ntn; tile += gridDim.x) {
    const int nt = tile / MT, mt = tile % MT, m0 = mt * 128;
    if (nt < 64) {
      const int pi = nt >> 4, n0 = (nt & 15) * 128;
      const int mi = pi == 0 ? 0 : (pi == 1 ? 2 : (pi == 2 ? 3 : 5));
      const float* Bw = proj + (size_t)pi * DM * DI + n0;
      bf16_t* dst = pi == 0 ? p.R : (pi == 1 ? p.K : (pi == 2 ? p.V : p.Z));
      if (pi == 3) {
        gemm_tile<1>(p.H, DM, mixb + mi * DM, m0, DM, Bw, Bw + 64, DI, 128, smem,
                     [&](int row, int col, float v) { dst[(size_t)row * DI + n0 + col] = f2bf(siluf_(v)); });
      } else {
        gemm_tile<1>(p.H, DM, mixb + mi * DM, m0, DM, Bw, Bw + 64, DI, 128, smem,
                     [&](int row, int col, float v) { dst[(size_t)row * DI + n0 + col] = f2bf(v); });
      }
    } else if (nt == 64) {
      const float* w1 = p.rw_w1 + (size_t)j * 2 * DM * 64;
      gemm_tile<1>(p.H, DM, mixb + 1 * DM, m0, DM, w1, w1 + DM * 64, 64, 128, smem,
                   [&](int row, int col, float v) { p.LRW[(size_t)row * 128 + col] = f2bf(tanhf(v)); });
    } else if (nt == 65) {
      const float* a1 = p.rw_a1 + (size_t)j * 2 * DM * 64;
      gemm_tile<1>(p.H, DM, mixb + 4 * DM, m0, DM, a1, a1 + DM * 64, 64, 128, smem,
                   [&](int row, int col, float v) { p.LRA[(size_t)row * 128 + col] = f2bf(v); });
    } else if (nt == 66) {
      const float* v1 = p.rw_v1;
      gemm_tile<1>(p.H, DM, mixb + 3 * DM, m0, DM, v1, v1, 32, 32, smem, [&](int row, int col, float v) {
        if (col < 32) p.LRV[(size_t)row * 32 + col] = f2bf(v);
      });
    } else {
      const int n0 = (nt - 67) * 128;
      const float* Bw = p.rw_proj + (size_t)2 * DM * DI + n0;
      gemm_tile<1>(p.H0, DM, p.rw_mix + 3 * DM, m0, DM, Bw, Bw + 64, DI, 128, smem,
                   [&](int row, int col, float v) { p.VF[(size_t)row * DI + n0 + col] = f2bf(v); });
    }
  }
}

__device__ void phase_rw_lr2(const Params& p, int j, char* smem) {
  const int ntn = j == 0 ? 64 : 80;
  for (int tile = blockIdx.x; tile < MT * ntn; tile += gridDim.x) {
    const int nt = tile / MT, mt = tile % MT, m0 = mt * 128;
    const int kind = nt >> 4, n0 = (nt & 15) * 128;
    if (kind < 2) {
      const int d = kind;
      const float* Bw = p.rw_w2 + ((size_t)j * 2 + d) * 64 * DI + n0;
      const float* w0 = p.rw_w0 + ((size_t)j * 2 + d) * DI + n0;
      bf16_t* dst = d == 0 ? p.WF : p.WB;
      gemm_tile<0>(p.LRW + d * 64, 128, nullptr, m0, 64, Bw, Bw + 64, DI, 128, smem, [&](int row, int col, float v) {
        const float u = v + w0[col];
        dst[(size_t)row * DI + n0 + col] = f2bf(-0.60653066f * sigmoidf_(u));
      });
    } else if (kind < 4) {
      const int d = kind - 2;
      const float* Bw = p.rw_a2 + ((size_t)j * 2 + d) * 64 * DI + n0;
      const float* a0 = p.rw_a0 + ((size_t)j * 2 + d) * DI + n0;
      bf16_t* dst = d == 0 ? p.AF : p.AB;
      gemm_tile<0>(p.LRA + d * 64, 128, nullptr, m0, 64, Bw, Bw + 64, DI, 128, smem, [&](int row, int col, float v) {
        dst[(size_t)row * DI + n0 + col] = f2bf(sigmoidf_(v + a0[col]));
      });
    } else {
      const float* Bw = p.rw_v2 + n0;
      const float* v0 = p.rw_v0 + n0;
      gemm_tile<0>(p.LRV, 32, nullptr, m0, 32, Bw, Bw + 64, DI, 128, smem, [&](int row, int col, float v) {
        const size_t idx = (size_t)row * DI + n0 + col;
        const float vv = bf2f(p.V[idx]), vf = bf2f(p.VF[idx]);
        p.V[idx] = f2bf(vv + (vf - vv) * sigmoidf_(v + v0[col]));
      });
    }
  }
}

constexpr int RCH = 32;
__device__ __forceinline__ int scan_pos(int dir, int s) { return dir == 0 ? s : (s < CTX ? CTX - 1 - s : TT + CTX - 1 - s); }

__device__ void phase_rw_scan(const Params& p, int j, char* smem) {
  float* op = (float*)smem;
  float* vv = op + RCH * 5 * 64;
  float* yb = vv + RCH * 64;
  float* sc = yb + RCH * 64;
  const int tid = threadIdx.x, lane = tid & 63, w = tid >> 6;
  const int ptau = tid >> 3, pc8 = (tid & 7) * 8;
  const int r2 = lane >> 3, ko = (lane & 7) * 8;
  const int row0 = w * 16 + r2, row1 = row0 + 8;
  for (int unit = blockIdx.x; unit < GB * 64; unit += gridDim.x) {
    const int bl = unit >> 6, h = (unit >> 1) & 31, dir = unit & 1;
    const bf16_t* LW = dir == 0 ? p.WF : p.WB;
    const bf16_t* AA = dir == 0 ? p.AF : p.AB;
    bf16_t* Y = dir == 0 ? p.YF : p.YB;
    float pkk[8], pka[8], prk[8];
#pragma unroll
    for (int e = 0; e < 8; ++e) {
      const int cc = j * DI + h * 64 + pc8 + e;
      pkk[e] = p.rw_kk[cc]; pka[e] = p.rw_ka[cc]; prk[e] = p.rw_rk[cc];
    }
    float S0[8], S1[8];
#pragma unroll
    for (int e = 0; e < 8; ++e) { S0[e] = 0.f; S1[e] = 0.f; }
    uint4 gr, gk, gv, gw, ga;
    auto gload = [&](int chunk) {
      const int pos = scan_pos(dir, chunk * RCH + ptau);
      const size_t base = ((size_t)bl * TT + pos) * DI + h * 64 + pc8;
      gr = *(const uint4*)(p.R + base); gk = *(const uint4*)(p.K + base); gv = *(const uint4*)(p.V + base);
      gw = *(const uint4*)(LW + base); ga = *(const uint4*)(AA + base);
    };
    gload(0);
    for (int chunk = 0; chunk < TT / RCH; ++chunk) {
      {
        float r[8], k[8], v[8], lw[8], a[8];
        unpack8(gr, r); unpack8(gk, k); unpack8(gv, v); unpack8(gw, lw); unpack8(ga, a);
        float kkv[8], ss = 0.f;
#pragma unroll
        for (int e = 0; e < 8; ++e) { kkv[e] = k[e] * pkk[e]; ss += kkv[e] * kkv[e]; }
        ss = red8(ss);
        const float inv = rsqrtf(fmaxf(ss, 1e-24f));
        float br = 0.f, kr = 0.f, bon = 0.f;
        float o0[8], o1[8], o2[8], o3[8], o4[8];
#pragma unroll
        for (int e = 0; e < 8; ++e) {
          const float kkn = kkv[e] * inv;
          const float wd = __expf(lw[e]);
          const float kd = k[e] * (1.f + (a[e] - 1.f) * pka[e]);
          const float bb = kkn * a[e];
          o0[e] = -kkn; o1[e] = wd * r[e]; o2[e] = wd; o3[e] = bb; o4[e] = kd;
          br += bb * r[e]; kr += kd * r[e]; bon += r[e] * kd * prk[e];
        }
        br = red8(br); kr = red8(kr); bon = red8(bon);
        float* od = op + ptau * 320 + pc8;
        *(float4*)(od) = make_float4(o0[0], o0[1], o0[2], o0[3]); *(float4*)(od + 4) = make_float4(o0[4], o0[5], o0[6], o0[7]);
        *(float4*)(od + 64) = make_float4(o1[0], o1[1], o1[2], o1[3]); *(float4*)(od + 68) = make_float4(o1[4], o1[5], o1[6], o1[7]);
        *(float4*)(od + 128) = make_float4(o2[0], o2[1], o2[2], o2[3]); *(float4*)(od + 132) = make_float4(o2[4], o2[5], o2[6], o2[7]);
        *(float4*)(od + 192) = make_float4(o3[0], o3[1], o3[2], o3[3]); *(float4*)(od + 196) = make_float4(o3[4], o3[5], o3[6], o3[7]);
        *(float4*)(od + 256) = make_float4(o4[0], o4[1], o4[2], o4[3]); *(float4*)(od + 260) = make_float4(o4[4], o4[5], o4[6], o4[7]);
        float* vd = vv + ptau * 64 + pc8;
        *(float4*)(vd) = make_float4(v[0], v[1], v[2], v[3]); *(float4*)(vd + 4) = make_float4(v[4], v[5], v[6], v[7]);
        if ((tid & 7) == 0) {
          sc[ptau * 2] = br; sc[ptau * 2 + 1] = kr;
          const int pos = scan_pos(dir, chunk * RCH + ptau);
          p.BN[((size_t)dir * NTG + (size_t)bl * TT + pos) * 32 + h] = bon;
        }
      }
      __syncthreads();
      if (chunk + 1 < TT / RCH) gload(chunk + 1);
#pragma unroll 2
      for (int tau = 0; tau < RCH; ++tau) {
        const float* o = op + tau * 320 + ko;
        const float4 n0 = *(const float4*)(o), n1 = *(const float4*)(o + 4);
        const float4 q0 = *(const float4*)(o + 64), q1 = *(const float4*)(o + 68);
        const float4 w0 = *(const float4*)(o + 128), w1 = *(const float4*)(o + 132);
        const float4 b0 = *(const float4*)(o + 192), b1 = *(const float4*)(o + 196);
        const float4 k0 = *(const float4*)(o + 256), k1 = *(const float4*)(o + 260);
        const float v0 = vv[tau * 64 + row0], v1 = vv[tau * 64 + row1];
        const float br = sc[tau * 2], kr = sc[tau * 2 + 1];
        const float nk[8] = {n0.x, n0.y, n0.z, n0.w, n1.x, n1.y, n1.z, n1.w};
        const float wr[8] = {q0.x, q0.y, q0.z, q0.w, q1.x, q1.y, q1.z, q1.w};
        const float wd[8] = {w0.x, w0.y, w0.z, w0.w, w1.x, w1.y, w1.z, w1.w};
        const float bb[8] = {b0.x, b0.y, b0.z, b0.w, b1.x, b1.y, b1.z, b1.w};
        const float kd[8] = {k0.x, k0.y, k0.z, k0.w, k1.x, k1.y, k1.z, k1.w};
        float d10 = 0.f, d11 = 0.f, d20 = 0.f, d21 = 0.f;
#pragma unroll
        for (int e = 0; e < 8; ++e) {
          d10 += S0[e] * nk[e]; d11 += S1[e] * nk[e];
          d20 += S0[e] * wr[e]; d21 += S1[e] * wr[e];
        }
        d10 = red8(d10); d11 = red8(d11); d20 = red8(d20); d21 = red8(d21);
        const float y0 = d20 + d10 * br + v0 * kr;
        const float y1 = d21 + d11 * br + v1 * kr;
#pragma unroll
        for (int e = 0; e < 8; ++e) {
          S0[e] = S0[e] * wd[e] + d10 * bb[e] + v0 * kd[e];
          S1[e] = S1[e] * wd[e] + d11 * bb[e] + v1 * kd[e];
        }
        if ((lane & 7) == 0) { yb[tau * 64 + row0] = y0; yb[tau * 64 + row1] = y1; }
      }
      __syncthreads();
      {
        const int pos = scan_pos(dir, chunk * RCH + ptau);
        const float* ys = yb + ptau * 64 + pc8;
        float yv[8];
#pragma unroll
        for (int e = 0; e < 8; ++e) yv[e] = ys[e];
        *(uint4*)(Y + ((size_t)bl * TT + pos) * DI + h * 64 + pc8) = pack8(yv);
      }
    }
    __syncthreads();
  }
}

__device__ void phase_rw_gate(const Params& p, int j) {
  const int tid = threadIdx.x, h = tid >> 3;
  const int c0 = tid * 8;
  float lnw[8], lnb[8];
#pragma unroll
  for (int e = 0; e < 8; ++e) { lnw[e] = p.rw_lnw[j * DI + c0 + e]; lnb[e] = p.rw_lnb[j * DI + c0 + e]; }
  for (int tg = blockIdx.x; tg < NTG; tg += gridDim.x) {
    const size_t base = (size_t)tg * DI + c0;
    float yf[8], yb[8], v[8], z[8];
    unpack8(*(const uint4*)(p.YF + base), yf); unpack8(*(const uint4*)(p.YB + base), yb);
    unpack8(*(const uint4*)(p.V + base), v); unpack8(*(const uint4*)(p.Z + base), z);
    const float bon = p.BN[(size_t)tg * 32 + h] + p.BN[((size_t)NTG + tg) * 32 + h];
    float y[8], s = 0.f;
#pragma unroll
    for (int e = 0; e < 8; ++e) { y[e] = yf[e] + yb[e]; s += y[e]; }
    const float mu = red8(s) * (1.f / 64.f);
    float s2 = 0.f;
#pragma unroll
    for (int e = 0; e < 8; ++e) { y[e] -= mu; s2 += y[e] * y[e]; }
    const float rstd = rsqrtf(red8(s2) * (1.f / 64.f) + 64e-5f);
#pragma unroll
    for (int e = 0; e < 8; ++e) y[e] = (y[e] * rstd * lnw[e] + lnb[e] + bon * v[e]) * z[e];
    *(uint4*)(p.YF + base) = pack8(y);
  }
}

__device__ void phase_out(const Params& p, const float* wo, char* smem) {
  for (int tile = blockIdx.x; tile < MT * 8; tile += gridDim.x) {
    const int nt = tile / MT, mt = tile % MT, m0 = mt * 128, n0 = nt * 128;
    const float* Bw = wo + n0;
    gemm_tile<0>(p.YF, DI, nullptr, m0, DI, Bw, Bw + 64, DM, 128, smem,
                 [&](int row, int col, float v) { p.O[(size_t)row * DM + n0 + col] = v; });
  }
}

__device__ void phase_hg_proj(const Params& p, int j, char* smem) {
  const float* win = p.hg_win + (size_t)j * DM * 5 * DI;
  for (int tile = blockIdx.x; tile < MT * 80; tile += gridDim.x) {
    const int nt = tile / MT, mt = tile % MT, m0 = mt * 128;
    const int seg = nt >> 4, n0 = (nt & 15) * 128;
    const float* Bw = win + (size_t)seg * DI + n0;
    bf16_t* dst = seg == 0 ? p.R : (seg == 1 ? p.WF : (seg == 2 ? p.WB : (seg == 3 ? p.V : p.Z)));
    if (seg == 0 || seg == 4) {
      gemm_tile<0>(p.H, DM, nullptr, m0, DM, Bw, Bw + 64, 5 * DI, 128, smem,
                   [&](int row, int col, float v) { dst[(size_t)row * DI + n0 + col] = f2bf(siluf_(v)); });
    } else {
      gemm_tile<0>(p.H, DM, nullptr, m0, DM, Bw, Bw + 64, 5 * DI, 128, smem,
                   [&](int row, int col, float v) { dst[(size_t)row * DI + n0 + col] = f2bf(v); });
    }
  }
}

constexpr int HC = 32;
constexpr int QS = 136;
constexpr int SS = 40;
__device__ void phase_hg_scan(const Params& p, int layer, char* smem) {
  bf16_t* qe = (bf16_t*)smem;
  bf16_t* ke = qe + HC * QS;
  bf16_t* kdT = ke + HC * QS;
  bf16_t* vT = kdT + 128 * SS;
  bf16_t* att = vT + 64 * SS;
  bf16_t* ST = att + HC * SS;
  float* dC = (float*)(ST + 64 * QS);
  const int tid = threadIdx.x, lane = tid & 63, w = tid >> 6;
  for (int unit = blockIdx.x; unit < GB * 64; unit += gridDim.x) {
    const int vs = unit & 1, dir = (unit >> 1) & 1, h = (unit >> 2) & 15, bl = unit >> 6;
    const bf16_t* FL = dir == 0 ? p.WF : p.WB;
    bf16_t* Y = dir == 0 ? p.YF : p.YB;
    const float lb = p.LB[layer * DI + h * 128 + (tid & 127)];
    f32x16 sacc[2];
#pragma unroll
    for (int r = 0; r < 16; ++r) { sacc[0][r] = 0.f; sacc[1][r] = 0.f; }
    __syncthreads();
    for (int idx = tid; idx < 64 * QS / 2; idx += 256) ((unsigned*)ST)[idx] = 0u;
    uint4 gq0, gq1, gf0, gf1, gvv;
    const int st = tid >> 3, sc16 = (tid & 7) * 16, sc8 = (tid & 7) * 8;
    auto gload = [&](int chunk) {
      const int pos = scan_pos(dir, chunk * HC + st);
      const size_t base = ((size_t)bl * TT + pos) * DI + h * 128;
      gq0 = *(const uint4*)(p.R + base + sc16); gq1 = *(const uint4*)(p.R + base + sc16 + 8);
      gf0 = *(const uint4*)(FL + base + sc16); gf1 = *(const uint4*)(FL + base + sc16 + 8);
      gvv = *(const uint4*)(p.V + base + vs * 64 + sc8);
    };
    gload(0);
    for (int chunk = 0; chunk < TT / HC; ++chunk) {
      __syncthreads();
      *(uint4*)(qe + st * QS + sc16) = gq0; *(uint4*)(qe + st * QS + sc16 + 8) = gq1;
      *(uint4*)(ke + st * QS + sc16) = gf0; *(uint4*)(ke + st * QS + sc16 + 8) = gf1;
      {
        const bf16_t* vp = (const bf16_t*)&gvv;
#pragma unroll
        for (int e = 0; e < 8; ++e) vT[(sc8 + e) * SS + st] = vp[e];
      }
      __syncthreads();
      if (chunk + 1 < TT / HC) gload(chunk + 1);
      if (tid < 128) {
        const int k = tid;
        float cum = 0.f;
        for (int t = 0; t < HC; ++t) {
          const float q = bf2f(qe[t * QS + k]);
          const float fl = bf2f(ke[t * QS + k]);
          const float f = lb + (1.f - lb) * sigmoidf_(fl);
          cum += __logf(f);
          qe[t * QS + k] = f2bf(q * __expf(cum));
          ke[t * QS + k] = f2bf((1.f - f) * __expf(fminf(-cum, 80.f)));
        }
        const float eC = __expf(cum);
        dC[k] = eC;
        for (int t = 0; t < HC; t += 2) {
          const float a = bf2f(ke[t * QS + k]) * eC, b = bf2f(ke[(t + 1) * QS + k]) * eC;
          *(unsigned*)(kdT + k * SS + t) = pack2(a, b);
        }
      }
      __syncthreads();
      {
        const int mi = w >> 1, ni = w & 1;
        f32x4 a4 = {0.f, 0.f, 0.f, 0.f};
#pragma unroll
        for (int kk = 0; kk < 4; ++kk) {
          const bf16x8 af = *(const bf16x8*)(qe + (mi * 16 + (lane & 15)) * QS + kk * 32 + (lane >> 4) * 8);
          const bf16x8 bf = *(const bf16x8*)(ke + (ni * 16 + (lane & 15)) * QS + kk * 32 + (lane >> 4) * 8);
          a4 = __builtin_amdgcn_mfma_f32_16x16x32_bf16(af, bf, a4, 0, 0, 0);
        }
        const int s = ni * 16 + (lane & 15);
#pragma unroll
        for (int r = 0; r < 4; ++r) {
          const int t = mi * 16 + (lane >> 4) * 4 + r;
          att[t * SS + s] = f2bf(s <= t ? a4[r] : 0.f);
        }
      }
      __syncthreads();
      {
#pragma unroll
        for (int mh = 0; mh < 2; ++mh) {
          f32x4 y4 = {0.f, 0.f, 0.f, 0.f};
          {
            const bf16x8 af = *(const bf16x8*)(att + (mh * 16 + (lane & 15)) * SS + (lane >> 4) * 8);
            const bf16x8 bf = *(const bf16x8*)(vT + (w * 16 + (lane & 15)) * SS + (lane >> 4) * 8);
            y4 = __builtin_amdgcn_mfma_f32_16x16x32_bf16(af, bf, y4, 0, 0, 0);
          }
#pragma unroll
          for (int kk = 0; kk < 4; ++kk) {
            const bf16x8 af = *(const bf16x8*)(qe + (mh * 16 + (lane & 15)) * QS + kk * 32 + (lane >> 4) * 8);
            const bf16x8 bf = *(const bf16x8*)(ST + (w * 16 + (lane & 15)) * QS + kk * 32 + (lane >> 4) * 8);
            y4 = __builtin_amdgcn_mfma_f32_16x16x32_bf16(af, bf, y4, 0, 0, 0);
          }
#pragma unroll
          for (int r = 0; r < 4; ++r) {
            const int t = mh * 16 + (lane >> 4) * 4 + r;
            const int pos = scan_pos(dir, chunk * HC + t);
            Y[((size_t)bl * TT + pos) * DI + h * 128 + vs * 64 + w * 16 + (lane & 15)] = f2bf(y4[r]);
          }
        }
      }
      __syncthreads();
      {
        float dk[16];
#pragma unroll
        for (int r = 0; r < 16; ++r) dk[r] = dC[w * 32 + (r & 3) + 8 * (r >> 2) + 4 * (lane >> 5)];
#pragma unroll
        for (int nt = 0; nt < 2; ++nt) {
#pragma unroll
          for (int r = 0; r < 16; ++r) sacc[nt][r] *= dk[r];
#pragma unroll
          for (int ks = 0; ks < 2; ++ks) {
            const bf16x8 af = *(const bf16x8*)(kdT + (w * 32 + (lane & 31)) * SS + ks * 16 + (lane >> 5) * 8);
            const bf16x8 bf = *(const bf16x8*)(vT + (nt * 32 + (lane & 31)) * SS + ks * 16 + (lane >> 5) * 8);
            sacc[nt] = __builtin_amdgcn_mfma_f32_32x32x16_bf16(af, bf, sacc[nt], 0, 0, 0);
          }
#pragma unroll
          for (int gq = 0; gq < 4; ++gq) {
            uint2 u;
            u.x = pack2(sacc[nt][gq * 4 + 0], sacc[nt][gq * 4 + 1]);
            u.y = pack2(sacc[nt][gq * 4 + 2], sacc[nt][gq * 4 + 3]);
            *(uint2*)(ST + (nt * 32 + (lane & 31)) * QS + w * 32 + gq * 8 + (lane >> 5) * 4) = u;
          }
        }
      }
    }
    __syncthreads();
  }
}

__device__ void phase_hg_gate(const Params& p, int j) {
  const int tid = threadIdx.x;
  const int c0 = tid * 8;
  float gn[8];
#pragma unroll
  for (int e = 0; e < 8; ++e) gn[e] = p.hg_gn[j * 128 + ((c0 + e) & 127)];
  for (int tg = blockIdx.x; tg < NTG; tg += gridDim.x) {
    const size_t base = (size_t)tg * DI + c0;
    float yf[8], yb[8], z[8];
    unpack8(*(const uint4*)(p.YF + base), yf); unpack8(*(const uint4*)(p.YB + base), yb);
    unpack8(*(const uint4*)(p.Z + base), z);
    float y[8], s2 = 0.f;
#pragma unroll
    for (int e = 0; e < 8; ++e) { y[e] = yf[e] + yb[e]; s2 += y[e] * y[e]; }
    const float rstd = rsqrtf(red16(s2) * (1.f / 128.f) + EPS);
#pragma unroll
    for (int e = 0; e < 8; ++e) y[e] = y[e] * rstd * gn[e] * z[e];
    *(uint4*)(p.YF + base) = pack8(y);
  }
}

__global__ void __launch_bounds__(256) fwd_megakernel(Params p) {
  cg::grid_group grid = cg::this_grid();
  __shared__ __attribute__((aligned(16))) char smem[60 * 1024];
  phase_mod(p, smem);
  grid.sync();
  for (int g = 0; g < NG; ++g) {
    for (int layer = 0; layer < 4; ++layer) {
      phase_resnorm(p, g, layer - 1, layer);
      grid.sync();
      const int j = layer >> 1;
      if ((layer & 1) == 0) {
        phase_rw_proj(p, j, smem);
        grid.sync();
        phase_rw_lr2(p, j, smem);
        grid.sync();
        phase_rw_scan(p, j, smem);
        grid.sync();
        phase_rw_gate(p, j);
        grid.sync();
        phase_out(p, p.rw_wo + (size_t)j * DI * DM, smem);
        grid.sync();
      } else {
        phase_hg_proj(p, j, smem);
        grid.sync();
        phase_hg_scan(p, layer, smem);
        grid.sync();
        phase_hg_gate(p, j);
        grid.sync();
        phase_out(p, p.hg_wo + (size_t)j * DI * DM, smem);
        grid.sync();
      }
    }
    phase_resnorm(p, g, 3, -1);
    grid.sync();
  }
}

extern "C" void kernel_launch(void* const* d_in, const int* in_sizes, int n_in, void* d_out, int out_size, void* d_ws,
                              size_t ws_size, hipStream_t stream) {
  static int grid_blocks = 0;
  if (!grid_blocks) {
    int dev = 0, cus = 0, per_cu = 0;
    hipGetDevice(&dev);
    hipDeviceGetAttribute(&cus, hipDeviceAttributeMultiprocessorCount, dev);
    hipOccupancyMaxActiveBlocksPerMultiprocessor(&per_cu, fwd_megakernel, 256, 0);
    if (per_cu > 1) per_cu = 1;
    grid_blocks = cus * per_cu;
  }
  Params p{};
  const float** fp = (const float**)&p;
  for (int i = 0; i < 29; ++i) fp[i] = (const float*)d_in[i];
  p.out = (float*)d_out;
  char* w = (char*)d_ws;
  size_t off = 0;
  auto take = [&](size_t bytes) { char* r = w + off; off += (bytes + 255) & ~(size_t)255; return r; };
  const size_t DIW = (size_t)NTG * DI * 2;
  p.R = (bf16_t*)take(DIW); p.K = (bf16_t*)take(DIW); p.V = (bf16_t*)take(DIW); p.Z = (bf16_t*)take(DIW);
  p.WF = (bf16_t*)take(DIW); p.WB = (bf16_t*)take(DIW); p.AF = (bf16_t*)take(DIW); p.AB = (bf16_t*)take(DIW);
  p.YF = (bf16_t*)take(DIW); p.YB = (bf16_t*)take(DIW); p.VF = (bf16_t*)take(DIW);
  p.H = (bf16_t*)take((size_t)NTG * DM * 2); p.H0 = (bf16_t*)take((size_t)NTG * DM * 2);
  p.LRW = (bf16_t*)take((size_t)NTG * 128 * 2); p.LRA = (bf16_t*)take((size_t)NTG * 128 * 2);
  p.LRV = (bf16_t*)take((size_t)NTG * 32 * 2);
  p.O = (float*)take((size_t)NTG * DM * 4);
  p.BN = (float*)take((size_t)2 * NTG * 32 * 4);
  p.CTXB = (float*)take((size_t)NB * CTX * DM * 4);
  p.MODV = (float*)take((size_t)4 * 9 * 3 * DM * 4);
  p.LB = (float*)take((size_t)4 * DI * 4);
  if (off > ws_size) { fprintf(stderr, "workspace too small: need %zu have %zu\n", off, ws_size); return; }
  void* args[] = {&p};
  hipError_t e = hipLaunchCooperativeKernel((void*)fwd_megakernel, dim3(grid_blocks), dim3(256), args, 0, stream);
  if (e != hipSuccess) fprintf(stderr, "cooperative launch failed: %s (grid %d)\n", hipGetErrorString(e), grid_blocks);
}
```

```cpp
#include <hip/hip_runtime.h>
#include <hip/hip_cooperative_groups.h>
#include <cstdio>
#include <cstdint>
namespace cg = cooperative_groups;

typedef unsigned short bf16_t;
using bf16x8 = __attribute__((ext_vector_type(8))) short;
using f32x16 = __attribute__((ext_vector_type(16))) float;
using f32x4 = __attribute__((ext_vector_type(4))) float;

constexpr int NB = 8, SEQ = 4096, CTX = 256, TT = 4352, DM = 1024, DI = 2048;
constexpr int GB = 4, NG = NB / GB, NTG = GB * TT;
constexpr int MT = NTG / 128;
constexpr float EPS = 1e-6f;

struct Params {
  const float *x, *c, *ctx, *c_ctx, *mod_w, *mod_b, *pre_g, *post_g, *rw_mix, *rw_proj, *rw_wo, *rw_w0, *rw_w1,
      *rw_w2, *rw_a0, *rw_a1, *rw_a2, *rw_v0, *rw_v1, *rw_v2, *rw_kk, *rw_ka, *rw_rk, *rw_lnw, *rw_lnb, *hg_win,
      *hg_wo, *hg_gn, *hg_lb;
  float* out;
  bf16_t *R, *K, *V, *Z, *WF, *YF, *YB, *VF, *H, *H0, *LRW, *LRA, *LRV;
  float *O, *BN, *CTXB, *MODV, *LB;
};

__device__ __forceinline__ bf16_t f2bf(float f) {
  unsigned u = __float_as_uint(f);
  u += 0x7fffu + ((u >> 16) & 1u);
  return (bf16_t)(u >> 16);
}
__device__ __forceinline__ float bf2f(bf16_t h) { return __uint_as_float(((unsigned)h) << 16); }
__device__ __forceinline__ unsigned pack2(float a, float b) { return (unsigned)f2bf(a) | ((unsigned)f2bf(b) << 16); }
__device__ __forceinline__ float lo2f(unsigned u) { return __uint_as_float(u << 16); }
__device__ __forceinline__ float hi2f(unsigned u) { return __uint_as_float(u & 0xffff0000u); }
__device__ __forceinline__ float sigmoidf_(float x) { return 1.f / (1.f + __expf(-x)); }
__device__ __forceinline__ float siluf_(float x) { return x / (1.f + __expf(-x)); }

__device__ __forceinline__ void lds_barrier() { asm volatile("s_waitcnt lgkmcnt(0)\n\ts_barrier" ::: "memory"); }

template <int CTRL>
__device__ __forceinline__ float dppf(float v) {
  return __int_as_float(__builtin_amdgcn_update_dpp(0, __float_as_int(v), CTRL, 0xf, 0xf, true));
}
__device__ __forceinline__ float red4(float v) { v += dppf<0xB1>(v); v += dppf<0x4E>(v); return v; }
__device__ __forceinline__ float red8(float v) { v = red4(v); v += dppf<0x141>(v); return v; }
__device__ __forceinline__ float red16(float v) { v = red8(v); v += dppf<0x140>(v); return v; }
__device__ __forceinline__ float red64(float v) {
  v = red16(v);
  v += __shfl_xor(v, 16);
  v += __shfl_xor(v, 32);
  return v;
}

__device__ __forceinline__ void unpack8(const uint4& u, float* f) {
  f[0] = lo2f(u.x); f[1] = hi2f(u.x); f[2] = lo2f(u.y); f[3] = hi2f(u.y);
  f[4] = lo2f(u.z); f[5] = hi2f(u.z); f[6] = lo2f(u.w); f[7] = hi2f(u.w);
}
__device__ __forceinline__ uint4 pack8(const float* f) {
  uint4 u; u.x = pack2(f[0], f[1]); u.y = pack2(f[2], f[3]); u.z = pack2(f[4], f[5]); u.w = pack2(f[6], f[7]);
  return u;
}

__device__ __forceinline__ const float* row_in(const Params& p, int b, int t) {
  return t < CTX ? p.ctx + ((size_t)b * CTX + t) * DM : p.x + ((size_t)b * SEQ + (t - CTX)) * DM;
}
__device__ __forceinline__ float* row_cur(const Params& p, int b, int t) {
  return t < CTX ? p.CTXB + ((size_t)b * CTX + t) * DM : p.out + ((size_t)b * SEQ + (t - CTX)) * DM;
}

__device__ void phase_mod(const Params& p, char* smem) {
  float* red = (float*)smem;
  const int tid = threadIdx.x, cl = tid & 63, kp = tid >> 6;
  for (int task = blockIdx.x; task < 4 * 48; task += gridDim.x) {
    const int l = task / 48, col = (task % 48) * 64 + cl;
    float acc[9];
#pragma unroll
    for (int r = 0; r < 9; ++r) acc[r] = 0.f;
    const float* W = p.mod_w + (size_t)l * DM * 3 * DM + col;
    for (int k = kp * 256; k < kp * 256 + 256; ++k) {
      const float w = W[(size_t)k * 3 * DM];
#pragma unroll
      for (int r = 0; r < 9; ++r) {
        const float cv = r < 8 ? p.c[r * DM + k] : p.c_ctx[k];
        acc[r] += siluf_(cv) * w;
      }
    }
    __syncthreads();
#pragma unroll
    for (int r = 0; r < 9; ++r) red[(kp * 9 + r) * 64 + cl] = acc[r];
    __syncthreads();
    for (int idx = tid; idx < 9 * 64; idx += 256) {
      const int r = idx >> 6, c2 = idx & 63;
      float s = 0.f;
      for (int q = 0; q < 4; ++q) s += red[(q * 9 + r) * 64 + c2];
      const int cc = (task % 48) * 64 + c2;
      p.MODV[((size_t)l * 9 + r) * 3 * DM + cc] = s + p.mod_b[l * 3 * DM + cc];
    }
  }
  for (int cidx = blockIdx.x * 256 + tid; cidx < DI; cidx += gridDim.x * 256) {
    float v[4], m = -1e30f;
    for (int l = 0; l < 4; ++l) { v[l] = p.hg_lb[l * DI + cidx]; m = fmaxf(m, v[l]); }
    float s = 0.f;
    for (int l = 0; l < 4; ++l) { v[l] = __expf(v[l] - m); s += v[l]; }
    float cum = 0.f;
    for (int l = 0; l < 4; ++l) { cum += v[l] / s; p.LB[l * DI + cidx] = cum - v[0] / s; }
  }
}

__device__ void phase_resnorm(const Params& p, int g, int lu, int ln) {
  const int lane = threadIdx.x & 63;
  const int wv = blockIdx.x * 4 + (threadIdx.x >> 6), nw = gridDim.x * 4;
  for (int tg = wv; tg < NTG; tg += nw) {
    const int bl = tg / TT, t = tg % TT, b = g * GB + bl;
    const bool isctx = t < CTX;
    const int mrow = isctx ? 8 : b;
    float xv[16];
    const float* src = (lu <= 0) ? row_in(p, b, t) : row_cur(p, b, t);
#pragma unroll
    for (int j = 0; j < 4; ++j) {
      const float4 v4 = *(const float4*)(src + j * 256 + lane * 4);
      xv[j * 4 + 0] = v4.x; xv[j * 4 + 1] = v4.y; xv[j * 4 + 2] = v4.z; xv[j * 4 + 3] = v4.w;
    }
    if (lu >= 0 && !(isctx && lu == 3)) {
      float ov[16], ss = 0.f;
      const float* orow = p.O + (size_t)tg * DM;
#pragma unroll
      for (int j = 0; j < 4; ++j) {
        const float4 v4 = *(const float4*)(orow + j * 256 + lane * 4);
        ov[j * 4 + 0] = v4.x; ov[j * 4 + 1] = v4.y; ov[j * 4 + 2] = v4.z; ov[j * 4 + 3] = v4.w;
      }
#pragma unroll
      for (int e = 0; e < 16; ++e) ss += ov[e] * ov[e];
      ss = red64(ss);
      const float rstd = rsqrtf(ss * (1.f / DM) + EPS);
      const float* gate = p.MODV + ((size_t)lu * 9 + mrow) * 3 * DM + 2 * DM;
      const float* pg = p.post_g + lu * DM;
      float* dst = row_cur(p, b, t);
#pragma unroll
      for (int j = 0; j < 4; ++j) {
        const int cc = j * 256 + lane * 4;
        const float4 g4 = *(const float4*)(gate + cc);
        const float4 p4 = *(const float4*)(pg + cc);
        xv[j * 4 + 0] += g4.x * (ov[j * 4 + 0] * rstd * p4.x);
        xv[j * 4 + 1] += g4.y * (ov[j * 4 + 1] * rstd * p4.y);
        xv[j * 4 + 2] += g4.z * (ov[j * 4 + 2] * rstd * p4.z);
        xv[j * 4 + 3] += g4.w * (ov[j * 4 + 3] * rstd * p4.w);
        *(float4*)(dst + cc) = make_float4(xv[j * 4 + 0], xv[j * 4 + 1], xv[j * 4 + 2], xv[j * 4 + 3]);
      }
    }
    if (ln >= 0) {
      for (int pass = 0; pass < (ln == 2 ? 2 : 1); ++pass) {
        const int lp = pass == 0 ? ln : 0;
        bf16_t* hdst = (pass == 0 ? p.H : p.H0) + (size_t)tg * DM;
        if (pass == 1) {
          const float* s0 = row_in(p, b, t);
#pragma unroll
          for (int j = 0; j < 4; ++j) {
            const float4 v4 = *(const float4*)(s0 + j * 256 + lane * 4);
            xv[j * 4 + 0] = v4.x; xv[j * 4 + 1] = v4.y; xv[j * 4 + 2] = v4.z; xv[j * 4 + 3] = v4.w;
          }
        }
        float ss = 0.f;
#pragma unroll
        for (int e = 0; e < 16; ++e) ss += xv[e] * xv[e];
        ss = red64(ss);
        const float rstd = rsqrtf(ss * (1.f / DM) + EPS);
        const float* mv = p.MODV + ((size_t)lp * 9 + mrow) * 3 * DM;
        const float* pg = p.pre_g + lp * DM;
#pragma unroll
        for (int j = 0; j < 4; ++j) {
          const int cc = j * 256 + lane * 4;
          const float4 sh = *(const float4*)(mv + cc);
          const float4 sc = *(const float4*)(mv + DM + cc);
          const float4 p4 = *(const float4*)(pg + cc);
          const float h0 = xv[j * 4 + 0] * rstd * p4.x * (1.f + sc.x) + sh.x;
          const float h1 = xv[j * 4 + 1] * rstd * p4.y * (1.f + sc.y) + sh.y;
          const float h2 = xv[j * 4 + 2] * rstd * p4.z * (1.f + sc.z) + sh.z;
          const float h3 = xv[j * 4 + 3] * rstd * p4.w * (1.f + sc.w) + sh.w;
          uint2 u; u.x = pack2(h0, h1); u.y = pack2(h2, h3);
          *(uint2*)(hdst + cc) = u;
        }
      }
    }
  }
}

constexpr int LDT = 40;

template <int AMODE, class Epi>
__device__ __forceinline__ void gemm_tile(const bf16_t* __restrict__ A, int lda, const float* __restrict__ mix, int m0,
                                          int K, const float* __restrict__ B0, const float* __restrict__ B1, int ldb,
                                          int nvalid, char* smem, Epi epi) {
  bf16_t* As = (bf16_t*)smem;
  bf16_t* Bs = As + 128 * LDT;
  const int tid = threadIdx.x, lane = tid & 63, w = tid >> 6, wm = w >> 1, wn = w & 1;
  const int arow = tid >> 1, akh = tid & 1;
  const int bn = tid & 127, bkh = tid >> 7;
  const float* Bp = bn < 64 ? B0 + bn : B1 + (bn - 64);
  const bool bvalid = bn < nvalid;
  const int tg = m0 + arow;
  const int t = tg % TT;
  const bf16_t* Arow = A + (size_t)tg * lda + akh * 16;

  f32x16 acc[2][2];
#pragma unroll
  for (int i = 0; i < 2; ++i)
#pragma unroll
    for (int j = 0; j < 2; ++j)
#pragma unroll
      for (int r = 0; r < 16; ++r) acc[i][j][r] = 0.f;

  uint4 ra0, ra1, rn0, rn1;
  float rb[16];
  auto load_regs = [&](int k0) {
    ra0 = *(const uint4*)(Arow + k0);
    ra1 = *(const uint4*)(Arow + k0 + 8);
    if (AMODE == 1) {
      int nb; bool valid;
      if (t < CTX) {
        const bool half = k0 >= 512;
        nb = half ? 1 : -1;
        valid = half ? (t + 1 < CTX) : (t >= 1);
      } else {
        const int tl = t - CTX, row = tl >> 6, col = tl & 63, q = k0 >> 8;
        if (q == 0) { nb = -1; valid = col > 0; }
        else if (q == 1) { nb = 1; valid = col < 63; }
        else if (q == 2) { nb = -64; valid = row > 0; }
        else { nb = 64; valid = row < 63; }
      }
      if (valid) {
        const bf16_t* Nrow = Arow + (ptrdiff_t)nb * lda;
        rn0 = *(const uint4*)(Nrow + k0);
        rn1 = *(const uint4*)(Nrow + k0 + 8);
      } else {
        rn0 = make_uint4(0, 0, 0, 0); rn1 = rn0;
      }
    }
#pragma unroll
    for (int j = 0; j < 16; ++j) rb[j] = bvalid ? Bp[(size_t)(k0 + bkh * 16 + j) * ldb] : 0.f;
  };
  auto store_lds = [&](int k0) {
    uint4 o0 = ra0, o1 = ra1;
    if (AMODE == 1) {
      float h[16], n[16];
      unpack8(ra0, h); unpack8(ra1, h + 8); unpack8(rn0, n); unpack8(rn1, n + 8);
      const float* mp = mix + k0 + akh * 16;
#pragma unroll
      for (int e = 0; e < 16; e += 4) {
        const float4 m4 = *(const float4*)(mp + e);
        h[e + 0] += (n[e + 0] - h[e + 0]) * m4.x;
        h[e + 1] += (n[e + 1] - h[e + 1]) * m4.y;
        h[e + 2] += (n[e + 2] - h[e + 2]) * m4.z;
        h[e + 3] += (n[e + 3] - h[e + 3]) * m4.w;
      }
      o0 = pack8(h); o1 = pack8(h + 8);
    }
    *(uint4*)(As + arow * LDT + akh * 16) = o0;
    *(uint4*)(As + arow * LDT + akh * 16 + 8) = o1;
    *(uint4*)(Bs + bn * LDT + bkh * 16) = pack8(rb);
    *(uint4*)(Bs + bn * LDT + bkh * 16 + 8) = pack8(rb + 8);
  };

  load_regs(0);
  for (int k0 = 0; k0 < K; k0 += 32) {
    lds_barrier();
    store_lds(k0);
    lds_barrier();
    if (k0 + 32 < K) load_regs(k0 + 32);
#pragma unroll
    for (int kk = 0; kk < 2; ++kk) {
      bf16x8 af[2], bf[2];
#pragma unroll
      for (int i = 0; i < 2; ++i)
        af[i] = *(const bf16x8*)(As + (wm * 64 + i * 32 + (lane & 31)) * LDT + kk * 16 + (lane >> 5) * 8);
#pragma unroll
      for (int j = 0; j < 2; ++j)
        bf[j] = *(const bf16x8*)(Bs + (wn * 64 + j * 32 + (lane & 31)) * LDT + kk * 16 + (lane >> 5) * 8);
#pragma unroll
      for (int i = 0; i < 2; ++i)
#pragma unroll
        for (int j = 0; j < 2; ++j) acc[i][j] = __builtin_amdgcn_mfma_f32_32x32x16_bf16(af[i], bf[j], acc[i][j], 0, 0, 0);
    }
  }
#pragma unroll
  for (int i = 0; i < 2; ++i)
#pragma unroll
    for (int j = 0; j < 2; ++j)
#pragma unroll
      for (int r = 0; r < 16; ++r) {
        const int row = m0 + wm * 64 + i * 32 + (r & 3) + 8 * (r >> 2) + 4 * (lane >> 5);
        const int col = wn * 64 + j * 32 + (lane & 31);
        epi(row, col, acc[i][j][r]);
      }
}

__device__ void phase_rw_proj(const Params& p, int j, char* smem) {
  const int ntn = j == 0 ? 66 : 83;
  const float* mixb = p.rw_mix + (size_t)j * 6 * DM;
  const float* proj = p.rw_proj + (size_t)j * 4 * DM * DI;
  for (int tile = blockIdx.x; tile < MT * ntn; tile += gridDim.x) {
    const int nt = tile / MT, mt = tile % MT, m0 = mt * 128;
    if (nt < 64) {
      const int pi = nt >> 4, n0 = (nt & 15) * 128;
      const int mi = pi == 0 ? 0 : (pi == 1 ? 2 : (pi == 2 ? 3 : 5));
      const float* Bw = proj + (size_t)pi * DM * DI + n0;
      bf16_t* dst = pi == 0 ? p.R : (pi == 1 ? p.K : (pi == 2 ? p.V : p.Z));
      if (pi == 3) {
        gemm_tile<1>(p.H, DM, mixb + mi * DM, m0, DM, Bw, Bw + 64, DI, 128, smem,
                     [&](int row, int col, float v) { dst[(size_t)row * DI + n0 + col] = f2bf(siluf_(v)); });
      } else {
        gemm_tile<1>(p.H, DM, mixb + mi * DM, m0, DM, Bw, Bw + 64, DI, 128, smem,
                     [&](int row, int col, float v) { dst[(size_t)row * DI + n0 + col] = f2bf(v); });
      }
    } else if (nt == 64) {
      const float* w1 = p.rw_w1 + (size_t)j * 2 * DM * 64;
      gemm_tile<1>(p.H, DM, mixb + 1 * DM, m0, DM, w1, w1 + DM * 64, 64, 128, smem,
                   [&](int row, int col, float v) { p.LRW[(size_t)row * 128 + col] = f2bf(tanhf(v)); });
    } else if (nt == 65) {
      const float* a1 = p.rw_a1 + (size_t)j * 2 * DM * 64;
      gemm_tile<1>(p.H, DM, mixb + 4 * DM, m0, DM, a1, a1 + DM * 64, 64, 128, smem,
                   [&](int row, int col, float v) { p.LRA[(size_t)row * 128 + col] = f2bf(v); });
    } else if (nt == 66) {
      const float* v1 = p.rw_v1;
      gemm_tile<1>(p.H, DM, mixb + 3 * DM, m0, DM, v1, v1, 32, 32, smem, [&](int row, int col, float v) {
        if (col < 32) p.LRV[(size_t)row * 32 + col] = f2bf(v);
      });
    } else {
      const int n0 = (nt - 67) * 128;
      const float* Bw = p.rw_proj + (size_t)2 * DM * DI + n0;
      gemm_tile<1>(p.H0, DM, p.rw_mix + 3 * DM, m0, DM, Bw, Bw + 64, DI, 128, smem,
                   [&](int row, int col, float v) { p.VF[(size_t)row * DI + n0 + col] = f2bf(v); });
    }
  }
}

__device__ void phase_rw_lr2(const Params& p, int j, char* smem) {
  for (int tile = blockIdx.x; tile < MT * 16; tile += gridDim.x) {
    const int nt = tile / MT, mt = tile % MT, m0 = mt * 128;
    const int n0 = nt * 128;
    const float* Bw = p.rw_v2 + n0;
    const float* v0 = p.rw_v0 + n0;
    gemm_tile<0>(p.LRV, 32, nullptr, m0, 32, Bw, Bw + 64, DI, 128, smem, [&](int row, int col, float v) {
      const size_t idx = (size_t)row * DI + n0 + col;
      const float vv = bf2f(p.V[idx]), vf = bf2f(p.VF[idx]);
      p.V[idx] = f2bf(vv + (vf - vv) * sigmoidf_(v + v0[col]));
    });
  }
}

constexpr int RCH = 32;
__device__ __forceinline__ int scan_pos(int dir, int s) { return dir == 0 ? s : (s < CTX ? CTX - 1 - s : TT + CTX - 1 - s); }

__device__ void phase_rw_scan(const Params& p, int j, char* smem) {
  float* op = (float*)smem;
  float* vv = op + RCH * 5 * 64;
  float* yb = vv + RCH * 64;
  float* sc = yb + RCH * 64;
  float* LWs = sc + RCH * 2;
  float* AAs = LWs + RCH * 64;
  bf16_t* LRs = (bf16_t*)(AAs + RCH * 64);
  bf16_t* W2T = LRs + 2 * RCH * 72;
  const int tid = threadIdx.x, lane = tid & 63, w = tid >> 6;
  const int ptau = tid >> 3, pc8 = (tid & 7) * 8;
  const int r2 = lane >> 3, ko = (lane & 7) * 8;
  const int row0 = w * 16 + r2, row1 = row0 + 8;
  for (int unit = blockIdx.x; unit < GB * 64; unit += gridDim.x) {
    const int bl = unit >> 6, h = (unit >> 1) & 31, dir = unit & 1;
    bf16_t* Y = dir == 0 ? p.YF : p.YB;
    float pkk[8], pka[8], prk[8];
#pragma unroll
    for (int e = 0; e < 8; ++e) {
      const int cc = j * DI + h * 64 + pc8 + e;
      pkk[e] = p.rw_kk[cc]; pka[e] = p.rw_ka[cc]; prk[e] = p.rw_rk[cc];
    }
    __syncthreads();
    {
      const int c = tid & 63, rq = tid >> 6;
#pragma unroll
      for (int m = 0; m < 2; ++m) {
        const float* W2 = (m == 0 ? p.rw_w2 : p.rw_a2) + ((size_t)j * 2 + dir) * 64 * DI + h * 64 + c;
        float tmp[16];
#pragma unroll
        for (int e = 0; e < 16; ++e) tmp[e] = W2[(size_t)(rq * 16 + e) * DI];
        *(uint4*)(W2T + (m * 64 + c) * 72 + rq * 16) = pack8(tmp);
        *(uint4*)(W2T + (m * 64 + c) * 72 + rq * 16 + 8) = pack8(tmp + 8);
      }
    }
    const int mm = w >> 1, nh = w & 1;
    const float bias = (mm == 0 ? p.rw_w0 : p.rw_a0)[((size_t)j * 2 + dir) * DI + h * 64 + nh * 32 + (lane & 31)];
    float S0[8], S1[8];
#pragma unroll
    for (int e = 0; e < 8; ++e) { S0[e] = 0.f; S1[e] = 0.f; }
    uint4 gr, gk, gv, gl0, gl1;
    const int lmat = (tid & 7) >> 2, lcol = (tid & 3) * 16;
    auto gload = [&](int chunk) {
      const int pos = scan_pos(dir, chunk * RCH + ptau);
      const size_t tg = (size_t)bl * TT + pos;
      const size_t base = tg * DI + h * 64 + pc8;
      gr = *(const uint4*)(p.R + base); gk = *(const uint4*)(p.K + base); gv = *(const uint4*)(p.V + base);
      const bf16_t* lr = (lmat == 0 ? p.LRW : p.LRA) + tg * 128 + dir * 64 + lcol;
      gl0 = *(const uint4*)(lr); gl1 = *(const uint4*)(lr + 8);
    };
    gload(0);
    for (int chunk = 0; chunk < TT / RCH; ++chunk) {
      *(uint4*)(LRs + (lmat * RCH + ptau) * 72 + lcol) = gl0;
      *(uint4*)(LRs + (lmat * RCH + ptau) * 72 + lcol + 8) = gl1;
      lds_barrier();
      {
        f32x16 acc;
#pragma unroll
        for (int r = 0; r < 16; ++r) acc[r] = 0.f;
#pragma unroll
        for (int kk = 0; kk < 4; ++kk) {
          const bf16x8 af = *(const bf16x8*)(LRs + (mm * RCH + (lane & 31)) * 72 + kk * 16 + (lane >> 5) * 8);
          const bf16x8 bf = *(const bf16x8*)(W2T + (mm * 64 + nh * 32 + (lane & 31)) * 72 + kk * 16 + (lane >> 5) * 8);
          acc = __builtin_amdgcn_mfma_f32_32x32x16_bf16(af, bf, acc, 0, 0, 0);
        }
        float* dstm = (mm == 0 ? LWs : AAs) + nh * 32 + (lane & 31);
#pragma unroll
        for (int r = 0; r < 16; ++r) {
          const int t = (r & 3) + 8 * (r >> 2) + 4 * (lane >> 5);
          const float sg = sigmoidf_(acc[r] + bias);
          dstm[t * 64] = mm == 0 ? -0.60653066f * sg : sg;
        }
      }
      lds_barrier();
      {
        float r[8], k[8], v[8], lw[8], a[8];
        unpack8(gr, r); unpack8(gk, k); unpack8(gv, v);
#pragma unroll
        for (int e = 0; e < 8; ++e) { lw[e] = LWs[ptau * 64 + pc8 + e]; a[e] = AAs[ptau * 64 + pc8 + e]; }
        float kkv[8], ss = 0.f;
#pragma unroll
        for (int e = 0; e < 8; ++e) { kkv[e] = k[e] * pkk[e]; ss += kkv[e] * kkv[e]; }
        ss = red8(ss);
        const float inv = rsqrtf(fmaxf(ss, 1e-24f));
        float br = 0.f, kr = 0.f, bon = 0.f;
        float o0[8], o1[8], o2[8], o3[8], o4[8];
#pragma unroll
        for (int e = 0; e < 8; ++e) {
          const float kkn = kkv[e] * inv;
          const float wd = __expf(lw[e]);
          const float kd = k[e] * (1.f + (a[e] - 1.f) * pka[e]);
          const float bb = kkn * a[e];
          o0[e] = -kkn; o1[e] = wd * r[e]; o2[e] = wd; o3[e] = bb; o4[e] = kd;
          br += bb * r[e]; kr += kd * r[e]; bon += r[e] * kd * prk[e];
        }
        br = red8(br); kr = red8(kr); bon = red8(bon);
        float* od = op + ptau * 320 + pc8;
        *(float4*)(od) = make_float4(o0[0], o0[1], o0[2], o0[3]); *(float4*)(od + 4) = make_float4(o0[4], o0[5], o0[6], o0[7]);
        *(float4*)(od + 64) = make_float4(o1[0], o1[1], o1[2], o1[3]); *(float4*)(od + 68) = make_float4(o1[4], o1[5], o1[6], o1[7]);
        *(float4*)(od + 128) = make_float4(o2[0], o2[1], o2[2], o2[3]); *(float4*)(od + 132) = make_float4(o2[4], o2[5], o2[6], o2[7]);
        *(float4*)(od + 192) = make_float4(o3[0], o3[1], o3[2], o3[3]); *(float4*)(od + 196) = make_float4(o3[4], o3[5], o3[6], o3[7]);
        *(float4*)(od + 256) = make_float4(o4[0], o4[1], o4[2], o4[3]); *(float4*)(od + 260) = make_float4(o4[4], o4[5], o4[6], o4[7]);
        float* vd = vv + ptau * 64 + pc8;
        *(float4*)(vd) = make_float4(v[0], v[1], v[2], v[3]); *(float4*)(vd + 4) = make_float4(v[4], v[5], v[6], v[7]);
        if ((tid & 7) == 0) {
          sc[ptau * 2] = br; sc[ptau * 2 + 1] = kr;
          const int pos = scan_pos(dir, chunk * RCH + ptau);
          p.BN[((size_t)dir * NTG + (size_t)bl * TT + pos) * 32 + h] = bon;
        }
      }
      lds_barrier();
      if (chunk + 1 < TT / RCH) gload(chunk + 1);
#pragma unroll 2
      for (int tau = 0; tau < RCH; ++tau) {
        const float* o = op + tau * 320 + ko;
        const float4 n0 = *(const float4*)(o), n1 = *(const float4*)(o + 4);
        const float4 q0 = *(const float4*)(o + 64), q1 = *(const float4*)(o + 68);
        const float4 w0 = *(const float4*)(o + 128), w1 = *(const float4*)(o + 132);
        const float4 b0 = *(const float4*)(o + 192), b1 = *(const float4*)(o + 196);
        const float4 k0 = *(const float4*)(o + 256), k1 = *(const float4*)(o + 260);
        const float v0 = vv[tau * 64 + row0], v1 = vv[tau * 64 + row1];
        const float br = sc[tau * 2], kr = sc[tau * 2 + 1];
        const float nk[8] = {n0.x, n0.y, n0.z, n0.w, n1.x, n1.y, n1.z, n1.w};
        const float wr[8] = {q0.x, q0.y, q0.z, q0.w, q1.x, q1.y, q1.z, q1.w};
        const float wd[8] = {w0.x, w0.y, w0.z, w0.w, w1.x, w1.y, w1.z, w1.w};
        const float bb[8] = {b0.x, b0.y, b0.z, b0.w, b1.x, b1.y, b1.z, b1.w};
        const float kd[8] = {k0.x, k0.y, k0.z, k0.w, k1.x, k1.y, k1.z, k1.w};
        float d10 = 0.f, d11 = 0.f, d20 = 0.f, d21 = 0.f;
#pragma unroll
        for (int e = 0; e < 8; ++e) {
          d10 += S0[e] * nk[e]; d11 += S1[e] * nk[e];
          d20 += S0[e] * wr[e]; d21 += S1[e] * wr[e];
        }
        d10 = red8(d10); d11 = red8(d11); d20 = red8(d20); d21 = red8(d21);
        const float y0 = d20 + d10 * br + v0 * kr;
        const float y1 = d21 + d11 * br + v1 * kr;
#pragma unroll
        for (int e = 0; e < 8; ++e) {
          S0[e] = S0[e] * wd[e] + d10 * bb[e] + v0 * kd[e];
          S1[e] = S1[e] * wd[e] + d11 * bb[e] + v1 * kd[e];
        }
        if ((lane & 7) == 0) { yb[tau * 64 + row0] = y0; yb[tau * 64 + row1] = y1; }
      }
      lds_barrier();
      {
        const int pos = scan_pos(dir, chunk * RCH + ptau);
        const float* ys = yb + ptau * 64 + pc8;
        float yv[8];
#pragma unroll
        for (int e = 0; e < 8; ++e) yv[e] = ys[e];
        *(uint4*)(Y + ((size_t)bl * TT + pos) * DI + h * 64 + pc8) = pack8(yv);
      }
    }
    lds_barrier();
  }
}

__device__ void phase_rw_gate(const Params& p, int j) {
  const int tid = threadIdx.x, h = tid >> 3;
  const int c0 = tid * 8;
  float lnw[8], lnb[8];
#pragma unroll
  for (int e = 0; e < 8; ++e) { lnw[e] = p.rw_lnw[j * DI + c0 + e]; lnb[e] = p.rw_lnb[j * DI + c0 + e]; }
  for (int tg = blockIdx.x; tg < NTG; tg += gridDim.x) {
    const size_t base = (size_t)tg * DI + c0;
    float yf[8], yb[8], v[8], z[8];
    unpack8(*(const uint4*)(p.YF + base), yf); unpack8(*(const uint4*)(p.YB + base), yb);
    unpack8(*(const uint4*)(p.V + base), v); unpack8(*(const uint4*)(p.Z + base), z);
    const float bon = p.BN[(size_t)tg * 32 + h] + p.BN[((size_t)NTG + tg) * 32 + h];
    float y[8], s = 0.f;
#pragma unroll
    for (int e = 0; e < 8; ++e) { y[e] = yf[e] + yb[e]; s += y[e]; }
    const float mu = red8(s) * (1.f / 64.f);
    float s2 = 0.f;
#pragma unroll
    for (int e = 0; e < 8; ++e) { y[e] -= mu; s2 += y[e] * y[e]; }
    const float rstd = rsqrtf(red8(s2) * (1.f / 64.f) + 64e-5f);
#pragma unroll
    for (int e = 0; e < 8; ++e) y[e] = (y[e] * rstd * lnw[e] + lnb[e] + bon * v[e]) * z[e];
    *(uint4*)(p.YF + base) = pack8(y);
  }
}

__device__ void phase_out(const Params& p, const float* wo, char* smem) {
  for (int tile = blockIdx.x; tile < MT * 8; tile += gridDim.x) {
    const int nt = tile / MT, mt = tile % MT, m0 = mt * 128, n0 = nt * 128;
    const float* Bw = wo + n0;
    gemm_tile<0>(p.YF, DI, nullptr, m0, DI, Bw, Bw + 64, DM, 128, smem,
                 [&](int row, int col, float v) { p.O[(size_t)row * DM + n0 + col] = v; });
  }
}

__device__ void phase_hg_proj(const Params& p, int j, char* smem) {
  const float* win = p.hg_win + (size_t)j * DM * 5 * DI;
  for (int tile = blockIdx.x; tile < MT * 80; tile += gridDim.x) {
    const int nt = tile / MT, mt = tile % MT, m0 = mt * 128;
    const int seg = nt >> 4, n0 = (nt & 15) * 128;
    const float* Bw = win + (size_t)seg * DI + n0;
    bf16_t* dst = seg == 0 ? p.R : (seg == 1 ? p.K : (seg == 2 ? p.WF : (seg == 3 ? p.V : p.Z)));
    if (seg == 0 || seg == 4) {
      gemm_tile<0>(p.H, DM, nullptr, m0, DM, Bw, Bw + 64, 5 * DI, 128, smem,
                   [&](int row, int col, float v) { dst[(size_t)row * DI + n0 + col] = f2bf(siluf_(v)); });
    } else {
      gemm_tile<0>(p.H, DM, nullptr, m0, DM, Bw, Bw + 64, 5 * DI, 128, smem,
                   [&](int row, int col, float v) { dst[(size_t)row * DI + n0 + col] = f2bf(v); });
    }
  }
}

constexpr int HC = 32;
constexpr int QS = 136;
constexpr int SS = 40;
__device__ void phase_hg_scan(const Params& p, int layer, char* smem) {
  bf16_t* qe = (bf16_t*)smem;
  bf16_t* ke = qe + HC * QS;
  bf16_t* kdT = ke + HC * QS;
  bf16_t* vT = kdT + 128 * SS;
  bf16_t* att = vT + 64 * SS;
  bf16_t* ST = att + HC * SS;
  float* dC = (float*)(ST + 64 * QS);
  const int tid = threadIdx.x, lane = tid & 63, w = tid >> 6;
  for (int unit = blockIdx.x; unit < GB * 64; unit += gridDim.x) {
    const int vs = unit & 1, dir = (unit >> 1) & 1, h = (unit >> 2) & 15, bl = unit >> 6;
    const bf16_t* FL = dir == 0 ? p.K : p.WF;
    bf16_t* Y = dir == 0 ? p.YF : p.YB;
    const int st = lane & 31, cg = w * 2 + (lane >> 5), kb = cg * 16, vb = cg * 8;
    float lbv[16];
#pragma unroll
    for (int e = 0; e < 16; ++e) lbv[e] = p.LB[layer * DI + h * 128 + kb + e];
    f32x16 sacc[2];
#pragma unroll
    for (int r = 0; r < 16; ++r) { sacc[0][r] = 0.f; sacc[1][r] = 0.f; }
    __syncthreads();
    for (int idx = tid; idx < 64 * QS / 2; idx += 256) ((unsigned*)ST)[idx] = 0u;
    uint4 gq0, gq1, gf0, gf1, gvv;
    auto gload = [&](int chunk) {
      const int pos = scan_pos(dir, chunk * HC + st);
      const size_t base = ((size_t)bl * TT + pos) * DI + h * 128;
      gq0 = *(const uint4*)(p.R + base + kb); gq1 = *(const uint4*)(p.R + base + kb + 8);
      gf0 = *(const uint4*)(FL + base + kb); gf1 = *(const uint4*)(FL + base + kb + 8);
      gvv = *(const uint4*)(p.V + base + vs * 64 + vb);
    };
    gload(0);
    for (int chunk = 0; chunk < TT / HC; ++chunk) {
      float q[16], cum[16], one[16];
      {
        float fl[16];
        unpack8(gq0, q); unpack8(gq1, q + 8); unpack8(gf0, fl); unpack8(gf1, fl + 8);
#pragma unroll
        for (int e = 0; e < 16; ++e) {
          const float f = lbv[e] + (1.f - lbv[e]) * sigmoidf_(fl[e]);
          one[e] = 1.f - f;
          cum[e] = __logf(f);
        }
#pragma unroll
        for (int d = 1; d < 32; d <<= 1) {
#pragma unroll
          for (int e = 0; e < 16; ++e) {
            const float tmp = __shfl_up(cum[e], d, 32);
            if (st >= d) cum[e] += tmp;
          }
        }
      }
      const uint4 vreg = gvv;
      lds_barrier();
      {
        float qo[16], ko[16];
#pragma unroll
        for (int e = 0; e < 16; ++e) {
          const float cC = __shfl(cum[e], 31, 32);
          const float ec = __expf(fmaxf(cum[e], -80.f));
          const float inv = 1.f / ec;
          const float eC = __expf(cC);
          qo[e] = q[e] * ec;
          ko[e] = one[e] * inv;
          kdT[(kb + e) * SS + st] = f2bf(one[e] * inv * eC);
          if (st == 31) dC[kb + e] = eC;
        }
        *(uint4*)(qe + st * QS + kb) = pack8(qo); *(uint4*)(qe + st * QS + kb + 8) = pack8(qo + 8);
        *(uint4*)(ke + st * QS + kb) = pack8(ko); *(uint4*)(ke + st * QS + kb + 8) = pack8(ko + 8);
        const bf16_t* vp = (const bf16_t*)&vreg;
#pragma unroll
        for (int e = 0; e < 8; ++e) vT[(vb + e) * SS + st] = vp[e];
      }
      lds_barrier();
      if (chunk + 1 < TT / HC) gload(chunk + 1);
      {
        const int mi = w >> 1, ni = w & 1;
        f32x4 a4 = {0.f, 0.f, 0.f, 0.f};
#pragma unroll
        for (int kk = 0; kk < 4; ++kk) {
          const bf16x8 af = *(const bf16x8*)(qe + (mi * 16 + (lane & 15)) * QS + kk * 32 + (lane >> 4) * 8);
          const bf16x8 bf = *(const bf16x8*)(ke + (ni * 16 + (lane & 15)) * QS + kk * 32 + (lane >> 4) * 8);
          a4 = __builtin_amdgcn_mfma_f32_16x16x32_bf16(af, bf, a4, 0, 0, 0);
        }
        const int s = ni * 16 + (lane & 15);
#pragma unroll
        for (int r = 0; r < 4; ++r) {
          const int t = mi * 16 + (lane >> 4) * 4 + r;
          att[t * SS + s] = f2bf(s <= t ? a4[r] : 0.f);
        }
      }
      lds_barrier();
      {
#pragma unroll
        for (int mh = 0; mh < 2; ++mh) {
          f32x4 y4 = {0.f, 0.f, 0.f, 0.f};
          {
            const bf16x8 af = *(const bf16x8*)(att + (mh * 16 + (lane & 15)) * SS + (lane >> 4) * 8);
            const bf16x8 bf = *(const bf16x8*)(vT + (w * 16 + (lane & 15)) * SS + (lane >> 4) * 8);
            y4 = __builtin_amdgcn_mfma_f32_16x16x32_bf16(af, bf, y4, 0, 0, 0);
          }
#pragma unroll
          for (int kk = 0; kk < 4; ++kk) {
            const bf16x8 af = *(const bf16x8*)(qe + (mh * 16 + (lane & 15)) * QS + kk * 32 + (lane >> 4) * 8);
            const bf16x8 bf = *(const bf16x8*)(ST + (w * 16 + (lane & 15)) * QS + kk * 32 + (lane >> 4) * 8);
            y4 = __builtin_amdgcn_mfma_f32_16x16x32_bf16(af, bf, y4, 0, 0, 0);
          }
#pragma unroll
          for (int r = 0; r < 4; ++r) {
            const int t = mh * 16 + (lane >> 4) * 4 + r;
            const int pos = scan_pos(dir, chunk * HC + t);
            Y[((size_t)bl * TT + pos) * DI + h * 128 + vs * 64 + w * 16 + (lane & 15)] = f2bf(y4[r]);
          }
        }
      }
      lds_barrier();
      {
        float dk[16];
#pragma unroll
        for (int r = 0; r < 16; ++r) dk[r] = dC[w * 32 + (r & 3) + 8 * (r >> 2) + 4 * (lane >> 5)];
#pragma unroll
        for (int nt = 0; nt < 2; ++nt) {
#pragma unroll
          for (int r = 0; r < 16; ++r) sacc[nt][r] *= dk[r];
#pragma unroll
          for (int ks = 0; ks < 2; ++ks) {
            const bf16x8 af = *(const bf16x8*)(kdT + (w * 32 + (lane & 31)) * SS + ks * 16 + (lane >> 5) * 8);
            const bf16x8 bf = *(const bf16x8*)(vT + (nt * 32 + (lane & 31)) * SS + ks * 16 + (lane >> 5) * 8);
            sacc[nt] = __builtin_amdgcn_mfma_f32_32x32x16_bf16(af, bf, sacc[nt], 0, 0, 0);
          }
#pragma unroll
          for (int gq = 0; gq < 4; ++gq) {
            uint2 u;
            u.x = pack2(sacc[nt][gq * 4 + 0], sacc[nt][gq * 4 + 1]);
            u.y = pack2(sacc[nt][gq * 4 + 2], sacc[nt][gq * 4 + 3]);
            *(uint2*)(ST + (nt * 32 + (lane & 31)) * QS + w * 32 + gq * 8 + (lane >> 5) * 4) = u;
          }
        }
      }
    }
    lds_barrier();
  }
}

__device__ void phase_hg_gate(const Params& p, int j) {
  const int tid = threadIdx.x;
  const int c0 = tid * 8;
  float gn[8];
#pragma unroll
  for (int e = 0; e < 8; ++e) gn[e] = p.hg_gn[j * 128 + ((c0 + e) & 127)];
  for (int tg = blockIdx.x; tg < NTG; tg += gridDim.x) {
    const size_t base = (size_t)tg * DI + c0;
    float yf[8], yb[8], z[8];
    unpack8(*(const uint4*)(p.YF + base), yf); unpack8(*(const uint4*)(p.YB + base), yb);
    unpack8(*(const uint4*)(p.Z + base), z);
    float y[8], s2 = 0.f;
#pragma unroll
    for (int e = 0; e < 8; ++e) { y[e] = yf[e] + yb[e]; s2 += y[e] * y[e]; }
    const float rstd = rsqrtf(red16(s2) * (1.f / 128.f) + EPS);
#pragma unroll
    for (int e = 0; e < 8; ++e) y[e] = y[e] * rstd * gn[e] * z[e];
    *(uint4*)(p.YF + base) = pack8(y);
  }
}

__global__ void __launch_bounds__(256) fwd_megakernel(Params p) {
  cg::grid_group grid = cg::this_grid();
  __shared__ __attribute__((aligned(16))) char smem[120 * 1024];
  phase_mod(p, smem);
  grid.sync();
  for (int g = 0; g < NG; ++g) {
    for (int layer = 0; layer < 4; ++layer) {
      phase_resnorm(p, g, layer - 1, layer);
      grid.sync();
      const int j = layer >> 1;
      if ((layer & 1) == 0) {
        phase_rw_proj(p, j, smem);
        grid.sync();
        if (j == 1) { phase_rw_lr2(p, j, smem); grid.sync(); }
        phase_rw_scan(p, j, smem);
        grid.sync();
        phase_rw_gate(p, j);
        grid.sync();
        phase_out(p, p.rw_wo + (size_t)j * DI * DM, smem);
        grid.sync();
      } else {
        phase_hg_proj(p, j, smem);
        grid.sync();
        phase_hg_scan(p, layer, smem);
        grid.sync();
        phase_hg_gate(p, j);
        grid.sync();
        phase_out(p, p.hg_wo + (size_t)j * DI * DM, smem);
        grid.sync();
      }
    }
    phase_resnorm(p, g, 3, -1);
    grid.sync();
  }
}

extern "C" void kernel_launch(void* const* d_in, const int* in_sizes, int n_in, void* d_out, int out_size, void* d_ws,
                              size_t ws_size, hipStream_t stream) {
  static int grid_blocks = 0;
  if (!grid_blocks) {
    int dev = 0, cus = 0, per_cu = 0;
    hipGetDevice(&dev);
    hipDeviceGetAttribute(&cus, hipDeviceAttributeMultiprocessorCount, dev);
    hipOccupancyMaxActiveBlocksPerMultiprocessor(&per_cu, fwd_megakernel, 256, 0);
    if (per_cu > 1) per_cu = 1;
    grid_blocks = cus * per_cu;
  }
  Params p{};
  const float** fp = (const float**)&p;
  for (int i = 0; i < 29; ++i) fp[i] = (const float*)d_in[i];
  p.out = (float*)d_out;
  char* w = (char*)d_ws;
  size_t off = 0;
  auto take = [&](size_t bytes) { char* r = w + off; off += (bytes + 255) & ~(size_t)255; return r; };
  const size_t DIW = (size_t)NTG * DI * 2;
  p.R = (bf16_t*)take(DIW); p.K = (bf16_t*)take(DIW); p.V = (bf16_t*)take(DIW); p.Z = (bf16_t*)take(DIW);
  p.WF = (bf16_t*)take(DIW); p.YF = (bf16_t*)take(DIW); p.YB = (bf16_t*)take(DIW);
  p.VF = p.YF;
  p.H = p.YB; p.H0 = p.YB + (size_t)NTG * DM;
  p.LRW = (bf16_t*)take((size_t)NTG * 128 * 2); p.LRA = (bf16_t*)take((size_t)NTG * 128 * 2);
  p.LRV = (bf16_t*)take((size_t)NTG * 32 * 2);
  p.O = (float*)p.R;
  p.BN = (float*)take((size_t)2 * NTG * 32 * 4);
  p.CTXB = (float*)take((size_t)NB * CTX * DM * 4);
  p.MODV = (float*)take((size_t)4 * 9 * 3 * DM * 4);
  p.LB = (float*)take((size_t)4 * DI * 4);
  if (off > ws_size) { fprintf(stderr, "workspace too small: need %zu have %zu\n", off, ws_size); return; }
  void* args[] = {&p};
  hipError_t e = hipLaunchCooperativeKernel((void*)fwd_megakernel, dim3(grid_blocks), dim3(256), args, 0, stream);
  if (e != hipSuccess) fprintf(stderr, "cooperative launch failed: %s (grid %d)\n", hipGetErrorString(e), grid_blocks);
}
```

```cpp
#include <hip/hip_runtime.h>
#include <hip/hip_cooperative_groups.h>
#include <cstdio>
#include <cstdint>
namespace cg = cooperative_groups;

typedef unsigned short bf16_t;
using bf16x8 = __attribute__((ext_vector_type(8))) short;
using f32x16 = __attribute__((ext_vector_type(16))) float;
using f32x4 = __attribute__((ext_vector_type(4))) float;

constexpr int NB = 8, SEQ = 4096, CTX = 256, TT = 4352, DM = 1024, DI = 2048;
constexpr int GB = 4, NG = NB / GB, NTG = GB * TT;
constexpr int MT = NTG / 128;
constexpr float EPS = 1e-6f;

constexpr size_t OFF_PROJ = 0;
constexpr size_t OFF_RWO = OFF_PROJ + (size_t)2 * 4 * DI * DM;
constexpr size_t OFF_W1 = OFF_RWO + (size_t)2 * DM * DI;
constexpr size_t OFF_A1 = OFF_W1 + (size_t)2 * 128 * DM;
constexpr size_t OFF_V1 = OFF_A1 + (size_t)2 * 128 * DM;
constexpr size_t OFF_V2 = OFF_V1 + (size_t)32 * DM;
constexpr size_t OFF_HWIN = OFF_V2 + (size_t)DI * 32;
constexpr size_t OFF_HWO = OFF_HWIN + (size_t)2 * 5 * DI * DM;
constexpr size_t WT_TOTAL = OFF_HWO + (size_t)2 * DM * DI;
__device__ bf16_t g_wt[WT_TOTAL];

struct Params {
  const float *x, *c, *ctx, *c_ctx, *mod_w, *mod_b, *pre_g, *post_g, *rw_mix, *rw_proj, *rw_wo, *rw_w0, *rw_w1,
      *rw_w2, *rw_a0, *rw_a1, *rw_a2, *rw_v0, *rw_v1, *rw_v2, *rw_kk, *rw_ka, *rw_rk, *rw_lnw, *rw_lnb, *hg_win,
      *hg_wo, *hg_gn, *hg_lb;
  float* out;
  bf16_t *R, *K, *V, *Z, *WF, *YF, *YB, *VF, *H, *H0, *LRW, *LRA, *LRV;
  float *O, *BN, *CTXB, *MODV, *LB;
};

__device__ __forceinline__ bf16_t f2bf(float f) {
  unsigned u = __float_as_uint(f);
  u += 0x7fffu + ((u >> 16) & 1u);
  return (bf16_t)(u >> 16);
}
__device__ __forceinline__ float bf2f(bf16_t h) { return __uint_as_float(((unsigned)h) << 16); }
__device__ __forceinline__ unsigned pack2(float a, float b) { return (unsigned)f2bf(a) | ((unsigned)f2bf(b) << 16); }
__device__ __forceinline__ float lo2f(unsigned u) { return __uint_as_float(u << 16); }
__device__ __forceinline__ float hi2f(unsigned u) { return __uint_as_float(u & 0xffff0000u); }
__device__ __forceinline__ float sigmoidf_(float x) { return 1.f / (1.f + __expf(-x)); }
__device__ __forceinline__ float siluf_(float x) { return x / (1.f + __expf(-x)); }

__device__ __forceinline__ void lds_barrier() { asm volatile("s_waitcnt lgkmcnt(0)\n\ts_barrier" ::: "memory"); }

template <int CTRL>
__device__ __forceinline__ float dppf(float v) {
  return __int_as_float(__builtin_amdgcn_update_dpp(0, __float_as_int(v), CTRL, 0xf, 0xf, true));
}
__device__ __forceinline__ float red4(float v) { v += dppf<0xB1>(v); v += dppf<0x4E>(v); return v; }
__device__ __forceinline__ float red8(float v) { v = red4(v); v += dppf<0x141>(v); return v; }
__device__ __forceinline__ float red16(float v) { v = red8(v); v += dppf<0x140>(v); return v; }
__device__ __forceinline__ float red64(float v) {
  v = red16(v);
  v += __shfl_xor(v, 16);
  v += __shfl_xor(v, 32);
  return v;
}

__device__ __forceinline__ void unpack8(const uint4& u, float* f) {
  f[0] = lo2f(u.x); f[1] = hi2f(u.x); f[2] = lo2f(u.y); f[3] = hi2f(u.y);
  f[4] = lo2f(u.z); f[5] = hi2f(u.z); f[6] = lo2f(u.w); f[7] = hi2f(u.w);
}
__device__ __forceinline__ uint4 pack8(const float* f) {
  uint4 u; u.x = pack2(f[0], f[1]); u.y = pack2(f[2], f[3]); u.z = pack2(f[4], f[5]); u.w = pack2(f[6], f[7]);
  return u;
}

__device__ __forceinline__ const float* row_in(const Params& p, int b, int t) {
  return t < CTX ? p.ctx + ((size_t)b * CTX + t) * DM : p.x + ((size_t)b * SEQ + (t - CTX)) * DM;
}
__device__ __forceinline__ float* row_cur(const Params& p, int b, int t) {
  return t < CTX ? p.CTXB + ((size_t)b * CTX + t) * DM : p.out + ((size_t)b * SEQ + (t - CTX)) * DM;
}

__device__ void phase_mod(const Params& p, char* smem) {
  float* red = (float*)smem;
  const int tid = threadIdx.x, cl = tid & 63, kp = tid >> 6;
  for (int task = blockIdx.x; task < 4 * 48; task += gridDim.x) {
    const int l = task / 48, col = (task % 48) * 64 + cl;
    float acc[9];
#pragma unroll
    for (int r = 0; r < 9; ++r) acc[r] = 0.f;
    const float* W = p.mod_w + (size_t)l * DM * 3 * DM + col;
    for (int k = kp * 256; k < kp * 256 + 256; ++k) {
      const float w = W[(size_t)k * 3 * DM];
#pragma unroll
      for (int r = 0; r < 9; ++r) {
        const float cv = r < 8 ? p.c[r * DM + k] : p.c_ctx[k];
        acc[r] += siluf_(cv) * w;
      }
    }
    __syncthreads();
#pragma unroll
    for (int r = 0; r < 9; ++r) red[(kp * 9 + r) * 64 + cl] = acc[r];
    __syncthreads();
    for (int idx = tid; idx < 9 * 64; idx += 256) {
      const int r = idx >> 6, c2 = idx & 63;
      float s = 0.f;
      for (int q = 0; q < 4; ++q) s += red[(q * 9 + r) * 64 + c2];
      const int cc = (task % 48) * 64 + c2;
      p.MODV[((size_t)l * 9 + r) * 3 * DM + cc] = s + p.mod_b[l * 3 * DM + cc];
    }
  }
  for (int cidx = blockIdx.x * 256 + tid; cidx < DI; cidx += gridDim.x * 256) {
    float v[4], m = -1e30f;
    for (int l = 0; l < 4; ++l) { v[l] = p.hg_lb[l * DI + cidx]; m = fmaxf(m, v[l]); }
    float s = 0.f;
    for (int l = 0; l < 4; ++l) { v[l] = __expf(v[l] - m); s += v[l]; }
    float cum = 0.f;
    for (int l = 0; l < 4; ++l) { cum += v[l] / s; p.LB[l * DI + cidx] = cum - v[0] / s; }
  }
}

__device__ void conv_matrix(const float* __restrict__ src, int K, int N, bf16_t* __restrict__ dst, char* smem) {
  float* ts = (float*)smem;
  const int tid = threadIdx.x;
  const int ntn = N / 32, ntile = (K / 64) * ntn;
  for (int tile = blockIdx.x; tile < ntile; tile += gridDim.x) {
    const int k0 = (tile / ntn) * 64, n0 = (tile % ntn) * 32;
    __syncthreads();
#pragma unroll
    for (int i = 0; i < 2; ++i) {
      const int k = (tid >> 3) + 32 * i, n4 = (tid & 7) * 4;
      const float4 v = *(const float4*)(src + (size_t)(k0 + k) * N + n0 + n4);
      ts[k * 33 + n4 + 0] = v.x; ts[k * 33 + n4 + 1] = v.y; ts[k * 33 + n4 + 2] = v.z; ts[k * 33 + n4 + 3] = v.w;
    }
    __syncthreads();
    const int n = tid >> 3, k8 = (tid & 7) * 8;
    float f[8];
#pragma unroll
    for (int e = 0; e < 8; ++e) f[e] = ts[(k8 + e) * 33 + n];
    *(uint4*)(dst + (size_t)(n0 + n) * K + k0 + k8) = pack8(f);
  }
}
__device__ void phase_wconv(const Params& p, char* smem) {
  for (int m = 0; m < 8; ++m) conv_matrix(p.rw_proj + (size_t)m * DM * DI, DM, DI, g_wt + OFF_PROJ + (size_t)m * DI * DM, smem);
  for (int j = 0; j < 2; ++j) conv_matrix(p.rw_wo + (size_t)j * DI * DM, DI, DM, g_wt + OFF_RWO + (size_t)j * DM * DI, smem);
  for (int m = 0; m < 4; ++m) {
    conv_matrix(p.rw_w1 + (size_t)m * DM * 64, DM, 64, g_wt + OFF_W1 + (size_t)m * 64 * DM, smem);
    conv_matrix(p.rw_a1 + (size_t)m * DM * 64, DM, 64, g_wt + OFF_A1 + (size_t)m * 64 * DM, smem);
  }
  conv_matrix(p.rw_v1, DM, 32, g_wt + OFF_V1, smem);
  for (int j = 0; j < 2; ++j) conv_matrix(p.hg_win + (size_t)j * DM * 5 * DI, DM, 5 * DI, g_wt + OFF_HWIN + (size_t)j * 5 * DI * DM, smem);
  for (int j = 0; j < 2; ++j) conv_matrix(p.hg_wo + (size_t)j * DI * DM, DI, DM, g_wt + OFF_HWO + (size_t)j * DM * DI, smem);
  for (int idx = blockIdx.x * 256 + threadIdx.x; idx < DI * 32; idx += gridDim.x * 256) {
    const int n = idx >> 5, k = idx & 31;
    g_wt[OFF_V2 + idx] = f2bf(p.rw_v2[(size_t)k * DI + n]);
  }
}

__device__ void phase_resnorm(const Params& p, int g, int lu, int ln) {
  const int lane = threadIdx.x & 63;
  const int wv = blockIdx.x * 4 + (threadIdx.x >> 6), nw = gridDim.x * 4;
  for (int tg = wv; tg < NTG; tg += nw) {
    const int bl = tg / TT, t = tg % TT, b = g * GB + bl;
    const bool isctx = t < CTX;
    const int mrow = isctx ? 8 : b;
    float xv[16];
    const float* src = (lu <= 0) ? row_in(p, b, t) : row_cur(p, b, t);
#pragma unroll
    for (int j = 0; j < 4; ++j) {
      const float4 v4 = *(const float4*)(src + j * 256 + lane * 4);
      xv[j * 4 + 0] = v4.x; xv[j * 4 + 1] = v4.y; xv[j * 4 + 2] = v4.z; xv[j * 4 + 3] = v4.w;
    }
    if (lu >= 0 && !(isctx && lu == 3)) {
      float ov[16], ss = 0.f;
      const float* orow = p.O + (size_t)tg * DM;
#pragma unroll
      for (int j = 0; j < 4; ++j) {
        const float4 v4 = *(const float4*)(orow + j * 256 + lane * 4);
        ov[j * 4 + 0] = v4.x; ov[j * 4 + 1] = v4.y; ov[j * 4 + 2] = v4.z; ov[j * 4 + 3] = v4.w;
      }
#pragma unroll
      for (int e = 0; e < 16; ++e) ss += ov[e] * ov[e];
      ss = red64(ss);
      const float rstd = rsqrtf(ss * (1.f / DM) + EPS);
      const float* gate = p.MODV + ((size_t)lu * 9 + mrow) * 3 * DM + 2 * DM;
      const float* pg = p.post_g + lu * DM;
      float* dst = row_cur(p, b, t);
#pragma unroll
      for (int j = 0; j < 4; ++j) {
        const int cc = j * 256 + lane * 4;
        const float4 g4 = *(const float4*)(gate + cc);
        const float4 p4 = *(const float4*)(pg + cc);
        xv[j * 4 + 0] += g4.x * (ov[j * 4 + 0] * rstd * p4.x);
        xv[j * 4 + 1] += g4.y * (ov[j * 4 + 1] * rstd * p4.y);
        xv[j * 4 + 2] += g4.z * (ov[j * 4 + 2] * rstd * p4.z);
        xv[j * 4 + 3] += g4.w * (ov[j * 4 + 3] * rstd * p4.w);
        *(float4*)(dst + cc) = make_float4(xv[j * 4 + 0], xv[j * 4 + 1], xv[j * 4 + 2], xv[j * 4 + 3]);
      }
    }
    if (ln >= 0) {
      for (int pass = 0; pass < (ln == 2 ? 2 : 1); ++pass) {
        const int lp = pass == 0 ? ln : 0;
        bf16_t* hdst = (pass == 0 ? p.H : p.H0) + (size_t)tg * DM;
        if (pass == 1) {
          const float* s0 = row_in(p, b, t);
#pragma unroll
          for (int j = 0; j < 4; ++j) {
            const float4 v4 = *(const float4*)(s0 + j * 256 + lane * 4);
            xv[j * 4 + 0] = v4.x; xv[j * 4 + 1] = v4.y; xv[j * 4 + 2] = v4.z; xv[j * 4 + 3] = v4.w;
          }
        }
        float ss = 0.f;
#pragma unroll
        for (int e = 0; e < 16; ++e) ss += xv[e] * xv[e];
        ss = red64(ss);
        const float rstd = rsqrtf(ss * (1.f / DM) + EPS);
        const float* mv = p.MODV + ((size_t)lp * 9 + mrow) * 3 * DM;
        const float* pg = p.pre_g + lp * DM;
#pragma unroll
        for (int j = 0; j < 4; ++j) {
          const int cc = j * 256 + lane * 4;
          const float4 sh = *(const float4*)(mv + cc);
          const float4 sc = *(const float4*)(mv + DM + cc);
          const float4 p4 = *(const float4*)(pg + cc);
          const float h0 = xv[j * 4 + 0] * rstd * p4.x * (1.f + sc.x) + sh.x;
          const float h1 = xv[j * 4 + 1] * rstd * p4.y * (1.f + sc.y) + sh.y;
          const float h2 = xv[j * 4 + 2] * rstd * p4.z * (1.f + sc.z) + sh.z;
          const float h3 = xv[j * 4 + 3] * rstd * p4.w * (1.f + sc.w) + sh.w;
          uint2 u; u.x = pack2(h0, h1); u.y = pack2(h2, h3);
          *(uint2*)(hdst + cc) = u;
        }
      }
    }
  }
}

constexpr int LDK = 72;
template <int P> struct IC { static constexpr int value = P; };

template <int AMODE, class Epi>
__device__ __forceinline__ void gemm_tile(const bf16_t* __restrict__ A, int lda, const float* __restrict__ mix, int m0,
                                          int K, const bf16_t* __restrict__ Bt, int nvalid, char* smem, Epi epi) {
  bf16_t* As = (bf16_t*)smem;
  bf16_t* Bs = As + 2 * 128 * LDK;
  float* mixs = (float*)(Bs + 2 * 128 * LDK);
  const int tid = threadIdx.x, lane = tid & 63, w = tid >> 6, wm = w >> 1, wn = w & 1;
  const int lrow = tid >> 1, kh = tid & 1;
  const int tg = m0 + lrow;
  const int t = tg % TT;
  const bf16_t* Arow = A + (size_t)tg * lda + kh * 32;
  const bf16_t* Brow = Bt + (size_t)lrow * K + kh * 32;
  const bool bvalid = lrow < nvalid;
  const int KT = (K + 63) >> 6;

  __syncthreads();
  if (AMODE == 1) *(float4*)(mixs + tid * 4) = *(const float4*)(mix + tid * 4);

  f32x16 acc[2][2];
#pragma unroll
  for (int i = 0; i < 2; ++i)
#pragma unroll
    for (int j = 0; j < 2; ++j)
#pragma unroll
      for (int r = 0; r < 16; ++r) acc[i][j][r] = 0.f;

  struct RegSet { uint4 a0, a1, a2, a3, n0, n1, n2, n3, b0, b1, b2, b3; };
  RegSet s0, s1;
  auto load_regs = [&](RegSet& s, int kt) {
    const int k0 = kt * 64;
    const bool kval = (k0 + kh * 32) < K;
    const uint4 z4 = make_uint4(0, 0, 0, 0);
    const uint4* ap = (const uint4*)(Arow + k0);
    const uint4* bp = (const uint4*)(Brow + k0);
    if (kval) { s.a0 = ap[0]; s.a1 = ap[1]; s.a2 = ap[2]; s.a3 = ap[3]; } else { s.a0 = z4; s.a1 = z4; s.a2 = z4; s.a3 = z4; }
    if (kval && bvalid) { s.b0 = bp[0]; s.b1 = bp[1]; s.b2 = bp[2]; s.b3 = bp[3]; } else { s.b0 = z4; s.b1 = z4; s.b2 = z4; s.b3 = z4; }
    if (AMODE == 1) {
      int nb; bool valid;
      if (t < CTX) {
        const bool half = k0 >= 512;
        nb = half ? 1 : -1;
        valid = half ? (t + 1 < CTX) : (t >= 1);
      } else {
        const int tl = t - CTX, row = tl >> 6, col = tl & 63, q = k0 >> 8;
        if (q == 0) { nb = -1; valid = col > 0; }
        else if (q == 1) { nb = 1; valid = col < 63; }
        else if (q == 2) { nb = -64; valid = row > 0; }
        else { nb = 64; valid = row < 63; }
      }
      const uint4* np = (const uint4*)(Arow + (ptrdiff_t)nb * lda + k0);
      if (valid) { s.n0 = np[0]; s.n1 = np[1]; s.n2 = np[2]; s.n3 = np[3]; } else { s.n0 = z4; s.n1 = z4; s.n2 = z4; s.n3 = z4; }
    }
  };
  auto mix8 = [&](const uint4& hv, const uint4& nv, const float* mp) -> uint4 {
    float h[8], n[8];
    unpack8(hv, h); unpack8(nv, n);
    const float4 ma = *(const float4*)(mp), mb = *(const float4*)(mp + 4);
    h[0] += (n[0] - h[0]) * ma.x; h[1] += (n[1] - h[1]) * ma.y; h[2] += (n[2] - h[2]) * ma.z; h[3] += (n[3] - h[3]) * ma.w;
    h[4] += (n[4] - h[4]) * mb.x; h[5] += (n[5] - h[5]) * mb.y; h[6] += (n[6] - h[6]) * mb.z; h[7] += (n[7] - h[7]) * mb.w;
    return pack8(h);
  };
  auto store_lds = [&](const RegSet& s, int kt, int buf) {
    uint4* ad = (uint4*)(As + (buf * 128 + lrow) * LDK + kh * 32);
    uint4* bd = (uint4*)(Bs + (buf * 128 + lrow) * LDK + kh * 32);
    if (AMODE == 1) {
      const float* mp = mixs + kt * 64 + kh * 32;
      ad[0] = mix8(s.a0, s.n0, mp); ad[1] = mix8(s.a1, s.n1, mp + 8);
      ad[2] = mix8(s.a2, s.n2, mp + 16); ad[3] = mix8(s.a3, s.n3, mp + 24);
    } else {
      ad[0] = s.a0; ad[1] = s.a1; ad[2] = s.a2; ad[3] = s.a3;
    }
    bd[0] = s.b0; bd[1] = s.b1; bd[2] = s.b2; bd[3] = s.b3;
  };
  auto compute = [&](int buf) {
    const bf16_t* ab = As + (buf * 128 + wm * 64 + (lane & 31)) * LDK + (lane >> 5) * 8;
    const bf16_t* bb = Bs + (buf * 128 + wn * 64 + (lane & 31)) * LDK + (lane >> 5) * 8;
#pragma unroll
    for (int kk = 0; kk < 4; ++kk) {
      const bf16x8 af0 = *(const bf16x8*)(ab + kk * 16), af1 = *(const bf16x8*)(ab + 32 * LDK + kk * 16);
      const bf16x8 bf0 = *(const bf16x8*)(bb + kk * 16), bf1 = *(const bf16x8*)(bb + 32 * LDK + kk * 16);
      acc[0][0] = __builtin_amdgcn_mfma_f32_32x32x16_bf16(af0, bf0, acc[0][0], 0, 0, 0);
      acc[0][1] = __builtin_amdgcn_mfma_f32_32x32x16_bf16(af0, bf1, acc[0][1], 0, 0, 0);
      acc[1][0] = __builtin_amdgcn_mfma_f32_32x32x16_bf16(af1, bf0, acc[1][0], 0, 0, 0);
      acc[1][1] = __builtin_amdgcn_mfma_f32_32x32x16_bf16(af1, bf1, acc[1][1], 0, 0, 0);
    }
  };
  load_regs(s0, 0);
  if (KT > 1) load_regs(s1, 1);
  lds_barrier();
  store_lds(s0, 0, 0);
  if (KT > 2) load_regs(s0, 2);
  lds_barrier();
  for (int kt = 0; kt < KT; kt += 2) {
    if (kt + 1 < KT) store_lds(s1, kt + 1, 1);
    if (kt + 3 < KT) load_regs(s1, kt + 3);
    compute(0);
    lds_barrier();
    if (kt + 1 < KT) {
      if (kt + 2 < KT) store_lds(s0, kt + 2, 0);
      if (kt + 4 < KT) load_regs(s0, kt + 4);
      compute(1);
      lds_barrier();
    }
  }
#pragma unroll
  for (int i = 0; i < 2; ++i)
#pragma unroll
    for (int j = 0; j < 2; ++j)
#pragma unroll
      for (int r = 0; r < 16; ++r) {
        const int row = m0 + wm * 64 + i * 32 + (r & 3) + 8 * (r >> 2) + 4 * (lane >> 5);
        const int col = wn * 64 + j * 32 + (lane & 31);
        epi(row, col, acc[i][j][r]);
      }
}

__device__ void phase_rw_proj(const Params& p, int j, char* smem) {
  const int ntn = j == 0 ? 66 : 83;
  const float* mixb = p.rw_mix + (size_t)j * 6 * DM;
  for (int tile = blockIdx.x; tile < MT * ntn; tile += gridDim.x) {
    const int mt = tile / ntn, nt = tile % ntn, m0 = mt * 128;
    if (nt < 64) {
      const int pi = nt >> 4, n0 = (nt & 15) * 128;
      const int mi = pi == 0 ? 0 : (pi == 1 ? 2 : (pi == 2 ? 3 : 5));
      const bf16_t* Bw = g_wt + OFF_PROJ + ((size_t)(j * 4 + pi) * DI + n0) * DM;
      bf16_t* dst = pi == 0 ? p.R : (pi == 1 ? p.K : (pi == 2 ? p.V : p.Z));
      if (pi == 3) {
        gemm_tile<1>(p.H, DM, mixb + mi * DM, m0, DM, Bw, 128, smem,
                     [&](int row, int col, float v) { dst[(size_t)row * DI + n0 + col] = f2bf(siluf_(v)); });
      } else {
        gemm_tile<1>(p.H, DM, mixb + mi * DM, m0, DM, Bw, 128, smem,
                     [&](int row, int col, float v) { dst[(size_t)row * DI + n0 + col] = f2bf(v); });
      }
    } else if (nt == 64) {
      gemm_tile<1>(p.H, DM, mixb + 1 * DM, m0, DM, g_wt + OFF_W1 + (size_t)j * 128 * DM, 128, smem,
                   [&](int row, int col, float v) { p.LRW[(size_t)row * 128 + col] = f2bf(tanhf(v)); });
    } else if (nt == 65) {
      gemm_tile<1>(p.H, DM, mixb + 4 * DM, m0, DM, g_wt + OFF_A1 + (size_t)j * 128 * DM, 128, smem,
                   [&](int row, int col, float v) { p.LRA[(size_t)row * 128 + col] = f2bf(v); });
    } else if (nt == 66) {
      gemm_tile<1>(p.H, DM, mixb + 3 * DM, m0, DM, g_wt + OFF_V1, 32, smem, [&](int row, int col, float v) {
        if (col < 32) p.LRV[(size_t)row * 32 + col] = f2bf(v);
      });
    } else {
      const int n0 = (nt - 67) * 128;
      const bf16_t* Bw = g_wt + OFF_PROJ + ((size_t)2 * DI + n0) * DM;
      gemm_tile<1>(p.H0, DM, p.rw_mix + 3 * DM, m0, DM, Bw, 128, smem,
                   [&](int row, int col, float v) { p.VF[(size_t)row * DI + n0 + col] = f2bf(v); });
    }
  }
}

__device__ void phase_rw_lr2(const Params& p, int j, char* smem) {
  for (int tile = blockIdx.x; tile < MT * 16; tile += gridDim.x) {
    const int mt = tile / 16, nt = tile % 16, m0 = mt * 128;
    const int n0 = nt * 128;
    const bf16_t* Bw = g_wt + OFF_V2 + (size_t)n0 * 32;
    const float* v0 = p.rw_v0 + n0;
    gemm_tile<0>(p.LRV, 32, nullptr, m0, 32, Bw, 128, smem, [&](int row, int col, float v) {
      const size_t idx = (size_t)row * DI + n0 + col;
      const float vv = bf2f(p.V[idx]), vf = bf2f(p.VF[idx]);
      p.V[idx] = f2bf(vv + (vf - vv) * sigmoidf_(v + v0[col]));
    });
  }
}

constexpr int RCH = 32;
__device__ __forceinline__ int scan_pos(int dir, int s) { return dir == 0 ? s : (s < CTX ? CTX - 1 - s : TT + CTX - 1 - s); }

__device__ void phase_rw_scan(const Params& p, int j, char* smem) {
  float* op = (float*)smem;
  float* vv = op + RCH * 5 * 64;
  float* yb = vv + RCH * 64;
  float* sc = yb + RCH * 64;
  float* LWs = sc + RCH * 2;
  float* AAs = LWs + RCH * 64;
  bf16_t* LRs = (bf16_t*)(AAs + RCH * 64);
  bf16_t* W2T = LRs + 2 * RCH * 72;
  const int tid = threadIdx.x, lane = tid & 63, w = tid >> 6;
  const int ptau = tid >> 3, pc8 = (tid & 7) * 8;
  const int r2 = lane >> 3, ko = (lane & 7) * 8;
  const int row0 = w * 16 + r2, row1 = row0 + 8;
  for (int unit = blockIdx.x; unit < GB * 64; unit += gridDim.x) {
    const int bl = unit >> 6, h = (unit >> 1) & 31, dir = unit & 1;
    bf16_t* Y = dir == 0 ? p.YF : p.YB;
    float pkk[8], pka[8], prk[8];
#pragma unroll
    for (int e = 0; e < 8; ++e) {
      const int cc = j * DI + h * 64 + pc8 + e;
      pkk[e] = p.rw_kk[cc]; pka[e] = p.rw_ka[cc]; prk[e] = p.rw_rk[cc];
    }
    __syncthreads();
    {
      const int c = tid & 63, rq = tid >> 6;
#pragma unroll
      for (int m = 0; m < 2; ++m) {
        const float* W2 = (m == 0 ? p.rw_w2 : p.rw_a2) + ((size_t)j * 2 + dir) * 64 * DI + h * 64 + c;
        float tmp[16];
#pragma unroll
        for (int e = 0; e < 16; ++e) tmp[e] = W2[(size_t)(rq * 16 + e) * DI];
        *(uint4*)(W2T + (m * 64 + c) * 72 + rq * 16) = pack8(tmp);
        *(uint4*)(W2T + (m * 64 + c) * 72 + rq * 16 + 8) = pack8(tmp + 8);
      }
    }
    const int mm = w >> 1, nh = w & 1;
    const float bias = (mm == 0 ? p.rw_w0 : p.rw_a0)[((size_t)j * 2 + dir) * DI + h * 64 + nh * 32 + (lane & 31)];
    float S0[8], S1[8];
#pragma unroll
    for (int e = 0; e < 8; ++e) { S0[e] = 0.f; S1[e] = 0.f; }
    uint4 gr, gk, gv, gl0, gl1;
    const int lmat = (tid & 7) >> 2, lcol = (tid & 3) * 16;
    auto gload = [&](int chunk) {
      const int pos = scan_pos(dir, chunk * RCH + ptau);
      const size_t tg = (size_t)bl * TT + pos;
      const size_t base = tg * DI + h * 64 + pc8;
      gr = *(const uint4*)(p.R + base); gk = *(const uint4*)(p.K + base); gv = *(const uint4*)(p.V + base);
      const bf16_t* lr = (lmat == 0 ? p.LRW : p.LRA) + tg * 128 + dir * 64 + lcol;
      gl0 = *(const uint4*)(lr); gl1 = *(const uint4*)(lr + 8);
    };
    gload(0);
    for (int chunk = 0; chunk < TT / RCH; ++chunk) {
      *(uint4*)(LRs + (lmat * RCH + ptau) * 72 + lcol) = gl0;
      *(uint4*)(LRs + (lmat * RCH + ptau) * 72 + lcol + 8) = gl1;
      lds_barrier();
      {
        f32x16 acc;
#pragma unroll
        for (int r = 0; r < 16; ++r) acc[r] = 0.f;
#pragma unroll
        for (int kk = 0; kk < 4; ++kk) {
          const bf16x8 af = *(const bf16x8*)(LRs + (mm * RCH + (lane & 31)) * 72 + kk * 16 + (lane >> 5) * 8);
          const bf16x8 bf = *(const bf16x8*)(W2T + (mm * 64 + nh * 32 + (lane & 31)) * 72 + kk * 16 + (lane >> 5) * 8);
          acc = __builtin_amdgcn_mfma_f32_32x32x16_bf16(af, bf, acc, 0, 0, 0);
        }
        float* dstm = (mm == 0 ? LWs : AAs) + nh * 32 + (lane & 31);
#pragma unroll
        for (int r = 0; r < 16; ++r) {
          const int t = (r & 3) + 8 * (r >> 2) + 4 * (lane >> 5);
          const float sg = sigmoidf_(acc[r] + bias);
          dstm[t * 64] = mm == 0 ? -0.60653066f * sg : sg;
        }
      }
      lds_barrier();
      {
        float r[8], k[8], v[8], lw[8], a[8];
        unpack8(gr, r); unpack8(gk, k); unpack8(gv, v);
#pragma unroll
        for (int e = 0; e < 8; ++e) { lw[e] = LWs[ptau * 64 + pc8 + e]; a[e] = AAs[ptau * 64 + pc8 + e]; }
        float kkv[8], ss = 0.f;
#pragma unroll
        for (int e = 0; e < 8; ++e) { kkv[e] = k[e] * pkk[e]; ss += kkv[e] * kkv[e]; }
        ss = red8(ss);
        const float inv = rsqrtf(fmaxf(ss, 1e-24f));
        float br = 0.f, kr = 0.f, bon = 0.f;
        float o0[8], o1[8], o2[8], o3[8], o4[8];
#pragma unroll
        for (int e = 0; e < 8; ++e) {
          const float kkn = kkv[e] * inv;
          const float wd = __expf(lw[e]);
          const float kd = k[e] * (1.f + (a[e] - 1.f) * pka[e]);
          const float bb = kkn * a[e];
          o0[e] = -kkn; o1[e] = wd * r[e]; o2[e] = wd; o3[e] = bb; o4[e] = kd;
          br += bb * r[e]; kr += kd * r[e]; bon += r[e] * kd * prk[e];
        }
        br = red8(br); kr = red8(kr); bon = red8(bon);
        float* od = op + ptau * 320 + pc8;
        *(float4*)(od) = make_float4(o0[0], o0[1], o0[2], o0[3]); *(float4*)(od + 4) = make_float4(o0[4], o0[5], o0[6], o0[7]);
        *(float4*)(od + 64) = make_float4(o1[0], o1[1], o1[2], o1[3]); *(float4*)(od + 68) = make_float4(o1[4], o1[5], o1[6], o1[7]);
        *(float4*)(od + 128) = make_float4(o2[0], o2[1], o2[2], o2[3]); *(float4*)(od + 132) = make_float4(o2[4], o2[5], o2[6], o2[7]);
        *(float4*)(od + 192) = make_float4(o3[0], o3[1], o3[2], o3[3]); *(float4*)(od + 196) = make_float4(o3[4], o3[5], o3[6], o3[7]);
        *(float4*)(od + 256) = make_float4(o4[0], o4[1], o4[2], o4[3]); *(float4*)(od + 260) = make_float4(o4[4], o4[5], o4[6], o4[7]);
        float* vd = vv + ptau * 64 + pc8;
        *(float4*)(vd) = make_float4(v[0], v[1], v[2], v[3]); *(float4*)(vd + 4) = make_float4(v[4], v[5], v[6], v[7]);
        if ((tid & 7) == 0) {
          sc[ptau * 2] = br; sc[ptau * 2 + 1] = kr;
          const int pos = scan_pos(dir, chunk * RCH + ptau);
          p.BN[((size_t)dir * NTG + (size_t)bl * TT + pos) * 32 + h] = bon;
        }
      }
      lds_barrier();
      if (chunk + 1 < TT / RCH) gload(chunk + 1);
#pragma unroll 2
      for (int tau = 0; tau < RCH; ++tau) {
        const float* o = op + tau * 320 + ko;
        const float4 n0 = *(const float4*)(o), n1 = *(const float4*)(o + 4);
        const float4 q0 = *(const float4*)(o + 64), q1 = *(const float4*)(o + 68);
        const float4 w0 = *(const float4*)(o + 128), w1 = *(const float4*)(o + 132);
        const float4 b0 = *(const float4*)(o + 192), b1 = *(const float4*)(o + 196);
        const float4 k0 = *(const float4*)(o + 256), k1 = *(const float4*)(o + 260);
        const float v0 = vv[tau * 64 + row0], v1 = vv[tau * 64 + row1];
        const float br = sc[tau * 2], kr = sc[tau * 2 + 1];
        const float nk[8] = {n0.x, n0.y, n0.z, n0.w, n1.x, n1.y, n1.z, n1.w};
        const float wr[8] = {q0.x, q0.y, q0.z, q0.w, q1.x, q1.y, q1.z, q1.w};
        const float wd[8] = {w0.x, w0.y, w0.z, w0.w, w1.x, w1.y, w1.z, w1.w};
        const float bb[8] = {b0.x, b0.y, b0.z, b0.w, b1.x, b1.y, b1.z, b1.w};
        const float kd[8] = {k0.x, k0.y, k0.z, k0.w, k1.x, k1.y, k1.z, k1.w};
        float d10 = 0.f, d11 = 0.f, d20 = 0.f, d21 = 0.f;
#pragma unroll
        for (int e = 0; e < 8; ++e) {
          d10 += S0[e] * nk[e]; d11 += S1[e] * nk[e];
          d20 += S0[e] * wr[e]; d21 += S1[e] * wr[e];
        }
        d10 = red8(d10); d11 = red8(d11); d20 = red8(d20); d21 = red8(d21);
        const float y0 = d20 + d10 * br + v0 * kr;
        const float y1 = d21 + d11 * br + v1 * kr;
#pragma unroll
        for (int e = 0; e < 8; ++e) {
          S0[e] = S0[e] * wd[e] + d10 * bb[e] + v0 * kd[e];
          S1[e] = S1[e] * wd[e] + d11 * bb[e] + v1 * kd[e];
        }
        if ((lane & 7) == 0) { yb[tau * 64 + row0] = y0; yb[tau * 64 + row1] = y1; }
      }
      lds_barrier();
      {
        const int pos = scan_pos(dir, chunk * RCH + ptau);
        const float* ys = yb + ptau * 64 + pc8;
        float yv[8];
#pragma unroll
        for (int e = 0; e < 8; ++e) yv[e] = ys[e];
        *(uint4*)(Y + ((size_t)bl * TT + pos) * DI + h * 64 + pc8) = pack8(yv);
      }
    }
    lds_barrier();
  }
}

__device__ void phase_rw_gate(const Params& p, int j) {
  const int tid = threadIdx.x, h = tid >> 3;
  const int c0 = tid * 8;
  float lnw[8], lnb[8];
#pragma unroll
  for (int e = 0; e < 8; ++e) { lnw[e] = p.rw_lnw[j * DI + c0 + e]; lnb[e] = p.rw_lnb[j * DI + c0 + e]; }
  for (int tg = blockIdx.x; tg < NTG; tg += gridDim.x) {
    const size_t base = (size_t)tg * DI + c0;
    float yf[8], yb[8], v[8], z[8];
    unpack8(*(const uint4*)(p.YF + base), yf); unpack8(*(const uint4*)(p.YB + base), yb);
    unpack8(*(const uint4*)(p.V + base), v); unpack8(*(const uint4*)(p.Z + base), z);
    const float bon = p.BN[(size_t)tg * 32 + h] + p.BN[((size_t)NTG + tg) * 32 + h];
    float y[8], s = 0.f;
#pragma unroll
    for (int e = 0; e < 8; ++e) { y[e] = yf[e] + yb[e]; s += y[e]; }
    const float mu = red8(s) * (1.f / 64.f);
    float s2 = 0.f;
#pragma unroll
    for (int e = 0; e < 8; ++e) { y[e] -= mu; s2 += y[e] * y[e]; }
    const float rstd = rsqrtf(red8(s2) * (1.f / 64.f) + 64e-5f);
#pragma unroll
    for (int e = 0; e < 8; ++e) y[e] = (y[e] * rstd * lnw[e] + lnb[e] + bon * v[e]) * z[e];
    *(uint4*)(p.YF + base) = pack8(y);
  }
}

__device__ void phase_out(const Params& p, const bf16_t* wo, char* smem) {
  for (int tile = blockIdx.x; tile < MT * 8; tile += gridDim.x) {
    const int mt = tile / 8, nt = tile % 8, m0 = mt * 128, n0 = nt * 128;
    const bf16_t* Bw = wo + (size_t)n0 * DI;
    gemm_tile<0>(p.YF, DI, nullptr, m0, DI, Bw, 128, smem,
                 [&](int row, int col, float v) { p.O[(size_t)row * DM + n0 + col] = v; });
  }
}

__device__ void phase_hg_proj(const Params& p, int j, char* smem) {
  for (int tile = blockIdx.x; tile < MT * 80; tile += gridDim.x) {
    const int mt = tile / 80, nt = tile % 80, m0 = mt * 128;
    const int seg = nt >> 4, n0 = (nt & 15) * 128;
    const bf16_t* Bw = g_wt + OFF_HWIN + ((size_t)j * 5 * DI + (size_t)seg * DI + n0) * DM;
    bf16_t* dst = seg == 0 ? p.R : (seg == 1 ? p.K : (seg == 2 ? p.WF : (seg == 3 ? p.V : p.Z)));
    if (seg == 0 || seg == 4) {
      gemm_tile<0>(p.H, DM, nullptr, m0, DM, Bw, 128, smem,
                   [&](int row, int col, float v) { dst[(size_t)row * DI + n0 + col] = f2bf(siluf_(v)); });
    } else {
      gemm_tile<0>(p.H, DM, nullptr, m0, DM, Bw, 128, smem,
                   [&](int row, int col, float v) { dst[(size_t)row * DI + n0 + col] = f2bf(v); });
    }
  }
}

constexpr int HC = 32;
constexpr int QS = 136;
constexpr int SS = 40;
__device__ void phase_hg_scan(const Params& p, int layer, char* smem) {
  bf16_t* qe = (bf16_t*)smem;
  bf16_t* ke = qe + HC * QS;
  bf16_t* kdT = ke + HC * QS;
  bf16_t* vT = kdT + 128 * SS;
  bf16_t* att = vT + 64 * SS;
  bf16_t* ST = att + HC * SS;
  float* dC = (float*)(ST + 64 * QS);
  const int tid = threadIdx.x, lane = tid & 63, w = tid >> 6;
  for (int unit = blockIdx.x; unit < GB * 64; unit += gridDim.x) {
    const int vs = unit & 1, dir = (unit >> 1) & 1, h = (unit >> 2) & 15, bl = unit >> 6;
    const bf16_t* FL = dir == 0 ? p.K : p.WF;
    bf16_t* Y = dir == 0 ? p.YF : p.YB;
    const int st = lane & 31, cg = w * 2 + (lane >> 5), kb = cg * 16, vb = cg * 8;
    float lbv[16];
#pragma unroll
    for (int e = 0; e < 16; ++e) lbv[e] = p.LB[layer * DI + h * 128 + kb + e];
    f32x16 sacc[2];
#pragma unroll
    for (int r = 0; r < 16; ++r) { sacc[0][r] = 0.f; sacc[1][r] = 0.f; }
    __syncthreads();
    for (int idx = tid; idx < 64 * QS / 2; idx += 256) ((unsigned*)ST)[idx] = 0u;
    uint4 gq0, gq1, gf0, gf1, gvv;
    auto gload = [&](int chunk) {
      const int pos = scan_pos(dir, chunk * HC + st);
      const size_t base = ((size_t)bl * TT + pos) * DI + h * 128;
      gq0 = *(const uint4*)(p.R + base + kb); gq1 = *(const uint4*)(p.R + base + kb + 8);
      gf0 = *(const uint4*)(FL + base + kb); gf1 = *(const uint4*)(FL + base + kb + 8);
      gvv = *(const uint4*)(p.V + base + vs * 64 + vb);
    };
    gload(0);
    for (int chunk = 0; chunk < TT / HC; ++chunk) {
      float q[16], cum[16], one[16];
      {
        float fl[16];
        unpack8(gq0, q); unpack8(gq1, q + 8); unpack8(gf0, fl); unpack8(gf1, fl + 8);
#pragma unroll
        for (int e = 0; e < 16; ++e) {
          const float f = lbv[e] + (1.f - lbv[e]) * sigmoidf_(fl[e]);
          one[e] = 1.f - f;
          cum[e] = __logf(f);
        }
#pragma unroll
        for (int d = 1; d < 32; d <<= 1) {
#pragma unroll
          for (int e = 0; e < 16; ++e) {
            const float tmp = __shfl_up(cum[e], d, 32);
            if (st >= d) cum[e] += tmp;
          }
        }
      }
      const uint4 vreg = gvv;
      lds_barrier();
      {
        float qo[16], ko[16];
#pragma unroll
        for (int e = 0; e < 16; ++e) {
          const float cC = __shfl(cum[e], 31, 32);
          const float ec = __expf(fmaxf(cum[e], -80.f));
          const float inv = 1.f / ec;
          const float eC = __expf(cC);
          qo[e] = q[e] * ec;
          ko[e] = one[e] * inv;
          kdT[(kb + e) * SS + st] = f2bf(one[e] * inv * eC);
          if (st == 31) dC[kb + e] = eC;
        }
        *(uint4*)(qe + st * QS + kb) = pack8(qo); *(uint4*)(qe + st * QS + kb + 8) = pack8(qo + 8);
        *(uint4*)(ke + st * QS + kb) = pack8(ko); *(uint4*)(ke + st * QS + kb + 8) = pack8(ko + 8);
        const bf16_t* vp = (const bf16_t*)&vreg;
#pragma unroll
        for (int e = 0; e < 8; ++e) vT[(vb + e) * SS + st] = vp[e];
      }
      lds_barrier();
      if (chunk + 1 < TT / HC) gload(chunk + 1);
      {
        const int mi = w >> 1, ni = w & 1;
        f32x4 a4 = {0.f, 0.f, 0.f, 0.f};
#pragma unroll
        for (int kk = 0; kk < 4; ++kk) {
          const bf16x8 af = *(const bf16x8*)(qe + (mi * 16 + (lane & 15)) * QS + kk * 32 + (lane >> 4) * 8);
          const bf16x8 bf = *(const bf16x8*)(ke + (ni * 16 + (lane & 15)) * QS + kk * 32 + (lane >> 4) * 8);
          a4 = __builtin_amdgcn_mfma_f32_16x16x32_bf16(af, bf, a4, 0, 0, 0);
        }
        const int s = ni * 16 + (lane & 15);
#pragma unroll
        for (int r = 0; r < 4; ++r) {
          const int t = mi * 16 + (lane >> 4) * 4 + r;
          att[t * SS + s] = f2bf(s <= t ? a4[r] : 0.f);
        }
      }
      lds_barrier();
      {
#pragma unroll
        for (int mh = 0; mh < 2; ++mh) {
          f32x4 y4 = {0.f, 0.f, 0.f, 0.f};
          {
            const bf16x8 af = *(const bf16x8*)(att + (mh * 16 + (lane & 15)) * SS + (lane >> 4) * 8);
            const bf16x8 bf = *(const bf16x8*)(vT + (w * 16 + (lane & 15)) * SS + (lane >> 4) * 8);
            y4 = __builtin_amdgcn_mfma_f32_16x16x32_bf16(af, bf, y4, 0, 0, 0);
          }
#pragma unroll
          for (int kk = 0; kk < 4; ++kk) {
            const bf16x8 af = *(const bf16x8*)(qe + (mh * 16 + (lane & 15)) * QS + kk * 32 + (lane >> 4) * 8);
            const bf16x8 bf = *(const bf16x8*)(ST + (w * 16 + (lane & 15)) * QS + kk * 32 + (lane >> 4) * 8);
            y4 = __builtin_amdgcn_mfma_f32_16x16x32_bf16(af, bf, y4, 0, 0, 0);
          }
#pragma unroll
          for (int r = 0; r < 4; ++r) {
            const int t = mh * 16 + (lane >> 4) * 4 + r;
            const int pos = scan_pos(dir, chunk * HC + t);
            Y[((size_t)bl * TT + pos) * DI + h * 128 + vs * 64 + w * 16 + (lane & 15)] = f2bf(y4[r]);
          }
        }
      }
      lds_barrier();
      {
        float dk[16];
#pragma unroll
        for (int r = 0; r < 16; ++r) dk[r] = dC[w * 32 + (r & 3) + 8 * (r >> 2) + 4 * (lane >> 5)];
#pragma unroll
        for (int nt = 0; nt < 2; ++nt) {
#pragma unroll
          for (int r = 0; r < 16; ++r) sacc[nt][r] *= dk[r];
#pragma unroll
          for (int ks = 0; ks < 2; ++ks) {
            const bf16x8 af = *(const bf16x8*)(kdT + (w * 32 + (lane & 31)) * SS + ks * 16 + (lane >> 5) * 8);
            const bf16x8 bf = *(const bf16x8*)(vT + (nt * 32 + (lane & 31)) * SS + ks * 16 + (lane >> 5) * 8);
            sacc[nt] = __builtin_amdgcn_mfma_f32_32x32x16_bf16(af, bf, sacc[nt], 0, 0, 0);
          }
#pragma unroll
          for (int gq = 0; gq < 4; ++gq) {
            uint2 u;
            u.x = pack2(sacc[nt][gq * 4 + 0], sacc[nt][gq * 4 + 1]);
            u.y = pack2(sacc[nt][gq * 4 + 2], sacc[nt][gq * 4 + 3]);
            *(uint2*)(ST + (nt * 32 + (lane & 31)) * QS + w * 32 + gq * 8 + (lane >> 5) * 4) = u;
          }
        }
      }
    }
    lds_barrier();
  }
}

__device__ void phase_hg_gate(const Params& p, int j) {
  const int tid = threadIdx.x;
  const int c0 = tid * 8;
  float gn[8];
#pragma unroll
  for (int e = 0; e < 8; ++e) gn[e] = p.hg_gn[j * 128 + ((c0 + e) & 127)];
  for (int tg = blockIdx.x; tg < NTG; tg += gridDim.x) {
    const size_t base = (size_t)tg * DI + c0;
    float yf[8], yb[8], z[8];
    unpack8(*(const uint4*)(p.YF + base), yf); unpack8(*(const uint4*)(p.YB + base), yb);
    unpack8(*(const uint4*)(p.Z + base), z);
    float y[8], s2 = 0.f;
#pragma unroll
    for (int e = 0; e < 8; ++e) { y[e] = yf[e] + yb[e]; s2 += y[e] * y[e]; }
    const float rstd = rsqrtf(red16(s2) * (1.f / 128.f) + EPS);
#pragma unroll
    for (int e = 0; e < 8; ++e) y[e] = y[e] * rstd * gn[e] * z[e];
    *(uint4*)(p.YF + base) = pack8(y);
  }
}

__global__ void __launch_bounds__(256) fwd_megakernel(Params p) {
  cg::grid_group grid = cg::this_grid();
  __shared__ __attribute__((aligned(16))) char smem[120 * 1024];
  phase_mod(p, smem);
  phase_wconv(p, smem);
  grid.sync();
  for (int g = 0; g < NG; ++g) {
    for (int layer = 0; layer < 4; ++layer) {
      phase_resnorm(p, g, layer - 1, layer);
      grid.sync();
      const int j = layer >> 1;
      if ((layer & 1) == 0) {
        phase_rw_proj(p, j, smem);
        grid.sync();
        if (j == 1) { phase_rw_lr2(p, j, smem); grid.sync(); }
        phase_rw_scan(p, j, smem);
        grid.sync();
        phase_rw_gate(p, j);
        grid.sync();
        phase_out(p, g_wt + OFF_RWO + (size_t)j * DM * DI, smem);
        grid.sync();
      } else {
        phase_hg_proj(p, j, smem);
        grid.sync();
        phase_hg_scan(p, layer, smem);
        grid.sync();
        phase_hg_gate(p, j);
        grid.sync();
        phase_out(p, g_wt + OFF_HWO + (size_t)j * DM * DI, smem);
        grid.sync();
      }
    }
    phase_resnorm(p, g, 3, -1);
    grid.sync();
  }
}

extern "C" void kernel_launch(void* const* d_in, const int* in_sizes, int n_in, void* d_out, int out_size, void* d_ws,
                              size_t ws_size, hipStream_t stream) {
  static int grid_blocks = 0;
  if (!grid_blocks) {
    int dev = 0, cus = 0, per_cu = 0;
    hipGetDevice(&dev);
    hipDeviceGetAttribute(&cus, hipDeviceAttributeMultiprocessorCount, dev);
    hipOccupancyMaxActiveBlocksPerMultiprocessor(&per_cu, fwd_megakernel, 256, 0);
    if (per_cu > 1) per_cu = 1;
    grid_blocks = cus * per_cu;
  }
  Params p{};
  const float** fp = (const float**)&p;
  for (int i = 0; i < 29; ++i) fp[i] = (const float*)d_in[i];
  p.out = (float*)d_out;
  char* w = (char*)d_ws;
  size_t off = 0;
  auto take = [&](size_t bytes) { char* r = w + off; off += (bytes + 255) & ~(size_t)255; return r; };
  const size_t DIW = (size_t)NTG * DI * 2;
  p.R = (bf16_t*)take(DIW); p.K = (bf16_t*)take(DIW); p.V = (bf16_t*)take(DIW); p.Z = (bf16_t*)take(DIW);
  p.WF = (bf16_t*)take(DIW); p.YF = (bf16_t*)take(DIW); p.YB = (bf16_t*)take(DIW);
  p.VF = p.YF;
  p.H = p.YB; p.H0 = p.YB + (size_t)NTG * DM;
  p.LRW = (bf16_t*)take((size_t)NTG * 128 * 2); p.LRA = (bf16_t*)take((size_t)NTG * 128 * 2);
  p.LRV = (bf16_t*)take((size_t)NTG * 32 * 2);
  p.O = (float*)p.R;
  p.BN = (float*)take((size_t)2 * NTG * 32 * 4);
  p.CTXB = (float*)take((size_t)NB * CTX * DM * 4);
  p.MODV = (float*)take((size_t)4 * 9 * 3 * DM * 4);
  p.LB = (float*)take((size_t)4 * DI * 4);
  if (off > ws_size) { fprintf(stderr, "workspace too small: need %zu have %zu\n", off, ws_size); return; }
  void* args[] = {&p};
  hipError_t e = hipLaunchCooperativeKernel((void*)fwd_megakernel, dim3(grid_blocks), dim3(256), args, 0, stream);
  if (e != hipSuccess) fprintf(stderr, "cooperative launch failed: %s (grid %d)\n", hipGetErrorString(e), grid_blocks);
}
```

```cpp
#include <hip/hip_runtime.h>
#include <hip/hip_cooperative_groups.h>
#include <cstdio>
#include <cstdint>
namespace cg = cooperative_groups;

typedef unsigned short bf16_t;
using bf16x8 = __attribute__((ext_vector_type(8))) short;
using f32x16 = __attribute__((ext_vector_type(16))) float;
using f32x4 = __attribute__((ext_vector_type(4))) float;

constexpr int NB = 8, SEQ = 4096, CTX = 256, TT = 4352, DM = 1024, DI = 2048;
constexpr int GB = 4, NG = NB / GB, NTG = GB * TT;
constexpr int MT = NTG / 256;
constexpr float EPS = 1e-6f;

constexpr size_t OFF_PROJ = 0;
constexpr size_t OFF_RWO = OFF_PROJ + (size_t)2 * 4 * DI * DM;
constexpr size_t OFF_W1 = OFF_RWO + (size_t)2 * DM * DI;
constexpr size_t OFF_A1 = OFF_W1 + (size_t)2 * 128 * DM;
constexpr size_t OFF_V1 = OFF_A1 + (size_t)2 * 128 * DM;
constexpr size_t OFF_V2 = OFF_V1 + (size_t)32 * DM;
constexpr size_t OFF_HWIN = OFF_V2 + (size_t)DI * 32;
constexpr size_t OFF_HWO = OFF_HWIN + (size_t)2 * 5 * DI * DM;
constexpr size_t WT_TOTAL = OFF_HWO + (size_t)2 * DM * DI;
__device__ bf16_t g_wt[WT_TOTAL];

struct Params {
  const float *x, *c, *ctx, *c_ctx, *mod_w, *mod_b, *pre_g, *post_g, *rw_mix, *rw_proj, *rw_wo, *rw_w0, *rw_w1,
      *rw_w2, *rw_a0, *rw_a1, *rw_a2, *rw_v0, *rw_v1, *rw_v2, *rw_kk, *rw_ka, *rw_rk, *rw_lnw, *rw_lnb, *hg_win,
      *hg_wo, *hg_gn, *hg_lb;
  float* out;
  bf16_t *R, *K, *V, *Z, *WF, *YF, *YB, *VF, *H, *H0, *LRW, *LRA, *LRV;
  float *O, *BN, *CTXB, *MODV, *LB;
};

__device__ __forceinline__ bf16_t f2bf(float f) {
  unsigned u = __float_as_uint(f);
  u += 0x7fffu + ((u >> 16) & 1u);
  return (bf16_t)(u >> 16);
}
__device__ __forceinline__ float bf2f(bf16_t h) { return __uint_as_float(((unsigned)h) << 16); }
__device__ __forceinline__ unsigned pack2(float a, float b) { return (unsigned)f2bf(a) | ((unsigned)f2bf(b) << 16); }
__device__ __forceinline__ float lo2f(unsigned u) { return __uint_as_float(u << 16); }
__device__ __forceinline__ float hi2f(unsigned u) { return __uint_as_float(u & 0xffff0000u); }
__device__ __forceinline__ float sigmoidf_(float x) { return 1.f / (1.f + __expf(-x)); }
__device__ __forceinline__ float siluf_(float x) { return x / (1.f + __expf(-x)); }

__device__ __forceinline__ void lds_barrier() { asm volatile("s_waitcnt lgkmcnt(0)\n\ts_barrier" ::: "memory"); }

__device__ __forceinline__ int opaque_tid() { int t = threadIdx.x; asm volatile("" : "+v"(t)); return t; }

template <int CTRL>
__device__ __forceinline__ float dppf(float v) {
  return __int_as_float(__builtin_amdgcn_update_dpp(0, __float_as_int(v), CTRL, 0xf, 0xf, true));
}
__device__ __forceinline__ float red4(float v) { v += dppf<0xB1>(v); v += dppf<0x4E>(v); return v; }
__device__ __forceinline__ float red8(float v) { v = red4(v); v += dppf<0x141>(v); return v; }
__device__ __forceinline__ float red16(float v) { v = red8(v); v += dppf<0x140>(v); return v; }
__device__ __forceinline__ float red64(float v) {
  v = red16(v);
  v += __shfl_xor(v, 16);
  v += __shfl_xor(v, 32);
  return v;
}

__device__ __forceinline__ void unpack8(const uint4& u, float* f) {
  f[0] = lo2f(u.x); f[1] = hi2f(u.x); f[2] = lo2f(u.y); f[3] = hi2f(u.y);
  f[4] = lo2f(u.z); f[5] = hi2f(u.z); f[6] = lo2f(u.w); f[7] = hi2f(u.w);
}
__device__ __forceinline__ uint4 pack8(const float* f) {
  uint4 u; u.x = pack2(f[0], f[1]); u.y = pack2(f[2], f[3]); u.z = pack2(f[4], f[5]); u.w = pack2(f[6], f[7]);
  return u;
}

__device__ __forceinline__ const float* row_in(const Params& p, int b, int t) {
  return t < CTX ? p.ctx + ((size_t)b * CTX + t) * DM : p.x + ((size_t)b * SEQ + (t - CTX)) * DM;
}
__device__ __forceinline__ float* row_cur(const Params& p, int b, int t) {
  return t < CTX ? p.CTXB + ((size_t)b * CTX + t) * DM : p.out + ((size_t)b * SEQ + (t - CTX)) * DM;
}

__device__ __forceinline__ void phase_mod(const Params& p, char* smem) {
  float* red = (float*)smem;
  const int tid = opaque_tid(), cl = tid & 63, kp = tid >> 6;
  for (int task = blockIdx.x; task < 4 * 48; task += gridDim.x) {
    const int l = task / 48, col = (task % 48) * 64 + cl;
    float acc[9];
#pragma unroll
    for (int r = 0; r < 9; ++r) acc[r] = 0.f;
    const float* W = p.mod_w + (size_t)l * DM * 3 * DM + col;
    for (int k = kp * 256; k < kp * 256 + 256; ++k) {
      const float w = W[(size_t)k * 3 * DM];
#pragma unroll
      for (int r = 0; r < 9; ++r) {
        const float cv = r < 8 ? p.c[r * DM + k] : p.c_ctx[k];
        acc[r] += siluf_(cv) * w;
      }
    }
    __syncthreads();
#pragma unroll
    for (int r = 0; r < 9; ++r) red[(kp * 9 + r) * 64 + cl] = acc[r];
    __syncthreads();
    for (int idx = tid; idx < 9 * 64; idx += 256) {
      const int r = idx >> 6, c2 = idx & 63;
      float s = 0.f;
      for (int q = 0; q < 4; ++q) s += red[(q * 9 + r) * 64 + c2];
      const int cc = (task % 48) * 64 + c2;
      p.MODV[((size_t)l * 9 + r) * 3 * DM + cc] = s + p.mod_b[l * 3 * DM + cc];
    }
  }
  for (int cidx = blockIdx.x * 256 + tid; cidx < DI; cidx += gridDim.x * 256) {
    float v[4], m = -1e30f;
    for (int l = 0; l < 4; ++l) { v[l] = p.hg_lb[l * DI + cidx]; m = fmaxf(m, v[l]); }
    float s = 0.f;
    for (int l = 0; l < 4; ++l) { v[l] = __expf(v[l] - m); s += v[l]; }
    float cum = 0.f;
    for (int l = 0; l < 4; ++l) { cum += v[l] / s; p.LB[l * DI + cidx] = cum - v[0] / s; }
  }
}

__device__ __forceinline__ void conv_matrix(const float* __restrict__ src, int K, int N, bf16_t* __restrict__ dst, char* smem) {
  float* ts = (float*)smem;
  const int tid = opaque_tid();
  const int ntn = N / 32, ntile = (K / 64) * ntn;
  for (int tile = blockIdx.x; tile < ntile; tile += gridDim.x) {
    const int k0 = (tile / ntn) * 64, n0 = (tile % ntn) * 32;
    __syncthreads();
#pragma unroll
    for (int i = 0; i < 2; ++i) {
      const int k = (tid >> 3) + 32 * i, n4 = (tid & 7) * 4;
      const float4 v = *(const float4*)(src + (size_t)(k0 + k) * N + n0 + n4);
      ts[k * 33 + n4 + 0] = v.x; ts[k * 33 + n4 + 1] = v.y; ts[k * 33 + n4 + 2] = v.z; ts[k * 33 + n4 + 3] = v.w;
    }
    __syncthreads();
    const int n = tid >> 3, k8 = (tid & 7) * 8;
    float f[8];
#pragma unroll
    for (int e = 0; e < 8; ++e) f[e] = ts[(k8 + e) * 33 + n];
    *(uint4*)(dst + (size_t)(n0 + n) * K + k0 + k8) = pack8(f);
  }
}
__device__ __forceinline__ void phase_wconv(const Params& p, char* smem) {
  for (int m = 0; m < 8; ++m) conv_matrix(p.rw_proj + (size_t)m * DM * DI, DM, DI, g_wt + OFF_PROJ + (size_t)m * DI * DM, smem);
  for (int j = 0; j < 2; ++j) conv_matrix(p.rw_wo + (size_t)j * DI * DM, DI, DM, g_wt + OFF_RWO + (size_t)j * DM * DI, smem);
  for (int m = 0; m < 4; ++m) {
    conv_matrix(p.rw_w1 + (size_t)m * DM * 64, DM, 64, g_wt + OFF_W1 + (size_t)m * 64 * DM, smem);
    conv_matrix(p.rw_a1 + (size_t)m * DM * 64, DM, 64, g_wt + OFF_A1 + (size_t)m * 64 * DM, smem);
  }
  conv_matrix(p.rw_v1, DM, 32, g_wt + OFF_V1, smem);
  for (int j = 0; j < 2; ++j) conv_matrix(p.hg_win + (size_t)j * DM * 5 * DI, DM, 5 * DI, g_wt + OFF_HWIN + (size_t)j * 5 * DI * DM, smem);
  for (int j = 0; j < 2; ++j) conv_matrix(p.hg_wo + (size_t)j * DI * DM, DI, DM, g_wt + OFF_HWO + (size_t)j * DM * DI, smem);
  for (int idx = blockIdx.x * 256 + opaque_tid(); idx < DI * 32; idx += gridDim.x * 256) {
    const int n = idx >> 5, k = idx & 31;
    g_wt[OFF_V2 + idx] = f2bf(p.rw_v2[(size_t)k * DI + n]);
  }
}

__device__ __forceinline__ void phase_resnorm(const Params& p, int g, int lu, int ln) {
  const int tid = opaque_tid();
  const int lane = tid & 63;
  const int wv = blockIdx.x * 4 + (tid >> 6), nw = gridDim.x * 4;
  for (int tg = wv; tg < NTG; tg += nw) {
    const int bl = tg / TT, t = tg % TT, b = g * GB + bl;
    const bool isctx = t < CTX;
    const int mrow = isctx ? 8 : b;
    float xv[16];
    const float* src = (lu <= 0) ? row_in(p, b, t) : row_cur(p, b, t);
#pragma unroll
    for (int j = 0; j < 4; ++j) {
      const float4 v4 = *(const float4*)(src + j * 256 + lane * 4);
      xv[j * 4 + 0] = v4.x; xv[j * 4 + 1] = v4.y; xv[j * 4 + 2] = v4.z; xv[j * 4 + 3] = v4.w;
    }
    if (lu >= 0 && !(isctx && lu == 3)) {
      float ov[16], ss = 0.f;
      const float* orow = p.O + (size_t)tg * DM;
#pragma unroll
      for (int j = 0; j < 4; ++j) {
        const float4 v4 = *(const float4*)(orow + j * 256 + lane * 4);
        ov[j * 4 + 0] = v4.x; ov[j * 4 + 1] = v4.y; ov[j * 4 + 2] = v4.z; ov[j * 4 + 3] = v4.w;
      }
#pragma unroll
      for (int e = 0; e < 16; ++e) ss += ov[e] * ov[e];
      ss = red64(ss);
      const float rstd = rsqrtf(ss * (1.f / DM) + EPS);
      const float* gate = p.MODV + ((size_t)lu * 9 + mrow) * 3 * DM + 2 * DM;
      const float* pg = p.post_g + lu * DM;
      float* dst = row_cur(p, b, t);
#pragma unroll
      for (int j = 0; j < 4; ++j) {
        const int cc = j * 256 + lane * 4;
        const float4 g4 = *(const float4*)(gate + cc);
        const float4 p4 = *(const float4*)(pg + cc);
        xv[j * 4 + 0] += g4.x * (ov[j * 4 + 0] * rstd * p4.x);
        xv[j * 4 + 1] += g4.y * (ov[j * 4 + 1] * rstd * p4.y);
        xv[j * 4 + 2] += g4.z * (ov[j * 4 + 2] * rstd * p4.z);
        xv[j * 4 + 3] += g4.w * (ov[j * 4 + 3] * rstd * p4.w);
        *(float4*)(dst + cc) = make_float4(xv[j * 4 + 0], xv[j * 4 + 1], xv[j * 4 + 2], xv[j * 4 + 3]);
      }
    }
    if (ln >= 0) {
      for (int pass = 0; pass < (ln == 2 ? 2 : 1); ++pass) {
        const int lp = pass == 0 ? ln : 0;
        bf16_t* hdst = (pass == 0 ? p.H : p.H0) + (size_t)tg * DM;
        if (pass == 1) {
          const float* s0 = row_in(p, b, t);
#pragma unroll
          for (int j = 0; j < 4; ++j) {
            const float4 v4 = *(const float4*)(s0 + j * 256 + lane * 4);
            xv[j * 4 + 0] = v4.x; xv[j * 4 + 1] = v4.y; xv[j * 4 + 2] = v4.z; xv[j * 4 + 3] = v4.w;
          }
        }
        float ss = 0.f;
#pragma unroll
        for (int e = 0; e < 16; ++e) ss += xv[e] * xv[e];
        ss = red64(ss);
        const float rstd = rsqrtf(ss * (1.f / DM) + EPS);
        const float* mv = p.MODV + ((size_t)lp * 9 + mrow) * 3 * DM;
        const float* pg = p.pre_g + lp * DM;
#pragma unroll
        for (int j = 0; j < 4; ++j) {
          const int cc = j * 256 + lane * 4;
          const float4 sh = *(const float4*)(mv + cc);
          const float4 sc = *(const float4*)(mv + DM + cc);
          const float4 p4 = *(const float4*)(pg + cc);
          const float h0 = xv[j * 4 + 0] * rstd * p4.x * (1.f + sc.x) + sh.x;
          const float h1 = xv[j * 4 + 1] * rstd * p4.y * (1.f + sc.y) + sh.y;
          const float h2 = xv[j * 4 + 2] * rstd * p4.z * (1.f + sc.z) + sh.z;
          const float h3 = xv[j * 4 + 3] * rstd * p4.w * (1.f + sc.w) + sh.w;
          uint2 u; u.x = pack2(h0, h1); u.y = pack2(h2, h3);
          *(uint2*)(hdst + cc) = u;
        }
      }
    }
  }
}

constexpr int LDK = 72;
constexpr int TM = 256;

template <int AMODE, class Epi>
__device__ __forceinline__ void gemm_tile(const bf16_t* __restrict__ A, int lda, const float* __restrict__ mix, int m0,
                                          int K, const bf16_t* __restrict__ Bt, int nvalid, char* smem, Epi epi) {
  bf16_t* As = (bf16_t*)smem;
  bf16_t* Bs = As + 2 * TM * LDK;
  float* mixs = (float*)(Bs + 2 * 128 * LDK);
  const int tid = opaque_tid(), lane = tid & 63, w = tid >> 6, wm = w >> 1, wn = w & 1;
  const int lr = lane >> 3, ch = (lane & 7) * 8;
  const int arow0 = w * 64 + lr, brow0 = w * 32 + lr;
  const bf16_t* Ap = A + (size_t)(m0 + arow0) * lda + ch;
  const bf16_t* Bp = Bt + (size_t)brow0 * K + ch;
  const size_t astep = (size_t)8 * lda, bstep = (size_t)8 * K;
  const int KT = (K + 63) >> 6;
  const int tbase = m0 % TT;
  const bool isctx = tbase < CTX;
  unsigned vmask = 0;
  if (AMODE == 1) {
#pragma unroll
    for (int i = 0; i < 8; ++i) {
      const int t = tbase + arow0 + i * 8;
      unsigned m;
      if (isctx) {
        m = (t >= 1 ? 3u : 0u) | (t + 1 < CTX ? 12u : 0u);
      } else {
        const int tl = t - CTX, row = tl >> 6, col = tl & 63;
        m = (col > 0 ? 1u : 0u) | (col < 63 ? 2u : 0u) | (row > 0 ? 4u : 0u) | (row < 63 ? 8u : 0u);
      }
      vmask |= m << (4 * i);
    }
  }

  __syncthreads();
  if (AMODE == 1) *(float4*)(mixs + tid * 4) = *(const float4*)(mix + tid * 4);

  f32x16 acc[4][2];
#pragma unroll
  for (int i = 0; i < 4; ++i)
#pragma unroll
    for (int j = 0; j < 2; ++j)
#pragma unroll
      for (int r = 0; r < 16; ++r) acc[i][j][r] = 0.f;

  uint4 a0, a1, a2, a3, a4, a5, a6, a7, n0, n1, n2, n3, n4, n5, n6, n7, b0, b1, b2, b3;
  auto load_regs = [&](int kt) {
    const int k0 = kt * 64;
    const uint4 z4 = make_uint4(0, 0, 0, 0);
    const bool kval = (k0 + ch) < K;
    const bf16_t* ap = Ap + k0;
    const bf16_t* bp = Bp + k0;
    a0 = z4; if (kval) a0 = *(const uint4*)(ap + 0 * astep);
    a1 = z4; if (kval) a1 = *(const uint4*)(ap + 1 * astep);
    a2 = z4; if (kval) a2 = *(const uint4*)(ap + 2 * astep);
    a3 = z4; if (kval) a3 = *(const uint4*)(ap + 3 * astep);
    a4 = z4; if (kval) a4 = *(const uint4*)(ap + 4 * astep);
    a5 = z4; if (kval) a5 = *(const uint4*)(ap + 5 * astep);
    a6 = z4; if (kval) a6 = *(const uint4*)(ap + 6 * astep);
    a7 = z4; if (kval) a7 = *(const uint4*)(ap + 7 * astep);
    b0 = z4; if (kval && (brow0 + 0) < nvalid) b0 = *(const uint4*)(bp + 0 * bstep);
    b1 = z4; if (kval && (brow0 + 8) < nvalid) b1 = *(const uint4*)(bp + 1 * bstep);
    b2 = z4; if (kval && (brow0 + 16) < nvalid) b2 = *(const uint4*)(bp + 2 * bstep);
    b3 = z4; if (kval && (brow0 + 24) < nvalid) b3 = *(const uint4*)(bp + 3 * bstep);
    if (AMODE == 1) {
      const int q = k0 >> 8;
      const int nb = isctx ? (q < 2 ? -1 : 1) : (q == 0 ? -1 : (q == 1 ? 1 : (q == 2 ? -64 : 64)));
      const bf16_t* np = ap + (ptrdiff_t)nb * lda;
      const unsigned vm = vmask >> q;
      n0 = z4; if ((vm >> 0) & 1u) n0 = *(const uint4*)(np + 0 * astep);
      n1 = z4; if ((vm >> 4) & 1u) n1 = *(const uint4*)(np + 1 * astep);
      n2 = z4; if ((vm >> 8) & 1u) n2 = *(const uint4*)(np + 2 * astep);
      n3 = z4; if ((vm >> 12) & 1u) n3 = *(const uint4*)(np + 3 * astep);
      n4 = z4; if ((vm >> 16) & 1u) n4 = *(const uint4*)(np + 4 * astep);
      n5 = z4; if ((vm >> 20) & 1u) n5 = *(const uint4*)(np + 5 * astep);
      n6 = z4; if ((vm >> 24) & 1u) n6 = *(const uint4*)(np + 6 * astep);
      n7 = z4; if ((vm >> 28) & 1u) n7 = *(const uint4*)(np + 7 * astep);
    }
  };
  auto mix8 = [&](const uint4& hv, const uint4& nv, const float4& ma, const float4& mb) -> uint4 {
    float h[8], n[8];
    unpack8(hv, h); unpack8(nv, n);
    h[0] += (n[0] - h[0]) * ma.x; h[1] += (n[1] - h[1]) * ma.y; h[2] += (n[2] - h[2]) * ma.z; h[3] += (n[3] - h[3]) * ma.w;
    h[4] += (n[4] - h[4]) * mb.x; h[5] += (n[5] - h[5]) * mb.y; h[6] += (n[6] - h[6]) * mb.z; h[7] += (n[7] - h[7]) * mb.w;
    return pack8(h);
  };
  auto store_lds = [&](int kt, int buf) {
    bf16_t* ad = As + (buf * TM + arow0) * LDK + ch;
    bf16_t* bd = Bs + (buf * 128 + brow0) * LDK + ch;
    if (AMODE == 1) {
      const float4 ma = *(const float4*)(mixs + kt * 64 + ch), mb = *(const float4*)(mixs + kt * 64 + ch + 4);
      *(uint4*)(ad + 0 * LDK) = mix8(a0, n0, ma, mb);
      *(uint4*)(ad + 8 * LDK) = mix8(a1, n1, ma, mb);
      *(uint4*)(ad + 16 * LDK) = mix8(a2, n2, ma, mb);
      *(uint4*)(ad + 24 * LDK) = mix8(a3, n3, ma, mb);
      *(uint4*)(ad + 32 * LDK) = mix8(a4, n4, ma, mb);
      *(uint4*)(ad + 40 * LDK) = mix8(a5, n5, ma, mb);
      *(uint4*)(ad + 48 * LDK) = mix8(a6, n6, ma, mb);
      *(uint4*)(ad + 56 * LDK) = mix8(a7, n7, ma, mb);
    } else {
      *(uint4*)(ad + 0 * LDK) = a0;
      *(uint4*)(ad + 8 * LDK) = a1;
      *(uint4*)(ad + 16 * LDK) = a2;
      *(uint4*)(ad + 24 * LDK) = a3;
      *(uint4*)(ad + 32 * LDK) = a4;
      *(uint4*)(ad + 40 * LDK) = a5;
      *(uint4*)(ad + 48 * LDK) = a6;
      *(uint4*)(ad + 56 * LDK) = a7;
    }
    *(uint4*)(bd + 0 * LDK) = b0;
    *(uint4*)(bd + 8 * LDK) = b1;
    *(uint4*)(bd + 16 * LDK) = b2;
    *(uint4*)(bd + 24 * LDK) = b3;
  };
  auto compute = [&](int buf) {
    const bf16_t* ab = As + (buf * TM + wm * 128 + (lane & 31)) * LDK + (lane >> 5) * 8;
    const bf16_t* bb = Bs + (buf * 128 + wn * 64 + (lane & 31)) * LDK + (lane >> 5) * 8;
#pragma unroll
    for (int kk = 0; kk < 4; ++kk) {
      const bf16x8 bf0 = *(const bf16x8*)(bb + kk * 16), bf1 = *(const bf16x8*)(bb + 32 * LDK + kk * 16);
#pragma unroll
      for (int i = 0; i < 4; ++i) {
        const bf16x8 af = *(const bf16x8*)(ab + i * 32 * LDK + kk * 16);
        acc[i][0] = __builtin_amdgcn_mfma_f32_32x32x16_bf16(af, bf0, acc[i][0], 0, 0, 0);
        acc[i][1] = __builtin_amdgcn_mfma_f32_32x32x16_bf16(af, bf1, acc[i][1], 0, 0, 0);
      }
    }
  };
  load_regs(0);
  lds_barrier();
  store_lds(0, 0);
  if (KT > 1) load_regs(1);
  lds_barrier();
  for (int kt = 0; kt < KT; ++kt) {
    if (kt + 1 < KT) store_lds(kt + 1, (kt + 1) & 1);
    if (kt + 2 < KT) load_regs(kt + 2);
    compute(kt & 1);
    lds_barrier();
  }
  float* Cs = (float*)smem;
  for (int hh = 0; hh < 2; ++hh) {
    if (hh == 1) lds_barrier();
    if (wm == hh) {
#pragma unroll
      for (int i = 0; i < 4; ++i)
#pragma unroll
        for (int j = 0; j < 2; ++j)
#pragma unroll
          for (int r = 0; r < 16; ++r)
            Cs[(i * 32 + (r & 3) + 8 * (r >> 2) + 4 * (lane >> 5)) * 132 + wn * 64 + j * 32 + (lane & 31)] = acc[i][j][r];
    }
    lds_barrier();
#pragma unroll 2
    for (int it = 0; it < 8; ++it) {
      const int idx = it * 256 + tid, row = idx >> 4, c8 = (idx & 15) * 8;
      const float4 v0 = *(const float4*)(Cs + row * 132 + c8), v1 = *(const float4*)(Cs + row * 132 + c8 + 4);
      float v[8] = {v0.x, v0.y, v0.z, v0.w, v1.x, v1.y, v1.z, v1.w};
      epi(m0 + hh * 128 + row, c8, v);
    }
  }
}

__device__ __forceinline__ void phase_rw_proj(const Params& p, int j, char* smem) {
  const int ntn = j == 0 ? 66 : 83;
  const float* mixb = p.rw_mix + (size_t)j * 6 * DM;
  for (int tile = blockIdx.x; tile < MT * ntn; tile += gridDim.x) {
    const int mt = tile / ntn, nt = tile % ntn, m0 = mt * 256;
    if (nt < 64) {
      const int pi = nt >> 4, n0 = (nt & 15) * 128;
      const int mi = pi == 0 ? 0 : (pi == 1 ? 2 : (pi == 2 ? 3 : 5));
      const bf16_t* Bw = g_wt + OFF_PROJ + ((size_t)(j * 4 + pi) * DI + n0) * DM;
      bf16_t* dst = pi == 0 ? p.R : (pi == 1 ? p.K : (pi == 2 ? p.V : p.Z));
      if (pi == 3) {
        gemm_tile<1>(p.H, DM, mixb + mi * DM, m0, DM, Bw, 128, smem,
                     [&](int row, int col, float* v) {
#pragma unroll
        for (int e = 0; e < 8; ++e) v[e] = siluf_(v[e]);
        *(uint4*)(dst + (size_t)row * DI + n0 + col) = pack8(v); });
      } else {
        gemm_tile<1>(p.H, DM, mixb + mi * DM, m0, DM, Bw, 128, smem,
                     [&](int row, int col, float* v) { *(uint4*)(dst + (size_t)row * DI + n0 + col) = pack8(v); });
      }
    } else if (nt == 64) {
      gemm_tile<1>(p.H, DM, mixb + 1 * DM, m0, DM, g_wt + OFF_W1 + (size_t)j * 128 * DM, 128, smem,
                   [&](int row, int col, float* v) {
#pragma unroll
        for (int e = 0; e < 8; ++e) v[e] = tanhf(v[e]);
        *(uint4*)(p.LRW + (size_t)row * 128 + col) = pack8(v); });
    } else if (nt == 65) {
      gemm_tile<1>(p.H, DM, mixb + 4 * DM, m0, DM, g_wt + OFF_A1 + (size_t)j * 128 * DM, 128, smem,
                   [&](int row, int col, float* v) { *(uint4*)(p.LRA + (size_t)row * 128 + col) = pack8(v); });
    } else if (nt == 66) {
      gemm_tile<1>(p.H, DM, mixb + 3 * DM, m0, DM, g_wt + OFF_V1, 32, smem, [&](int row, int col, float* v) {
        if (col < 32) *(uint4*)(p.LRV + (size_t)row * 32 + col) = pack8(v);
      });
    } else {
      const int n0 = (nt - 67) * 128;
      const bf16_t* Bw = g_wt + OFF_PROJ + ((size_t)2 * DI + n0) * DM;
      gemm_tile<1>(p.H0, DM, p.rw_mix + 3 * DM, m0, DM, Bw, 128, smem,
                   [&](int row, int col, float* v) { *(uint4*)(p.VF + (size_t)row * DI + n0 + col) = pack8(v); });
    }
  }
}

__device__ __forceinline__ void phase_rw_lr2(const Params& p, int j, char* smem) {
  for (int tile = blockIdx.x; tile < MT * 16; tile += gridDim.x) {
    const int mt = tile / 16, nt = tile % 16, m0 = mt * 256;
    const int n0 = nt * 128;
    const bf16_t* Bw = g_wt + OFF_V2 + (size_t)n0 * 32;
    const float* v0 = p.rw_v0 + n0;
    gemm_tile<0>(p.LRV, 32, nullptr, m0, 32, Bw, 128, smem, [&](int row, int col, float* v) {
      const size_t idx = (size_t)row * DI + n0 + col;
      float vv[8], vf[8];
      unpack8(*(const uint4*)(p.V + idx), vv); unpack8(*(const uint4*)(p.VF + idx), vf);
#pragma unroll
      for (int e = 0; e < 8; ++e) vv[e] += (vf[e] - vv[e]) * sigmoidf_(v[e] + v0[col + e]);
      *(uint4*)(p.V + idx) = pack8(vv);
    });
  }
}

constexpr int RCH = 32;
__device__ __forceinline__ int scan_pos(int dir, int s) { return dir == 0 ? s : (s < CTX ? CTX - 1 - s : TT + CTX - 1 - s); }

__device__ __forceinline__ void phase_rw_scan(const Params& p, int j, char* smem) {
  float* op = (float*)smem;
  float* vv = op + RCH * 5 * 64;
  float* yb = vv + RCH * 64;
  float* sc = yb + RCH * 64;
  float* LWs = sc + RCH * 2;
  float* AAs = LWs + RCH * 64;
  bf16_t* LRs = (bf16_t*)(AAs + RCH * 64);
  bf16_t* W2T = LRs + 2 * RCH * 72;
  const int tid = opaque_tid(), lane = tid & 63, w = tid >> 6;
  const int ptau = tid >> 3, pc8 = (tid & 7) * 8;
  const int r2 = lane >> 3, ko = (lane & 7) * 8;
  const int row0 = w * 16 + r2, row1 = row0 + 8;
  for (int unit = blockIdx.x; unit < GB * 64; unit += gridDim.x) {
    const int bl = unit >> 6, h = (unit >> 1) & 31, dir = unit & 1;
    bf16_t* Y = dir == 0 ? p.YF : p.YB;
    float pkk[8], pka[8], prk[8];
#pragma unroll
    for (int e = 0; e < 8; ++e) {
      const int cc = j * DI + h * 64 + pc8 + e;
      pkk[e] = p.rw_kk[cc]; pka[e] = p.rw_ka[cc]; prk[e] = p.rw_rk[cc];
    }
    __syncthreads();
    {
      const int c = tid & 63, rq = tid >> 6;
#pragma unroll
      for (int m = 0; m < 2; ++m) {
        const float* W2 = (m == 0 ? p.rw_w2 : p.rw_a2) + ((size_t)j * 2 + dir) * 64 * DI + h * 64 + c;
        float tmp[16];
#pragma unroll
        for (int e = 0; e < 16; ++e) tmp[e] = W2[(size_t)(rq * 16 + e) * DI];
        *(uint4*)(W2T + (m * 64 + c) * 72 + rq * 16) = pack8(tmp);
        *(uint4*)(W2T + (m * 64 + c) * 72 + rq * 16 + 8) = pack8(tmp + 8);
      }
    }
    const int mm = w >> 1, nh = w & 1;
    const float bias = (mm == 0 ? p.rw_w0 : p.rw_a0)[((size_t)j * 2 + dir) * DI + h * 64 + nh * 32 + (lane & 31)];
    float S0[8], S1[8];
#pragma unroll
    for (int e = 0; e < 8; ++e) { S0[e] = 0.f; S1[e] = 0.f; }
    uint4 gr, gk, gv, gl0, gl1;
    const int lmat = (tid & 7) >> 2, lcol = (tid & 3) * 16;
    auto gload = [&](int chunk) {
      const int pos = scan_pos(dir, chunk * RCH + ptau);
      const size_t tg = (size_t)bl * TT + pos;
      const size_t base = tg * DI + h * 64 + pc8;
      gr = *(const uint4*)(p.R + base); gk = *(const uint4*)(p.K + base); gv = *(const uint4*)(p.V + base);
      const bf16_t* lr = (lmat == 0 ? p.LRW : p.LRA) + tg * 128 + dir * 64 + lcol;
      gl0 = *(const uint4*)(lr); gl1 = *(const uint4*)(lr + 8);
    };
    gload(0);
    for (int chunk = 0; chunk < TT / RCH; ++chunk) {
      *(uint4*)(LRs + (lmat * RCH + ptau) * 72 + lcol) = gl0;
      *(uint4*)(LRs + (lmat * RCH + ptau) * 72 + lcol + 8) = gl1;
      lds_barrier();
      {
        f32x16 acc;
#pragma unroll
        for (int r = 0; r < 16; ++r) acc[r] = 0.f;
#pragma unroll
        for (int kk = 0; kk < 4; ++kk) {
          const bf16x8 af = *(const bf16x8*)(LRs + (mm * RCH + (lane & 31)) * 72 + kk * 16 + (lane >> 5) * 8);
          const bf16x8 bf = *(const bf16x8*)(W2T + (mm * 64 + nh * 32 + (lane & 31)) * 72 + kk * 16 + (lane >> 5) * 8);
          acc = __builtin_amdgcn_mfma_f32_32x32x16_bf16(af, bf, acc, 0, 0, 0);
        }
        float* dstm = (mm == 0 ? LWs : AAs) + nh * 32 + (lane & 31);
#pragma unroll
        for (int r = 0; r < 16; ++r) {
          const int t = (r & 3) + 8 * (r >> 2) + 4 * (lane >> 5);
          const float sg = sigmoidf_(acc[r] + bias);
          dstm[t * 64] = mm == 0 ? -0.60653066f * sg : sg;
        }
      }
      lds_barrier();
      {
        float r[8], k[8], v[8], lw[8], a[8];
        unpack8(gr, r); unpack8(gk, k); unpack8(gv, v);
#pragma unroll
        for (int e = 0; e < 8; ++e) { lw[e] = LWs[ptau * 64 + pc8 + e]; a[e] = AAs[ptau * 64 + pc8 + e]; }
        float kkv[8], ss = 0.f;
#pragma unroll
        for (int e = 0; e < 8; ++e) { kkv[e] = k[e] * pkk[e]; ss += kkv[e] * kkv[e]; }
        ss = red8(ss);
        const float inv = rsqrtf(fmaxf(ss, 1e-24f));
        float br = 0.f, kr = 0.f, bon = 0.f;
        float o0[8], o1[8], o2[8], o3[8], o4[8];
#pragma unroll
        for (int e = 0; e < 8; ++e) {
          const float kkn = kkv[e] * inv;
          const float wd = __expf(lw[e]);
          const float kd = k[e] * (1.f + (a[e] - 1.f) * pka[e]);
          const float bb = kkn * a[e];
          o0[e] = -kkn; o1[e] = wd * r[e]; o2[e] = wd; o3[e] = bb; o4[e] = kd;
          br += bb * r[e]; kr += kd * r[e]; bon += r[e] * kd * prk[e];
        }
        br = red8(br); kr = red8(kr); bon = red8(bon);
        float* od = op + ptau * 320 + pc8;
        *(float4*)(od) = make_float4(o0[0], o0[1], o0[2], o0[3]); *(float4*)(od + 4) = make_float4(o0[4], o0[5], o0[6], o0[7]);
        *(float4*)(od + 64) = make_float4(o1[0], o1[1], o1[2], o1[3]); *(float4*)(od + 68) = make_float4(o1[4], o1[5], o1[6], o1[7]);
        *(float4*)(od + 128) = make_float4(o2[0], o2[1], o2[2], o2[3]); *(float4*)(od + 132) = make_float4(o2[4], o2[5], o2[6], o2[7]);
        *(float4*)(od + 192) = make_float4(o3[0], o3[1], o3[2], o3[3]); *(float4*)(od + 196) = make_float4(o3[4], o3[5], o3[6], o3[7]);
        *(float4*)(od + 256) = make_float4(o4[0], o4[1], o4[2], o4[3]); *(float4*)(od + 260) = make_float4(o4[4], o4[5], o4[6], o4[7]);
        float* vd = vv + ptau * 64 + pc8;
        *(float4*)(vd) = make_float4(v[0], v[1], v[2], v[3]); *(float4*)(vd + 4) = make_float4(v[4], v[5], v[6], v[7]);
        if ((tid & 7) == 0) {
          sc[ptau * 2] = br; sc[ptau * 2 + 1] = kr;
          const int pos = scan_pos(dir, chunk * RCH + ptau);
          p.BN[((size_t)dir * NTG + (size_t)bl * TT + pos) * 32 + h] = bon;
        }
      }
      lds_barrier();
      if (chunk + 1 < TT / RCH) gload(chunk + 1);
#pragma unroll 2
      for (int tau = 0; tau < RCH; ++tau) {
        const float* o = op + tau * 320 + ko;
        const float4 n0 = *(const float4*)(o), n1 = *(const float4*)(o + 4);
        const float4 q0 = *(const float4*)(o + 64), q1 = *(const float4*)(o + 68);
        const float4 w0 = *(const float4*)(o + 128), w1 = *(const float4*)(o + 132);
        const float4 b0 = *(const float4*)(o + 192), b1 = *(const float4*)(o + 196);
        const float4 k0 = *(const float4*)(o + 256), k1 = *(const float4*)(o + 260);
        const float v0 = vv[tau * 64 + row0], v1 = vv[tau * 64 + row1];
        const float br = sc[tau * 2], kr = sc[tau * 2 + 1];
        const float nk[8] = {n0.x, n0.y, n0.z, n0.w, n1.x, n1.y, n1.z, n1.w};
        const float wr[8] = {q0.x, q0.y, q0.z, q0.w, q1.x, q1.y, q1.z, q1.w};
        const float wd[8] = {w0.x, w0.y, w0.z, w0.w, w1.x, w1.y, w1.z, w1.w};
        const float bb[8] = {b0.x, b0.y, b0.z, b0.w, b1.x, b1.y, b1.z, b1.w};
        const float kd[8] = {k0.x, k0.y, k0.z, k0.w, k1.x, k1.y, k1.z, k1.w};
        float d10 = 0.f, d11 = 0.f, d20 = 0.f, d21 = 0.f;
#pragma unroll
        for (int e = 0; e < 8; ++e) {
          d10 += S0[e] * nk[e]; d11 += S1[e] * nk[e];
          d20 += S0[e] * wr[e]; d21 += S1[e] * wr[e];
        }
        d10 = red8(d10); d11 = red8(d11); d20 = red8(d20); d21 = red8(d21);
        const float y0 = d20 + d10 * br + v0 * kr;
        const float y1 = d21 + d11 * br + v1 * kr;
#pragma unroll
        for (int e = 0; e < 8; ++e) {
          S0[e] = S0[e] * wd[e] + d10 * bb[e] + v0 * kd[e];
          S1[e] = S1[e] * wd[e] + d11 * bb[e] + v1 * kd[e];
        }
        if ((lane & 7) == 0) { yb[tau * 64 + row0] = y0; yb[tau * 64 + row1] = y1; }
      }
      lds_barrier();
      {
        const int pos = scan_pos(dir, chunk * RCH + ptau);
        const float* ys = yb + ptau * 64 + pc8;
        float yv[8];
#pragma unroll
        for (int e = 0; e < 8; ++e) yv[e] = ys[e];
        *(uint4*)(Y + ((size_t)bl * TT + pos) * DI + h * 64 + pc8) = pack8(yv);
      }
    }
    lds_barrier();
  }
}

__device__ __forceinline__ void phase_rw_gate(const Params& p, int j) {
  const int tid = opaque_tid(), h = tid >> 3;
  const int c0 = tid * 8;
  float lnw[8], lnb[8];
#pragma unroll
  for (int e = 0; e < 8; ++e) { lnw[e] = p.rw_lnw[j * DI + c0 + e]; lnb[e] = p.rw_lnb[j * DI + c0 + e]; }
  for (int tg = blockIdx.x; tg < NTG; tg += gridDim.x) {
    const size_t base = (size_t)tg * DI + c0;
    float yf[8], yb[8], v[8], z[8];
    unpack8(*(const uint4*)(p.YF + base), yf); unpack8(*(const uint4*)(p.YB + base), yb);
    unpack8(*(const uint4*)(p.V + base), v); unpack8(*(const uint4*)(p.Z + base), z);
    const float bon = p.BN[(size_t)tg * 32 + h] + p.BN[((size_t)NTG + tg) * 32 + h];
    float y[8], s = 0.f;
#pragma unroll
    for (int e = 0; e < 8; ++e) { y[e] = yf[e] + yb[e]; s += y[e]; }
    const float mu = red8(s) * (1.f / 64.f);
    float s2 = 0.f;
#pragma unroll
    for (int e = 0; e < 8; ++e) { y[e] -= mu; s2 += y[e] * y[e]; }
    const float rstd = rsqrtf(red8(s2) * (1.f / 64.f) + 64e-5f);
#pragma unroll
    for (int e = 0; e < 8; ++e) y[e] = (y[e] * rstd * lnw[e] + lnb[e] + bon * v[e]) * z[e];
    *(uint4*)(p.YF + base) = pack8(y);
  }
}

__device__ __forceinline__ void phase_out(const Params& p, const bf16_t* wo, char* smem) {
  for (int tile = blockIdx.x; tile < MT * 8; tile += gridDim.x) {
    const int mt = tile / 8, nt = tile % 8, m0 = mt * 256, n0 = nt * 128;
    const bf16_t* Bw = wo + (size_t)n0 * DI;
    gemm_tile<0>(p.YF, DI, nullptr, m0, DI, Bw, 128, smem,
                 [&](int row, int col, float* v) {
      float* o = p.O + (size_t)row * DM + n0 + col;
      *(float4*)o = make_float4(v[0], v[1], v[2], v[3]); *(float4*)(o + 4) = make_float4(v[4], v[5], v[6], v[7]); });
  }
}

__device__ __forceinline__ void phase_hg_proj(const Params& p, int j, char* smem) {
  for (int tile = blockIdx.x; tile < MT * 80; tile += gridDim.x) {
    const int mt = tile / 80, nt = tile % 80, m0 = mt * 256;
    const int seg = nt >> 4, n0 = (nt & 15) * 128;
    const bf16_t* Bw = g_wt + OFF_HWIN + ((size_t)j * 5 * DI + (size_t)seg * DI + n0) * DM;
    bf16_t* dst = seg == 0 ? p.R : (seg == 1 ? p.K : (seg == 2 ? p.WF : (seg == 3 ? p.V : p.Z)));
    if (seg == 0 || seg == 4) {
      gemm_tile<0>(p.H, DM, nullptr, m0, DM, Bw, 128, smem,
                   [&](int row, int col, float* v) {
#pragma unroll
        for (int e = 0; e < 8; ++e) v[e] = siluf_(v[e]);
        *(uint4*)(dst + (size_t)row * DI + n0 + col) = pack8(v); });
    } else {
      gemm_tile<0>(p.H, DM, nullptr, m0, DM, Bw, 128, smem,
                   [&](int row, int col, float* v) { *(uint4*)(dst + (size_t)row * DI + n0 + col) = pack8(v); });
    }
  }
}

constexpr int HC = 32;
constexpr int QS = 136;
constexpr int SS = 40;
__device__ __forceinline__ void phase_hg_scan(const Params& p, int layer, char* smem) {
  bf16_t* qe = (bf16_t*)smem;
  bf16_t* ke = qe + HC * QS;
  bf16_t* kdT = ke + HC * QS;
  bf16_t* vT = kdT + 128 * SS;
  bf16_t* att = vT + 64 * SS;
  bf16_t* ST = att + HC * SS;
  float* dC = (float*)(ST + 64 * QS);
  const int tid = opaque_tid(), lane = tid & 63, w = tid >> 6;
  for (int unit = blockIdx.x; unit < GB * 64; unit += gridDim.x) {
    const int vs = unit & 1, dir = (unit >> 1) & 1, h = (unit >> 2) & 15, bl = unit >> 6;
    const bf16_t* FL = dir == 0 ? p.K : p.WF;
    bf16_t* Y = dir == 0 ? p.YF : p.YB;
    const int st = lane & 31, cg = w * 2 + (lane >> 5), kb = cg * 16, vb = cg * 8;
    float lbv[16];
#pragma unroll
    for (int e = 0; e < 16; ++e) lbv[e] = p.LB[layer * DI + h * 128 + kb + e];
    f32x16 sacc[2];
#pragma unroll
    for (int r = 0; r < 16; ++r) { sacc[0][r] = 0.f; sacc[1][r] = 0.f; }
    __syncthreads();
    for (int idx = tid; idx < 64 * QS / 2; idx += 256) ((unsigned*)ST)[idx] = 0u;
    uint4 gq0, gq1, gf0, gf1, gvv;
    auto gload = [&](int chunk) {
      const int pos = scan_pos(dir, chunk * HC + st);
      const size_t base = ((size_t)bl * TT + pos) * DI + h * 128;
      gq0 = *(const uint4*)(p.R + base + kb); gq1 = *(const uint4*)(p.R + base + kb + 8);
      gf0 = *(const uint4*)(FL + base + kb); gf1 = *(const uint4*)(FL + base + kb + 8);
      gvv = *(const uint4*)(p.V + base + vs * 64 + vb);
    };
    gload(0);
    for (int chunk = 0; chunk < TT / HC; ++chunk) {
      float q[16], cum[16], one[16];
      {
        float fl[16];
        unpack8(gq0, q); unpack8(gq1, q + 8); unpack8(gf0, fl); unpack8(gf1, fl + 8);
#pragma unroll
        for (int e = 0; e < 16; ++e) {
          const float f = lbv[e] + (1.f - lbv[e]) * sigmoidf_(fl[e]);
          one[e] = 1.f - f;
          cum[e] = __logf(f);
        }
#pragma unroll
        for (int d = 1; d < 32; d <<= 1) {
#pragma unroll
          for (int e = 0; e < 16; ++e) {
            const float tmp = __shfl_up(cum[e], d, 32);
            if (st >= d) cum[e] += tmp;
          }
        }
      }
      const uint4 vreg = gvv;
      lds_barrier();
      {
        float qo[16], ko[16];
#pragma unroll
        for (int e = 0; e < 16; ++e) {
          const float cC = __shfl(cum[e], 31, 32);
          const float ec = __expf(fmaxf(cum[e], -80.f));
          const float inv = 1.f / ec;
          const float eC = __expf(cC);
          qo[e] = q[e] * ec;
          ko[e] = one[e] * inv;
          kdT[(kb + e) * SS + st] = f2bf(one[e] * inv * eC);
          if (st == 31) dC[kb + e] = eC;
        }
        *(uint4*)(qe + st * QS + kb) = pack8(qo); *(uint4*)(qe + st * QS + kb + 8) = pack8(qo + 8);
        *(uint4*)(ke + st * QS + kb) = pack8(ko); *(uint4*)(ke + st * QS + kb + 8) = pack8(ko + 8);
        const bf16_t* vp = (const bf16_t*)&vreg;
#pragma unroll
        for (int e = 0; e < 8; ++e) vT[(vb + e) * SS + st] = vp[e];
      }
      lds_barrier();
      if (chunk + 1 < TT / HC) gload(chunk + 1);
      {
        const int mi = w >> 1, ni = w & 1;
        f32x4 a4 = {0.f, 0.f, 0.f, 0.f};
#pragma unroll
        for (int kk = 0; kk < 4; ++kk) {
          const bf16x8 af = *(const bf16x8*)(qe + (mi * 16 + (lane & 15)) * QS + kk * 32 + (lane >> 4) * 8);
          const bf16x8 bf = *(const bf16x8*)(ke + (ni * 16 + (lane & 15)) * QS + kk * 32 + (lane >> 4) * 8);
          a4 = __builtin_amdgcn_mfma_f32_16x16x32_bf16(af, bf, a4, 0, 0, 0);
        }
        const int s = ni * 16 + (lane & 15);
#pragma unroll
        for (int r = 0; r < 4; ++r) {
          const int t = mi * 16 + (lane >> 4) * 4 + r;
          att[t * SS + s] = f2bf(s <= t ? a4[r] : 0.f);
        }
      }
      lds_barrier();
      {
#pragma unroll
        for (int mh = 0; mh < 2; ++mh) {
          f32x4 y4 = {0.f, 0.f, 0.f, 0.f};
          {
            const bf16x8 af = *(const bf16x8*)(att + (mh * 16 + (lane & 15)) * SS + (lane >> 4) * 8);
            const bf16x8 bf = *(const bf16x8*)(vT + (w * 16 + (lane & 15)) * SS + (lane >> 4) * 8);
            y4 = __builtin_amdgcn_mfma_f32_16x16x32_bf16(af, bf, y4, 0, 0, 0);
          }
#pragma unroll
          for (int kk = 0; kk < 4; ++kk) {
            const bf16x8 af = *(const bf16x8*)(qe + (mh * 16 + (lane & 15)) * QS + kk * 32 + (lane >> 4) * 8);
            const bf16x8 bf = *(const bf16x8*)(ST + (w * 16 + (lane & 15)) * QS + kk * 32 + (lane >> 4) * 8);
            y4 = __builtin_amdgcn_mfma_f32_16x16x32_bf16(af, bf, y4, 0, 0, 0);
          }
#pragma unroll
          for (int r = 0; r < 4; ++r) {
            const int t = mh * 16 + (lane >> 4) * 4 + r;
            const int pos = scan_pos(dir, chunk * HC + t);
            Y[((size_t)bl * TT + pos) * DI + h * 128 + vs * 64 + w * 16 + (lane & 15)] = f2bf(y4[r]);
          }
        }
      }
      lds_barrier();
      {
        float dk[16];
#pragma unroll
        for (int r = 0; r < 16; ++r) dk[r] = dC[w * 32 + (r & 3) + 8 * (r >> 2) + 4 * (lane >> 5)];
#pragma unroll
        for (int nt = 0; nt < 2; ++nt) {
#pragma unroll
          for (int r = 0; r < 16; ++r) sacc[nt][r] *= dk[r];
#pragma unroll
          for (int ks = 0; ks < 2; ++ks) {
            const bf16x8 af = *(const bf16x8*)(kdT + (w * 32 + (lane & 31)) * SS + ks * 16 + (lane >> 5) * 8);
            const bf16x8 bf = *(const bf16x8*)(vT + (nt * 32 + (lane & 31)) * SS + ks * 16 + (lane >> 5) * 8);
            sacc[nt] = __builtin_amdgcn_mfma_f32_32x32x16_bf16(af, bf, sacc[nt], 0, 0, 0);
          }
#pragma unroll
          for (int gq = 0; gq < 4; ++gq) {
            uint2 u;
            u.x = pack2(sacc[nt][gq * 4 + 0], sacc[nt][gq * 4 + 1]);
            u.y = pack2(sacc[nt][gq * 4 + 2], sacc[nt][gq * 4 + 3]);
            *(uint2*)(ST + (nt * 32 + (lane & 31)) * QS + w * 32 + gq * 8 + (lane >> 5) * 4) = u;
          }
        }
      }
    }
    lds_barrier();
  }
}

__device__ __forceinline__ void phase_hg_gate(const Params& p, int j) {
  const int tid = opaque_tid();
  const int c0 = tid * 8;
  float gn[8];
#pragma unroll
  for (int e = 0; e < 8; ++e) gn[e] = p.hg_gn[j * 128 + ((c0 + e) & 127)];
  for (int tg = blockIdx.x; tg < NTG; tg += gridDim.x) {
    const size_t base = (size_t)tg * DI + c0;
    float yf[8], yb[8], z[8];
    unpack8(*(const uint4*)(p.YF + base), yf); unpack8(*(const uint4*)(p.YB + base), yb);
    unpack8(*(const uint4*)(p.Z + base), z);
    float y[8], s2 = 0.f;
#pragma unroll
    for (int e = 0; e < 8; ++e) { y[e] = yf[e] + yb[e]; s2 += y[e] * y[e]; }
    const float rstd = rsqrtf(red16(s2) * (1.f / 128.f) + EPS);
#pragma unroll
    for (int e = 0; e < 8; ++e) y[e] = y[e] * rstd * gn[e] * z[e];
    *(uint4*)(p.YF + base) = pack8(y);
  }
}

__global__ void __launch_bounds__(256) fwd_megakernel(Params p) {
  cg::grid_group grid = cg::this_grid();
  __shared__ __attribute__((aligned(16))) char smem[120 * 1024];
  phase_mod(p, smem);
  phase_wconv(p, smem);
  grid.sync();
  for (int g = 0; g < NG; ++g) {
    for (int layer = 0; layer < 4; ++layer) {
      phase_resnorm(p, g, layer - 1, layer);
      grid.sync();
      const int j = layer >> 1;
      if ((layer & 1) == 0) {
        phase_rw_proj(p, j, smem);
        grid.sync();
        if (j == 1) { phase_rw_lr2(p, j, smem); grid.sync(); }
        phase_rw_scan(p, j, smem);
        grid.sync();
        phase_rw_gate(p, j);
        grid.sync();
        phase_out(p, g_wt + OFF_RWO + (size_t)j * DM * DI, smem);
        grid.sync();
      } else {
        phase_hg_proj(p, j, smem);
        grid.sync();
        phase_hg_scan(p, layer, smem);
        grid.sync();
        phase_hg_gate(p, j);
        grid.sync();
        phase_out(p, g_wt + OFF_HWO + (size_t)j * DM * DI, smem);
        grid.sync();
      }
    }
    phase_resnorm(p, g, 3, -1);
    grid.sync();
  }
}

extern "C" void kernel_launch(void* const* d_in, const int* in_sizes, int n_in, void* d_out, int out_size, void* d_ws,
                              size_t ws_size, hipStream_t stream) {
  static int grid_blocks = 0;
  if (!grid_blocks) {
    int dev = 0, cus = 0, per_cu = 0;
    hipGetDevice(&dev);
    hipDeviceGetAttribute(&cus, hipDeviceAttributeMultiprocessorCount, dev);
    hipOccupancyMaxActiveBlocksPerMultiprocessor(&per_cu, fwd_megakernel, 256, 0);
    if (per_cu > 1) per_cu = 1;
    grid_blocks = cus * per_cu;
  }
  Params p{};
  const float** fp = (const float**)&p;
  for (int i = 0; i < 29; ++i) fp[i] = (const float*)d_in[i];
  p.out = (float*)d_out;
  char* w = (char*)d_ws;
  size_t off = 0;
  auto take = [&](size_t bytes) { char* r = w + off; off += (bytes + 255) & ~(size_t)255; return r; };
  const size_t DIW = (size_t)NTG * DI * 2;
  p.R = (bf16_t*)take(DIW); p.K = (bf16_t*)take(DIW); p.V = (bf16_t*)take(DIW); p.Z = (bf16_t*)take(DIW);
  p.WF = (bf16_t*)take(DIW); p.YF = (bf16_t*)take(DIW); p.YB = (bf16_t*)take(DIW);
  p.VF = p.YF;
  p.H = p.YB; p.H0 = p.YB + (size_t)NTG * DM;
  p.LRW = (bf16_t*)take((size_t)NTG * 128 * 2); p.LRA = (bf16_t*)take((size_t)NTG * 128 * 2);
  p.LRV = (bf16_t*)take((size_t)NTG * 32 * 2);
  p.O = (float*)p.R;
  p.BN = (float*)take((size_t)2 * NTG * 32 * 4);
  p.CTXB = (float*)take((size_t)NB * CTX * DM * 4);
  p.MODV = (float*)take((size_t)4 * 9 * 3 * DM * 4);
  p.LB = (float*)take((size_t)4 * DI * 4);
  if (off > ws_size) { fprintf(stderr, "workspace too small: need %zu have %zu\n", off, ws_size); return; }
  void* args[] = {&p};
  hipError_t e = hipLaunchCooperativeKernel((void*)fwd_megakernel, dim3(grid_blocks), dim3(256), args, 0, stream);
  if (e != hipSuccess) fprintf(stderr, "cooperative launch failed: %s (grid %d)\n", hipGetErrorString(e), grid_blocks);
}
```

```cpp
#include <hip/hip_runtime.h>
#include <hip/hip_cooperative_groups.h>
#include <cstdio>
#include <cstdint>
namespace cg = cooperative_groups;

typedef unsigned short bf16_t;
using bf16x8 = __attribute__((ext_vector_type(8))) short;
using f32x16 = __attribute__((ext_vector_type(16))) float;
using f32x4 = __attribute__((ext_vector_type(4))) float;
using f2_t = __attribute__((ext_vector_type(2))) float;

constexpr int NB = 8, SEQ = 4096, CTX = 256, TT = 4352, DM = 1024, DI = 2048;
constexpr int GB = 4, NG = NB / GB, NTG = GB * TT;
constexpr int MT = NTG / 256;
constexpr float EPS = 1e-6f;

constexpr size_t OFF_PROJ = 0;
constexpr size_t OFF_RWO = OFF_PROJ + (size_t)2 * 4 * DI * DM;
constexpr size_t OFF_W1 = OFF_RWO + (size_t)2 * DM * DI;
constexpr size_t OFF_A1 = OFF_W1 + (size_t)2 * 128 * DM;
constexpr size_t OFF_V1 = OFF_A1 + (size_t)2 * 128 * DM;
constexpr size_t OFF_V2 = OFF_V1 + (size_t)32 * DM;
constexpr size_t OFF_HWIN = OFF_V2 + (size_t)DI * 32;
constexpr size_t OFF_HWO = OFF_HWIN + (size_t)2 * 5 * DI * DM;
constexpr size_t WT_TOTAL = OFF_HWO + (size_t)2 * DM * DI;
__device__ bf16_t g_wt[WT_TOTAL];

struct Params {
  const float *x, *c, *ctx, *c_ctx, *mod_w, *mod_b, *pre_g, *post_g, *rw_mix, *rw_proj, *rw_wo, *rw_w0, *rw_w1,
      *rw_w2, *rw_a0, *rw_a1, *rw_a2, *rw_v0, *rw_v1, *rw_v2, *rw_kk, *rw_ka, *rw_rk, *rw_lnw, *rw_lnb, *hg_win,
      *hg_wo, *hg_gn, *hg_lb;
  float* out;
  bf16_t *R, *K, *V, *Z, *WF, *YF, *YB, *VF, *H, *H0, *LRW, *LRA, *LRV;
  float *O, *BN, *CTXB, *MODV, *LB;
};

typedef __bf16 hwbf2_t __attribute__((ext_vector_type(2)));
typedef float hwf2_t __attribute__((ext_vector_type(2)));
__device__ __forceinline__ unsigned pack2(float a, float b) {
  hwf2_t f = {a, b};
  hwbf2_t h = __builtin_convertvector(f, hwbf2_t);
  return __builtin_bit_cast(unsigned, h);
}
__device__ __forceinline__ bf16_t f2bf(float f) { return (bf16_t)(pack2(f, f) & 0xffffu); }
__device__ __forceinline__ float bf2f(bf16_t h) { return __uint_as_float(((unsigned)h) << 16); }
__device__ __forceinline__ float lo2f(unsigned u) { return __uint_as_float(u << 16); }
__device__ __forceinline__ float hi2f(unsigned u) { return __uint_as_float(u & 0xffff0000u); }
__device__ __forceinline__ float sigmoidf_(float x) { return 1.f / (1.f + __expf(-x)); }
__device__ __forceinline__ float siluf_(float x) { return x / (1.f + __expf(-x)); }

__device__ __forceinline__ void lds_barrier() { asm volatile("s_waitcnt lgkmcnt(0)\n\ts_barrier" ::: "memory"); }

__device__ __forceinline__ int opaque_tid() { int t = threadIdx.x; asm volatile("" : "+v"(t)); return t; }

template <int CTRL>
__device__ __forceinline__ float dppf(float v) {
  return __int_as_float(__builtin_amdgcn_update_dpp(0, __float_as_int(v), CTRL, 0xf, 0xf, true));
}
__device__ __forceinline__ float red4(float v) { v += dppf<0xB1>(v); v += dppf<0x4E>(v); return v; }
__device__ __forceinline__ float red8(float v) { v = red4(v); v += dppf<0x141>(v); return v; }
__device__ __forceinline__ float red16(float v) { v = red8(v); v += dppf<0x140>(v); return v; }
__device__ __forceinline__ float red64(float v) {
  v = red16(v);
  v += __shfl_xor(v, 16);
  v += __shfl_xor(v, 32);
  return v;
}

__device__ __forceinline__ void unpack8(const uint4& u, float* f) {
  f[0] = lo2f(u.x); f[1] = hi2f(u.x); f[2] = lo2f(u.y); f[3] = hi2f(u.y);
  f[4] = lo2f(u.z); f[5] = hi2f(u.z); f[6] = lo2f(u.w); f[7] = hi2f(u.w);
}
__device__ __forceinline__ uint4 pack8(const float* f) {
  uint4 u; u.x = pack2(f[0], f[1]); u.y = pack2(f[2], f[3]); u.z = pack2(f[4], f[5]); u.w = pack2(f[6], f[7]);
  return u;
}

__device__ __forceinline__ const float* row_in(const Params& p, int b, int t) {
  return t < CTX ? p.ctx + ((size_t)b * CTX + t) * DM : p.x + ((size_t)b * SEQ + (t - CTX)) * DM;
}
__device__ __forceinline__ float* row_cur(const Params& p, int b, int t) {
  return t < CTX ? p.CTXB + ((size_t)b * CTX + t) * DM : p.out + ((size_t)b * SEQ + (t - CTX)) * DM;
}

__device__ __forceinline__ void phase_mod(const Params& p, char* smem) {
  float* red = (float*)smem;
  const int tid = opaque_tid(), cl = tid & 63, kp = tid >> 6;
  for (int task = blockIdx.x; task < 4 * 48; task += gridDim.x) {
    const int l = task / 48, col = (task % 48) * 64 + cl;
    float acc[9];
#pragma unroll
    for (int r = 0; r < 9; ++r) acc[r] = 0.f;
    const float* W = p.mod_w + (size_t)l * DM * 3 * DM + col;
    for (int k = kp * 256; k < kp * 256 + 256; ++k) {
      const float w = W[(size_t)k * 3 * DM];
#pragma unroll
      for (int r = 0; r < 9; ++r) {
        const float cv = r < 8 ? p.c[r * DM + k] : p.c_ctx[k];
        acc[r] += siluf_(cv) * w;
      }
    }
    __syncthreads();
#pragma unroll
    for (int r = 0; r < 9; ++r) red[(kp * 9 + r) * 64 + cl] = acc[r];
    __syncthreads();
    for (int idx = tid; idx < 9 * 64; idx += 256) {
      const int r = idx >> 6, c2 = idx & 63;
      float s = 0.f;
      for (int q = 0; q < 4; ++q) s += red[(q * 9 + r) * 64 + c2];
      const int cc = (task % 48) * 64 + c2;
      p.MODV[((size_t)l * 9 + r) * 3 * DM + cc] = s + p.mod_b[l * 3 * DM + cc];
    }
  }
  for (int cidx = blockIdx.x * 256 + tid; cidx < DI; cidx += gridDim.x * 256) {
    float v[4], m = -1e30f;
    for (int l = 0; l < 4; ++l) { v[l] = p.hg_lb[l * DI + cidx]; m = fmaxf(m, v[l]); }
    float s = 0.f;
    for (int l = 0; l < 4; ++l) { v[l] = __expf(v[l] - m); s += v[l]; }
    float cum = 0.f;
    for (int l = 0; l < 4; ++l) { cum += v[l] / s; p.LB[l * DI + cidx] = cum - v[0] / s; }
  }
}

__device__ __forceinline__ void conv_matrix(const float* __restrict__ src, int K, int N, bf16_t* __restrict__ dst, char* smem) {
  float* ts = (float*)smem;
  const int tid = opaque_tid();
  const int ntn = N / 32, ntile = (K / 64) * ntn;
  for (int tile = blockIdx.x; tile < ntile; tile += gridDim.x) {
    const int k0 = (tile / ntn) * 64, n0 = (tile % ntn) * 32;
    __syncthreads();
#pragma unroll
    for (int i = 0; i < 2; ++i) {
      const int k = (tid >> 3) + 32 * i, n4 = (tid & 7) * 4;
      const float4 v = *(const float4*)(src + (size_t)(k0 + k) * N + n0 + n4);
      ts[k * 33 + n4 + 0] = v.x; ts[k * 33 + n4 + 1] = v.y; ts[k * 33 + n4 + 2] = v.z; ts[k * 33 + n4 + 3] = v.w;
    }
    __syncthreads();
    const int n = tid >> 3, k8 = (tid & 7) * 8;
    float f[8];
#pragma unroll
    for (int e = 0; e < 8; ++e) f[e] = ts[(k8 + e) * 33 + n];
    *(uint4*)(dst + (size_t)(n0 + n) * K + k0 + k8) = pack8(f);
  }
}
__device__ __forceinline__ void phase_wconv(const Params& p, char* smem) {
  for (int m = 0; m < 8; ++m) conv_matrix(p.rw_proj + (size_t)m * DM * DI, DM, DI, g_wt + OFF_PROJ + (size_t)m * DI * DM, smem);
  for (int j = 0; j < 2; ++j) conv_matrix(p.rw_wo + (size_t)j * DI * DM, DI, DM, g_wt + OFF_RWO + (size_t)j * DM * DI, smem);
  for (int m = 0; m < 4; ++m) {
    conv_matrix(p.rw_w1 + (size_t)m * DM * 64, DM, 64, g_wt + OFF_W1 + (size_t)m * 64 * DM, smem);
    conv_matrix(p.rw_a1 + (size_t)m * DM * 64, DM, 64, g_wt + OFF_A1 + (size_t)m * 64 * DM, smem);
  }
  conv_matrix(p.rw_v1, DM, 32, g_wt + OFF_V1, smem);
  for (int j = 0; j < 2; ++j) conv_matrix(p.hg_win + (size_t)j * DM * 5 * DI, DM, 5 * DI, g_wt + OFF_HWIN + (size_t)j * 5 * DI * DM, smem);
  for (int j = 0; j < 2; ++j) conv_matrix(p.hg_wo + (size_t)j * DI * DM, DI, DM, g_wt + OFF_HWO + (size_t)j * DM * DI, smem);
  for (int idx = blockIdx.x * 256 + opaque_tid(); idx < DI * 32; idx += gridDim.x * 256) {
    const int n = idx >> 5, k = idx & 31;
    g_wt[OFF_V2 + idx] = f2bf(p.rw_v2[(size_t)k * DI + n]);
  }
}

__device__ __forceinline__ void phase_resnorm(const Params& p, int g, int lu, int ln) {
  const int tid = opaque_tid();
  const int lane = tid & 63;
  const int wv = blockIdx.x * 4 + (tid >> 6), nw = gridDim.x * 4;
  for (int tg = wv; tg < NTG; tg += nw) {
    const int bl = tg / TT, t = tg % TT, b = g * GB + bl;
    const bool isctx = t < CTX;
    const int mrow = isctx ? 8 : b;
    float xv[16];
    const float* src = (lu <= 0) ? row_in(p, b, t) : row_cur(p, b, t);
#pragma unroll
    for (int j = 0; j < 4; ++j) {
      const float4 v4 = *(const float4*)(src + j * 256 + lane * 4);
      xv[j * 4 + 0] = v4.x; xv[j * 4 + 1] = v4.y; xv[j * 4 + 2] = v4.z; xv[j * 4 + 3] = v4.w;
    }
    if (lu >= 0 && !(isctx && lu == 3)) {
      float ov[16], ss = 0.f;
      const float* orow = p.O + (size_t)tg * DM;
#pragma unroll
      for (int j = 0; j < 4; ++j) {
        const float4 v4 = *(const float4*)(orow + j * 256 + lane * 4);
        ov[j * 4 + 0] = v4.x; ov[j * 4 + 1] = v4.y; ov[j * 4 + 2] = v4.z; ov[j * 4 + 3] = v4.w;
      }
#pragma unroll
      for (int e = 0; e < 16; ++e) ss += ov[e] * ov[e];
      ss = red64(ss);
      const float rstd = rsqrtf(ss * (1.f / DM) + EPS);
      const float* gate = p.MODV + ((size_t)lu * 9 + mrow) * 3 * DM + 2 * DM;
      const float* pg = p.post_g + lu * DM;
      float* dst = row_cur(p, b, t);
#pragma unroll
      for (int j = 0; j < 4; ++j) {
        const int cc = j * 256 + lane * 4;
        const float4 g4 = *(const float4*)(gate + cc);
        const float4 p4 = *(const float4*)(pg + cc);
        xv[j * 4 + 0] += g4.x * (ov[j * 4 + 0] * rstd * p4.x);
        xv[j * 4 + 1] += g4.y * (ov[j * 4 + 1] * rstd * p4.y);
        xv[j * 4 + 2] += g4.z * (ov[j * 4 + 2] * rstd * p4.z);
        xv[j * 4 + 3] += g4.w * (ov[j * 4 + 3] * rstd * p4.w);
        *(float4*)(dst + cc) = make_float4(xv[j * 4 + 0], xv[j * 4 + 1], xv[j * 4 + 2], xv[j * 4 + 3]);
      }
    }
    if (ln >= 0) {
      for (int pass = 0; pass < (ln == 2 ? 2 : 1); ++pass) {
        const int lp = pass == 0 ? ln : 0;
        bf16_t* hdst = (pass == 0 ? p.H : p.H0) + (size_t)tg * DM;
        if (pass == 1) {
          const float* s0 = row_in(p, b, t);
#pragma unroll
          for (int j = 0; j < 4; ++j) {
            const float4 v4 = *(const float4*)(s0 + j * 256 + lane * 4);
            xv[j * 4 + 0] = v4.x; xv[j * 4 + 1] = v4.y; xv[j * 4 + 2] = v4.z; xv[j * 4 + 3] = v4.w;
          }
        }
        float ss = 0.f;
#pragma unroll
        for (int e = 0; e < 16; ++e) ss += xv[e] * xv[e];
        ss = red64(ss);
        const float rstd = rsqrtf(ss * (1.f / DM) + EPS);
        const float* mv = p.MODV + ((size_t)lp * 9 + mrow) * 3 * DM;
        const float* pg = p.pre_g + lp * DM;
#pragma unroll
        for (int j = 0; j < 4; ++j) {
          const int cc = j * 256 + lane * 4;
          const float4 sh = *(const float4*)(mv + cc);
          const float4 sc = *(const float4*)(mv + DM + cc);
          const float4 p4 = *(const float4*)(pg + cc);
          const float h0 = xv[j * 4 + 0] * rstd * p4.x * (1.f + sc.x) + sh.x;
          const float h1 = xv[j * 4 + 1] * rstd * p4.y * (1.f + sc.y) + sh.y;
          const float h2 = xv[j * 4 + 2] * rstd * p4.z * (1.f + sc.z) + sh.z;
          const float h3 = xv[j * 4 + 3] * rstd * p4.w * (1.f + sc.w) + sh.w;
          uint2 u; u.x = pack2(h0, h1); u.y = pack2(h2, h3);
          *(uint2*)(hdst + cc) = u;
        }
      }
    }
  }
}

constexpr int LDK = 72;
constexpr int TM = 256;

template <int AMODE, class Epi>
__device__ __forceinline__ void gemm_tile(const bf16_t* __restrict__ A, int lda, const float* __restrict__ mix, int m0,
                                          int K, const bf16_t* __restrict__ Bt, int nvalid, char* smem, Epi epi) {
  bf16_t* As = (bf16_t*)smem;
  bf16_t* Bs = As + 2 * TM * LDK;
  float* mixs = (float*)(Bs + 2 * 128 * LDK);
  const int tid = opaque_tid(), lane = tid & 63, w = tid >> 6, wm = w >> 1, wn = w & 1;
  const int lr = lane >> 3, ch = (lane & 7) * 8;
  const int arow0 = w * 64 + lr, brow0 = w * 32 + lr;
  const bf16_t* Ap = A + (size_t)(m0 + arow0) * lda + ch;
  const bf16_t* Bp = Bt + (size_t)brow0 * K + ch;
  const size_t astep = (size_t)8 * lda, bstep = (size_t)8 * K;
  const int KT = (K + 63) >> 6;
  const int tbase = m0 % TT;
  const bool isctx = tbase < CTX;
  unsigned vmask = 0;
  if (AMODE == 1) {
#pragma unroll
    for (int i = 0; i < 8; ++i) {
      const int t = tbase + arow0 + i * 8;
      unsigned m;
      if (isctx) {
        m = (t >= 1 ? 3u : 0u) | (t + 1 < CTX ? 12u : 0u);
      } else {
        const int tl = t - CTX, row = tl >> 6, col = tl & 63;
        m = (col > 0 ? 1u : 0u) | (col < 63 ? 2u : 0u) | (row > 0 ? 4u : 0u) | (row < 63 ? 8u : 0u);
      }
      vmask |= m << (4 * i);
    }
  }

  __syncthreads();
  if (AMODE == 1) *(float4*)(mixs + tid * 4) = *(const float4*)(mix + tid * 4);

  f32x16 acc[4][2];
#pragma unroll
  for (int i = 0; i < 4; ++i)
#pragma unroll
    for (int j = 0; j < 2; ++j)
#pragma unroll
      for (int r = 0; r < 16; ++r) acc[i][j][r] = 0.f;

  uint4 a0, a1, a2, a3, a4, a5, a6, a7, n0, n1, n2, n3, n4, n5, n6, n7, b0, b1, b2, b3;
  auto load_regs = [&](int kt) {
    const int k0 = kt * 64;
    const uint4 z4 = make_uint4(0, 0, 0, 0);
    const bool kval = (k0 + ch) < K;
    const bf16_t* ap = Ap + k0;
    const bf16_t* bp = Bp + k0;
    a0 = z4; if (kval) a0 = *(const uint4*)(ap + 0 * astep);
    a1 = z4; if (kval) a1 = *(const uint4*)(ap + 1 * astep);
    a2 = z4; if (kval) a2 = *(const uint4*)(ap + 2 * astep);
    a3 = z4; if (kval) a3 = *(const uint4*)(ap + 3 * astep);
    a4 = z4; if (kval) a4 = *(const uint4*)(ap + 4 * astep);
    a5 = z4; if (kval) a5 = *(const uint4*)(ap + 5 * astep);
    a6 = z4; if (kval) a6 = *(const uint4*)(ap + 6 * astep);
    a7 = z4; if (kval) a7 = *(const uint4*)(ap + 7 * astep);
    b0 = z4; if (kval && (brow0 + 0) < nvalid) b0 = *(const uint4*)(bp + 0 * bstep);
    b1 = z4; if (kval && (brow0 + 8) < nvalid) b1 = *(const uint4*)(bp + 1 * bstep);
    b2 = z4; if (kval && (brow0 + 16) < nvalid) b2 = *(const uint4*)(bp + 2 * bstep);
    b3 = z4; if (kval && (brow0 + 24) < nvalid) b3 = *(const uint4*)(bp + 3 * bstep);
    if (AMODE == 1) {
      const int q = k0 >> 8;
      const int nb = isctx ? (q < 2 ? -1 : 1) : (q == 0 ? -1 : (q == 1 ? 1 : (q == 2 ? -64 : 64)));
      const bf16_t* np = ap + (ptrdiff_t)nb * lda;
      const unsigned vm = vmask >> q;
      n0 = z4; if ((vm >> 0) & 1u) n0 = *(const uint4*)(np + 0 * astep);
      n1 = z4; if ((vm >> 4) & 1u) n1 = *(const uint4*)(np + 1 * astep);
      n2 = z4; if ((vm >> 8) & 1u) n2 = *(const uint4*)(np + 2 * astep);
      n3 = z4; if ((vm >> 12) & 1u) n3 = *(const uint4*)(np + 3 * astep);
      n4 = z4; if ((vm >> 16) & 1u) n4 = *(const uint4*)(np + 4 * astep);
      n5 = z4; if ((vm >> 20) & 1u) n5 = *(const uint4*)(np + 5 * astep);
      n6 = z4; if ((vm >> 24) & 1u) n6 = *(const uint4*)(np + 6 * astep);
      n7 = z4; if ((vm >> 28) & 1u) n7 = *(const uint4*)(np + 7 * astep);
    }
  };
  auto mix8 = [&](const uint4& hv, const uint4& nv, const float4& ma, const float4& mb) -> uint4 {
    float h[8], n[8];
    unpack8(hv, h); unpack8(nv, n);
    h[0] += (n[0] - h[0]) * ma.x; h[1] += (n[1] - h[1]) * ma.y; h[2] += (n[2] - h[2]) * ma.z; h[3] += (n[3] - h[3]) * ma.w;
    h[4] += (n[4] - h[4]) * mb.x; h[5] += (n[5] - h[5]) * mb.y; h[6] += (n[6] - h[6]) * mb.z; h[7] += (n[7] - h[7]) * mb.w;
    return pack8(h);
  };
  auto store_lds = [&](int kt, int buf) {
    bf16_t* ad = As + (buf * TM + arow0) * LDK + ch;
    bf16_t* bd = Bs + (buf * 128 + brow0) * LDK + ch;
    if (AMODE == 1) {
      const float4 ma = *(const float4*)(mixs + kt * 64 + ch), mb = *(const float4*)(mixs + kt * 64 + ch + 4);
      *(uint4*)(ad + 0 * LDK) = mix8(a0, n0, ma, mb);
      *(uint4*)(ad + 8 * LDK) = mix8(a1, n1, ma, mb);
      *(uint4*)(ad + 16 * LDK) = mix8(a2, n2, ma, mb);
      *(uint4*)(ad + 24 * LDK) = mix8(a3, n3, ma, mb);
      *(uint4*)(ad + 32 * LDK) = mix8(a4, n4, ma, mb);
      *(uint4*)(ad + 40 * LDK) = mix8(a5, n5, ma, mb);
      *(uint4*)(ad + 48 * LDK) = mix8(a6, n6, ma, mb);
      *(uint4*)(ad + 56 * LDK) = mix8(a7, n7, ma, mb);
    } else {
      *(uint4*)(ad + 0 * LDK) = a0;
      *(uint4*)(ad + 8 * LDK) = a1;
      *(uint4*)(ad + 16 * LDK) = a2;
      *(uint4*)(ad + 24 * LDK) = a3;
      *(uint4*)(ad + 32 * LDK) = a4;
      *(uint4*)(ad + 40 * LDK) = a5;
      *(uint4*)(ad + 48 * LDK) = a6;
      *(uint4*)(ad + 56 * LDK) = a7;
    }
    *(uint4*)(bd + 0 * LDK) = b0;
    *(uint4*)(bd + 8 * LDK) = b1;
    *(uint4*)(bd + 16 * LDK) = b2;
    *(uint4*)(bd + 24 * LDK) = b3;
  };
  auto compute = [&](int buf) {
    const bf16_t* ab = As + (buf * TM + wm * 128 + (lane & 31)) * LDK + (lane >> 5) * 8;
    const bf16_t* bb = Bs + (buf * 128 + wn * 64 + (lane & 31)) * LDK + (lane >> 5) * 8;
#pragma unroll
    for (int kk = 0; kk < 4; ++kk) {
      const bf16x8 bf0 = *(const bf16x8*)(bb + kk * 16), bf1 = *(const bf16x8*)(bb + 32 * LDK + kk * 16);
#pragma unroll
      for (int i = 0; i < 4; ++i) {
        const bf16x8 af = *(const bf16x8*)(ab + i * 32 * LDK + kk * 16);
        acc[i][0] = __builtin_amdgcn_mfma_f32_32x32x16_bf16(af, bf0, acc[i][0], 0, 0, 0);
        acc[i][1] = __builtin_amdgcn_mfma_f32_32x32x16_bf16(af, bf1, acc[i][1], 0, 0, 0);
      }
    }
  };
  load_regs(0);
  lds_barrier();
  store_lds(0, 0);
  if (KT > 1) load_regs(1);
  lds_barrier();
  for (int kt = 0; kt < KT; ++kt) {
    if (kt + 1 < KT) store_lds(kt + 1, (kt + 1) & 1);
    if (kt + 2 < KT) load_regs(kt + 2);
    compute(kt & 1);
    lds_barrier();
  }
  float* Cs = (float*)smem;
  for (int hh = 0; hh < 2; ++hh) {
    if (hh == 1) lds_barrier();
    if (wm == hh) {
#pragma unroll
      for (int i = 0; i < 4; ++i)
#pragma unroll
        for (int j = 0; j < 2; ++j)
#pragma unroll
          for (int r = 0; r < 16; ++r)
            Cs[(i * 32 + (r & 3) + 8 * (r >> 2) + 4 * (lane >> 5)) * 132 + wn * 64 + j * 32 + (lane & 31)] = acc[i][j][r];
    }
    lds_barrier();
#pragma unroll 2
    for (int it = 0; it < 8; ++it) {
      const int idx = it * 256 + tid, row = idx >> 4, c8 = (idx & 15) * 8;
      const float4 v0 = *(const float4*)(Cs + row * 132 + c8), v1 = *(const float4*)(Cs + row * 132 + c8 + 4);
      float v[8] = {v0.x, v0.y, v0.z, v0.w, v1.x, v1.y, v1.z, v1.w};
      epi(m0 + hh * 128 + row, c8, v);
    }
  }
}

__device__ __forceinline__ void phase_rw_proj(const Params& p, int j, char* smem) {
  const int ntn = j == 0 ? 66 : 83;
  const float* mixb = p.rw_mix + (size_t)j * 6 * DM;
  for (int tile = blockIdx.x; tile < MT * ntn; tile += gridDim.x) {
    const int mt = tile / ntn, nt = tile % ntn, m0 = mt * 256;
    if (nt < 64) {
      const int pi = nt >> 4, n0 = (nt & 15) * 128;
      const int mi = pi == 0 ? 0 : (pi == 1 ? 2 : (pi == 2 ? 3 : 5));
      const bf16_t* Bw = g_wt + OFF_PROJ + ((size_t)(j * 4 + pi) * DI + n0) * DM;
      bf16_t* dst = pi == 0 ? p.R : (pi == 1 ? p.K : (pi == 2 ? p.V : p.Z));
      if (pi == 3) {
        gemm_tile<1>(p.H, DM, mixb + mi * DM, m0, DM, Bw, 128, smem,
                     [&](int row, int col, float* v) {
#pragma unroll
        for (int e = 0; e < 8; ++e) v[e] = siluf_(v[e]);
        *(uint4*)(dst + (size_t)row * DI + n0 + col) = pack8(v); });
      } else {
        gemm_tile<1>(p.H, DM, mixb + mi * DM, m0, DM, Bw, 128, smem,
                     [&](int row, int col, float* v) { *(uint4*)(dst + (size_t)row * DI + n0 + col) = pack8(v); });
      }
    } else if (nt == 64) {
      gemm_tile<1>(p.H, DM, mixb + 1 * DM, m0, DM, g_wt + OFF_W1 + (size_t)j * 128 * DM, 128, smem,
                   [&](int row, int col, float* v) {
#pragma unroll
        for (int e = 0; e < 8; ++e) v[e] = tanhf(v[e]);
        *(uint4*)(p.LRW + (size_t)row * 128 + col) = pack8(v); });
    } else if (nt == 65) {
      gemm_tile<1>(p.H, DM, mixb + 4 * DM, m0, DM, g_wt + OFF_A1 + (size_t)j * 128 * DM, 128, smem,
                   [&](int row, int col, float* v) { *(uint4*)(p.LRA + (size_t)row * 128 + col) = pack8(v); });
    } else if (nt == 66) {
      gemm_tile<1>(p.H, DM, mixb + 3 * DM, m0, DM, g_wt + OFF_V1, 32, smem, [&](int row, int col, float* v) {
        if (col < 32) *(uint4*)(p.LRV + (size_t)row * 32 + col) = pack8(v);
      });
    } else {
      const int n0 = (nt - 67) * 128;
      const bf16_t* Bw = g_wt + OFF_PROJ + ((size_t)2 * DI + n0) * DM;
      gemm_tile<1>(p.H0, DM, p.rw_mix + 3 * DM, m0, DM, Bw, 128, smem,
                   [&](int row, int col, float* v) { *(uint4*)(p.VF + (size_t)row * DI + n0 + col) = pack8(v); });
    }
  }
}

__device__ __forceinline__ void phase_rw_lr2(const Params& p, int j, char* smem) {
  for (int tile = blockIdx.x; tile < MT * 16; tile += gridDim.x) {
    const int mt = tile / 16, nt = tile % 16, m0 = mt * 256;
    const int n0 = nt * 128;
    const bf16_t* Bw = g_wt + OFF_V2 + (size_t)n0 * 32;
    const float* v0 = p.rw_v0 + n0;
    gemm_tile<0>(p.LRV, 32, nullptr, m0, 32, Bw, 128, smem, [&](int row, int col, float* v) {
      const size_t idx = (size_t)row * DI + n0 + col;
      float vv[8], vf[8];
      unpack8(*(const uint4*)(p.V + idx), vv); unpack8(*(const uint4*)(p.VF + idx), vf);
#pragma unroll
      for (int e = 0; e < 8; ++e) vv[e] += (vf[e] - vv[e]) * sigmoidf_(v[e] + v0[col + e]);
      *(uint4*)(p.V + idx) = pack8(vv);
    });
  }
}

constexpr int RCH = 32;
__device__ __forceinline__ int scan_pos(int dir, int s) { return dir == 0 ? s : (s < CTX ? CTX - 1 - s : TT + CTX - 1 - s); }

__device__ __forceinline__ void phase_rw_scan(const Params& p, int j, char* smem) {
  float* op = (float*)smem;
  float* vv = op + RCH * 4 * 64;
  float* yb = vv + RCH * 64;
  float* sc = yb + RCH * 64;
  float* LWs = sc + RCH * 2;
  float* AAs = LWs + RCH * 64;
  float* CPs = AAs + RCH * 64;
  bf16_t* LRs = (bf16_t*)(CPs + RCH * 64);
  bf16_t* W2T = LRs + 2 * RCH * 72;
  const int tid = opaque_tid(), lane = tid & 63, w = tid >> 6;
  const int ptau = tid >> 3, pc8 = (tid & 7) * 8;
  const int r2 = lane >> 3, ko = (lane & 7) * 8;
  const int row0 = w * 16 + r2, row1 = row0 + 8;
  for (int unit = blockIdx.x; unit < GB * 64; unit += gridDim.x) {
    const int bl = unit >> 6, h = (unit >> 1) & 31, dir = unit & 1;
    bf16_t* Y = dir == 0 ? p.YF : p.YB;
    float pkk[8], pka[8], prk[8];
#pragma unroll
    for (int e = 0; e < 8; ++e) {
      const int cc = j * DI + h * 64 + pc8 + e;
      pkk[e] = p.rw_kk[cc]; pka[e] = p.rw_ka[cc]; prk[e] = p.rw_rk[cc];
    }
    __syncthreads();
    {
      const int c = tid & 63, rq = tid >> 6;
#pragma unroll
      for (int m = 0; m < 2; ++m) {
        const float* W2 = (m == 0 ? p.rw_w2 : p.rw_a2) + ((size_t)j * 2 + dir) * 64 * DI + h * 64 + c;
        float tmp[16];
#pragma unroll
        for (int e = 0; e < 16; ++e) tmp[e] = W2[(size_t)(rq * 16 + e) * DI];
        *(uint4*)(W2T + (m * 64 + c) * 72 + rq * 16) = pack8(tmp);
        *(uint4*)(W2T + (m * 64 + c) * 72 + rq * 16 + 8) = pack8(tmp + 8);
      }
    }
    const int mm = w >> 1, nh = w & 1;
    const float bias = (mm == 0 ? p.rw_w0 : p.rw_a0)[((size_t)j * 2 + dir) * DI + h * 64 + nh * 32 + (lane & 31)];
    f2_t S0[4], S1[4];
#pragma unroll
    for (int e = 0; e < 4; ++e) { S0[e] = f2_t{0.f, 0.f}; S1[e] = f2_t{0.f, 0.f}; }
    uint4 gr, gk, gv, gl0, gl1;
    const int lmat = (tid & 7) >> 2, lcol = (tid & 3) * 16;
    auto gload = [&](int chunk) {
      const int pos = scan_pos(dir, chunk * RCH + ptau);
      const size_t tg = (size_t)bl * TT + pos;
      const size_t base = tg * DI + h * 64 + pc8;
      gr = *(const uint4*)(p.R + base); gk = *(const uint4*)(p.K + base); gv = *(const uint4*)(p.V + base);
      const bf16_t* lr = (lmat == 0 ? p.LRW : p.LRA) + tg * 128 + dir * 64 + lcol;
      gl0 = *(const uint4*)(lr); gl1 = *(const uint4*)(lr + 8);
    };
    gload(0);
    for (int chunk = 0; chunk < TT / RCH; ++chunk) {
      *(uint4*)(LRs + (lmat * RCH + ptau) * 72 + lcol) = gl0;
      *(uint4*)(LRs + (lmat * RCH + ptau) * 72 + lcol + 8) = gl1;
      lds_barrier();
      {
        f32x16 acc;
#pragma unroll
        for (int r = 0; r < 16; ++r) acc[r] = 0.f;
#pragma unroll
        for (int kk = 0; kk < 4; ++kk) {
          const bf16x8 af = *(const bf16x8*)(LRs + (mm * RCH + (lane & 31)) * 72 + kk * 16 + (lane >> 5) * 8);
          const bf16x8 bf = *(const bf16x8*)(W2T + (mm * 64 + nh * 32 + (lane & 31)) * 72 + kk * 16 + (lane >> 5) * 8);
          acc = __builtin_amdgcn_mfma_f32_32x32x16_bf16(af, bf, acc, 0, 0, 0);
        }
        const int chn = nh * 32 + (lane & 31), hh = lane >> 5;
        if (mm == 0) {
          float lwv[16], pf[16], own[4], oth[4];
#pragma unroll
          for (int r = 0; r < 16; ++r) lwv[r] = -0.60653066f * sigmoidf_(acc[r] + bias);
#pragma unroll
          for (int g = 0; g < 4; ++g) {
            pf[g * 4] = lwv[g * 4];
            pf[g * 4 + 1] = pf[g * 4] + lwv[g * 4 + 1];
            pf[g * 4 + 2] = pf[g * 4 + 1] + lwv[g * 4 + 2];
            pf[g * 4 + 3] = pf[g * 4 + 2] + lwv[g * 4 + 3];
            own[g] = pf[g * 4 + 3];
            oth[g] = __shfl_xor(own[g], 32);
          }
          float base = 0.f;
#pragma unroll
          for (int g = 0; g < 4; ++g) {
            const float off = base + (hh ? oth[g] : 0.f);
#pragma unroll
            for (int q = 0; q < 4; ++q) {
              const int t = q + 8 * g + 4 * hh;
              const float c = off + pf[g * 4 + q];
              LWs[t * 64 + chn] = c;
              CPs[t * 64 + chn] = c - lwv[g * 4 + q];
            }
            base += own[g] + oth[g];
          }
        } else {
#pragma unroll
          for (int r = 0; r < 16; ++r) {
            const int t = (r & 3) + 8 * (r >> 2) + 4 * hh;
            AAs[t * 64 + chn] = sigmoidf_(acc[r] + bias);
          }
        }
      }
      lds_barrier();
      {
        float r[8], k[8], v[8], cm[8], cp[8], a[8];
        unpack8(gr, r); unpack8(gk, k); unpack8(gv, v);
#pragma unroll
        for (int e = 0; e < 8; ++e) {
          cm[e] = LWs[ptau * 64 + pc8 + e]; cp[e] = CPs[ptau * 64 + pc8 + e]; a[e] = AAs[ptau * 64 + pc8 + e];
        }
        float kkv[8], ss = 0.f;
#pragma unroll
        for (int e = 0; e < 8; ++e) { kkv[e] = k[e] * pkk[e]; ss += kkv[e] * kkv[e]; }
        ss = red8(ss);
        const float inv = rsqrtf(fmaxf(ss, 1e-24f));
        float br = 0.f, kr = 0.f, bon = 0.f;
        float o0[8], o1[8], o2[8], o3[8];
#pragma unroll
        for (int e = 0; e < 8; ++e) {
          const float kkn = kkv[e] * inv;
          const float P = __expf(cm[e]), Pp = __expf(cp[e]);
          const float iP = 1.f / P;
          const float kd = k[e] * (1.f + (a[e] - 1.f) * pka[e]);
          const float bb = kkn * a[e];
          o0[e] = -kkn * Pp; o1[e] = r[e] * P; o2[e] = bb * iP; o3[e] = kd * iP;
          br += bb * r[e]; kr += kd * r[e]; bon += r[e] * kd * prk[e];
        }
        br = red8(br); kr = red8(kr); bon = red8(bon);
        float* od = op + ptau * 256 + pc8;
        *(float4*)(od) = make_float4(o0[0], o0[1], o0[2], o0[3]); *(float4*)(od + 4) = make_float4(o0[4], o0[5], o0[6], o0[7]);
        *(float4*)(od + 64) = make_float4(o1[0], o1[1], o1[2], o1[3]); *(float4*)(od + 68) = make_float4(o1[4], o1[5], o1[6], o1[7]);
        *(float4*)(od + 128) = make_float4(o2[0], o2[1], o2[2], o2[3]); *(float4*)(od + 132) = make_float4(o2[4], o2[5], o2[6], o2[7]);
        *(float4*)(od + 192) = make_float4(o3[0], o3[1], o3[2], o3[3]); *(float4*)(od + 196) = make_float4(o3[4], o3[5], o3[6], o3[7]);
        float* vd = vv + ptau * 64 + pc8;
        *(float4*)(vd) = make_float4(v[0], v[1], v[2], v[3]); *(float4*)(vd + 4) = make_float4(v[4], v[5], v[6], v[7]);
        if ((tid & 7) == 0) {
          sc[ptau * 2] = br; sc[ptau * 2 + 1] = kr;
          const int pos = scan_pos(dir, chunk * RCH + ptau);
          p.BN[((size_t)dir * NTG + (size_t)bl * TT + pos) * 32 + h] = bon;
        }
      }
      lds_barrier();
      if (chunk + 1 < TT / RCH) gload(chunk + 1);
      {
        struct StepOps { float4 n0, n1, q0, q1, b0, b1, k0, k1; float v0, v1; float2 s; };
        auto ldops = [&](StepOps& o, int tau) {
          const float* ob = op + tau * 256 + ko;
          o.n0 = *(const float4*)(ob); o.n1 = *(const float4*)(ob + 4);
          o.q0 = *(const float4*)(ob + 64); o.q1 = *(const float4*)(ob + 68);
          o.b0 = *(const float4*)(ob + 128); o.b1 = *(const float4*)(ob + 132);
          o.k0 = *(const float4*)(ob + 192); o.k1 = *(const float4*)(ob + 196);
          o.v0 = vv[tau * 64 + row0]; o.v1 = vv[tau * 64 + row1];
          o.s = *(const float2*)(sc + tau * 2);
        };
        auto dostep = [&](const StepOps& o, int tau) {
          const float nk[8] = {o.n0.x, o.n0.y, o.n0.z, o.n0.w, o.n1.x, o.n1.y, o.n1.z, o.n1.w};
          const float rr[8] = {o.q0.x, o.q0.y, o.q0.z, o.q0.w, o.q1.x, o.q1.y, o.q1.z, o.q1.w};
          const float bb[8] = {o.b0.x, o.b0.y, o.b0.z, o.b0.w, o.b1.x, o.b1.y, o.b1.z, o.b1.w};
          const float kd[8] = {o.k0.x, o.k0.y, o.k0.z, o.k0.w, o.k1.x, o.k1.y, o.k1.z, o.k1.w};
          f2_t a10 = {0.f, 0.f}, a11 = {0.f, 0.f}, a20 = {0.f, 0.f}, a21 = {0.f, 0.f};
#pragma unroll
          for (int e = 0; e < 4; ++e) {
            const f2_t nk2 = {nk[2 * e], nk[2 * e + 1]}, rr2 = {rr[2 * e], rr[2 * e + 1]};
            a10 = __builtin_elementwise_fma(S0[e], nk2, a10); a11 = __builtin_elementwise_fma(S1[e], nk2, a11);
            a20 = __builtin_elementwise_fma(S0[e], rr2, a20); a21 = __builtin_elementwise_fma(S1[e], rr2, a21);
          }
          float d10 = a10.x + a10.y, d11 = a11.x + a11.y, d20 = a20.x + a20.y, d21 = a21.x + a21.y;
          d10 = red8(d10); d11 = red8(d11); d20 = red8(d20); d21 = red8(d21);
          const float y0 = d20 + d10 * o.s.x + o.v0 * o.s.y;
          const float y1 = d21 + d11 * o.s.x + o.v1 * o.s.y;
          const f2_t sa0 = {d10, d10}, sa1 = {d11, d11}, vv0 = {o.v0, o.v0}, vv1 = {o.v1, o.v1};
#pragma unroll
          for (int e = 0; e < 4; ++e) {
            const f2_t bb2 = {bb[2 * e], bb[2 * e + 1]}, kd2 = {kd[2 * e], kd[2 * e + 1]};
            S0[e] = __builtin_elementwise_fma(sa0, bb2, __builtin_elementwise_fma(vv0, kd2, S0[e]));
            S1[e] = __builtin_elementwise_fma(sa1, bb2, __builtin_elementwise_fma(vv1, kd2, S1[e]));
          }
          if ((lane & 7) == 0) { yb[tau * 64 + row0] = y0; yb[tau * 64 + row1] = y1; }
        };
        StepOps oa, ob2;
        ldops(oa, 0);
        for (int tau = 0; tau < RCH; tau += 2) {
          ldops(ob2, tau + 1);
          dostep(oa, tau);
          if (tau + 2 < RCH) ldops(oa, tau + 2);
          dostep(ob2, tau + 1);
        }
#pragma unroll
        for (int e = 0; e < 4; ++e) {
          const f2_t pc = {__expf(LWs[(RCH - 1) * 64 + ko + 2 * e]), __expf(LWs[(RCH - 1) * 64 + ko + 2 * e + 1])};
          S0[e] *= pc; S1[e] *= pc;
        }
      }
      lds_barrier();
      {
        const int pos = scan_pos(dir, chunk * RCH + ptau);
        const float* ys = yb + ptau * 64 + pc8;
        float yv[8];
#pragma unroll
        for (int e = 0; e < 8; ++e) yv[e] = ys[e];
        *(uint4*)(Y + ((size_t)bl * TT + pos) * DI + h * 64 + pc8) = pack8(yv);
      }
    }
    lds_barrier();
  }
}

__device__ __forceinline__ void phase_rw_gate(const Params& p, int j) {
  const int tid = opaque_tid(), h = tid >> 3;
  const int c0 = tid * 8;
  float lnw[8], lnb[8];
#pragma unroll
  for (int e = 0; e < 8; ++e) { lnw[e] = p.rw_lnw[j * DI + c0 + e]; lnb[e] = p.rw_lnb[j * DI + c0 + e]; }
  for (int tg = blockIdx.x; tg < NTG; tg += gridDim.x) {
    const size_t base = (size_t)tg * DI + c0;
    float yf[8], yb[8], v[8], z[8];
    unpack8(*(const uint4*)(p.YF + base), yf); unpack8(*(const uint4*)(p.YB + base), yb);
    unpack8(*(const uint4*)(p.V + base), v); unpack8(*(const uint4*)(p.Z + base), z);
    const float bon = p.BN[(size_t)tg * 32 + h] + p.BN[((size_t)NTG + tg) * 32 + h];
    float y[8], s = 0.f;
#pragma unroll
    for (int e = 0; e < 8; ++e) { y[e] = yf[e] + yb[e]; s += y[e]; }
    const float mu = red8(s) * (1.f / 64.f);
    float s2 = 0.f;
#pragma unroll
    for (int e = 0; e < 8; ++e) { y[e] -= mu; s2 += y[e] * y[e]; }
    const float rstd = rsqrtf(red8(s2) * (1.f / 64.f) + 64e-5f);
#pragma unroll
    for (int e = 0; e < 8; ++e) y[e] = (y[e] * rstd * lnw[e] + lnb[e] + bon * v[e]) * z[e];
    *(uint4*)(p.YF + base) = pack8(y);
  }
}

__device__ __forceinline__ void phase_out(const Params& p, const bf16_t* wo, char* smem) {
  for (int tile = blockIdx.x; tile < MT * 8; tile += gridDim.x) {
    const int mt = tile / 8, nt = tile % 8, m0 = mt * 256, n0 = nt * 128;
    const bf16_t* Bw = wo + (size_t)n0 * DI;
    gemm_tile<0>(p.YF, DI, nullptr, m0, DI, Bw, 128, smem,
                 [&](int row, int col, float* v) {
      float* o = p.O + (size_t)row * DM + n0 + col;
      *(float4*)o = make_float4(v[0], v[1], v[2], v[3]); *(float4*)(o + 4) = make_float4(v[4], v[5], v[6], v[7]); });
  }
}

__device__ __forceinline__ void phase_hg_proj(const Params& p, int j, char* smem) {
  for (int tile = blockIdx.x; tile < MT * 80; tile += gridDim.x) {
    const int mt = tile / 80, nt = tile % 80, m0 = mt * 256;
    const int seg = nt >> 4, n0 = (nt & 15) * 128;
    const bf16_t* Bw = g_wt + OFF_HWIN + ((size_t)j * 5 * DI + (size_t)seg * DI + n0) * DM;
    bf16_t* dst = seg == 0 ? p.R : (seg == 1 ? p.K : (seg == 2 ? p.WF : (seg == 3 ? p.V : p.Z)));
    if (seg == 0 || seg == 4) {
      gemm_tile<0>(p.H, DM, nullptr, m0, DM, Bw, 128, smem,
                   [&](int row, int col, float* v) {
#pragma unroll
        for (int e = 0; e < 8; ++e) v[e] = siluf_(v[e]);
        *(uint4*)(dst + (size_t)row * DI + n0 + col) = pack8(v); });
    } else {
      gemm_tile<0>(p.H, DM, nullptr, m0, DM, Bw, 128, smem,
                   [&](int row, int col, float* v) { *(uint4*)(dst + (size_t)row * DI + n0 + col) = pack8(v); });
    }
  }
}

constexpr int HC = 32;
constexpr int QS = 136;
constexpr int SS = 40;
__device__ __forceinline__ void phase_hg_scan(const Params& p, int layer, char* smem) {
  bf16_t* qe = (bf16_t*)smem;
  bf16_t* ke = qe + HC * QS;
  bf16_t* kdT = ke + HC * QS;
  bf16_t* vT = kdT + 128 * SS;
  bf16_t* att = vT + 64 * SS;
  bf16_t* ST = att + HC * SS;
  float* dC = (float*)(ST + 64 * QS);
  const int tid = opaque_tid(), lane = tid & 63, w = tid >> 6;
  for (int unit = blockIdx.x; unit < GB * 64; unit += gridDim.x) {
    const int vs = unit & 1, dir = (unit >> 1) & 1, h = (unit >> 2) & 15, bl = unit >> 6;
    const bf16_t* FL = dir == 0 ? p.K : p.WF;
    bf16_t* Y = dir == 0 ? p.YF : p.YB;
    const int st = lane & 31, cg = w * 2 + (lane >> 5), kb = cg * 16, vb = cg * 8;
    float lbv[16];
#pragma unroll
    for (int e = 0; e < 16; ++e) lbv[e] = p.LB[layer * DI + h * 128 + kb + e];
    f32x16 sacc[2];
#pragma unroll
    for (int r = 0; r < 16; ++r) { sacc[0][r] = 0.f; sacc[1][r] = 0.f; }
    __syncthreads();
    for (int idx = tid; idx < 64 * QS / 2; idx += 256) ((unsigned*)ST)[idx] = 0u;
    uint4 gq0, gq1, gf0, gf1, gvv;
    auto gload = [&](int chunk) {
      const int pos = scan_pos(dir, chunk * HC + st);
      const size_t base = ((size_t)bl * TT + pos) * DI + h * 128;
      gq0 = *(const uint4*)(p.R + base + kb); gq1 = *(const uint4*)(p.R + base + kb + 8);
      gf0 = *(const uint4*)(FL + base + kb); gf1 = *(const uint4*)(FL + base + kb + 8);
      gvv = *(const uint4*)(p.V + base + vs * 64 + vb);
    };
    gload(0);
    for (int chunk = 0; chunk < TT / HC; ++chunk) {
      float q[16], cum[16], one[16];
      {
        float fl[16];
        unpack8(gq0, q); unpack8(gq1, q + 8); unpack8(gf0, fl); unpack8(gf1, fl + 8);
#pragma unroll
        for (int e = 0; e < 16; ++e) {
          const float f = lbv[e] + (1.f - lbv[e]) * sigmoidf_(fl[e]);
          one[e] = 1.f - f;
          cum[e] = __logf(f);
        }
#pragma unroll
        for (int d = 1; d < 32; d <<= 1) {
#pragma unroll
          for (int e = 0; e < 16; ++e) {
            const float tmp = __shfl_up(cum[e], d, 32);
            if (st >= d) cum[e] += tmp;
          }
        }
      }
      const uint4 vreg = gvv;
      lds_barrier();
      {
        float qo[16], ko[16];
#pragma unroll
        for (int e = 0; e < 16; ++e) {
          const float cC = __shfl(cum[e], 31, 32);
          const float ec = __expf(fmaxf(cum[e], -80.f));
          const float inv = 1.f / ec;
          const float eC = __expf(cC);
          qo[e] = q[e] * ec;
          ko[e] = one[e] * inv;
          kdT[(kb + e) * SS + st] = f2bf(one[e] * inv * eC);
          if (st == 31) dC[kb + e] = eC;
        }
        *(uint4*)(qe + st * QS + kb) = pack8(qo); *(uint4*)(qe + st * QS + kb + 8) = pack8(qo + 8);
        *(uint4*)(ke + st * QS + kb) = pack8(ko); *(uint4*)(ke + st * QS + kb + 8) = pack8(ko + 8);
        const bf16_t* vp = (const bf16_t*)&vreg;
#pragma unroll
        for (int e = 0; e < 8; ++e) vT[(vb + e) * SS + st] = vp[e];
      }
      lds_barrier();
      if (chunk + 1 < TT / HC) gload(chunk + 1);
      {
        const int mi = w >> 1, ni = w & 1;
        f32x4 a4 = {0.f, 0.f, 0.f, 0.f};
#pragma unroll
        for (int kk = 0; kk < 4; ++kk) {
          const bf16x8 af = *(const bf16x8*)(qe + (mi * 16 + (lane & 15)) * QS + kk * 32 + (lane >> 4) * 8);
          const bf16x8 bf = *(const bf16x8*)(ke + (ni * 16 + (lane & 15)) * QS + kk * 32 + (lane >> 4) * 8);
          a4 = __builtin_amdgcn_mfma_f32_16x16x32_bf16(af, bf, a4, 0, 0, 0);
        }
        const int s = ni * 16 + (lane & 15);
#pragma unroll
        for (int r = 0; r < 4; ++r) {
          const int t = mi * 16 + (lane >> 4) * 4 + r;
          att[t * SS + s] = f2bf(s <= t ? a4[r] : 0.f);
        }
      }
      lds_barrier();
      {
#pragma unroll
        for (int mh = 0; mh < 2; ++mh) {
          f32x4 y4 = {0.f, 0.f, 0.f, 0.f};
          {
            const bf16x8 af = *(const bf16x8*)(att + (mh * 16 + (lane & 15)) * SS + (lane >> 4) * 8);
            const bf16x8 bf = *(const bf16x8*)(vT + (w * 16 + (lane & 15)) * SS + (lane >> 4) * 8);
            y4 = __builtin_amdgcn_mfma_f32_16x16x32_bf16(af, bf, y4, 0, 0, 0);
          }
#pragma unroll
          for (int kk = 0; kk < 4; ++kk) {
            const bf16x8 af = *(const bf16x8*)(qe + (mh * 16 + (lane & 15)) * QS + kk * 32 + (lane >> 4) * 8);
            const bf16x8 bf = *(const bf16x8*)(ST + (w * 16 + (lane & 15)) * QS + kk * 32 + (lane >> 4) * 8);
            y4 = __builtin_amdgcn_mfma_f32_16x16x32_bf16(af, bf, y4, 0, 0, 0);
          }
#pragma unroll
          for (int r = 0; r < 4; ++r) {
            const int t = mh * 16 + (lane >> 4) * 4 + r;
            const int pos = scan_pos(dir, chunk * HC + t);
            Y[((size_t)bl * TT + pos) * DI + h * 128 + vs * 64 + w * 16 + (lane & 15)] = f2bf(y4[r]);
          }
        }
      }
      lds_barrier();
      {
        float dk[16];
#pragma unroll
        for (int r = 0; r < 16; ++r) dk[r] = dC[w * 32 + (r & 3) + 8 * (r >> 2) + 4 * (lane >> 5)];
#pragma unroll
        for (int nt = 0; nt < 2; ++nt) {
#pragma unroll
          for (int r = 0; r < 16; ++r) sacc[nt][r] *= dk[r];
#pragma unroll
          for (int ks = 0; ks < 2; ++ks) {
            const bf16x8 af = *(const bf16x8*)(kdT + (w * 32 + (lane & 31)) * SS + ks * 16 + (lane >> 5) * 8);
            const bf16x8 bf = *(const bf16x8*)(vT + (nt * 32 + (lane & 31)) * SS + ks * 16 + (lane >> 5) * 8);
            sacc[nt] = __builtin_amdgcn_mfma_f32_32x32x16_bf16(af, bf, sacc[nt], 0, 0, 0);
          }
#pragma unroll
          for (int gq = 0; gq < 4; ++gq) {
            uint2 u;
            u.x = pack2(sacc[nt][gq * 4 + 0], sacc[nt][gq * 4 + 1]);
            u.y = pack2(sacc[nt][gq * 4 + 2], sacc[nt][gq * 4 + 3]);
            *(uint2*)(ST + (nt * 32 + (lane & 31)) * QS + w * 32 + gq * 8 + (lane >> 5) * 4) = u;
          }
        }
      }
    }
    lds_barrier();
  }
}

__device__ __forceinline__ void phase_hg_gate(const Params& p, int j) {
  const int tid = opaque_tid();
  const int c0 = tid * 8;
  float gn[8];
#pragma unroll
  for (int e = 0; e < 8; ++e) gn[e] = p.hg_gn[j * 128 + ((c0 + e) & 127)];
  for (int tg = blockIdx.x; tg < NTG; tg += gridDim.x) {
    const size_t base = (size_t)tg * DI + c0;
    float yf[8], yb[8], z[8];
    unpack8(*(const uint4*)(p.YF + base), yf); unpack8(*(const uint4*)(p.YB + base), yb);
    unpack8(*(const uint4*)(p.Z + base), z);
    float y[8], s2 = 0.f;
#pragma unroll
    for (int e = 0; e < 8; ++e) { y[e] = yf[e] + yb[e]; s2 += y[e] * y[e]; }
    const float rstd = rsqrtf(red16(s2) * (1.f / 128.f) + EPS);
#pragma unroll
    for (int e = 0; e < 8; ++e) y[e] = y[e] * rstd * gn[e] * z[e];
    *(uint4*)(p.YF + base) = pack8(y);
  }
}

__global__ void __launch_bounds__(256) fwd_megakernel(Params p) {
  cg::grid_group grid = cg::this_grid();
  __shared__ __attribute__((aligned(16))) char smem[120 * 1024];
  phase_mod(p, smem);
  phase_wconv(p, smem);
  grid.sync();
  for (int g = 0; g < NG; ++g) {
    for (int layer = 0; layer < 4; ++layer) {
      phase_resnorm(p, g, layer - 1, layer);
      grid.sync();
      const int j = layer >> 1;
      if ((layer & 1) == 0) {
        phase_rw_proj(p, j, smem);
        grid.sync();
        if (j == 1) { phase_rw_lr2(p, j, smem); grid.sync(); }
        phase_rw_scan(p, j, smem);
        grid.sync();
        phase_rw_gate(p, j);
        grid.sync();
        phase_out(p, g_wt + OFF_RWO + (size_t)j * DM * DI, smem);
        grid.sync();
      } else {
        phase_hg_proj(p, j, smem);
        grid.sync();
        phase_hg_scan(p, layer, smem);
        grid.sync();
        phase_hg_gate(p, j);
        grid.sync();
        phase_out(p, g_wt + OFF_HWO + (size_t)j * DM * DI, smem);
        grid.sync();
      }
    }
    phase_resnorm(p, g, 3, -1);
    grid.sync();
  }
}

extern "C" void kernel_launch(void* const* d_in, const int* in_sizes, int n_in, void* d_out, int out_size, void* d_ws,
                              size_t ws_size, hipStream_t stream) {
  static int grid_blocks = 0;
  if (!grid_blocks) {
    int dev = 0, cus = 0, per_cu = 0;
    hipGetDevice(&dev);
    hipDeviceGetAttribute(&cus, hipDeviceAttributeMultiprocessorCount, dev);
    hipOccupancyMaxActiveBlocksPerMultiprocessor(&per_cu, fwd_megakernel, 256, 0);
    if (per_cu > 1) per_cu = 1;
    grid_blocks = cus * per_cu;
  }
  Params p{};
  const float** fp = (const float**)&p;
  for (int i = 0; i < 29; ++i) fp[i] = (const float*)d_in[i];
  p.out = (float*)d_out;
  char* w = (char*)d_ws;
  size_t off = 0;
  auto take = [&](size_t bytes) { char* r = w + off; off += (bytes + 255) & ~(size_t)255; return r; };
  const size_t DIW = (size_t)NTG * DI * 2;
  p.R = (bf16_t*)take(DIW); p.K = (bf16_t*)take(DIW); p.V = (bf16_t*)take(DIW); p.Z = (bf16_t*)take(DIW);
  p.WF = (bf16_t*)take(DIW); p.YF = (bf16_t*)take(DIW); p.YB = (bf16_t*)take(DIW);
  p.VF = p.YF;
  p.H = p.YB; p.H0 = p.YB + (size_t)NTG * DM;
  p.LRW = (bf16_t*)take((size_t)NTG * 128 * 2); p.LRA = (bf16_t*)take((size_t)NTG * 128 * 2);
  p.LRV = (bf16_t*)take((size_t)NTG * 32 * 2);
  p.O = (float*)p.R;
  p.BN = (float*)take((size_t)2 * NTG * 32 * 4);
  p.CTXB = (float*)take((size_t)NB * CTX * DM * 4);
  p.MODV = (float*)take((size_t)4 * 9 * 3 * DM * 4);
  p.LB = (float*)take((size_t)4 * DI * 4);
  if (off > ws_size) { fprintf(stderr, "workspace too small: need %zu have %zu\n", off, ws_size); return; }
  void* args[] = {&p};
  hipError_t e = hipLaunchCooperativeKernel((void*)fwd_megakernel, dim3(grid_blocks), dim3(256), args, 0, stream);
  if (e != hipSuccess) fprintf(stderr, "cooperative launch failed: %s (grid %d)\n", hipGetErrorString(e), grid_blocks);
}
```

```cpp
#include <hip/hip_runtime.h>
#include <hip/hip_cooperative_groups.h>
#include <cstdio>
#include <cstdint>
namespace cg = cooperative_groups;

typedef unsigned short bf16_t;
using bf16x8 = __attribute__((ext_vector_type(8))) short;
using f32x16 = __attribute__((ext_vector_type(16))) float;
using f32x4 = __attribute__((ext_vector_type(4))) float;
using f2_t = __attribute__((ext_vector_type(2))) float;

constexpr int NB = 8, SEQ = 4096, CTX = 256, TT = 4352, DM = 1024, DI = 2048;
constexpr int GB = 4, NG = NB / GB, NTG = GB * TT;
constexpr int MT = NTG / 128;
constexpr float EPS = 1e-6f;

constexpr size_t OFF_PROJ = 0;
constexpr size_t OFF_RWO = OFF_PROJ + (size_t)2 * 4 * DI * DM;
constexpr size_t OFF_W1 = OFF_RWO + (size_t)2 * DM * DI;
constexpr size_t OFF_A1 = OFF_W1 + (size_t)2 * 128 * DM;
constexpr size_t OFF_V1 = OFF_A1 + (size_t)2 * 128 * DM;
constexpr size_t OFF_V2 = OFF_V1 + (size_t)32 * DM;
constexpr size_t OFF_HWIN = OFF_V2 + (size_t)DI * 32;
constexpr size_t OFF_HWO = OFF_HWIN + (size_t)2 * 5 * DI * DM;
constexpr size_t OFF_W2 = OFF_HWO + (size_t)2 * DM * DI;
constexpr size_t OFF_A2 = OFF_W2 + (size_t)4 * DI * 64;
constexpr size_t WT_TOTAL = OFF_A2 + (size_t)4 * DI * 64;
__device__ bf16_t g_wt[WT_TOTAL];

struct Params {
  const float *x, *c, *ctx, *c_ctx, *mod_w, *mod_b, *pre_g, *post_g, *rw_mix, *rw_proj, *rw_wo, *rw_w0, *rw_w1,
      *rw_w2, *rw_a0, *rw_a1, *rw_a2, *rw_v0, *rw_v1, *rw_v2, *rw_kk, *rw_ka, *rw_rk, *rw_lnw, *rw_lnb, *hg_win,
      *hg_wo, *hg_gn, *hg_lb;
  float* out;
  bf16_t *R, *K, *V, *Z, *WF, *YF, *YB, *VF, *H, *H0, *LRW, *LRA, *LRV;
  float *O, *BN, *CTXB, *MODV, *LB;
};

typedef __bf16 hwbf2_t __attribute__((ext_vector_type(2)));
typedef float hwf2_t __attribute__((ext_vector_type(2)));
__device__ __forceinline__ unsigned pack2(float a, float b) {
  hwf2_t f = {a, b};
  hwbf2_t h = __builtin_convertvector(f, hwbf2_t);
  return __builtin_bit_cast(unsigned, h);
}
__device__ __forceinline__ bf16_t f2bf(float f) { return (bf16_t)(pack2(f, f) & 0xffffu); }
__device__ __forceinline__ float bf2f(bf16_t h) { return __uint_as_float(((unsigned)h) << 16); }
__device__ __forceinline__ float lo2f(unsigned u) { return __uint_as_float(u << 16); }
__device__ __forceinline__ float hi2f(unsigned u) { return __uint_as_float(u & 0xffff0000u); }
__device__ __forceinline__ float sigmoidf_(float x) { return 1.f / (1.f + __expf(-x)); }
__device__ __forceinline__ float siluf_(float x) { return x / (1.f + __expf(-x)); }

__device__ __forceinline__ void lds_barrier() { asm volatile("s_waitcnt lgkmcnt(0)\n\ts_barrier" ::: "memory"); }

__device__ __forceinline__ int opaque_tid() { int t = threadIdx.x; asm volatile("" : "+v"(t)); return t; }

template <int CTRL>
__device__ __forceinline__ float dppf(float v) {
  return __int_as_float(__builtin_amdgcn_update_dpp(0, __float_as_int(v), CTRL, 0xf, 0xf, true));
}
__device__ __forceinline__ float red4(float v) { v += dppf<0xB1>(v); v += dppf<0x4E>(v); return v; }
__device__ __forceinline__ float red8(float v) { v = red4(v); v += dppf<0x141>(v); return v; }
__device__ __forceinline__ float red16(float v) { v = red8(v); v += dppf<0x140>(v); return v; }
__device__ __forceinline__ float red64(float v) {
  v = red16(v);
  v += __shfl_xor(v, 16);
  v += __shfl_xor(v, 32);
  return v;
}

__device__ __forceinline__ void unpack8(const uint4& u, float* f) {
  f[0] = lo2f(u.x); f[1] = hi2f(u.x); f[2] = lo2f(u.y); f[3] = hi2f(u.y);
  f[4] = lo2f(u.z); f[5] = hi2f(u.z); f[6] = lo2f(u.w); f[7] = hi2f(u.w);
}
__device__ __forceinline__ uint4 pack8(const float* f) {
  uint4 u; u.x = pack2(f[0], f[1]); u.y = pack2(f[2], f[3]); u.z = pack2(f[4], f[5]); u.w = pack2(f[6], f[7]);
  return u;
}

__device__ __forceinline__ const float* row_in(const Params& p, int b, int t) {
  return t < CTX ? p.ctx + ((size_t)b * CTX + t) * DM : p.x + ((size_t)b * SEQ + (t - CTX)) * DM;
}
__device__ __forceinline__ float* row_cur(const Params& p, int b, int t) {
  return t < CTX ? p.CTXB + ((size_t)b * CTX + t) * DM : p.out + ((size_t)b * SEQ + (t - CTX)) * DM;
}

__device__ __forceinline__ void phase_mod(const Params& p, char* smem) {
  float* red = (float*)smem;
  const int tid = opaque_tid(), cl = tid & 63, kp = tid >> 6;
  for (int task = blockIdx.x; task < 4 * 48; task += gridDim.x) {
    const int l = task / 48, col = (task % 48) * 64 + cl;
    float acc[9];
#pragma unroll
    for (int r = 0; r < 9; ++r) acc[r] = 0.f;
    const float* W = p.mod_w + (size_t)l * DM * 3 * DM + col;
    for (int k = kp * 256; k < kp * 256 + 256; ++k) {
      const float w = W[(size_t)k * 3 * DM];
#pragma unroll
      for (int r = 0; r < 9; ++r) {
        const float cv = r < 8 ? p.c[r * DM + k] : p.c_ctx[k];
        acc[r] += siluf_(cv) * w;
      }
    }
    __syncthreads();
#pragma unroll
    for (int r = 0; r < 9; ++r) red[(kp * 9 + r) * 64 + cl] = acc[r];
    __syncthreads();
    for (int idx = tid; idx < 9 * 64; idx += 256) {
      const int r = idx >> 6, c2 = idx & 63;
      float s = 0.f;
      for (int q = 0; q < 4; ++q) s += red[(q * 9 + r) * 64 + c2];
      const int cc = (task % 48) * 64 + c2;
      p.MODV[((size_t)l * 9 + r) * 3 * DM + cc] = s + p.mod_b[l * 3 * DM + cc];
    }
  }
  for (int cidx = blockIdx.x * 256 + tid; cidx < DI; cidx += gridDim.x * 256) {
    float v[4], m = -1e30f;
    for (int l = 0; l < 4; ++l) { v[l] = p.hg_lb[l * DI + cidx]; m = fmaxf(m, v[l]); }
    float s = 0.f;
    for (int l = 0; l < 4; ++l) { v[l] = __expf(v[l] - m); s += v[l]; }
    float cum = 0.f;
    for (int l = 0; l < 4; ++l) { cum += v[l] / s; p.LB[l * DI + cidx] = cum - v[0] / s; }
  }
}

__device__ __forceinline__ void conv_matrix(const float* __restrict__ src, int K, int N, bf16_t* __restrict__ dst, char* smem) {
  float* ts = (float*)smem;
  const int tid = opaque_tid();
  const int ntn = N / 32, ntile = (K / 64) * ntn;
  for (int tile = blockIdx.x; tile < ntile; tile += gridDim.x) {
    const int k0 = (tile / ntn) * 64, n0 = (tile % ntn) * 32;
    __syncthreads();
#pragma unroll
    for (int i = 0; i < 2; ++i) {
      const int k = (tid >> 3) + 32 * i, n4 = (tid & 7) * 4;
      const float4 v = *(const float4*)(src + (size_t)(k0 + k) * N + n0 + n4);
      ts[k * 33 + n4 + 0] = v.x; ts[k * 33 + n4 + 1] = v.y; ts[k * 33 + n4 + 2] = v.z; ts[k * 33 + n4 + 3] = v.w;
    }
    __syncthreads();
    const int n = tid >> 3, k8 = (tid & 7) * 8;
    float f[8];
#pragma unroll
    for (int e = 0; e < 8; ++e) f[e] = ts[(k8 + e) * 33 + n];
    *(uint4*)(dst + (size_t)(n0 + n) * K + k0 + k8) = pack8(f);
  }
}
__device__ __forceinline__ void phase_wconv(const Params& p, char* smem) {
  for (int m = 0; m < 8; ++m) conv_matrix(p.rw_proj + (size_t)m * DM * DI, DM, DI, g_wt + OFF_PROJ + (size_t)m * DI * DM, smem);
  for (int j = 0; j < 2; ++j) conv_matrix(p.rw_wo + (size_t)j * DI * DM, DI, DM, g_wt + OFF_RWO + (size_t)j * DM * DI, smem);
  for (int m = 0; m < 4; ++m) {
    conv_matrix(p.rw_w1 + (size_t)m * DM * 64, DM, 64, g_wt + OFF_W1 + (size_t)m * 64 * DM, smem);
    conv_matrix(p.rw_a1 + (size_t)m * DM * 64, DM, 64, g_wt + OFF_A1 + (size_t)m * 64 * DM, smem);
  }
  conv_matrix(p.rw_v1, DM, 32, g_wt + OFF_V1, smem);
  for (int m = 0; m < 4; ++m) {
    conv_matrix(p.rw_w2 + (size_t)m * 64 * DI, 64, DI, g_wt + OFF_W2 + (size_t)m * DI * 64, smem);
    conv_matrix(p.rw_a2 + (size_t)m * 64 * DI, 64, DI, g_wt + OFF_A2 + (size_t)m * DI * 64, smem);
  }
  for (int j = 0; j < 2; ++j) conv_matrix(p.hg_win + (size_t)j * DM * 5 * DI, DM, 5 * DI, g_wt + OFF_HWIN + (size_t)j * 5 * DI * DM, smem);
  for (int j = 0; j < 2; ++j) conv_matrix(p.hg_wo + (size_t)j * DI * DM, DI, DM, g_wt + OFF_HWO + (size_t)j * DM * DI, smem);
  for (int idx = blockIdx.x * 256 + opaque_tid(); idx < DI * 32; idx += gridDim.x * 256) {
    const int n = idx >> 5, k = idx & 31;
    g_wt[OFF_V2 + idx] = f2bf(p.rw_v2[(size_t)k * DI + n]);
  }
}

__device__ __forceinline__ void phase_resnorm(const Params& p, int g, int lu, int ln) {
  const int tid = opaque_tid();
  const int lane = tid & 63;
  const int wv = blockIdx.x * 4 + (tid >> 6), nw = gridDim.x * 4;
  for (int tg = wv; tg < NTG; tg += nw) {
    const int bl = tg / TT, t = tg % TT, b = g * GB + bl;
    const bool isctx = t < CTX;
    const int mrow = isctx ? 8 : b;
    float xv[16];
    const float* src = (lu <= 0) ? row_in(p, b, t) : row_cur(p, b, t);
#pragma unroll
    for (int j = 0; j < 4; ++j) {
      const float4 v4 = *(const float4*)(src + j * 256 + lane * 4);
      xv[j * 4 + 0] = v4.x; xv[j * 4 + 1] = v4.y; xv[j * 4 + 2] = v4.z; xv[j * 4 + 3] = v4.w;
    }
    if (lu >= 0 && !(isctx && lu == 3)) {
      float ov[16], ss = 0.f;
      const float* orow = p.O + (size_t)tg * DM;
#pragma unroll
      for (int j = 0; j < 4; ++j) {
        const float4 v4 = *(const float4*)(orow + j * 256 + lane * 4);
        ov[j * 4 + 0] = v4.x; ov[j * 4 + 1] = v4.y; ov[j * 4 + 2] = v4.z; ov[j * 4 + 3] = v4.w;
      }
#pragma unroll
      for (int e = 0; e < 16; ++e) ss += ov[e] * ov[e];
      ss = red64(ss);
      const float rstd = rsqrtf(ss * (1.f / DM) + EPS);
      const float* gate = p.MODV + ((size_t)lu * 9 + mrow) * 3 * DM + 2 * DM;
      const float* pg = p.post_g + lu * DM;
      float* dst = row_cur(p, b, t);
#pragma unroll
      for (int j = 0; j < 4; ++j) {
        const int cc = j * 256 + lane * 4;
        const float4 g4 = *(const float4*)(gate + cc);
        const float4 p4 = *(const float4*)(pg + cc);
        xv[j * 4 + 0] += g4.x * (ov[j * 4 + 0] * rstd * p4.x);
        xv[j * 4 + 1] += g4.y * (ov[j * 4 + 1] * rstd * p4.y);
        xv[j * 4 + 2] += g4.z * (ov[j * 4 + 2] * rstd * p4.z);
        xv[j * 4 + 3] += g4.w * (ov[j * 4 + 3] * rstd * p4.w);
        *(float4*)(dst + cc) = make_float4(xv[j * 4 + 0], xv[j * 4 + 1], xv[j * 4 + 2], xv[j * 4 + 3]);
      }
    }
    if (ln >= 0) {
      for (int pass = 0; pass < (ln == 2 ? 2 : 1); ++pass) {
        const int lp = pass == 0 ? ln : 0;
        bf16_t* hdst = (pass == 0 ? p.H : p.H0) + (size_t)tg * DM;
        if (pass == 1) {
          const float* s0 = row_in(p, b, t);
#pragma unroll
          for (int j = 0; j < 4; ++j) {
            const float4 v4 = *(const float4*)(s0 + j * 256 + lane * 4);
            xv[j * 4 + 0] = v4.x; xv[j * 4 + 1] = v4.y; xv[j * 4 + 2] = v4.z; xv[j * 4 + 3] = v4.w;
          }
        }
        float ss = 0.f;
#pragma unroll
        for (int e = 0; e < 16; ++e) ss += xv[e] * xv[e];
        ss = red64(ss);
        const float rstd = rsqrtf(ss * (1.f / DM) + EPS);
        const float* mv = p.MODV + ((size_t)lp * 9 + mrow) * 3 * DM;
        const float* pg = p.pre_g + lp * DM;
#pragma unroll
        for (int j = 0; j < 4; ++j) {
          const int cc = j * 256 + lane * 4;
          const float4 sh = *(const float4*)(mv + cc);
          const float4 sc = *(const float4*)(mv + DM + cc);
          const float4 p4 = *(const float4*)(pg + cc);
          const float h0 = xv[j * 4 + 0] * rstd * p4.x * (1.f + sc.x) + sh.x;
          const float h1 = xv[j * 4 + 1] * rstd * p4.y * (1.f + sc.y) + sh.y;
          const float h2 = xv[j * 4 + 2] * rstd * p4.z * (1.f + sc.z) + sh.z;
          const float h3 = xv[j * 4 + 3] * rstd * p4.w * (1.f + sc.w) + sh.w;
          uint2 u; u.x = pack2(h0, h1); u.y = pack2(h2, h3);
          *(uint2*)(hdst + cc) = u;
        }
      }
    }
  }
}

constexpr int LDK = 72;
constexpr int TM = 128;

template <int AMODE, class Epi>
__device__ __forceinline__ void gemm_tile(const bf16_t* __restrict__ A, int lda, const float* __restrict__ mix, int m0,
                                          int K, const bf16_t* __restrict__ Bt, int nvalid, char* smem, Epi epi) {
  bf16_t* As = (bf16_t*)smem;
  bf16_t* Bs = As + 2 * TM * LDK;
  float* mixs = (float*)(Bs + 2 * 128 * LDK);
  const int tid = opaque_tid(), lane = tid & 63, w = tid >> 6, wm = w >> 1, wn = w & 1;
  const int lr = lane >> 3, ch = (lane & 7) * 8;
  const int row0 = w * 32 + lr;
  const bf16_t* Ap = A + (size_t)(m0 + row0) * lda + ch;
  const bf16_t* Bp = Bt + (size_t)row0 * K + ch;
  const size_t astep = (size_t)8 * lda, bstep = (size_t)8 * K;
  const int KT = (K + 63) >> 6;
  const int tbase = m0 % TT;
  const bool isctx = tbase < CTX;
  unsigned vmask = 0;
  if (AMODE == 1) {
#pragma unroll
    for (int i = 0; i < 4; ++i) {
      const int t = tbase + row0 + i * 8;
      unsigned m;
      if (isctx) {
        m = (t >= 1 ? 3u : 0u) | (t + 1 < CTX ? 12u : 0u);
      } else {
        const int tl = t - CTX, row = tl >> 6, col = tl & 63;
        m = (col > 0 ? 1u : 0u) | (col < 63 ? 2u : 0u) | (row > 0 ? 4u : 0u) | (row < 63 ? 8u : 0u);
      }
      vmask |= m << (4 * i);
    }
  }

  __syncthreads();
  if (AMODE == 1) *(float4*)(mixs + tid * 4) = *(const float4*)(mix + tid * 4);

  f32x16 acc[2][2];
#pragma unroll
  for (int i = 0; i < 2; ++i)
#pragma unroll
    for (int j = 0; j < 2; ++j)
#pragma unroll
      for (int r = 0; r < 16; ++r) acc[i][j][r] = 0.f;

  uint4 a0, a1, a2, a3, n0, n1, n2, n3, b0, b1, b2, b3;
  auto load_regs = [&](int kt) {
    const int k0 = kt * 64;
    const uint4 z4 = make_uint4(0, 0, 0, 0);
    const bool kval = (k0 + ch) < K;
    const bf16_t* ap = Ap + k0;
    const bf16_t* bp = Bp + k0;
    a0 = z4; if (kval) a0 = *(const uint4*)(ap + 0 * astep);
    a1 = z4; if (kval) a1 = *(const uint4*)(ap + 1 * astep);
    a2 = z4; if (kval) a2 = *(const uint4*)(ap + 2 * astep);
    a3 = z4; if (kval) a3 = *(const uint4*)(ap + 3 * astep);
    b0 = z4; if (kval && (row0 + 0) < nvalid) b0 = *(const uint4*)(bp + 0 * bstep);
    b1 = z4; if (kval && (row0 + 8) < nvalid) b1 = *(const uint4*)(bp + 1 * bstep);
    b2 = z4; if (kval && (row0 + 16) < nvalid) b2 = *(const uint4*)(bp + 2 * bstep);
    b3 = z4; if (kval && (row0 + 24) < nvalid) b3 = *(const uint4*)(bp + 3 * bstep);
    if (AMODE == 1) {
      const int q = k0 >> 8;
      const int nb = isctx ? (q < 2 ? -1 : 1) : (q == 0 ? -1 : (q == 1 ? 1 : (q == 2 ? -64 : 64)));
      const bf16_t* np = ap + (ptrdiff_t)nb * lda;
      const unsigned vm = vmask >> q;
      n0 = z4; if ((vm >> 0) & 1u) n0 = *(const uint4*)(np + 0 * astep);
      n1 = z4; if ((vm >> 4) & 1u) n1 = *(const uint4*)(np + 1 * astep);
      n2 = z4; if ((vm >> 8) & 1u) n2 = *(const uint4*)(np + 2 * astep);
      n3 = z4; if ((vm >> 12) & 1u) n3 = *(const uint4*)(np + 3 * astep);
    }
  };
  auto mix8 = [&](const uint4& hv, const uint4& nv, const float4& ma, const float4& mb) -> uint4 {
    float h[8], n[8];
    unpack8(hv, h); unpack8(nv, n);
    h[0] += (n[0] - h[0]) * ma.x; h[1] += (n[1] - h[1]) * ma.y; h[2] += (n[2] - h[2]) * ma.z; h[3] += (n[3] - h[3]) * ma.w;
    h[4] += (n[4] - h[4]) * mb.x; h[5] += (n[5] - h[5]) * mb.y; h[6] += (n[6] - h[6]) * mb.z; h[7] += (n[7] - h[7]) * mb.w;
    return pack8(h);
  };
  auto store_lds = [&](int kt, int buf) {
    bf16_t* ad = As + (buf * TM + row0) * LDK + ch;
    bf16_t* bd = Bs + (buf * 128 + row0) * LDK + ch;
    if (AMODE == 1) {
      const float4 ma = *(const float4*)(mixs + kt * 64 + ch), mb = *(const float4*)(mixs + kt * 64 + ch + 4);
      *(uint4*)(ad + 0 * LDK) = mix8(a0, n0, ma, mb);
      *(uint4*)(ad + 8 * LDK) = mix8(a1, n1, ma, mb);
      *(uint4*)(ad + 16 * LDK) = mix8(a2, n2, ma, mb);
      *(uint4*)(ad + 24 * LDK) = mix8(a3, n3, ma, mb);
    } else {
      *(uint4*)(ad + 0 * LDK) = a0;
      *(uint4*)(ad + 8 * LDK) = a1;
      *(uint4*)(ad + 16 * LDK) = a2;
      *(uint4*)(ad + 24 * LDK) = a3;
    }
    *(uint4*)(bd + 0 * LDK) = b0;
    *(uint4*)(bd + 8 * LDK) = b1;
    *(uint4*)(bd + 16 * LDK) = b2;
    *(uint4*)(bd + 24 * LDK) = b3;
  };
  auto compute = [&](int buf) {
    const bf16_t* ab = As + (buf * TM + wm * 64 + (lane & 31)) * LDK + (lane >> 5) * 8;
    const bf16_t* bb = Bs + (buf * 128 + wn * 64 + (lane & 31)) * LDK + (lane >> 5) * 8;
#pragma unroll
    for (int kk = 0; kk < 4; ++kk) {
      const bf16x8 af0 = *(const bf16x8*)(ab + kk * 16), af1 = *(const bf16x8*)(ab + 32 * LDK + kk * 16);
      const bf16x8 bf0 = *(const bf16x8*)(bb + kk * 16), bf1 = *(const bf16x8*)(bb + 32 * LDK + kk * 16);
      acc[0][0] = __builtin_amdgcn_mfma_f32_32x32x16_bf16(af0, bf0, acc[0][0], 0, 0, 0);
      acc[0][1] = __builtin_amdgcn_mfma_f32_32x32x16_bf16(af0, bf1, acc[0][1], 0, 0, 0);
      acc[1][0] = __builtin_amdgcn_mfma_f32_32x32x16_bf16(af1, bf0, acc[1][0], 0, 0, 0);
      acc[1][1] = __builtin_amdgcn_mfma_f32_32x32x16_bf16(af1, bf1, acc[1][1], 0, 0, 0);
    }
  };
  load_regs(0);
  lds_barrier();
  store_lds(0, 0);
  if (KT > 1) load_regs(1);
  lds_barrier();
  for (int kt = 0; kt < KT; ++kt) {
    if (kt + 1 < KT) store_lds(kt + 1, (kt + 1) & 1);
    if (kt + 2 < KT) load_regs(kt + 2);
    compute(kt & 1);
    lds_barrier();
  }
  float* Cs = (float*)smem;
#pragma unroll
  for (int i = 0; i < 2; ++i)
#pragma unroll
    for (int j = 0; j < 2; ++j)
#pragma unroll
      for (int r = 0; r < 16; ++r)
        Cs[(wm * 64 + i * 32 + (r & 3) + 8 * (r >> 2) + 4 * (lane >> 5)) * 132 + wn * 64 + j * 32 + (lane & 31)] = acc[i][j][r];
  lds_barrier();
#pragma unroll 2
  for (int it = 0; it < 8; ++it) {
    const int idx = it * 256 + tid, row = idx >> 4, c8 = (idx & 15) * 8;
    const float4 v0 = *(const float4*)(Cs + row * 132 + c8), v1 = *(const float4*)(Cs + row * 132 + c8 + 4);
    float v[8] = {v0.x, v0.y, v0.z, v0.w, v1.x, v1.y, v1.z, v1.w};
    epi(m0 + row, c8, v);
  }
}

__device__ __forceinline__ void phase_rw_proj(const Params& p, int j, char* smem) {
  const int ntn = j == 0 ? 66 : 83;
  const float* mixb = p.rw_mix + (size_t)j * 6 * DM;
  for (int tile = blockIdx.x; tile < MT * ntn; tile += gridDim.x) {
    const int mt = tile / ntn, nt = tile % ntn, m0 = mt * 128;
    if (nt < 64) {
      const int pi = nt >> 4, n0 = (nt & 15) * 128;
      const int mi = pi == 0 ? 0 : (pi == 1 ? 2 : (pi == 2 ? 3 : 5));
      const bf16_t* Bw = g_wt + OFF_PROJ + ((size_t)(j * 4 + pi) * DI + n0) * DM;
      bf16_t* dst = pi == 0 ? p.R : (pi == 1 ? p.K : (pi == 2 ? p.V : p.Z));
      if (pi == 3) {
        gemm_tile<1>(p.H, DM, mixb + mi * DM, m0, DM, Bw, 128, smem,
                     [&](int row, int col, float* v) {
#pragma unroll
        for (int e = 0; e < 8; ++e) v[e] = siluf_(v[e]);
        *(uint4*)(dst + (size_t)row * DI + n0 + col) = pack8(v); });
      } else {
        gemm_tile<1>(p.H, DM, mixb + mi * DM, m0, DM, Bw, 128, smem,
                     [&](int row, int col, float* v) { *(uint4*)(dst + (size_t)row * DI + n0 + col) = pack8(v); });
      }
    } else if (nt == 64) {
      gemm_tile<1>(p.H, DM, mixb + 1 * DM, m0, DM, g_wt + OFF_W1 + (size_t)j * 128 * DM, 128, smem,
                   [&](int row, int col, float* v) {
#pragma unroll
        for (int e = 0; e < 8; ++e) v[e] = tanhf(v[e]);
        *(uint4*)(p.LRW + (size_t)row * 128 + col) = pack8(v); });
    } else if (nt == 65) {
      gemm_tile<1>(p.H, DM, mixb + 4 * DM, m0, DM, g_wt + OFF_A1 + (size_t)j * 128 * DM, 128, smem,
                   [&](int row, int col, float* v) { *(uint4*)(p.LRA + (size_t)row * 128 + col) = pack8(v); });
    } else if (nt == 66) {
      gemm_tile<1>(p.H, DM, mixb + 3 * DM, m0, DM, g_wt + OFF_V1, 32, smem, [&](int row, int col, float* v) {
        if (col < 32) *(uint4*)(p.LRV + (size_t)row * 32 + col) = pack8(v);
      });
    } else {
      const int n0 = (nt - 67) * 128;
      const bf16_t* Bw = g_wt + OFF_PROJ + ((size_t)2 * DI + n0) * DM;
      gemm_tile<1>(p.H0, DM, p.rw_mix + 3 * DM, m0, DM, Bw, 128, smem,
                   [&](int row, int col, float* v) { *(uint4*)(p.VF + (size_t)row * DI + n0 + col) = pack8(v); });
    }
  }
}

__device__ __forceinline__ void phase_rw_lr2(const Params& p, int j, char* smem) {
  for (int tile = blockIdx.x; tile < MT * 16; tile += gridDim.x) {
    const int mt = tile / 16, nt = tile % 16, m0 = mt * 128;
    const int n0 = nt * 128;
    const bf16_t* Bw = g_wt + OFF_V2 + (size_t)n0 * 32;
    const float* v0 = p.rw_v0 + n0;
    gemm_tile<0>(p.LRV, 32, nullptr, m0, 32, Bw, 128, smem, [&](int row, int col, float* v) {
      const size_t idx = (size_t)row * DI + n0 + col;
      float vv[8], vf[8];
      unpack8(*(const uint4*)(p.V + idx), vv); unpack8(*(const uint4*)(p.VF + idx), vf);
#pragma unroll
      for (int e = 0; e < 8; ++e) vv[e] += (vf[e] - vv[e]) * sigmoidf_(v[e] + v0[col + e]);
      *(uint4*)(p.V + idx) = pack8(vv);
    });
  }
}

constexpr int RCH = 32;
__device__ __forceinline__ int scan_pos(int dir, int s) { return dir == 0 ? s : (s < CTX ? CTX - 1 - s : TT + CTX - 1 - s); }

__device__ __forceinline__ void phase_rw_scan(const Params& p, int j, char* smem) {
  float* op = (float*)smem;
  float* vv = op + RCH * 4 * 64;
  float* sc = vv + RCH * 64;
  float* LWs = sc + RCH * 2;
  float* AAs = LWs + RCH * 64;
  float* yb = AAs;
  bf16_t* LRs = (bf16_t*)(AAs + RCH * 64);
  const int tid = opaque_tid(), lane = tid & 63, w = tid >> 6;
  const int ptau = tid >> 3, pc8 = (tid & 7) * 8;
  const int r2 = lane >> 3, ko = (lane & 7) * 8;
  const int row0 = w * 16 + r2, row1 = row0 + 8;
  for (int unit = blockIdx.x; unit < GB * 64; unit += gridDim.x) {
    const int bl = unit >> 6, h = (unit >> 1) & 31, dir = unit & 1;
    bf16_t* Y = dir == 0 ? p.YF : p.YB;
    float pkk[8], pka[8], prk[8];
#pragma unroll
    for (int e = 0; e < 8; ++e) {
      const int cc = j * DI + h * 64 + pc8 + e;
      pkk[e] = p.rw_kk[cc]; pka[e] = p.rw_ka[cc]; prk[e] = p.rw_rk[cc];
    }
    __syncthreads();
    const int mm = w >> 1, nh = w & 1;
    const float bias = (mm == 0 ? p.rw_w0 : p.rw_a0)[((size_t)j * 2 + dir) * DI + h * 64 + nh * 32 + (lane & 31)];
    bf16x8 wfr[4];
    {
      const bf16_t* w2g = g_wt + (mm == 0 ? OFF_W2 : OFF_A2) + (((size_t)j * 2 + dir) * DI + h * 64 + nh * 32 + (lane & 31)) * 64 + (lane >> 5) * 8;
#pragma unroll
      for (int kk = 0; kk < 4; ++kk) wfr[kk] = *(const bf16x8*)(w2g + kk * 16);
    }
    f2_t S0[4], S1[4];
#pragma unroll
    for (int e = 0; e < 4; ++e) { S0[e] = f2_t{0.f, 0.f}; S1[e] = f2_t{0.f, 0.f}; }
    uint4 gr, gk, gv, gl0, gl1;
    const int lmat = (tid & 7) >> 2, lcol = (tid & 3) * 16;
    auto gload = [&](int chunk) {
      const int pos = scan_pos(dir, chunk * RCH + ptau);
      const size_t tg = (size_t)bl * TT + pos;
      const size_t base = tg * DI + h * 64 + pc8;
      gr = *(const uint4*)(p.R + base); gk = *(const uint4*)(p.K + base); gv = *(const uint4*)(p.V + base);
      const bf16_t* lr = (lmat == 0 ? p.LRW : p.LRA) + tg * 128 + dir * 64 + lcol;
      gl0 = *(const uint4*)(lr); gl1 = *(const uint4*)(lr + 8);
    };
    gload(0);
    for (int chunk = 0; chunk < TT / RCH; ++chunk) {
      *(uint4*)(LRs + (lmat * RCH + ptau) * 72 + lcol) = gl0;
      *(uint4*)(LRs + (lmat * RCH + ptau) * 72 + lcol + 8) = gl1;
      lds_barrier();
      {
        f32x16 acc;
#pragma unroll
        for (int r = 0; r < 16; ++r) acc[r] = 0.f;
#pragma unroll
        for (int kk = 0; kk < 4; ++kk) {
          const bf16x8 af = *(const bf16x8*)(LRs + (mm * RCH + (lane & 31)) * 72 + kk * 16 + (lane >> 5) * 8);
          acc = __builtin_amdgcn_mfma_f32_32x32x16_bf16(af, wfr[kk], acc, 0, 0, 0);
        }
        const int chn = nh * 32 + (lane & 31), hh = lane >> 5;
        if (mm == 0) {
          float lwv[16], pf[16], own[4], oth[4];
#pragma unroll
          for (int r = 0; r < 16; ++r) lwv[r] = -0.60653066f * sigmoidf_(acc[r] + bias);
#pragma unroll
          for (int g = 0; g < 4; ++g) {
            pf[g * 4] = lwv[g * 4];
            pf[g * 4 + 1] = pf[g * 4] + lwv[g * 4 + 1];
            pf[g * 4 + 2] = pf[g * 4 + 1] + lwv[g * 4 + 2];
            pf[g * 4 + 3] = pf[g * 4 + 2] + lwv[g * 4 + 3];
            own[g] = pf[g * 4 + 3];
            oth[g] = __shfl_xor(own[g], 32);
          }
          float base = 0.f;
#pragma unroll
          for (int g = 0; g < 4; ++g) {
            const float off = base + (hh ? oth[g] : 0.f);
#pragma unroll
            for (int q = 0; q < 4; ++q) {
              const int t = q + 8 * g + 4 * hh;
              const float c = off + pf[g * 4 + q];
              LWs[t * 64 + chn] = c;
            }
            base += own[g] + oth[g];
          }
        } else {
#pragma unroll
          for (int r = 0; r < 16; ++r) {
            const int t = (r & 3) + 8 * (r >> 2) + 4 * hh;
            AAs[t * 64 + chn] = sigmoidf_(acc[r] + bias);
          }
        }
      }
      lds_barrier();
      {
        float r[8], k[8], v[8], cm[8], cp[8], a[8];
        unpack8(gr, r); unpack8(gk, k); unpack8(gv, v);
#pragma unroll
        for (int e = 0; e < 8; ++e) {
          cm[e] = LWs[ptau * 64 + pc8 + e]; cp[e] = ptau > 0 ? LWs[(ptau - 1) * 64 + pc8 + e] : 0.f; a[e] = AAs[ptau * 64 + pc8 + e];
        }
        float kkv[8], ss = 0.f;
#pragma unroll
        for (int e = 0; e < 8; ++e) { kkv[e] = k[e] * pkk[e]; ss += kkv[e] * kkv[e]; }
        ss = red8(ss);
        const float inv = rsqrtf(fmaxf(ss, 1e-24f));
        float br = 0.f, kr = 0.f, bon = 0.f;
        float o0[8], o1[8], o2[8], o3[8];
#pragma unroll
        for (int e = 0; e < 8; ++e) {
          const float kkn = kkv[e] * inv;
          const float P = __expf(cm[e]), Pp = __expf(cp[e]);
          const float iP = 1.f / P;
          const float kd = k[e] * (1.f + (a[e] - 1.f) * pka[e]);
          const float bb = kkn * a[e];
          o0[e] = -kkn * Pp; o1[e] = r[e] * P; o2[e] = bb * iP; o3[e] = kd * iP;
          br += bb * r[e]; kr += kd * r[e]; bon += r[e] * kd * prk[e];
        }
        br = red8(br); kr = red8(kr); bon = red8(bon);
        float* od = op + ptau * 256 + pc8;
        *(float4*)(od) = make_float4(o0[0], o0[1], o0[2], o0[3]); *(float4*)(od + 4) = make_float4(o0[4], o0[5], o0[6], o0[7]);
        *(float4*)(od + 64) = make_float4(o1[0], o1[1], o1[2], o1[3]); *(float4*)(od + 68) = make_float4(o1[4], o1[5], o1[6], o1[7]);
        *(float4*)(od + 128) = make_float4(o2[0], o2[1], o2[2], o2[3]); *(float4*)(od + 132) = make_float4(o2[4], o2[5], o2[6], o2[7]);
        *(float4*)(od + 192) = make_float4(o3[0], o3[1], o3[2], o3[3]); *(float4*)(od + 196) = make_float4(o3[4], o3[5], o3[6], o3[7]);
        float* vd = vv + ptau * 64 + pc8;
        *(float4*)(vd) = make_float4(v[0], v[1], v[2], v[3]); *(float4*)(vd + 4) = make_float4(v[4], v[5], v[6], v[7]);
        if ((tid & 7) == 0) {
          sc[ptau * 2] = br; sc[ptau * 2 + 1] = kr;
          const int pos = scan_pos(dir, chunk * RCH + ptau);
          p.BN[((size_t)dir * NTG + (size_t)bl * TT + pos) * 32 + h] = bon;
        }
      }
      lds_barrier();
      if (chunk + 1 < TT / RCH) gload(chunk + 1);
      {
        struct StepOps { float4 n0, n1, q0, q1, b0, b1, k0, k1; float v0, v1; float2 s; };
        auto ldops = [&](StepOps& o, int tau) {
          const float* ob = op + tau * 256 + ko;
          o.n0 = *(const float4*)(ob); o.n1 = *(const float4*)(ob + 4);
          o.q0 = *(const float4*)(ob + 64); o.q1 = *(const float4*)(ob + 68);
          o.b0 = *(const float4*)(ob + 128); o.b1 = *(const float4*)(ob + 132);
          o.k0 = *(const float4*)(ob + 192); o.k1 = *(const float4*)(ob + 196);
          o.v0 = vv[tau * 64 + row0]; o.v1 = vv[tau * 64 + row1];
          o.s = *(const float2*)(sc + tau * 2);
        };
        auto dostep = [&](const StepOps& o, int tau) {
          const float nk[8] = {o.n0.x, o.n0.y, o.n0.z, o.n0.w, o.n1.x, o.n1.y, o.n1.z, o.n1.w};
          const float rr[8] = {o.q0.x, o.q0.y, o.q0.z, o.q0.w, o.q1.x, o.q1.y, o.q1.z, o.q1.w};
          const float bb[8] = {o.b0.x, o.b0.y, o.b0.z, o.b0.w, o.b1.x, o.b1.y, o.b1.z, o.b1.w};
          const float kd[8] = {o.k0.x, o.k0.y, o.k0.z, o.k0.w, o.k1.x, o.k1.y, o.k1.z, o.k1.w};
          f2_t a10 = {0.f, 0.f}, a11 = {0.f, 0.f}, a20 = {0.f, 0.f}, a21 = {0.f, 0.f};
#pragma unroll
          for (int e = 0; e < 4; ++e) {
            const f2_t nk2 = {nk[2 * e], nk[2 * e + 1]}, rr2 = {rr[2 * e], rr[2 * e + 1]};
            a10 = __builtin_elementwise_fma(S0[e], nk2, a10); a11 = __builtin_elementwise_fma(S1[e], nk2, a11);
            a20 = __builtin_elementwise_fma(S0[e], rr2, a20); a21 = __builtin_elementwise_fma(S1[e], rr2, a21);
          }
          float d10 = a10.x + a10.y, d11 = a11.x + a11.y, d20 = a20.x + a20.y, d21 = a21.x + a21.y;
          d10 = red8(d10); d11 = red8(d11); d20 = red8(d20); d21 = red8(d21);
          const float y0 = d20 + d10 * o.s.x + o.v0 * o.s.y;
          const float y1 = d21 + d11 * o.s.x + o.v1 * o.s.y;
          const f2_t sa0 = {d10, d10}, sa1 = {d11, d11}, vv0 = {o.v0, o.v0}, vv1 = {o.v1, o.v1};
#pragma unroll
          for (int e = 0; e < 4; ++e) {
            const f2_t bb2 = {bb[2 * e], bb[2 * e + 1]}, kd2 = {kd[2 * e], kd[2 * e + 1]};
            S0[e] = __builtin_elementwise_fma(sa0, bb2, __builtin_elementwise_fma(vv0, kd2, S0[e]));
            S1[e] = __builtin_elementwise_fma(sa1, bb2, __builtin_elementwise_fma(vv1, kd2, S1[e]));
          }
          if ((lane & 7) == 0) { yb[tau * 64 + row0] = y0; yb[tau * 64 + row1] = y1; }
        };
        StepOps oa, ob2;
        ldops(oa, 0);
        for (int tau = 0; tau < RCH; tau += 2) {
          ldops(ob2, tau + 1);
          dostep(oa, tau);
          if (tau + 2 < RCH) ldops(oa, tau + 2);
          dostep(ob2, tau + 1);
        }
#pragma unroll
        for (int e = 0; e < 4; ++e) {
          const f2_t pc = {__expf(LWs[(RCH - 1) * 64 + ko + 2 * e]), __expf(LWs[(RCH - 1) * 64 + ko + 2 * e + 1])};
          S0[e] *= pc; S1[e] *= pc;
        }
      }
      lds_barrier();
      {
        const int pos = scan_pos(dir, chunk * RCH + ptau);
        const float* ys = yb + ptau * 64 + pc8;
        float yv[8];
#pragma unroll
        for (int e = 0; e < 8; ++e) yv[e] = ys[e];
        *(uint4*)(Y + ((size_t)bl * TT + pos) * DI + h * 64 + pc8) = pack8(yv);
      }
    }
    lds_barrier();
  }
}

__device__ __forceinline__ void phase_rw_gate(const Params& p, int j) {
  const int tid = opaque_tid(), h = tid >> 3;
  const int c0 = tid * 8;
  float lnw[8], lnb[8];
#pragma unroll
  for (int e = 0; e < 8; ++e) { lnw[e] = p.rw_lnw[j * DI + c0 + e]; lnb[e] = p.rw_lnb[j * DI + c0 + e]; }
  for (int tg = blockIdx.x; tg < NTG; tg += gridDim.x) {
    const size_t base = (size_t)tg * DI + c0;
    float yf[8], yb[8], v[8], z[8];
    unpack8(*(const uint4*)(p.YF + base), yf); unpack8(*(const uint4*)(p.YB + base), yb);
    unpack8(*(const uint4*)(p.V + base), v); unpack8(*(const uint4*)(p.Z + base), z);
    const float bon = p.BN[(size_t)tg * 32 + h] + p.BN[((size_t)NTG + tg) * 32 + h];
    float y[8], s = 0.f;
#pragma unroll
    for (int e = 0; e < 8; ++e) { y[e] = yf[e] + yb[e]; s += y[e]; }
    const float mu = red8(s) * (1.f / 64.f);
    float s2 = 0.f;
#pragma unroll
    for (int e = 0; e < 8; ++e) { y[e] -= mu; s2 += y[e] * y[e]; }
    const float rstd = rsqrtf(red8(s2) * (1.f / 64.f) + 64e-5f);
#pragma unroll
    for (int e = 0; e < 8; ++e) y[e] = (y[e] * rstd * lnw[e] + lnb[e] + bon * v[e]) * z[e];
    *(uint4*)(p.YF + base) = pack8(y);
  }
}

__device__ __forceinline__ void phase_out(const Params& p, const bf16_t* wo, char* smem) {
  for (int tile = blockIdx.x; tile < MT * 8; tile += gridDim.x) {
    const int mt = tile / 8, nt = tile % 8, m0 = mt * 128, n0 = nt * 128;
    const bf16_t* Bw = wo + (size_t)n0 * DI;
    gemm_tile<0>(p.YF, DI, nullptr, m0, DI, Bw, 128, smem,
                 [&](int row, int col, float* v) {
      float* o = p.O + (size_t)row * DM + n0 + col;
      *(float4*)o = make_float4(v[0], v[1], v[2], v[3]); *(float4*)(o + 4) = make_float4(v[4], v[5], v[6], v[7]); });
  }
}

__device__ __forceinline__ void phase_hg_proj(const Params& p, int j, char* smem) {
  const int layer = 2 * j + 1;
  for (int tile = blockIdx.x; tile < MT * 80; tile += gridDim.x) {
    const int mt = tile / 80, nt = tile % 80, m0 = mt * 128;
    const int seg = nt >> 4, n0 = (nt & 15) * 128;
    const bf16_t* Bw = g_wt + OFF_HWIN + ((size_t)j * 5 * DI + (size_t)seg * DI + n0) * DM;
    bf16_t* dst = seg == 0 ? p.R : (seg == 1 ? p.K : (seg == 2 ? p.WF : (seg == 3 ? p.V : p.Z)));
    if (seg == 0 || seg == 4) {
      gemm_tile<0>(p.H, DM, nullptr, m0, DM, Bw, 128, smem, [&](int row, int col, float* v) {
#pragma unroll
        for (int e = 0; e < 8; ++e) v[e] = siluf_(v[e]);
        *(uint4*)(dst + (size_t)row * DI + n0 + col) = pack8(v); });
    } else if (seg == 3) {
      gemm_tile<0>(p.H, DM, nullptr, m0, DM, Bw, 128, smem,
                   [&](int row, int col, float* v) { *(uint4*)(dst + (size_t)row * DI + n0 + col) = pack8(v); });
    } else {
      const float* lbp = p.LB + layer * DI + n0;
      gemm_tile<0>(p.H, DM, nullptr, m0, DM, Bw, 128, smem, [&](int row, int col, float* v) {
        const float4 l0 = *(const float4*)(lbp + col), l1 = *(const float4*)(lbp + col + 4);
        const float lb[8] = {l0.x, l0.y, l0.z, l0.w, l1.x, l1.y, l1.z, l1.w};
#pragma unroll
        for (int e = 0; e < 8; ++e) v[e] = __logf(lb[e] + (1.f - lb[e]) * sigmoidf_(v[e]));
        *(uint4*)(dst + (size_t)row * DI + n0 + col) = pack8(v); });
    }
  }
}

constexpr int HC = 32;
constexpr int QS = 136;
constexpr int SS = 40;
__device__ __forceinline__ void phase_hg_scan(const Params& p, int layer, char* smem) {
  bf16_t* qe = (bf16_t*)smem;
  bf16_t* ke = qe + HC * QS;
  bf16_t* kdT = ke + HC * QS;
  bf16_t* vT = kdT + 128 * SS;
  bf16_t* att = vT + 64 * SS;
  bf16_t* ST = att + HC * SS;
  float* dC = (float*)(ST + 64 * QS);
  const int tid = opaque_tid(), lane = tid & 63, w = tid >> 6;
  for (int unit = blockIdx.x; unit < GB * 64; unit += gridDim.x) {
    const int vs = unit & 1, dir = (unit >> 1) & 1, h = (unit >> 2) & 15, bl = unit >> 6;
    const bf16_t* FL = dir == 0 ? p.K : p.WF;
    bf16_t* Y = dir == 0 ? p.YF : p.YB;
    const int st = lane & 31, cg = w * 2 + (lane >> 5), kb = cg * 16, vb = cg * 8;
    f32x16 sacc[2];
#pragma unroll
    for (int r = 0; r < 16; ++r) { sacc[0][r] = 0.f; sacc[1][r] = 0.f; }
    __syncthreads();
    for (int idx = tid; idx < 64 * QS / 2; idx += 256) ((unsigned*)ST)[idx] = 0u;
    uint4 gq0, gq1, gf0, gf1, gvv;
    auto gload = [&](int chunk) {
      const int pos = scan_pos(dir, chunk * HC + st);
      const size_t base = ((size_t)bl * TT + pos) * DI + h * 128;
      gq0 = *(const uint4*)(p.R + base + kb); gq1 = *(const uint4*)(p.R + base + kb + 8);
      gf0 = *(const uint4*)(FL + base + kb); gf1 = *(const uint4*)(FL + base + kb + 8);
      gvv = *(const uint4*)(p.V + base + vs * 64 + vb);
    };
    gload(0);
    for (int chunk = 0; chunk < TT / HC; ++chunk) {
      float q[16], cum[16], one[16];
      {
        unpack8(gq0, q); unpack8(gq1, q + 8); unpack8(gf0, cum); unpack8(gf1, cum + 8);
#pragma unroll
        for (int e = 0; e < 16; ++e) {
          float c = cum[e];
          one[e] = 1.f - __expf(c);
          c += __int_as_float(__builtin_amdgcn_update_dpp(0, __float_as_int(c), 0x111, 0xf, 0xf, false));
          c += __int_as_float(__builtin_amdgcn_update_dpp(0, __float_as_int(c), 0x112, 0xf, 0xf, false));
          c += __int_as_float(__builtin_amdgcn_update_dpp(0, __float_as_int(c), 0x114, 0xf, 0xf, false));
          c += __int_as_float(__builtin_amdgcn_update_dpp(0, __float_as_int(c), 0x118, 0xf, 0xf, false));
          c += __int_as_float(__builtin_amdgcn_update_dpp(0, __float_as_int(c), 0x142, 0xa, 0xf, false));
          cum[e] = c;
        }
      }
      const uint4 vreg = gvv;
      lds_barrier();
      {
        float qo[16], ko[16];
#pragma unroll
        for (int e = 0; e < 16; ++e) {
          const float c31 = __int_as_float(__builtin_amdgcn_readlane(__float_as_int(cum[e]), 31));
          const float c63 = __int_as_float(__builtin_amdgcn_readlane(__float_as_int(cum[e]), 63));
          const float cC = (lane >> 5) ? c63 : c31;
          const float ec = __expf(fmaxf(cum[e], -80.f));
          const float inv = 1.f / ec;
          const float eC = __expf(cC);
          qo[e] = q[e] * ec;
          ko[e] = one[e] * inv;
          kdT[(kb + e) * SS + st] = f2bf(one[e] * inv * eC);
          if (st == 31) dC[kb + e] = eC;
        }
        *(uint4*)(qe + st * QS + kb) = pack8(qo); *(uint4*)(qe + st * QS + kb + 8) = pack8(qo + 8);
        *(uint4*)(ke + st * QS + kb) = pack8(ko); *(uint4*)(ke + st * QS + kb + 8) = pack8(ko + 8);
        const bf16_t* vp = (const bf16_t*)&vreg;
#pragma unroll
        for (int e = 0; e < 8; ++e) vT[(vb + e) * SS + st] = vp[e];
      }
      lds_barrier();
      if (chunk + 1 < TT / HC) gload(chunk + 1);
      {
        const int mi = w >> 1, ni = w & 1;
        f32x4 a4 = {0.f, 0.f, 0.f, 0.f};
#pragma unroll
        for (int kk = 0; kk < 4; ++kk) {
          const bf16x8 af = *(const bf16x8*)(qe + (mi * 16 + (lane & 15)) * QS + kk * 32 + (lane >> 4) * 8);
          const bf16x8 bf = *(const bf16x8*)(ke + (ni * 16 + (lane & 15)) * QS + kk * 32 + (lane >> 4) * 8);
          a4 = __builtin_amdgcn_mfma_f32_16x16x32_bf16(af, bf, a4, 0, 0, 0);
        }
        const int s = ni * 16 + (lane & 15);
#pragma unroll
        for (int r = 0; r < 4; ++r) {
          const int t = mi * 16 + (lane >> 4) * 4 + r;
          att[t * SS + s] = f2bf(s <= t ? a4[r] : 0.f);
        }
      }
      lds_barrier();
      {
#pragma unroll
        for (int mh = 0; mh < 2; ++mh) {
          f32x4 y4 = {0.f, 0.f, 0.f, 0.f};
          {
            const bf16x8 af = *(const bf16x8*)(att + (mh * 16 + (lane & 15)) * SS + (lane >> 4) * 8);
            const bf16x8 bf = *(const bf16x8*)(vT + (w * 16 + (lane & 15)) * SS + (lane >> 4) * 8);
            y4 = __builtin_amdgcn_mfma_f32_16x16x32_bf16(af, bf, y4, 0, 0, 0);
          }
#pragma unroll
          for (int kk = 0; kk < 4; ++kk) {
            const bf16x8 af = *(const bf16x8*)(qe + (mh * 16 + (lane & 15)) * QS + kk * 32 + (lane >> 4) * 8);
            const bf16x8 bf = *(const bf16x8*)(ST + (w * 16 + (lane & 15)) * QS + kk * 32 + (lane >> 4) * 8);
            y4 = __builtin_amdgcn_mfma_f32_16x16x32_bf16(af, bf, y4, 0, 0, 0);
          }
#pragma unroll
          for (int r = 0; r < 4; ++r) {
            const int t = mh * 16 + (lane >> 4) * 4 + r;
            const int pos = scan_pos(dir, chunk * HC + t);
            Y[((size_t)bl * TT + pos) * DI + h * 128 + vs * 64 + w * 16 + (lane & 15)] = f2bf(y4[r]);
          }
        }
      }
      lds_barrier();
      {
        float dk[16];
#pragma unroll
        for (int r = 0; r < 16; ++r) dk[r] = dC[w * 32 + (r & 3) + 8 * (r >> 2) + 4 * (lane >> 5)];
#pragma unroll
        for (int nt = 0; nt < 2; ++nt) {
#pragma unroll
          for (int r = 0; r < 16; ++r) sacc[nt][r] *= dk[r];
#pragma unroll
          for (int ks = 0; ks < 2; ++ks) {
            const bf16x8 af = *(const bf16x8*)(kdT + (w * 32 + (lane & 31)) * SS + ks * 16 + (lane >> 5) * 8);
            const bf16x8 bf = *(const bf16x8*)(vT + (nt * 32 + (lane & 31)) * SS + ks * 16 + (lane >> 5) * 8);
            sacc[nt] = __builtin_amdgcn_mfma_f32_32x32x16_bf16(af, bf, sacc[nt], 0, 0, 0);
          }
#pragma unroll
          for (int gq = 0; gq < 4; ++gq) {
            uint2 u;
            u.x = pack2(sacc[nt][gq * 4 + 0], sacc[nt][gq * 4 + 1]);
            u.y = pack2(sacc[nt][gq * 4 + 2], sacc[nt][gq * 4 + 3]);
            *(uint2*)(ST + (nt * 32 + (lane & 31)) * QS + w * 32 + gq * 8 + (lane >> 5) * 4) = u;
          }
        }
      }
    }
    lds_barrier();
  }
}

__device__ __forceinline__ void phase_hg_gate(const Params& p, int j) {
  const int tid = opaque_tid();
  const int c0 = tid * 8;
  float gn[8];
#pragma unroll
  for (int e = 0; e < 8; ++e) gn[e] = p.hg_gn[j * 128 + ((c0 + e) & 127)];
  for (int tg = blockIdx.x; tg < NTG; tg += gridDim.x) {
    const size_t base = (size_t)tg * DI + c0;
    float yf[8], yb[8], z[8];
    unpack8(*(const uint4*)(p.YF + base), yf); unpack8(*(const uint4*)(p.YB + base), yb);
    unpack8(*(const uint4*)(p.Z + base), z);
    float y[8], s2 = 0.f;
#pragma unroll
    for (int e = 0; e < 8; ++e) { y[e] = yf[e] + yb[e]; s2 += y[e] * y[e]; }
    const float rstd = rsqrtf(red16(s2) * (1.f / 128.f) + EPS);
#pragma unroll
    for (int e = 0; e < 8; ++e) y[e] = y[e] * rstd * gn[e] * z[e];
    *(uint4*)(p.YF + base) = pack8(y);
  }
}

__global__ void __launch_bounds__(256, 2) fwd_megakernel(Params p) {
  cg::grid_group grid = cg::this_grid();
  __shared__ __attribute__((aligned(16))) char smem[78 * 1024];
  phase_mod(p, smem);
  phase_wconv(p, smem);
  grid.sync();
  for (int g = 0; g < NG; ++g) {
    for (int layer = 0; layer < 4; ++layer) {
      phase_resnorm(p, g, layer - 1, layer);
      grid.sync();
      const int j = layer >> 1;
      if ((layer & 1) == 0) {
        phase_rw_proj(p, j, smem);
        grid.sync();
        if (j == 1) { phase_rw_lr2(p, j, smem); grid.sync(); }
        phase_rw_scan(p, j, smem);
        grid.sync();
        phase_rw_gate(p, j);
        grid.sync();
        phase_out(p, g_wt + OFF_RWO + (size_t)j * DM * DI, smem);
        grid.sync();
      } else {
        phase_hg_proj(p, j, smem);
        grid.sync();
        phase_hg_scan(p, layer, smem);
        grid.sync();
        phase_hg_gate(p, j);
        grid.sync();
        phase_out(p, g_wt + OFF_HWO + (size_t)j * DM * DI, smem);
        grid.sync();
      }
    }
    phase_resnorm(p, g, 3, -1);
    grid.sync();
  }
}

extern "C" void kernel_launch(void* const* d_in, const int* in_sizes, int n_in, void* d_out, int out_size, void* d_ws,
                              size_t ws_size, hipStream_t stream) {
  static int grid_blocks = 0;
  if (!grid_blocks) {
    int dev = 0, cus = 0, per_cu = 0;
    hipGetDevice(&dev);
    hipDeviceGetAttribute(&cus, hipDeviceAttributeMultiprocessorCount, dev);
    hipOccupancyMaxActiveBlocksPerMultiprocessor(&per_cu, fwd_megakernel, 256, 0);
    if (per_cu > 2) per_cu = 2;
    grid_blocks = cus * per_cu;
  }
  Params p{};
  const float** fp = (const float**)&p;
  for (int i = 0; i < 29; ++i) fp[i] = (const float*)d_in[i];
  p.out = (float*)d_out;
  char* w = (char*)d_ws;
  size_t off = 0;
  auto take = [&](size_t bytes) { char* r = w + off; off += (bytes + 255) & ~(size_t)255; return r; };
  const size_t DIW = (size_t)NTG * DI * 2;
  p.R = (bf16_t*)take(DIW); p.K = (bf16_t*)take(DIW); p.V = (bf16_t*)take(DIW); p.Z = (bf16_t*)take(DIW);
  p.WF = (bf16_t*)take(DIW); p.YF = (bf16_t*)take(DIW); p.YB = (bf16_t*)take(DIW);
  p.VF = p.YF;
  p.H = p.YB; p.H0 = p.YB + (size_t)NTG * DM;
  p.LRW = (bf16_t*)take((size_t)NTG * 128 * 2); p.LRA = (bf16_t*)take((size_t)NTG * 128 * 2);
  p.LRV = (bf16_t*)take((size_t)NTG * 32 * 2);
  p.O = (float*)p.R;
  p.BN = (float*)take((size_t)2 * NTG * 32 * 4);
  p.CTXB = (float*)take((size_t)NB * CTX * DM * 4);
  p.MODV = (float*)take((size_t)4 * 9 * 3 * DM * 4);
  p.LB = (float*)take((size_t)4 * DI * 4);
  if (off > ws_size) { fprintf(stderr, "workspace too small: need %zu have %zu\n", off, ws_size); return; }
  void* args[] = {&p};
  hipError_t e = hipLaunchCooperativeKernel((void*)fwd_megakernel, dim3(grid_blocks), dim3(256), args, 0, stream);
  if (e != hipSuccess) fprintf(stderr, "cooperative launch failed: %s (grid %d)\n", hipGetErrorString(e), grid_blocks);
}
```

```cpp
#include <hip/hip_runtime.h>
#include <hip/hip_cooperative_groups.h>
#include <cstdio>
#include <cstdint>
namespace cg = cooperative_groups;

typedef unsigned short bf16_t;
using bf16x8 = __attribute__((ext_vector_type(8))) short;
using f32x16 = __attribute__((ext_vector_type(16))) float;
using f32x4 = __attribute__((ext_vector_type(4))) float;
using f2_t = __attribute__((ext_vector_type(2))) float;

constexpr int NB = 8, SEQ = 4096, CTX = 256, TT = 4352, DM = 1024, DI = 2048;
constexpr int GB = 4, NG = NB / GB, NTG = GB * TT;
constexpr int MT = NTG / 128;
constexpr float EPS = 1e-6f;

constexpr size_t OFF_PROJ = 0;
constexpr size_t OFF_RWO = OFF_PROJ + (size_t)2 * 4 * DI * DM;
constexpr size_t OFF_W1 = OFF_RWO + (size_t)2 * DM * DI;
constexpr size_t OFF_A1 = OFF_W1 + (size_t)2 * 128 * DM;
constexpr size_t OFF_V1 = OFF_A1 + (size_t)2 * 128 * DM;
constexpr size_t OFF_V2 = OFF_V1 + (size_t)32 * DM;
constexpr size_t OFF_HWIN = OFF_V2 + (size_t)DI * 32;
constexpr size_t OFF_HWO = OFF_HWIN + (size_t)2 * 5 * DI * DM;
constexpr size_t OFF_W2 = OFF_HWO + (size_t)2 * DM * DI;
constexpr size_t OFF_A2 = OFF_W2 + (size_t)4 * DI * 64;
constexpr size_t WT_TOTAL = OFF_A2 + (size_t)4 * DI * 64;
__device__ bf16_t g_wt[WT_TOTAL];

struct Params {
  const float *x, *c, *ctx, *c_ctx, *mod_w, *mod_b, *pre_g, *post_g, *rw_mix, *rw_proj, *rw_wo, *rw_w0, *rw_w1,
      *rw_w2, *rw_a0, *rw_a1, *rw_a2, *rw_v0, *rw_v1, *rw_v2, *rw_kk, *rw_ka, *rw_rk, *rw_lnw, *rw_lnb, *hg_win,
      *hg_wo, *hg_gn, *hg_lb;
  float* out;
  bf16_t *R, *K, *V, *Z, *WF, *YF, *YB, *VF, *H, *HR, *HR0, *LRW, *LRA, *LRV;
  float *O, *BN, *CTXB, *MODV, *LB;
};

typedef __bf16 hwbf2_t __attribute__((ext_vector_type(2)));
typedef float hwf2_t __attribute__((ext_vector_type(2)));
__device__ __forceinline__ unsigned pack2(float a, float b) {
  hwf2_t f = {a, b};
  hwbf2_t h = __builtin_convertvector(f, hwbf2_t);
  return __builtin_bit_cast(unsigned, h);
}
__device__ __forceinline__ bf16_t f2bf(float f) { return (bf16_t)(pack2(f, f) & 0xffffu); }
__device__ __forceinline__ float bf2f(bf16_t h) { return __uint_as_float(((unsigned)h) << 16); }
__device__ __forceinline__ float lo2f(unsigned u) { return __uint_as_float(u << 16); }
__device__ __forceinline__ float hi2f(unsigned u) { return __uint_as_float(u & 0xffff0000u); }
__device__ __forceinline__ float sigmoidf_(float x) { return 1.f / (1.f + __expf(-x)); }
__device__ __forceinline__ float siluf_(float x) { return x / (1.f + __expf(-x)); }

__device__ __forceinline__ void lds_barrier() { asm volatile("s_waitcnt lgkmcnt(0)\n\ts_barrier" ::: "memory"); }

__device__ __forceinline__ int opaque_tid() { int t = threadIdx.x; asm volatile("" : "+v"(t)); return t; }

template <int CTRL>
__device__ __forceinline__ float dppf(float v) {
  return __int_as_float(__builtin_amdgcn_update_dpp(0, __float_as_int(v), CTRL, 0xf, 0xf, true));
}
__device__ __forceinline__ float red4(float v) { v += dppf<0xB1>(v); v += dppf<0x4E>(v); return v; }
__device__ __forceinline__ float red8(float v) { v = red4(v); v += dppf<0x141>(v); return v; }
__device__ __forceinline__ float red16(float v) { v = red8(v); v += dppf<0x140>(v); return v; }
__device__ __forceinline__ float red64(float v) {
  v = red16(v);
  v += __shfl_xor(v, 16);
  v += __shfl_xor(v, 32);
  return v;
}

__device__ __forceinline__ void unpack8(const uint4& u, float* f) {
  f[0] = lo2f(u.x); f[1] = hi2f(u.x); f[2] = lo2f(u.y); f[3] = hi2f(u.y);
  f[4] = lo2f(u.z); f[5] = hi2f(u.z); f[6] = lo2f(u.w); f[7] = hi2f(u.w);
}
__device__ __forceinline__ uint4 pack8(const float* f) {
  uint4 u; u.x = pack2(f[0], f[1]); u.y = pack2(f[2], f[3]); u.z = pack2(f[4], f[5]); u.w = pack2(f[6], f[7]);
  return u;
}

__device__ __forceinline__ const float* row_in(const Params& p, int b, int t) {
  return t < CTX ? p.ctx + ((size_t)b * CTX + t) * DM : p.x + ((size_t)b * SEQ + (t - CTX)) * DM;
}
__device__ __forceinline__ float* row_cur(const Params& p, int b, int t) {
  return t < CTX ? p.CTXB + ((size_t)b * CTX + t) * DM : p.out + ((size_t)b * SEQ + (t - CTX)) * DM;
}

__device__ __forceinline__ void phase_mod(const Params& p, char* smem) {
  float* red = (float*)smem;
  const int tid = opaque_tid(), cl = tid & 63, kp = tid >> 6;
  for (int task = blockIdx.x; task < 4 * 48; task += gridDim.x) {
    const int l = task / 48, col = (task % 48) * 64 + cl;
    float acc[9];
#pragma unroll
    for (int r = 0; r < 9; ++r) acc[r] = 0.f;
    const float* W = p.mod_w + (size_t)l * DM * 3 * DM + col;
    for (int k = kp * 256; k < kp * 256 + 256; ++k) {
      const float w = W[(size_t)k * 3 * DM];
#pragma unroll
      for (int r = 0; r < 9; ++r) {
        const float cv = r < 8 ? p.c[r * DM + k] : p.c_ctx[k];
        acc[r] += siluf_(cv) * w;
      }
    }
    __syncthreads();
#pragma unroll
    for (int r = 0; r < 9; ++r) red[(kp * 9 + r) * 64 + cl] = acc[r];
    __syncthreads();
    for (int idx = tid; idx < 9 * 64; idx += 256) {
      const int r = idx >> 6, c2 = idx & 63;
      float s = 0.f;
      for (int q = 0; q < 4; ++q) s += red[(q * 9 + r) * 64 + c2];
      const int cc = (task % 48) * 64 + c2;
      p.MODV[((size_t)l * 9 + r) * 3 * DM + cc] = s + p.mod_b[l * 3 * DM + cc];
    }
  }
  for (int cidx = blockIdx.x * 256 + tid; cidx < DI; cidx += gridDim.x * 256) {
    float v[4], m = -1e30f;
    for (int l = 0; l < 4; ++l) { v[l] = p.hg_lb[l * DI + cidx]; m = fmaxf(m, v[l]); }
    float s = 0.f;
    for (int l = 0; l < 4; ++l) { v[l] = __expf(v[l] - m); s += v[l]; }
    float cum = 0.f;
    for (int l = 0; l < 4; ++l) { cum += v[l] / s; p.LB[l * DI + cidx] = cum - v[0] / s; }
  }
}

__device__ __forceinline__ void conv_matrix(const float* __restrict__ src, int K, int N, bf16_t* __restrict__ dst, char* smem) {
  float* ts = (float*)smem;
  const int tid = opaque_tid();
  const int ntn = N / 32, ntile = (K / 64) * ntn;
  for (int tile = blockIdx.x; tile < ntile; tile += gridDim.x) {
    const int k0 = (tile / ntn) * 64, n0 = (tile % ntn) * 32;
    __syncthreads();
#pragma unroll
    for (int i = 0; i < 2; ++i) {
      const int k = (tid >> 3) + 32 * i, n4 = (tid & 7) * 4;
      const float4 v = *(const float4*)(src + (size_t)(k0 + k) * N + n0 + n4);
      ts[k * 33 + n4 + 0] = v.x; ts[k * 33 + n4 + 1] = v.y; ts[k * 33 + n4 + 2] = v.z; ts[k * 33 + n4 + 3] = v.w;
    }
    __syncthreads();
    const int n = tid >> 3, k8 = (tid & 7) * 8;
    float f[8];
#pragma unroll
    for (int e = 0; e < 8; ++e) f[e] = ts[(k8 + e) * 33 + n];
    *(uint4*)(dst + (size_t)(n0 + n) * K + k0 + k8) = pack8(f);
  }
}
__device__ __forceinline__ void phase_wconv(const Params& p, char* smem) {
  for (int m = 0; m < 8; ++m) conv_matrix(p.rw_proj + (size_t)m * DM * DI, DM, DI, g_wt + OFF_PROJ + (size_t)m * DI * DM, smem);
  for (int j = 0; j < 2; ++j) conv_matrix(p.rw_wo + (size_t)j * DI * DM, DI, DM, g_wt + OFF_RWO + (size_t)j * DM * DI, smem);
  for (int m = 0; m < 4; ++m) {
    conv_matrix(p.rw_w1 + (size_t)m * DM * 64, DM, 64, g_wt + OFF_W1 + (size_t)m * 64 * DM, smem);
    conv_matrix(p.rw_a1 + (size_t)m * DM * 64, DM, 64, g_wt + OFF_A1 + (size_t)m * 64 * DM, smem);
  }
  conv_matrix(p.rw_v1, DM, 32, g_wt + OFF_V1, smem);
  for (int m = 0; m < 4; ++m) {
    conv_matrix(p.rw_w2 + (size_t)m * 64 * DI, 64, DI, g_wt + OFF_W2 + (size_t)m * DI * 64, smem);
    conv_matrix(p.rw_a2 + (size_t)m * 64 * DI, 64, DI, g_wt + OFF_A2 + (size_t)m * DI * 64, smem);
  }
  for (int j = 0; j < 2; ++j) conv_matrix(p.hg_win + (size_t)j * DM * 5 * DI, DM, 5 * DI, g_wt + OFF_HWIN + (size_t)j * 5 * DI * DM, smem);
  for (int j = 0; j < 2; ++j) conv_matrix(p.hg_wo + (size_t)j * DI * DM, DI, DM, g_wt + OFF_HWO + (size_t)j * DM * DI, smem);
  for (int idx = blockIdx.x * 256 + opaque_tid(); idx < DI * 32; idx += gridDim.x * 256) {
    const int n = idx >> 5, k = idx & 31;
    g_wt[OFF_V2 + idx] = f2bf(p.rw_v2[(size_t)k * DI + n]);
  }
}

__device__ __forceinline__ void phase_resnorm(const Params& p, int g, int lu, int ln) {
  const int tid = opaque_tid();
  const int lane = tid & 63;
  const int wv = blockIdx.x * 4 + (tid >> 6), nw = gridDim.x * 4;
  for (int tg = wv; tg < NTG; tg += nw) {
    const int bl = tg / TT, t = tg % TT, b = g * GB + bl;
    const bool isctx = t < CTX;
    const int mrow = isctx ? 8 : b;
    float xv[16];
    const float* src = (lu <= 0) ? row_in(p, b, t) : row_cur(p, b, t);
#pragma unroll
    for (int j = 0; j < 4; ++j) {
      const float4 v4 = *(const float4*)(src + j * 256 + lane * 4);
      xv[j * 4 + 0] = v4.x; xv[j * 4 + 1] = v4.y; xv[j * 4 + 2] = v4.z; xv[j * 4 + 3] = v4.w;
    }
    if (lu >= 0 && !(isctx && lu == 3)) {
      float ov[16], ss = 0.f;
      const float* orow = p.O + (size_t)tg * DM;
#pragma unroll
      for (int j = 0; j < 4; ++j) {
        const float4 v4 = *(const float4*)(orow + j * 256 + lane * 4);
        ov[j * 4 + 0] = v4.x; ov[j * 4 + 1] = v4.y; ov[j * 4 + 2] = v4.z; ov[j * 4 + 3] = v4.w;
      }
#pragma unroll
      for (int e = 0; e < 16; ++e) ss += ov[e] * ov[e];
      ss = red64(ss);
      const float rstd = rsqrtf(ss * (1.f / DM) + EPS);
      const float* gate = p.MODV + ((size_t)lu * 9 + mrow) * 3 * DM + 2 * DM;
      const float* pg = p.post_g + lu * DM;
      float* dst = row_cur(p, b, t);
#pragma unroll
      for (int j = 0; j < 4; ++j) {
        const int cc = j * 256 + lane * 4;
        const float4 g4 = *(const float4*)(gate + cc);
        const float4 p4 = *(const float4*)(pg + cc);
        xv[j * 4 + 0] += g4.x * (ov[j * 4 + 0] * rstd * p4.x);
        xv[j * 4 + 1] += g4.y * (ov[j * 4 + 1] * rstd * p4.y);
        xv[j * 4 + 2] += g4.z * (ov[j * 4 + 2] * rstd * p4.z);
        xv[j * 4 + 3] += g4.w * (ov[j * 4 + 3] * rstd * p4.w);
        *(float4*)(dst + cc) = make_float4(xv[j * 4 + 0], xv[j * 4 + 1], xv[j * 4 + 2], xv[j * 4 + 3]);
      }
    }
    if (ln >= 0) {
      for (int pass = 0; pass < (ln == 2 ? 2 : 1); ++pass) {
        const int lp = pass == 0 ? ln : 0;
        bf16_t* hdst = (pass == 0 ? ((ln & 1) == 0 ? p.HR : p.H) : p.HR0) + (size_t)tg * DM;
        if (pass == 1) {
          const float* s0 = row_in(p, b, t);
#pragma unroll
          for (int j = 0; j < 4; ++j) {
            const float4 v4 = *(const float4*)(s0 + j * 256 + lane * 4);
            xv[j * 4 + 0] = v4.x; xv[j * 4 + 1] = v4.y; xv[j * 4 + 2] = v4.z; xv[j * 4 + 3] = v4.w;
          }
        }
        float ss = 0.f;
#pragma unroll
        for (int e = 0; e < 16; ++e) ss += xv[e] * xv[e];
        ss = red64(ss);
        const float rstd = rsqrtf(ss * (1.f / DM) + EPS);
        const float* mv = p.MODV + ((size_t)lp * 9 + mrow) * 3 * DM;
        const float* pg = p.pre_g + lp * DM;
#pragma unroll
        for (int j = 0; j < 4; ++j) {
          const int cc = j * 256 + lane * 4;
          const float4 sh = *(const float4*)(mv + cc);
          const float4 sc = *(const float4*)(mv + DM + cc);
          const float4 p4 = *(const float4*)(pg + cc);
          const float h0 = xv[j * 4 + 0] * rstd * p4.x * (1.f + sc.x) + sh.x;
          const float h1 = xv[j * 4 + 1] * rstd * p4.y * (1.f + sc.y) + sh.y;
          const float h2 = xv[j * 4 + 2] * rstd * p4.z * (1.f + sc.z) + sh.z;
          const float h3 = xv[j * 4 + 3] * rstd * p4.w * (1.f + sc.w) + sh.w;
          uint2 u; u.x = pack2(h0, h1); u.y = pack2(h2, h3);
          *(uint2*)(hdst + cc) = u;
        }
      }
    }
  }
}

constexpr int LDK = 72;
constexpr int TM = 128;

template <int AMODE, class Epi>
__device__ __forceinline__ void gemm_tile(const bf16_t* __restrict__ A, int lda, const float* __restrict__ mix, int m0,
                                          int K, const bf16_t* __restrict__ Bt, int nvalid, char* smem, Epi epi) {
  bf16_t* As = (bf16_t*)smem;
  bf16_t* Bs = As + 2 * TM * LDK;
  float* mixs = (float*)(Bs + 2 * 128 * LDK);
  const int tid = opaque_tid(), lane = tid & 63, w = tid >> 6, wm = w >> 1, wn = w & 1;
  const int lr = lane >> 3, ch = (lane & 7) * 8;
  const int row0 = w * 32 + lr;
  const bf16_t* Ap = A + (size_t)(m0 + row0) * lda + ch;
  const bf16_t* Bp = Bt + (size_t)row0 * K + ch;
  const size_t astep = (size_t)8 * lda, bstep = (size_t)8 * K;
  const int KT = (K + 63) >> 6;
  const int tbase = m0 % TT;
  const bool isctx = tbase < CTX;
  unsigned vmask = 0;
  if (AMODE == 1) {
#pragma unroll
    for (int i = 0; i < 4; ++i) {
      const int t = tbase + row0 + i * 8;
      unsigned m;
      if (isctx) {
        m = (t >= 1 ? 3u : 0u) | (t + 1 < CTX ? 12u : 0u);
      } else {
        const int tl = t - CTX, row = tl >> 6, col = tl & 63;
        m = (col > 0 ? 1u : 0u) | (col < 63 ? 2u : 0u) | (row > 0 ? 4u : 0u) | (row < 63 ? 8u : 0u);
      }
      vmask |= m << (4 * i);
    }
  }

  __syncthreads();
  if (AMODE == 1) *(float4*)(mixs + tid * 4) = *(const float4*)(mix + tid * 4);

  f32x16 acc[2][2];
#pragma unroll
  for (int i = 0; i < 2; ++i)
#pragma unroll
    for (int j = 0; j < 2; ++j)
#pragma unroll
      for (int r = 0; r < 16; ++r) acc[i][j][r] = 0.f;

  uint4 a0, a1, a2, a3, n0, n1, n2, n3, b0, b1, b2, b3;
  auto load_regs = [&](int kt) {
    const int k0 = kt * 64;
    const uint4 z4 = make_uint4(0, 0, 0, 0);
    const bool kval = (k0 + ch) < K;
    const bf16_t* ap = Ap + k0;
    const bf16_t* bp = Bp + k0;
    a0 = z4; if (kval) a0 = *(const uint4*)(ap + 0 * astep);
    a1 = z4; if (kval) a1 = *(const uint4*)(ap + 1 * astep);
    a2 = z4; if (kval) a2 = *(const uint4*)(ap + 2 * astep);
    a3 = z4; if (kval) a3 = *(const uint4*)(ap + 3 * astep);
    b0 = z4; if (kval && (row0 + 0) < nvalid) b0 = *(const uint4*)(bp + 0 * bstep);
    b1 = z4; if (kval && (row0 + 8) < nvalid) b1 = *(const uint4*)(bp + 1 * bstep);
    b2 = z4; if (kval && (row0 + 16) < nvalid) b2 = *(const uint4*)(bp + 2 * bstep);
    b3 = z4; if (kval && (row0 + 24) < nvalid) b3 = *(const uint4*)(bp + 3 * bstep);
    if (AMODE == 1) {
      const int q = k0 >> 8;
      const int nb = isctx ? (q < 2 ? -1 : 1) : (q == 0 ? -1 : (q == 1 ? 1 : (q == 2 ? -64 : 64)));
      const bf16_t* np = ap + (ptrdiff_t)nb * lda;
      const unsigned vm = vmask >> q;
      n0 = z4; if ((vm >> 0) & 1u) n0 = *(const uint4*)(np + 0 * astep);
      n1 = z4; if ((vm >> 4) & 1u) n1 = *(const uint4*)(np + 1 * astep);
      n2 = z4; if ((vm >> 8) & 1u) n2 = *(const uint4*)(np + 2 * astep);
      n3 = z4; if ((vm >> 12) & 1u) n3 = *(const uint4*)(np + 3 * astep);
    }
  };
  auto mix8 = [&](const uint4& hv, const uint4& nv, const float4& ma, const float4& mb) -> uint4 {
    float h[8], n[8];
    unpack8(hv, h); unpack8(nv, n);
    h[0] += (n[0] - h[0]) * ma.x; h[1] += (n[1] - h[1]) * ma.y; h[2] += (n[2] - h[2]) * ma.z; h[3] += (n[3] - h[3]) * ma.w;
    h[4] += (n[4] - h[4]) * mb.x; h[5] += (n[5] - h[5]) * mb.y; h[6] += (n[6] - h[6]) * mb.z; h[7] += (n[7] - h[7]) * mb.w;
    return pack8(h);
  };
  auto store_lds = [&](int kt, int buf) {
    bf16_t* ad = As + (buf * TM + row0) * LDK + ch;
    bf16_t* bd = Bs + (buf * 128 + row0) * LDK + ch;
    if (AMODE == 1) {
      const float4 ma = *(const float4*)(mixs + kt * 64 + ch), mb = *(const float4*)(mixs + kt * 64 + ch + 4);
      *(uint4*)(ad + 0 * LDK) = mix8(a0, n0, ma, mb);
      *(uint4*)(ad + 8 * LDK) = mix8(a1, n1, ma, mb);
      *(uint4*)(ad + 16 * LDK) = mix8(a2, n2, ma, mb);
      *(uint4*)(ad + 24 * LDK) = mix8(a3, n3, ma, mb);
    } else {
      *(uint4*)(ad + 0 * LDK) = a0;
      *(uint4*)(ad + 8 * LDK) = a1;
      *(uint4*)(ad + 16 * LDK) = a2;
      *(uint4*)(ad + 24 * LDK) = a3;
    }
    *(uint4*)(bd + 0 * LDK) = b0;
    *(uint4*)(bd + 8 * LDK) = b1;
    *(uint4*)(bd + 16 * LDK) = b2;
    *(uint4*)(bd + 24 * LDK) = b3;
  };
  auto compute = [&](int buf) {
    const bf16_t* ab = As + (buf * TM + wm * 64 + (lane & 31)) * LDK + (lane >> 5) * 8;
    const bf16_t* bb = Bs + (buf * 128 + wn * 64 + (lane & 31)) * LDK + (lane >> 5) * 8;
#pragma unroll
    for (int kk = 0; kk < 4; ++kk) {
      const bf16x8 af0 = *(const bf16x8*)(ab + kk * 16), af1 = *(const bf16x8*)(ab + 32 * LDK + kk * 16);
      const bf16x8 bf0 = *(const bf16x8*)(bb + kk * 16), bf1 = *(const bf16x8*)(bb + 32 * LDK + kk * 16);
      acc[0][0] = __builtin_amdgcn_mfma_f32_32x32x16_bf16(af0, bf0, acc[0][0], 0, 0, 0);
      acc[0][1] = __builtin_amdgcn_mfma_f32_32x32x16_bf16(af0, bf1, acc[0][1], 0, 0, 0);
      acc[1][0] = __builtin_amdgcn_mfma_f32_32x32x16_bf16(af1, bf0, acc[1][0], 0, 0, 0);
      acc[1][1] = __builtin_amdgcn_mfma_f32_32x32x16_bf16(af1, bf1, acc[1][1], 0, 0, 0);
    }
  };
  load_regs(0);
  lds_barrier();
  store_lds(0, 0);
  if (KT > 1) load_regs(1);
  lds_barrier();
  for (int kt = 0; kt < KT; ++kt) {
    if (kt + 1 < KT) store_lds(kt + 1, (kt + 1) & 1);
    if (kt + 2 < KT) load_regs(kt + 2);
    compute(kt & 1);
    lds_barrier();
  }
  float* Cs = (float*)smem;
#pragma unroll
  for (int i = 0; i < 2; ++i)
#pragma unroll
    for (int j = 0; j < 2; ++j)
#pragma unroll
      for (int r = 0; r < 16; ++r)
        Cs[(wm * 64 + i * 32 + (r & 3) + 8 * (r >> 2) + 4 * (lane >> 5)) * 132 + wn * 64 + j * 32 + (lane & 31)] = acc[i][j][r];
  lds_barrier();
#pragma unroll 2
  for (int it = 0; it < 8; ++it) {
    const int idx = it * 256 + tid, row = idx >> 4, c8 = (idx & 15) * 8;
    const float4 v0 = *(const float4*)(Cs + row * 132 + c8), v1 = *(const float4*)(Cs + row * 132 + c8 + 4);
    float v[8] = {v0.x, v0.y, v0.z, v0.w, v1.x, v1.y, v1.z, v1.w};
    epi(m0 + row, c8, v);
  }
}

__device__ __forceinline__ void phase_rw_proj(const Params& p, int j, char* smem, int zonly, int bid, int nb) {
  const int ntn = zonly ? 16 : (j == 0 ? 50 : 67);
  const float* mixb = p.rw_mix + (size_t)j * 6 * DM;
  for (int tile = bid; tile < MT * ntn; tile += nb) {
    const int mt = tile / ntn, ntl = tile % ntn, m0 = mt * 128;
    const int nt = zonly ? 48 + ntl : (ntl < 48 ? ntl : ntl + 16);
    if (nt < 64) {
      const int pi = nt >> 4, n0 = (nt & 15) * 128;
      const int mi = pi == 0 ? 0 : (pi == 1 ? 2 : (pi == 2 ? 3 : 5));
      const bf16_t* Bw = g_wt + OFF_PROJ + ((size_t)(j * 4 + pi) * DI + n0) * DM;
      bf16_t* dst = pi == 0 ? p.R : (pi == 1 ? p.K : (pi == 2 ? p.V : p.Z));
      if (pi == 3) {
        gemm_tile<1>(p.HR, DM, mixb + mi * DM, m0, DM, Bw, 128, smem,
                     [&](int row, int col, float* v) {
#pragma unroll
        for (int e = 0; e < 8; ++e) v[e] = siluf_(v[e]);
        *(uint4*)(dst + (size_t)row * DI + n0 + col) = pack8(v); });
      } else {
        gemm_tile<1>(p.HR, DM, mixb + mi * DM, m0, DM, Bw, 128, smem,
                     [&](int row, int col, float* v) { *(uint4*)(dst + (size_t)row * DI + n0 + col) = pack8(v); });
      }
    } else if (nt == 64) {
      gemm_tile<1>(p.HR, DM, mixb + 1 * DM, m0, DM, g_wt + OFF_W1 + (size_t)j * 128 * DM, 128, smem,
                   [&](int row, int col, float* v) {
#pragma unroll
        for (int e = 0; e < 8; ++e) v[e] = tanhf(v[e]);
        *(uint4*)(p.LRW + (size_t)row * 128 + col) = pack8(v); });
    } else if (nt == 65) {
      gemm_tile<1>(p.HR, DM, mixb + 4 * DM, m0, DM, g_wt + OFF_A1 + (size_t)j * 128 * DM, 128, smem,
                   [&](int row, int col, float* v) { *(uint4*)(p.LRA + (size_t)row * 128 + col) = pack8(v); });
    } else if (nt == 66) {
      gemm_tile<1>(p.HR, DM, mixb + 3 * DM, m0, DM, g_wt + OFF_V1, 32, smem, [&](int row, int col, float* v) {
        if (col < 32) *(uint4*)(p.LRV + (size_t)row * 32 + col) = pack8(v);
      });
    } else {
      const int n0 = (nt - 67) * 128;
      const bf16_t* Bw = g_wt + OFF_PROJ + ((size_t)2 * DI + n0) * DM;
      gemm_tile<1>(p.HR0, DM, p.rw_mix + 3 * DM, m0, DM, Bw, 128, smem,
                   [&](int row, int col, float* v) { *(uint4*)(p.VF + (size_t)row * DI + n0 + col) = pack8(v); });
    }
  }
}

__device__ __forceinline__ void phase_rw_lr2(const Params& p, int j, char* smem) {
  for (int tile = blockIdx.x; tile < MT * 16; tile += gridDim.x) {
    const int mt = tile / 16, nt = tile % 16, m0 = mt * 128;
    const int n0 = nt * 128;
    const bf16_t* Bw = g_wt + OFF_V2 + (size_t)n0 * 32;
    const float* v0 = p.rw_v0 + n0;
    gemm_tile<0>(p.LRV, 32, nullptr, m0, 32, Bw, 128, smem, [&](int row, int col, float* v) {
      const size_t idx = (size_t)row * DI + n0 + col;
      float vv[8], vf[8];
      unpack8(*(const uint4*)(p.V + idx), vv); unpack8(*(const uint4*)(p.VF + idx), vf);
#pragma unroll
      for (int e = 0; e < 8; ++e) vv[e] += (vf[e] - vv[e]) * sigmoidf_(v[e] + v0[col + e]);
      *(uint4*)(p.V + idx) = pack8(vv);
    });
  }
}

constexpr int RCH = 32;
__device__ __forceinline__ int scan_pos(int dir, int s) { return dir == 0 ? s : (s < CTX ? CTX - 1 - s : TT + CTX - 1 - s); }

__device__ __forceinline__ void phase_rw_scan(const Params& p, int j, char* smem) {
  float* op = (float*)smem;
  float* vv = op + RCH * 4 * 64;
  float* sc = vv + RCH * 64;
  float* LWs = sc + RCH * 2;
  float* AAs = LWs + RCH * 64;
  float* yb = AAs;
  bf16_t* LRs = (bf16_t*)(AAs + RCH * 64);
  const int tid = opaque_tid(), lane = tid & 63, w = tid >> 6;
  const int ptau = tid >> 3, pc8 = (tid & 7) * 8;
  const int r2 = lane >> 3, ko = (lane & 7) * 8;
  const int row0 = w * 16 + r2, row1 = row0 + 8;
  for (int unit = blockIdx.x; unit < GB * 64; unit += gridDim.x) {
    const int bl = unit >> 6, h = (unit >> 1) & 31, dir = unit & 1;
    bf16_t* Y = dir == 0 ? p.YF : p.YB;
    float pkk[8], pka[8], prk[8];
#pragma unroll
    for (int e = 0; e < 8; ++e) {
      const int cc = j * DI + h * 64 + pc8 + e;
      pkk[e] = p.rw_kk[cc]; pka[e] = p.rw_ka[cc]; prk[e] = p.rw_rk[cc];
    }
    __syncthreads();
    const int mm = w >> 1, nh = w & 1;
    const float bias = (mm == 0 ? p.rw_w0 : p.rw_a0)[((size_t)j * 2 + dir) * DI + h * 64 + nh * 32 + (lane & 31)];
    bf16x8 wfr[4];
    {
      const bf16_t* w2g = g_wt + (mm == 0 ? OFF_W2 : OFF_A2) + (((size_t)j * 2 + dir) * DI + h * 64 + nh * 32 + (lane & 31)) * 64 + (lane >> 5) * 8;
#pragma unroll
      for (int kk = 0; kk < 4; ++kk) wfr[kk] = *(const bf16x8*)(w2g + kk * 16);
    }
    f2_t S0[4], S1[4];
#pragma unroll
    for (int e = 0; e < 4; ++e) { S0[e] = f2_t{0.f, 0.f}; S1[e] = f2_t{0.f, 0.f}; }
    uint4 gr, gk, gv, gl0, gl1;
    const int lmat = (tid & 7) >> 2, lcol = (tid & 3) * 16;
    auto gload = [&](int chunk) {
      const int pos = scan_pos(dir, chunk * RCH + ptau);
      const size_t tg = (size_t)bl * TT + pos;
      const size_t base = tg * DI + h * 64 + pc8;
      gr = *(const uint4*)(p.R + base); gk = *(const uint4*)(p.K + base); gv = *(const uint4*)(p.V + base);
      const bf16_t* lr = (lmat == 0 ? p.LRW : p.LRA) + tg * 128 + dir * 64 + lcol;
      gl0 = *(const uint4*)(lr); gl1 = *(const uint4*)(lr + 8);
    };
    gload(0);
    for (int chunk = 0; chunk < TT / RCH; ++chunk) {
      *(uint4*)(LRs + (lmat * RCH + ptau) * 72 + lcol) = gl0;
      *(uint4*)(LRs + (lmat * RCH + ptau) * 72 + lcol + 8) = gl1;
      lds_barrier();
      {
        f32x16 acc;
#pragma unroll
        for (int r = 0; r < 16; ++r) acc[r] = 0.f;
#pragma unroll
        for (int kk = 0; kk < 4; ++kk) {
          const bf16x8 af = *(const bf16x8*)(LRs + (mm * RCH + (lane & 31)) * 72 + kk * 16 + (lane >> 5) * 8);
          acc = __builtin_amdgcn_mfma_f32_32x32x16_bf16(af, wfr[kk], acc, 0, 0, 0);
        }
        const int chn = nh * 32 + (lane & 31), hh = lane >> 5;
        if (mm == 0) {
          float lwv[16], pf[16], own[4], oth[4];
#pragma unroll
          for (int r = 0; r < 16; ++r) lwv[r] = -0.60653066f * sigmoidf_(acc[r] + bias);
#pragma unroll
          for (int g = 0; g < 4; ++g) {
            pf[g * 4] = lwv[g * 4];
            pf[g * 4 + 1] = pf[g * 4] + lwv[g * 4 + 1];
            pf[g * 4 + 2] = pf[g * 4 + 1] + lwv[g * 4 + 2];
            pf[g * 4 + 3] = pf[g * 4 + 2] + lwv[g * 4 + 3];
            own[g] = pf[g * 4 + 3];
            oth[g] = __shfl_xor(own[g], 32);
          }
          float base = 0.f;
#pragma unroll
          for (int g = 0; g < 4; ++g) {
            const float off = base + (hh ? oth[g] : 0.f);
#pragma unroll
            for (int q = 0; q < 4; ++q) {
              const int t = q + 8 * g + 4 * hh;
              const float c = off + pf[g * 4 + q];
              LWs[t * 64 + chn] = c;
            }
            base += own[g] + oth[g];
          }
        } else {
#pragma unroll
          for (int r = 0; r < 16; ++r) {
            const int t = (r & 3) + 8 * (r >> 2) + 4 * hh;
            AAs[t * 64 + chn] = sigmoidf_(acc[r] + bias);
          }
        }
      }
      lds_barrier();
      {
        float r[8], k[8], v[8], cm[8], cp[8], a[8];
        unpack8(gr, r); unpack8(gk, k); unpack8(gv, v);
#pragma unroll
        for (int e = 0; e < 8; ++e) {
          cm[e] = LWs[ptau * 64 + pc8 + e]; cp[e] = ptau > 0 ? LWs[(ptau - 1) * 64 + pc8 + e] : 0.f; a[e] = AAs[ptau * 64 + pc8 + e];
        }
        float kkv[8], ss = 0.f;
#pragma unroll
        for (int e = 0; e < 8; ++e) { kkv[e] = k[e] * pkk[e]; ss += kkv[e] * kkv[e]; }
        ss = red8(ss);
        const float inv = rsqrtf(fmaxf(ss, 1e-24f));
        float br = 0.f, kr = 0.f, bon = 0.f;
        float o0[8], o1[8], o2[8], o3[8];
#pragma unroll
        for (int e = 0; e < 8; ++e) {
          const float kkn = kkv[e] * inv;
          const float P = __expf(cm[e]), Pp = __expf(cp[e]);
          const float iP = 1.f / P;
          const float kd = k[e] * (1.f + (a[e] - 1.f) * pka[e]);
          const float bb = kkn * a[e];
          o0[e] = -kkn * Pp; o1[e] = r[e] * P; o2[e] = bb * iP; o3[e] = kd * iP;
          br += bb * r[e]; kr += kd * r[e]; bon += r[e] * kd * prk[e];
        }
        br = red8(br); kr = red8(kr); bon = red8(bon);
        float* od = op + ptau * 256 + pc8;
        *(float4*)(od) = make_float4(o0[0], o0[1], o0[2], o0[3]); *(float4*)(od + 4) = make_float4(o0[4], o0[5], o0[6], o0[7]);
        *(float4*)(od + 64) = make_float4(o1[0], o1[1], o1[2], o1[3]); *(float4*)(od + 68) = make_float4(o1[4], o1[5], o1[6], o1[7]);
        *(float4*)(od + 128) = make_float4(o2[0], o2[1], o2[2], o2[3]); *(float4*)(od + 132) = make_float4(o2[4], o2[5], o2[6], o2[7]);
        *(float4*)(od + 192) = make_float4(o3[0], o3[1], o3[2], o3[3]); *(float4*)(od + 196) = make_float4(o3[4], o3[5], o3[6], o3[7]);
        float* vd = vv + ptau * 64 + pc8;
        *(float4*)(vd) = make_float4(v[0], v[1], v[2], v[3]); *(float4*)(vd + 4) = make_float4(v[4], v[5], v[6], v[7]);
        if ((tid & 7) == 0) {
          sc[ptau * 2] = br; sc[ptau * 2 + 1] = kr;
          const int pos = scan_pos(dir, chunk * RCH + ptau);
          p.BN[((size_t)dir * NTG + (size_t)bl * TT + pos) * 32 + h] = bon;
        }
      }
      lds_barrier();
      if (chunk + 1 < TT / RCH) gload(chunk + 1);
      {
        struct StepOps { float4 n0, n1, q0, q1, b0, b1, k0, k1; float v0, v1; float2 s; };
        auto ldops = [&](StepOps& o, int tau) {
          const float* ob = op + tau * 256 + ko;
          o.n0 = *(const float4*)(ob); o.n1 = *(const float4*)(ob + 4);
          o.q0 = *(const float4*)(ob + 64); o.q1 = *(const float4*)(ob + 68);
          o.b0 = *(const float4*)(ob + 128); o.b1 = *(const float4*)(ob + 132);
          o.k0 = *(const float4*)(ob + 192); o.k1 = *(const float4*)(ob + 196);
          o.v0 = vv[tau * 64 + row0]; o.v1 = vv[tau * 64 + row1];
          o.s = *(const float2*)(sc + tau * 2);
        };
        auto dostep = [&](const StepOps& o, int tau) {
          const float nk[8] = {o.n0.x, o.n0.y, o.n0.z, o.n0.w, o.n1.x, o.n1.y, o.n1.z, o.n1.w};
          const float rr[8] = {o.q0.x, o.q0.y, o.q0.z, o.q0.w, o.q1.x, o.q1.y, o.q1.z, o.q1.w};
          const float bb[8] = {o.b0.x, o.b0.y, o.b0.z, o.b0.w, o.b1.x, o.b1.y, o.b1.z, o.b1.w};
          const float kd[8] = {o.k0.x, o.k0.y, o.k0.z, o.k0.w, o.k1.x, o.k1.y, o.k1.z, o.k1.w};
          f2_t a10 = {0.f, 0.f}, a11 = {0.f, 0.f}, a20 = {0.f, 0.f}, a21 = {0.f, 0.f};
#pragma unroll
          for (int e = 0; e < 4; ++e) {
            const f2_t nk2 = {nk[2 * e], nk[2 * e + 1]}, rr2 = {rr[2 * e], rr[2 * e + 1]};
            a10 = __builtin_elementwise_fma(S0[e], nk2, a10); a11 = __builtin_elementwise_fma(S1[e], nk2, a11);
            a20 = __builtin_elementwise_fma(S0[e], rr2, a20); a21 = __builtin_elementwise_fma(S1[e], rr2, a21);
          }
          float d10 = a10.x + a10.y, d11 = a11.x + a11.y, d20 = a20.x + a20.y, d21 = a21.x + a21.y;
          d10 = red8(d10); d11 = red8(d11); d20 = red8(d20); d21 = red8(d21);
          const float y0 = d20 + d10 * o.s.x + o.v0 * o.s.y;
          const float y1 = d21 + d11 * o.s.x + o.v1 * o.s.y;
          const f2_t sa0 = {d10, d10}, sa1 = {d11, d11}, vv0 = {o.v0, o.v0}, vv1 = {o.v1, o.v1};
#pragma unroll
          for (int e = 0; e < 4; ++e) {
            const f2_t bb2 = {bb[2 * e], bb[2 * e + 1]}, kd2 = {kd[2 * e], kd[2 * e + 1]};
            S0[e] = __builtin_elementwise_fma(sa0, bb2, __builtin_elementwise_fma(vv0, kd2, S0[e]));
            S1[e] = __builtin_elementwise_fma(sa1, bb2, __builtin_elementwise_fma(vv1, kd2, S1[e]));
          }
          if ((lane & 7) == 0) { yb[tau * 64 + row0] = y0; yb[tau * 64 + row1] = y1; }
        };
        StepOps oa, ob2;
        ldops(oa, 0);
#pragma unroll 1
        for (int tau = 0; tau < RCH; tau += 2) {
          ldops(ob2, tau + 1);
          dostep(oa, tau);
          ldops(oa, tau + 2);
          dostep(ob2, tau + 1);
        }
#pragma unroll
        for (int e = 0; e < 4; ++e) {
          const f2_t pc = {__expf(LWs[(RCH - 1) * 64 + ko + 2 * e]), __expf(LWs[(RCH - 1) * 64 + ko + 2 * e + 1])};
          S0[e] *= pc; S1[e] *= pc;
        }
      }
      lds_barrier();
      {
        const int pos = scan_pos(dir, chunk * RCH + ptau);
        const float* ys = yb + ptau * 64 + pc8;
        float yv[8];
#pragma unroll
        for (int e = 0; e < 8; ++e) yv[e] = ys[e];
        *(uint4*)(Y + ((size_t)bl * TT + pos) * DI + h * 64 + pc8) = pack8(yv);
      }
    }
    lds_barrier();
  }
}

__device__ __forceinline__ void phase_rw_gate(const Params& p, int j) {
  const int tid = opaque_tid(), h = tid >> 3;
  const int c0 = tid * 8;
  float lnw[8], lnb[8];
#pragma unroll
  for (int e = 0; e < 8; ++e) { lnw[e] = p.rw_lnw[j * DI + c0 + e]; lnb[e] = p.rw_lnb[j * DI + c0 + e]; }
  for (int tg = blockIdx.x; tg < NTG; tg += gridDim.x) {
    const size_t base = (size_t)tg * DI + c0;
    float yf[8], yb[8], v[8], z[8];
    unpack8(*(const uint4*)(p.YF + base), yf); unpack8(*(const uint4*)(p.YB + base), yb);
    unpack8(*(const uint4*)(p.V + base), v); unpack8(*(const uint4*)(p.Z + base), z);
    const float bon = p.BN[(size_t)tg * 32 + h] + p.BN[((size_t)NTG + tg) * 32 + h];
    float y[8], s = 0.f;
#pragma unroll
    for (int e = 0; e < 8; ++e) { y[e] = yf[e] + yb[e]; s += y[e]; }
    const float mu = red8(s) * (1.f / 64.f);
    float s2 = 0.f;
#pragma unroll
    for (int e = 0; e < 8; ++e) { y[e] -= mu; s2 += y[e] * y[e]; }
    const float rstd = rsqrtf(red8(s2) * (1.f / 64.f) + 64e-5f);
#pragma unroll
    for (int e = 0; e < 8; ++e) y[e] = (y[e] * rstd * lnw[e] + lnb[e] + bon * v[e]) * z[e];
    *(uint4*)(p.YF + base) = pack8(y);
  }
}

__device__ __forceinline__ void phase_out(const Params& p, const bf16_t* wo, char* smem) {
  for (int tile = blockIdx.x; tile < MT * 8; tile += gridDim.x) {
    const int mt = tile / 8, nt = tile % 8, m0 = mt * 128, n0 = nt * 128;
    const bf16_t* Bw = wo + (size_t)n0 * DI;
    gemm_tile<0>(p.YF, DI, nullptr, m0, DI, Bw, 128, smem,
                 [&](int row, int col, float* v) {
      float* o = p.O + (size_t)row * DM + n0 + col;
      *(float4*)o = make_float4(v[0], v[1], v[2], v[3]); *(float4*)(o + 4) = make_float4(v[4], v[5], v[6], v[7]); });
  }
}

__device__ __forceinline__ void phase_hg_proj(const Params& p, int j, char* smem) {
  const int layer = 2 * j + 1;
  for (int tile = blockIdx.x; tile < MT * 80; tile += gridDim.x) {
    const int mt = tile / 80, nt = tile % 80, m0 = mt * 128;
    const int seg = nt >> 4, n0 = (nt & 15) * 128;
    const bf16_t* Bw = g_wt + OFF_HWIN + ((size_t)j * 5 * DI + (size_t)seg * DI + n0) * DM;
    bf16_t* dst = seg == 0 ? p.R : (seg == 1 ? p.K : (seg == 2 ? p.WF : (seg == 3 ? p.V : p.Z)));
    if (seg == 0 || seg == 4) {
      gemm_tile<0>(p.H, DM, nullptr, m0, DM, Bw, 128, smem, [&](int row, int col, float* v) {
#pragma unroll
        for (int e = 0; e < 8; ++e) v[e] = siluf_(v[e]);
        *(uint4*)(dst + (size_t)row * DI + n0 + col) = pack8(v); });
    } else if (seg == 3) {
      gemm_tile<0>(p.H, DM, nullptr, m0, DM, Bw, 128, smem,
                   [&](int row, int col, float* v) { *(uint4*)(dst + (size_t)row * DI + n0 + col) = pack8(v); });
    } else {
      const float* lbp = p.LB + layer * DI + n0;
      gemm_tile<0>(p.H, DM, nullptr, m0, DM, Bw, 128, smem, [&](int row, int col, float* v) {
        const float4 l0 = *(const float4*)(lbp + col), l1 = *(const float4*)(lbp + col + 4);
        const float lb[8] = {l0.x, l0.y, l0.z, l0.w, l1.x, l1.y, l1.z, l1.w};
#pragma unroll
        for (int e = 0; e < 8; ++e) v[e] = __logf(lb[e] + (1.f - lb[e]) * sigmoidf_(v[e]));
        *(uint4*)(dst + (size_t)row * DI + n0 + col) = pack8(v); });
    }
  }
}

constexpr int HC = 32;
constexpr int QS = 136;
constexpr int SS = 40;
__device__ __forceinline__ void phase_hg_scan(const Params& p, int layer, char* smem) {
  bf16_t* qe = (bf16_t*)smem;
  bf16_t* ke = qe + HC * QS;
  bf16_t* kdT = ke + HC * QS;
  bf16_t* vT = kdT + 128 * SS;
  bf16_t* att = vT + 64 * SS;
  bf16_t* ST = att + HC * SS;
  float* dC = (float*)(ST + 64 * QS);
  const int tid = opaque_tid(), lane = tid & 63, w = tid >> 6;
  for (int unit = blockIdx.x; unit < GB * 64; unit += gridDim.x) {
    const int vs = unit & 1, dir = (unit >> 1) & 1, h = (unit >> 2) & 15, bl = unit >> 6;
    const bf16_t* FL = dir == 0 ? p.K : p.WF;
    bf16_t* Y = dir == 0 ? p.YF : p.YB;
    const int st = lane & 31, cg = w * 2 + (lane >> 5), kb = cg * 16, vb = cg * 8;
    f32x16 sacc[2];
#pragma unroll
    for (int r = 0; r < 16; ++r) { sacc[0][r] = 0.f; sacc[1][r] = 0.f; }
    __syncthreads();
    for (int idx = tid; idx < 64 * QS / 2; idx += 256) ((unsigned*)ST)[idx] = 0u;
    uint4 gq0, gq1, gf0, gf1, gvv;
    auto gload = [&](int chunk) {
      const int pos = scan_pos(dir, chunk * HC + st);
      const size_t base = ((size_t)bl * TT + pos) * DI + h * 128;
      gq0 = *(const uint4*)(p.R + base + kb); gq1 = *(const uint4*)(p.R + base + kb + 8);
      gf0 = *(const uint4*)(FL + base + kb); gf1 = *(const uint4*)(FL + base + kb + 8);
      gvv = *(const uint4*)(p.V + base + vs * 64 + vb);
    };
    gload(0);
    for (int chunk = 0; chunk < TT / HC; ++chunk) {
      float q[16], cum[16], one[16];
      {
        unpack8(gq0, q); unpack8(gq1, q + 8); unpack8(gf0, cum); unpack8(gf1, cum + 8);
#pragma unroll
        for (int e = 0; e < 16; ++e) {
          float c = cum[e];
          one[e] = 1.f - __expf(c);
          c += __int_as_float(__builtin_amdgcn_update_dpp(0, __float_as_int(c), 0x111, 0xf, 0xf, false));
          c += __int_as_float(__builtin_amdgcn_update_dpp(0, __float_as_int(c), 0x112, 0xf, 0xf, false));
          c += __int_as_float(__builtin_amdgcn_update_dpp(0, __float_as_int(c), 0x114, 0xf, 0xf, false));
          c += __int_as_float(__builtin_amdgcn_update_dpp(0, __float_as_int(c), 0x118, 0xf, 0xf, false));
          c += __int_as_float(__builtin_amdgcn_update_dpp(0, __float_as_int(c), 0x142, 0xa, 0xf, false));
          cum[e] = c;
        }
      }
      const uint4 vreg = gvv;
      lds_barrier();
      {
        float qo[16], ko[16];
#pragma unroll
        for (int e = 0; e < 16; ++e) {
          const float c31 = __int_as_float(__builtin_amdgcn_readlane(__float_as_int(cum[e]), 31));
          const float c63 = __int_as_float(__builtin_amdgcn_readlane(__float_as_int(cum[e]), 63));
          const float cC = (lane >> 5) ? c63 : c31;
          const float ec = __expf(fmaxf(cum[e], -80.f));
          const float inv = 1.f / ec;
          const float eC = __expf(cC);
          qo[e] = q[e] * ec;
          ko[e] = one[e] * inv;
          kdT[(kb + e) * SS + st] = f2bf(one[e] * inv * eC);
          if (st == 31) dC[kb + e] = eC;
        }
        *(uint4*)(qe + st * QS + kb) = pack8(qo); *(uint4*)(qe + st * QS + kb + 8) = pack8(qo + 8);
        *(uint4*)(ke + st * QS + kb) = pack8(ko); *(uint4*)(ke + st * QS + kb + 8) = pack8(ko + 8);
        const bf16_t* vp = (const bf16_t*)&vreg;
#pragma unroll
        for (int e = 0; e < 8; ++e) vT[(vb + e) * SS + st] = vp[e];
      }
      lds_barrier();
      if (chunk + 1 < TT / HC) gload(chunk + 1);
      {
        const int mi = w >> 1, ni = w & 1;
        f32x4 a4 = {0.f, 0.f, 0.f, 0.f};
#pragma unroll
        for (int kk = 0; kk < 4; ++kk) {
          const bf16x8 af = *(const bf16x8*)(qe + (mi * 16 + (lane & 15)) * QS + kk * 32 + (lane >> 4) * 8);
          const bf16x8 bf = *(const bf16x8*)(ke + (ni * 16 + (lane & 15)) * QS + kk * 32 + (lane >> 4) * 8);
          a4 = __builtin_amdgcn_mfma_f32_16x16x32_bf16(af, bf, a4, 0, 0, 0);
        }
        const int s = ni * 16 + (lane & 15);
#pragma unroll
        for (int r = 0; r < 4; ++r) {
          const int t = mi * 16 + (lane >> 4) * 4 + r;
          att[t * SS + s] = f2bf(s <= t ? a4[r] : 0.f);
        }
      }
      lds_barrier();
      {
#pragma unroll
        for (int mh = 0; mh < 2; ++mh) {
          f32x4 y4 = {0.f, 0.f, 0.f, 0.f};
          {
            const bf16x8 af = *(const bf16x8*)(att + (mh * 16 + (lane & 15)) * SS + (lane >> 4) * 8);
            const bf16x8 bf = *(const bf16x8*)(vT + (w * 16 + (lane & 15)) * SS + (lane >> 4) * 8);
            y4 = __builtin_amdgcn_mfma_f32_16x16x32_bf16(af, bf, y4, 0, 0, 0);
          }
#pragma unroll
          for (int kk = 0; kk < 4; ++kk) {
            const bf16x8 af = *(const bf16x8*)(qe + (mh * 16 + (lane & 15)) * QS + kk * 32 + (lane >> 4) * 8);
            const bf16x8 bf = *(const bf16x8*)(ST + (w * 16 + (lane & 15)) * QS + kk * 32 + (lane >> 4) * 8);
            y4 = __builtin_amdgcn_mfma_f32_16x16x32_bf16(af, bf, y4, 0, 0, 0);
          }
#pragma unroll
          for (int r = 0; r < 4; ++r) {
            const int t = mh * 16 + (lane >> 4) * 4 + r;
            const int pos = scan_pos(dir, chunk * HC + t);
            Y[((size_t)bl * TT + pos) * DI + h * 128 + vs * 64 + w * 16 + (lane & 15)] = f2bf(y4[r]);
          }
        }
      }
      lds_barrier();
      {
        float dk[16];
#pragma unroll
        for (int r = 0; r < 16; ++r) dk[r] = dC[w * 32 + (r & 3) + 8 * (r >> 2) + 4 * (lane >> 5)];
#pragma unroll
        for (int nt = 0; nt < 2; ++nt) {
#pragma unroll
          for (int r = 0; r < 16; ++r) sacc[nt][r] *= dk[r];
#pragma unroll
          for (int ks = 0; ks < 2; ++ks) {
            const bf16x8 af = *(const bf16x8*)(kdT + (w * 32 + (lane & 31)) * SS + ks * 16 + (lane >> 5) * 8);
            const bf16x8 bf = *(const bf16x8*)(vT + (nt * 32 + (lane & 31)) * SS + ks * 16 + (lane >> 5) * 8);
            sacc[nt] = __builtin_amdgcn_mfma_f32_32x32x16_bf16(af, bf, sacc[nt], 0, 0, 0);
          }
#pragma unroll
          for (int gq = 0; gq < 4; ++gq) {
            uint2 u;
            u.x = pack2(sacc[nt][gq * 4 + 0], sacc[nt][gq * 4 + 1]);
            u.y = pack2(sacc[nt][gq * 4 + 2], sacc[nt][gq * 4 + 3]);
            *(uint2*)(ST + (nt * 32 + (lane & 31)) * QS + w * 32 + gq * 8 + (lane >> 5) * 4) = u;
          }
        }
      }
    }
    lds_barrier();
  }
}

__device__ __forceinline__ void phase_hg_gate(const Params& p, int j) {
  const int tid = opaque_tid();
  const int c0 = tid * 8;
  float gn[8];
#pragma unroll
  for (int e = 0; e < 8; ++e) gn[e] = p.hg_gn[j * 128 + ((c0 + e) & 127)];
  for (int tg = blockIdx.x; tg < NTG; tg += gridDim.x) {
    const size_t base = (size_t)tg * DI + c0;
    float yf[8], yb[8], z[8];
    unpack8(*(const uint4*)(p.YF + base), yf); unpack8(*(const uint4*)(p.YB + base), yb);
    unpack8(*(const uint4*)(p.Z + base), z);
    float y[8], s2 = 0.f;
#pragma unroll
    for (int e = 0; e < 8; ++e) { y[e] = yf[e] + yb[e]; s2 += y[e] * y[e]; }
    const float rstd = rsqrtf(red16(s2) * (1.f / 128.f) + EPS);
#pragma unroll
    for (int e = 0; e < 8; ++e) y[e] = y[e] * rstd * gn[e] * z[e];
    *(uint4*)(p.YF + base) = pack8(y);
  }
}

__global__ void __launch_bounds__(256, 2) fwd_megakernel(Params p) {
  cg::grid_group grid = cg::this_grid();
  __shared__ __attribute__((aligned(16))) char smem[78 * 1024];
  phase_mod(p, smem);
  phase_wconv(p, smem);
  grid.sync();
  for (int g = 0; g < NG; ++g) {
    for (int layer = 0; layer < 4; ++layer) {
      phase_resnorm(p, g, layer - 1, layer);
      grid.sync();
      const int j = layer >> 1;
      if ((layer & 1) == 0) {
        phase_rw_proj(p, j, smem, 0, blockIdx.x, gridDim.x);
        grid.sync();
        if (j == 1) { phase_rw_lr2(p, j, smem); grid.sync(); }
        if (gridDim.x >= 2 * GB * 64) {
          if (blockIdx.x < GB * 64) phase_rw_scan(p, j, smem);
          else phase_rw_proj(p, j, smem, 1, blockIdx.x - GB * 64, gridDim.x - GB * 64);
        } else {
          phase_rw_scan(p, j, smem);
          phase_rw_proj(p, j, smem, 1, blockIdx.x, gridDim.x);
        }
        grid.sync();
        phase_rw_gate(p, j);
        grid.sync();
        phase_out(p, g_wt + OFF_RWO + (size_t)j * DM * DI, smem);
        grid.sync();
      } else {
        phase_hg_proj(p, j, smem);
        grid.sync();
        phase_hg_scan(p, layer, smem);
        grid.sync();
        phase_hg_gate(p, j);
        grid.sync();
        phase_out(p, g_wt + OFF_HWO + (size_t)j * DM * DI, smem);
        grid.sync();
      }
    }
    phase_resnorm(p, g, 3, -1);
    grid.sync();
  }
}

extern "C" void kernel_launch(void* const* d_in, const int* in_sizes, int n_in, void* d_out, int out_size, void* d_ws,
                              size_t ws_size, hipStream_t stream) {
  static int grid_blocks = 0;
  if (!grid_blocks) {
    int dev = 0, cus = 0, per_cu = 0;
    hipGetDevice(&dev);
    hipDeviceGetAttribute(&cus, hipDeviceAttributeMultiprocessorCount, dev);
    hipOccupancyMaxActiveBlocksPerMultiprocessor(&per_cu, fwd_megakernel, 256, 0);
    if (per_cu > 2) per_cu = 2;
    grid_blocks = cus * per_cu;
  }
  Params p{};
  const float** fp = (const float**)&p;
  for (int i = 0; i < 29; ++i) fp[i] = (const float*)d_in[i];
  p.out = (float*)d_out;
  char* w = (char*)d_ws;
  size_t off = 0;
  auto take = [&](size_t bytes) { char* r = w + off; off += (bytes + 255) & ~(size_t)255; return r; };
  const size_t DIW = (size_t)NTG * DI * 2;
  p.R = (bf16_t*)take(DIW); p.K = (bf16_t*)take(DIW); p.V = (bf16_t*)take(DIW); p.Z = (bf16_t*)take(DIW);
  p.WF = (bf16_t*)take(DIW); p.YF = (bf16_t*)take(DIW); p.YB = (bf16_t*)take(DIW);
  p.VF = p.YF;
  p.H = p.YB;
  p.HR = p.WF; p.HR0 = p.WF + (size_t)NTG * DM;
  p.LRW = (bf16_t*)take((size_t)NTG * 128 * 2); p.LRA = (bf16_t*)take((size_t)NTG * 128 * 2);
  p.LRV = (bf16_t*)take((size_t)NTG * 32 * 2);
  p.O = (float*)p.R;
  p.BN = (float*)take((size_t)2 * NTG * 32 * 4);
  p.CTXB = (float*)take((size_t)NB * CTX * DM * 4);
  p.MODV = (float*)take((size_t)4 * 9 * 3 * DM * 4);
  p.LB = (float*)take((size_t)4 * DI * 4);
  if (off > ws_size) { fprintf(stderr, "workspace too small: need %zu have %zu\n", off, ws_size); return; }
  void* args[] = {&p};
  hipError_t e = hipLaunchCooperativeKernel((void*)fwd_megakernel, dim3(grid_blocks), dim3(256), args, 0, stream);
  if (e != hipSuccess) fprintf(stderr, "cooperative launch failed: %s (grid %d)\n", hipGetErrorString(e), grid_blocks);
}
```

```cpp
#include <hip/hip_runtime.h>
#include <hip/hip_cooperative_groups.h>
#include <cstdio>
#include <cstdint>
namespace cg = cooperative_groups;

typedef unsigned short bf16_t;
using bf16x8 = __attribute__((ext_vector_type(8))) short;
using f32x16 = __attribute__((ext_vector_type(16))) float;
using f32x4 = __attribute__((ext_vector_type(4))) float;
using f2_t = __attribute__((ext_vector_type(2))) float;

constexpr int NB = 8, SEQ = 4096, CTX = 256, TT = 4352, DM = 1024, DI = 2048;
constexpr int GB = 4, NG = NB / GB, NTG = GB * TT;
constexpr int MT = NTG / 128;
constexpr float EPS = 1e-6f;

constexpr size_t OFF_PROJ = 0;
constexpr size_t OFF_RWO = OFF_PROJ + (size_t)2 * 4 * DI * DM;
constexpr size_t OFF_W1 = OFF_RWO + (size_t)2 * DM * DI;
constexpr size_t OFF_A1 = OFF_W1 + (size_t)2 * 128 * DM;
constexpr size_t OFF_V1 = OFF_A1 + (size_t)2 * 128 * DM;
constexpr size_t OFF_V2 = OFF_V1 + (size_t)32 * DM;
constexpr size_t OFF_HWIN = OFF_V2 + (size_t)DI * 32;
constexpr size_t OFF_HWO = OFF_HWIN + (size_t)2 * 5 * DI * DM;
constexpr size_t OFF_W2 = OFF_HWO + (size_t)2 * DM * DI;
constexpr size_t OFF_A2 = OFF_W2 + (size_t)4 * DI * 64;
constexpr size_t WT_TOTAL = OFF_A2 + (size_t)4 * DI * 64;
__device__ bf16_t g_wt[WT_TOTAL];

struct Params {
  const float *x, *c, *ctx, *c_ctx, *mod_w, *mod_b, *pre_g, *post_g, *rw_mix, *rw_proj, *rw_wo, *rw_w0, *rw_w1,
      *rw_w2, *rw_a0, *rw_a1, *rw_a2, *rw_v0, *rw_v1, *rw_v2, *rw_kk, *rw_ka, *rw_rk, *rw_lnw, *rw_lnb, *hg_win,
      *hg_wo, *hg_gn, *hg_lb;
  float* out;
  bf16_t *R, *K, *V, *Z, *WF, *YF, *YB, *VF, *H, *HR, *HR0, *LRW, *LRA, *LRV;
  float *O, *BN, *CTXB, *MODV, *LB;
  unsigned* bar;
};

typedef __bf16 hwbf2_t __attribute__((ext_vector_type(2)));
typedef float hwf2_t __attribute__((ext_vector_type(2)));
__device__ __forceinline__ unsigned pack2(float a, float b) {
  hwf2_t f = {a, b};
  hwbf2_t h = __builtin_convertvector(f, hwbf2_t);
  return __builtin_bit_cast(unsigned, h);
}
__device__ __forceinline__ bf16_t f2bf(float f) { return (bf16_t)(pack2(f, f) & 0xffffu); }
__device__ __forceinline__ float bf2f(bf16_t h) { return __uint_as_float(((unsigned)h) << 16); }
typedef _Float16 h2_t __attribute__((ext_vector_type(2)));
using f16x8 = __attribute__((ext_vector_type(8))) _Float16;
__device__ __forceinline__ unsigned pack2h(float a, float b) {
  h2_t h = {(_Float16)a, (_Float16)b};
  return __builtin_bit_cast(unsigned, h);
}
__device__ __forceinline__ uint4 pack8h(const float* f) {
  uint4 u; u.x = pack2h(f[0], f[1]); u.y = pack2h(f[2], f[3]); u.z = pack2h(f[4], f[5]); u.w = pack2h(f[6], f[7]);
  return u;
}
__device__ __forceinline__ unsigned mixh2(unsigned h, unsigned n, unsigned m) {
  const h2_t hv = __builtin_bit_cast(h2_t, h), nv = __builtin_bit_cast(h2_t, n), mv = __builtin_bit_cast(h2_t, m);
  const h2_t r = hv + (nv - hv) * mv;
  return __builtin_bit_cast(unsigned, r);
}
__device__ __forceinline__ float lo2f(unsigned u) { return __uint_as_float(u << 16); }
__device__ __forceinline__ float hi2f(unsigned u) { return __uint_as_float(u & 0xffff0000u); }
__device__ __forceinline__ float sigmoidf_(float x) { return 1.f / (1.f + __expf(-x)); }
__device__ __forceinline__ float siluf_(float x) { return x / (1.f + __expf(-x)); }

__device__ __forceinline__ void lds_barrier() { asm volatile("s_waitcnt lgkmcnt(0)\n\ts_barrier" ::: "memory"); }

__device__ __forceinline__ int opaque_tid() { int t = threadIdx.x; asm volatile("" : "+v"(t)); return t; }

template <int CTRL>
__device__ __forceinline__ float dppf(float v) {
  return __int_as_float(__builtin_amdgcn_update_dpp(0, __float_as_int(v), CTRL, 0xf, 0xf, true));
}
__device__ __forceinline__ float red4(float v) { v += dppf<0xB1>(v); v += dppf<0x4E>(v); return v; }
__device__ __forceinline__ float red8(float v) { v = red4(v); v += dppf<0x141>(v); return v; }
__device__ __forceinline__ float red16(float v) { v = red8(v); v += dppf<0x140>(v); return v; }
__device__ __forceinline__ float red64(float v) {
  v = red16(v);
  v += __shfl_xor(v, 16);
  v += __shfl_xor(v, 32);
  return v;
}

__device__ __forceinline__ void unpack8(const uint4& u, float* f) {
  f[0] = lo2f(u.x); f[1] = hi2f(u.x); f[2] = lo2f(u.y); f[3] = hi2f(u.y);
  f[4] = lo2f(u.z); f[5] = hi2f(u.z); f[6] = lo2f(u.w); f[7] = hi2f(u.w);
}
__device__ __forceinline__ uint4 pack8(const float* f) {
  uint4 u; u.x = pack2(f[0], f[1]); u.y = pack2(f[2], f[3]); u.z = pack2(f[4], f[5]); u.w = pack2(f[6], f[7]);
  return u;
}


#define XB_TMO      128
#define XB_XCNT(j)  (256  + 64 * (j))
#define XB_XSUB(j)  (1280 + 64 * (j))
#define XB_XGEN(j)  (2304 + 64 * (j))
#define XB_TOP      3328
#define XB_TOPGEN   3392
#define XCD_BAR_WORDS 3456
#define XB_SPIN_CAP (1u << 23)
#define LAS __attribute__((address_space(3)))
__device__ __forceinline__ unsigned xb_ld(unsigned* p)              { return __hip_atomic_load(p, __ATOMIC_RELAXED, __HIP_MEMORY_SCOPE_AGENT); }
__device__ __forceinline__ unsigned xb_add(unsigned* p, unsigned v) { return __hip_atomic_fetch_add(p, v, __ATOMIC_RELAXED, __HIP_MEMORY_SCOPE_AGENT); }
__device__ __forceinline__ unsigned xb_xcc_id() { return (unsigned)__builtin_amdgcn_s_getreg((3 << 11) | 20) & 0xFu; }
#define XB_SPIN(cond, bar) do { unsigned _sp = 0; while (cond) { __builtin_amdgcn_s_sleep(1); \
    if ((++_sp & 255u) == 0u) { if (xb_ld(&(bar)[XB_TMO])) break; if (_sp > XB_SPIN_CAP) { atomicAdd(&(bar)[XB_TMO], 1u); break; } } } } while (0)
struct XcdBarrier { unsigned* bar; unsigned x; volatile LAS unsigned* st; };
__device__ __forceinline__ XcdBarrier xcd_barrier_post(unsigned* bar, volatile LAS unsigned* st) {
  XcdBarrier b; b.bar = bar; b.x = xb_xcc_id(); b.st = st;
  if (threadIdx.x == 0) (void)xb_add(&bar[XB_XCNT(b.x)], 1u);
  return b;
}
__device__ __forceinline__ void xcd_barrier_complete(unsigned* bar, unsigned x, unsigned& nloc, unsigned& nx) {
  const unsigned G = gridDim.x * gridDim.y * gridDim.z;
  unsigned sum, cnt, mine, sp = 0u;
  for (;;) {
    sum = 0u; cnt = 0u; mine = 0u;
#pragma unroll
    for (unsigned j = 0; j < 16; ++j) { const unsigned c = xb_ld(&bar[XB_XCNT(j)]); sum += c; cnt += (c > 0u) ? 1u : 0u; mine = (j == x) ? c : mine; }
    if (sum == G) break;
    __builtin_amdgcn_s_sleep(1);
    if ((++sp & 255u) == 0u) { if (xb_ld(&bar[XB_TMO])) break; if (sp > XB_SPIN_CAP) { atomicAdd(&bar[XB_TMO], 1u); break; } }
  }
  nloc = mine > 0u ? mine : 1u; nx = cnt > 0u ? cnt : 1u;
}
__device__ __forceinline__ void xcd_barrier(const XcdBarrier& b) {
  asm volatile("s_waitcnt vmcnt(0)" ::: "memory");
  __syncthreads();
  if (threadIdx.x == 0) {
    unsigned* bar = b.bar;
    __builtin_amdgcn_s_waitcnt(0);
    unsigned nloc = b.st[0], nx = b.st[1];
    if (nloc == 0u) { xcd_barrier_complete(bar, b.x, nloc, nx); b.st[0] = nloc; b.st[1] = nx; }
    const unsigned old = xb_add(&bar[XB_XSUB(b.x)], 1u);
    const unsigned gen = old / nloc;
    if (old + 1u == (gen + 1u) * nloc) {
      __builtin_amdgcn_fence(__ATOMIC_RELEASE, "agent");
      asm volatile("s_waitcnt vmcnt(0)" ::: "memory");
      const unsigned og = xb_add(&bar[XB_TOP], 1u);
      const unsigned tg = og / nx;
      if (og + 1u == (tg + 1u) * nx) xb_add(&bar[XB_TOPGEN], 1u);
      else XB_SPIN(xb_ld(&bar[XB_TOPGEN]) == tg, bar);
      __builtin_amdgcn_fence(__ATOMIC_ACQUIRE, "agent");
      xb_add(&bar[XB_XGEN(b.x)], 1u);
      asm volatile("s_waitcnt vmcnt(0)" ::: "memory");
    } else {
      XB_SPIN(xb_ld(&bar[XB_XGEN(b.x)]) == gen, bar);
      __builtin_amdgcn_fence(__ATOMIC_ACQUIRE, "agent");
      asm volatile("s_waitcnt vmcnt(0)" ::: "memory");
    }
  }
  __syncthreads();
}

__device__ __forceinline__ const float* row_in(const Params& p, int b, int t) {
  return t < CTX ? p.ctx + ((size_t)b * CTX + t) * DM : p.x + ((size_t)b * SEQ + (t - CTX)) * DM;
}
__device__ __forceinline__ float* row_cur(const Params& p, int b, int t) {
  return t < CTX ? p.CTXB + ((size_t)b * CTX + t) * DM : p.out + ((size_t)b * SEQ + (t - CTX)) * DM;
}

__device__ __forceinline__ void phase_mod(const Params& p, char* smem) {
  float* red = (float*)smem;
  const int tid = opaque_tid(), cl = tid & 63, kp = tid >> 6;
  for (int task = blockIdx.x; task < 4 * 48; task += gridDim.x) {
    const int l = task / 48, col = (task % 48) * 64 + cl;
    float acc[9];
#pragma unroll
    for (int r = 0; r < 9; ++r) acc[r] = 0.f;
    const float* W = p.mod_w + (size_t)l * DM * 3 * DM + col;
    for (int k = kp * 256; k < kp * 256 + 256; ++k) {
      const float w = W[(size_t)k * 3 * DM];
#pragma unroll
      for (int r = 0; r < 9; ++r) {
        const float cv = r < 8 ? p.c[r * DM + k] : p.c_ctx[k];
        acc[r] += siluf_(cv) * w;
      }
    }
    __syncthreads();
#pragma unroll
    for (int r = 0; r < 9; ++r) red[(kp * 9 + r) * 64 + cl] = acc[r];
    __syncthreads();
    for (int idx = tid; idx < 9 * 64; idx += 256) {
      const int r = idx >> 6, c2 = idx & 63;
      float s = 0.f;
      for (int q = 0; q < 4; ++q) s += red[(q * 9 + r) * 64 + c2];
      const int cc = (task % 48) * 64 + c2;
      p.MODV[((size_t)l * 9 + r) * 3 * DM + cc] = s + p.mod_b[l * 3 * DM + cc];
    }
  }
  for (int cidx = blockIdx.x * 256 + tid; cidx < DI; cidx += gridDim.x * 256) {
    float v[4], m = -1e30f;
    for (int l = 0; l < 4; ++l) { v[l] = p.hg_lb[l * DI + cidx]; m = fmaxf(m, v[l]); }
    float s = 0.f;
    for (int l = 0; l < 4; ++l) { v[l] = __expf(v[l] - m); s += v[l]; }
    float cum = 0.f;
    for (int l = 0; l < 4; ++l) { cum += v[l] / s; p.LB[l * DI + cidx] = cum - v[0] / s; }
  }
}

__device__ __forceinline__ void conv_matrix(const float* __restrict__ src, int K, int N, bf16_t* __restrict__ dst, char* smem, bool f16out = false) {
  float* ts = (float*)smem;
  const int tid = opaque_tid();
  const int ntn = N / 32, ntile = (K / 64) * ntn;
  for (int tile = blockIdx.x; tile < ntile; tile += gridDim.x) {
    const int k0 = (tile / ntn) * 64, n0 = (tile % ntn) * 32;
    __syncthreads();
#pragma unroll
    for (int i = 0; i < 2; ++i) {
      const int k = (tid >> 3) + 32 * i, n4 = (tid & 7) * 4;
      const float4 v = *(const float4*)(src + (size_t)(k0 + k) * N + n0 + n4);
      ts[k * 33 + n4 + 0] = v.x; ts[k * 33 + n4 + 1] = v.y; ts[k * 33 + n4 + 2] = v.z; ts[k * 33 + n4 + 3] = v.w;
    }
    __syncthreads();
    const int n = tid >> 3, k8 = (tid & 7) * 8;
    float f[8];
#pragma unroll
    for (int e = 0; e < 8; ++e) f[e] = ts[(k8 + e) * 33 + n];
    *(uint4*)(dst + (size_t)(n0 + n) * K + k0 + k8) = f16out ? pack8h(f) : pack8(f);
  }
}
__device__ __forceinline__ void phase_wconv(const Params& p, char* smem) {
  for (int m = 0; m < 8; ++m) conv_matrix(p.rw_proj + (size_t)m * DM * DI, DM, DI, g_wt + OFF_PROJ + (size_t)m * DI * DM, smem, true);
  for (int j = 0; j < 2; ++j) conv_matrix(p.rw_wo + (size_t)j * DI * DM, DI, DM, g_wt + OFF_RWO + (size_t)j * DM * DI, smem);
  for (int m = 0; m < 4; ++m) {
    conv_matrix(p.rw_w1 + (size_t)m * DM * 64, DM, 64, g_wt + OFF_W1 + (size_t)m * 64 * DM, smem, true);
    conv_matrix(p.rw_a1 + (size_t)m * DM * 64, DM, 64, g_wt + OFF_A1 + (size_t)m * 64 * DM, smem, true);
  }
  conv_matrix(p.rw_v1, DM, 32, g_wt + OFF_V1, smem, true);
  for (int m = 0; m < 4; ++m) {
    conv_matrix(p.rw_w2 + (size_t)m * 64 * DI, 64, DI, g_wt + OFF_W2 + (size_t)m * DI * 64, smem);
    conv_matrix(p.rw_a2 + (size_t)m * 64 * DI, 64, DI, g_wt + OFF_A2 + (size_t)m * DI * 64, smem);
  }
  for (int j = 0; j < 2; ++j) conv_matrix(p.hg_win + (size_t)j * DM * 5 * DI, DM, 5 * DI, g_wt + OFF_HWIN + (size_t)j * 5 * DI * DM, smem);
  for (int j = 0; j < 2; ++j) conv_matrix(p.hg_wo + (size_t)j * DI * DM, DI, DM, g_wt + OFF_HWO + (size_t)j * DM * DI, smem);
  for (int idx = blockIdx.x * 256 + opaque_tid(); idx < DI * 32; idx += gridDim.x * 256) {
    const int n = idx >> 5, k = idx & 31;
    g_wt[OFF_V2 + idx] = f2bf(p.rw_v2[(size_t)k * DI + n]);
  }
}

__device__ __forceinline__ void phase_resnorm(const Params& p, int g, int lu, int ln) {
  const int tid = opaque_tid();
  const int lane = tid & 63;
  const int wv = blockIdx.x * 4 + (tid >> 6), nw = gridDim.x * 4;
  for (int tg = wv; tg < NTG; tg += nw) {
    const int bl = tg / TT, t = tg % TT, b = g * GB + bl;
    const bool isctx = t < CTX;
    const int mrow = isctx ? 8 : b;
    float xv[16];
    const float* src = (lu <= 0) ? row_in(p, b, t) : row_cur(p, b, t);
#pragma unroll
    for (int j = 0; j < 4; ++j) {
      const float4 v4 = *(const float4*)(src + j * 256 + lane * 4);
      xv[j * 4 + 0] = v4.x; xv[j * 4 + 1] = v4.y; xv[j * 4 + 2] = v4.z; xv[j * 4 + 3] = v4.w;
    }
    if (lu >= 0 && !(isctx && lu == 3)) {
      float ov[16], ss = 0.f;
      const float* orow = p.O + (size_t)tg * DM;
#pragma unroll
      for (int j = 0; j < 4; ++j) {
        const float4 v4 = *(const float4*)(orow + j * 256 + lane * 4);
        ov[j * 4 + 0] = v4.x; ov[j * 4 + 1] = v4.y; ov[j * 4 + 2] = v4.z; ov[j * 4 + 3] = v4.w;
      }
#pragma unroll
      for (int e = 0; e < 16; ++e) ss += ov[e] * ov[e];
      ss = red64(ss);
      const float rstd = rsqrtf(ss * (1.f / DM) + EPS);
      const float* gate = p.MODV + ((size_t)lu * 9 + mrow) * 3 * DM + 2 * DM;
      const float* pg = p.post_g + lu * DM;
      float* dst = row_cur(p, b, t);
#pragma unroll
      for (int j = 0; j < 4; ++j) {
        const int cc = j * 256 + lane * 4;
        const float4 g4 = *(const float4*)(gate + cc);
        const float4 p4 = *(const float4*)(pg + cc);
        xv[j * 4 + 0] += g4.x * (ov[j * 4 + 0] * rstd * p4.x);
        xv[j * 4 + 1] += g4.y * (ov[j * 4 + 1] * rstd * p4.y);
        xv[j * 4 + 2] += g4.z * (ov[j * 4 + 2] * rstd * p4.z);
        xv[j * 4 + 3] += g4.w * (ov[j * 4 + 3] * rstd * p4.w);
        *(float4*)(dst + cc) = make_float4(xv[j * 4 + 0], xv[j * 4 + 1], xv[j * 4 + 2], xv[j * 4 + 3]);
      }
    }
    if (ln >= 0) {
      for (int pass = 0; pass < (ln == 2 ? 2 : 1); ++pass) {
        const int lp = pass == 0 ? ln : 0;
        bf16_t* hdst = (pass == 0 ? ((ln & 1) == 0 ? p.HR : p.H) : p.HR0) + (size_t)tg * DM;
        if (pass == 1) {
          const float* s0 = row_in(p, b, t);
#pragma unroll
          for (int j = 0; j < 4; ++j) {
            const float4 v4 = *(const float4*)(s0 + j * 256 + lane * 4);
            xv[j * 4 + 0] = v4.x; xv[j * 4 + 1] = v4.y; xv[j * 4 + 2] = v4.z; xv[j * 4 + 3] = v4.w;
          }
        }
        float ss = 0.f;
#pragma unroll
        for (int e = 0; e < 16; ++e) ss += xv[e] * xv[e];
        ss = red64(ss);
        const float rstd = rsqrtf(ss * (1.f / DM) + EPS);
        const float* mv = p.MODV + ((size_t)lp * 9 + mrow) * 3 * DM;
        const float* pg = p.pre_g + lp * DM;
#pragma unroll
        for (int j = 0; j < 4; ++j) {
          const int cc = j * 256 + lane * 4;
          const float4 sh = *(const float4*)(mv + cc);
          const float4 sc = *(const float4*)(mv + DM + cc);
          const float4 p4 = *(const float4*)(pg + cc);
          const float h0 = xv[j * 4 + 0] * rstd * p4.x * (1.f + sc.x) + sh.x;
          const float h1 = xv[j * 4 + 1] * rstd * p4.y * (1.f + sc.y) + sh.y;
          const float h2 = xv[j * 4 + 2] * rstd * p4.z * (1.f + sc.z) + sh.z;
          const float h3 = xv[j * 4 + 3] * rstd * p4.w * (1.f + sc.w) + sh.w;
          uint2 u;
          if ((ln & 1) == 0) {
            const float L = 60000.f;
            u.x = pack2h(fminf(fmaxf(h0, -L), L), fminf(fmaxf(h1, -L), L));
            u.y = pack2h(fminf(fmaxf(h2, -L), L), fminf(fmaxf(h3, -L), L));
          } else {
            u.x = pack2(h0, h1); u.y = pack2(h2, h3);
          }
          *(uint2*)(hdst + cc) = u;
        }
      }
    }
  }
}

constexpr int LDK = 72;
constexpr int TM = 128;

template <int AMODE, class Epi>
__device__ __forceinline__ void gemm_tile(const bf16_t* __restrict__ A, int lda, const float* __restrict__ mix, int m0,
                                          int K, const bf16_t* __restrict__ Bt, int nvalid, char* smem, Epi epi) {
  bf16_t* As = (bf16_t*)smem;
  bf16_t* Bs = As + 2 * TM * LDK;
  float* mixs = (float*)(Bs + 2 * 128 * LDK);
  const int tid = opaque_tid(), lane = tid & 63, w = tid >> 6, wm = w >> 1, wn = w & 1;
  const int lr = lane >> 3, ch = (lane & 7) * 8;
  const int row0 = w * 32 + lr;
  const bf16_t* Ap = A + (size_t)(m0 + row0) * lda + ch;
  const bf16_t* Bp = Bt + (size_t)row0 * K + ch;
  const size_t astep = (size_t)8 * lda, bstep = (size_t)8 * K;
  const int KT = (K + 63) >> 6;
  const int tbase = m0 % TT;
  const bool isctx = tbase < CTX;
  unsigned vmask = 0;
  if (AMODE == 1) {
#pragma unroll
    for (int i = 0; i < 4; ++i) {
      const int t = tbase + row0 + i * 8;
      unsigned m;
      if (isctx) {
        m = (t >= 1 ? 3u : 0u) | (t + 1 < CTX ? 12u : 0u);
      } else {
        const int tl = t - CTX, row = tl >> 6, col = tl & 63;
        m = (col > 0 ? 1u : 0u) | (col < 63 ? 2u : 0u) | (row > 0 ? 4u : 0u) | (row < 63 ? 8u : 0u);
      }
      vmask |= m << (4 * i);
    }
  }

  __syncthreads();
  if (AMODE == 1) {
    const float4 m4 = *(const float4*)(mix + tid * 4);
    ((uint2*)mixs)[tid] = make_uint2(pack2h(m4.x, m4.y), pack2h(m4.z, m4.w));
  }

  f32x16 acc[2][2];
#pragma unroll
  for (int i = 0; i < 2; ++i)
#pragma unroll
    for (int j = 0; j < 2; ++j)
#pragma unroll
      for (int r = 0; r < 16; ++r) acc[i][j][r] = 0.f;

  uint4 a0, a1, a2, a3, n0, n1, n2, n3, b0, b1, b2, b3;
  auto load_regs = [&](int kt) {
    const int k0 = kt * 64;
    const uint4 z4 = make_uint4(0, 0, 0, 0);
    const bool kval = (k0 + ch) < K;
    const bf16_t* ap = Ap + k0;
    const bf16_t* bp = Bp + k0;
    a0 = z4; if (kval) a0 = *(const uint4*)(ap + 0 * astep);
    a1 = z4; if (kval) a1 = *(const uint4*)(ap + 1 * astep);
    a2 = z4; if (kval) a2 = *(const uint4*)(ap + 2 * astep);
    a3 = z4; if (kval) a3 = *(const uint4*)(ap + 3 * astep);
    b0 = z4; if (kval && (row0 + 0) < nvalid) b0 = *(const uint4*)(bp + 0 * bstep);
    b1 = z4; if (kval && (row0 + 8) < nvalid) b1 = *(const uint4*)(bp + 1 * bstep);
    b2 = z4; if (kval && (row0 + 16) < nvalid) b2 = *(const uint4*)(bp + 2 * bstep);
    b3 = z4; if (kval && (row0 + 24) < nvalid) b3 = *(const uint4*)(bp + 3 * bstep);
    if (AMODE == 1) {
      const int q = k0 >> 8;
      const int nb = isctx ? (q < 2 ? -1 : 1) : (q == 0 ? -1 : (q == 1 ? 1 : (q == 2 ? -64 : 64)));
      const bf16_t* np = ap + (ptrdiff_t)nb * lda;
      const unsigned vm = vmask >> q;
      n0 = z4; if ((vm >> 0) & 1u) n0 = *(const uint4*)(np + 0 * astep);
      n1 = z4; if ((vm >> 4) & 1u) n1 = *(const uint4*)(np + 1 * astep);
      n2 = z4; if ((vm >> 8) & 1u) n2 = *(const uint4*)(np + 2 * astep);
      n3 = z4; if ((vm >> 12) & 1u) n3 = *(const uint4*)(np + 3 * astep);
    }
  };
  auto mix8 = [&](const uint4& hv, const uint4& nv, const uint4& mv) -> uint4 {
    uint4 o;
    o.x = mixh2(hv.x, nv.x, mv.x); o.y = mixh2(hv.y, nv.y, mv.y); o.z = mixh2(hv.z, nv.z, mv.z); o.w = mixh2(hv.w, nv.w, mv.w);
    return o;
  };
  auto store_lds = [&](int kt, int buf) {
    bf16_t* ad = As + (buf * TM + row0) * LDK + ch;
    bf16_t* bd = Bs + (buf * 128 + row0) * LDK + ch;
    if (AMODE == 1) {
      const uint4 mv = *(const uint4*)((const bf16_t*)mixs + kt * 64 + ch);
      *(uint4*)(ad + 0 * LDK) = mix8(a0, n0, mv);
      *(uint4*)(ad + 8 * LDK) = mix8(a1, n1, mv);
      *(uint4*)(ad + 16 * LDK) = mix8(a2, n2, mv);
      *(uint4*)(ad + 24 * LDK) = mix8(a3, n3, mv);
    } else {
      *(uint4*)(ad + 0 * LDK) = a0;
      *(uint4*)(ad + 8 * LDK) = a1;
      *(uint4*)(ad + 16 * LDK) = a2;
      *(uint4*)(ad + 24 * LDK) = a3;
    }
    *(uint4*)(bd + 0 * LDK) = b0;
    *(uint4*)(bd + 8 * LDK) = b1;
    *(uint4*)(bd + 16 * LDK) = b2;
    *(uint4*)(bd + 24 * LDK) = b3;
  };
  auto compute = [&](int buf) {
    const bf16_t* ab = As + (buf * TM + wm * 64 + (lane & 31)) * LDK + (lane >> 5) * 8;
    const bf16_t* bb = Bs + (buf * 128 + wn * 64 + (lane & 31)) * LDK + (lane >> 5) * 8;
#pragma unroll
    for (int kk = 0; kk < 4; ++kk) {
      const bf16x8 af0 = *(const bf16x8*)(ab + kk * 16), af1 = *(const bf16x8*)(ab + 32 * LDK + kk * 16);
      const bf16x8 bf0 = *(const bf16x8*)(bb + kk * 16), bf1 = *(const bf16x8*)(bb + 32 * LDK + kk * 16);
      if (AMODE == 1) {
        const f16x8 ha0 = __builtin_bit_cast(f16x8, af0), ha1 = __builtin_bit_cast(f16x8, af1);
        const f16x8 hb0 = __builtin_bit_cast(f16x8, bf0), hb1 = __builtin_bit_cast(f16x8, bf1);
        acc[0][0] = __builtin_amdgcn_mfma_f32_32x32x16_f16(ha0, hb0, acc[0][0], 0, 0, 0);
        acc[0][1] = __builtin_amdgcn_mfma_f32_32x32x16_f16(ha0, hb1, acc[0][1], 0, 0, 0);
        acc[1][0] = __builtin_amdgcn_mfma_f32_32x32x16_f16(ha1, hb0, acc[1][0], 0, 0, 0);
        acc[1][1] = __builtin_amdgcn_mfma_f32_32x32x16_f16(ha1, hb1, acc[1][1], 0, 0, 0);
      } else {
        acc[0][0] = __builtin_amdgcn_mfma_f32_32x32x16_bf16(af0, bf0, acc[0][0], 0, 0, 0);
        acc[0][1] = __builtin_amdgcn_mfma_f32_32x32x16_bf16(af0, bf1, acc[0][1], 0, 0, 0);
        acc[1][0] = __builtin_amdgcn_mfma_f32_32x32x16_bf16(af1, bf0, acc[1][0], 0, 0, 0);
        acc[1][1] = __builtin_amdgcn_mfma_f32_32x32x16_bf16(af1, bf1, acc[1][1], 0, 0, 0);
      }
    }
  };
  load_regs(0);
  lds_barrier();
  store_lds(0, 0);
  if (KT > 1) load_regs(1);
  lds_barrier();
  for (int kt = 0; kt < KT; ++kt) {
    if (kt + 1 < KT) store_lds(kt + 1, (kt + 1) & 1);
    if (kt + 2 < KT) load_regs(kt + 2);
    compute(kt & 1);
    lds_barrier();
  }
  float* Cs = (float*)smem;
#pragma unroll
  for (int i = 0; i < 2; ++i)
#pragma unroll
    for (int j = 0; j < 2; ++j)
#pragma unroll
      for (int r = 0; r < 16; ++r)
        Cs[(wm * 64 + i * 32 + (r & 3) + 8 * (r >> 2) + 4 * (lane >> 5)) * 132 + wn * 64 + j * 32 + (lane & 31)] = acc[i][j][r];
  lds_barrier();
#pragma unroll 2
  for (int it = 0; it < 8; ++it) {
    const int idx = it * 256 + tid, row = idx >> 4, c8 = (idx & 15) * 8;
    const float4 v0 = *(const float4*)(Cs + row * 132 + c8), v1 = *(const float4*)(Cs + row * 132 + c8 + 4);
    float v[8] = {v0.x, v0.y, v0.z, v0.w, v1.x, v1.y, v1.z, v1.w};
    epi(m0 + row, c8, v);
  }
}

__device__ __forceinline__ void phase_rw_proj(const Params& p, int j, char* smem, int zonly, int bid, int nb) {
  const int ntn = zonly ? 16 : (j == 0 ? 50 : 67);
  const float* mixb = p.rw_mix + (size_t)j * 6 * DM;
  for (int tile = bid; tile < MT * ntn; tile += nb) {
    const int mt = tile / ntn, ntl = tile % ntn, m0 = mt * 128;
    const int nt = zonly ? 48 + ntl : (ntl < 48 ? ntl : ntl + 16);
    if (nt < 64) {
      const int pi = nt >> 4, n0 = (nt & 15) * 128;
      const int mi = pi == 0 ? 0 : (pi == 1 ? 2 : (pi == 2 ? 3 : 5));
      const bf16_t* Bw = g_wt + OFF_PROJ + ((size_t)(j * 4 + pi) * DI + n0) * DM;
      bf16_t* dst = pi == 0 ? p.R : (pi == 1 ? p.K : (pi == 2 ? p.V : p.Z));
      if (pi == 3) {
        gemm_tile<1>(p.HR, DM, mixb + mi * DM, m0, DM, Bw, 128, smem,
                     [&](int row, int col, float* v) {
#pragma unroll
        for (int e = 0; e < 8; ++e) v[e] = siluf_(v[e]);
        *(uint4*)(dst + (size_t)row * DI + n0 + col) = pack8(v); });
      } else {
        gemm_tile<1>(p.HR, DM, mixb + mi * DM, m0, DM, Bw, 128, smem,
                     [&](int row, int col, float* v) { *(uint4*)(dst + (size_t)row * DI + n0 + col) = pack8(v); });
      }
    } else if (nt == 64) {
      gemm_tile<1>(p.HR, DM, mixb + 1 * DM, m0, DM, g_wt + OFF_W1 + (size_t)j * 128 * DM, 128, smem,
                   [&](int row, int col, float* v) {
#pragma unroll
        for (int e = 0; e < 8; ++e) v[e] = tanhf(v[e]);
        *(uint4*)(p.LRW + (size_t)row * 128 + col) = pack8(v); });
    } else if (nt == 65) {
      gemm_tile<1>(p.HR, DM, mixb + 4 * DM, m0, DM, g_wt + OFF_A1 + (size_t)j * 128 * DM, 128, smem,
                   [&](int row, int col, float* v) { *(uint4*)(p.LRA + (size_t)row * 128 + col) = pack8(v); });
    } else if (nt == 66) {
      gemm_tile<1>(p.HR, DM, mixb + 3 * DM, m0, DM, g_wt + OFF_V1, 32, smem, [&](int row, int col, float* v) {
        if (col < 32) *(uint4*)(p.LRV + (size_t)row * 32 + col) = pack8(v);
      });
    } else {
      const int n0 = (nt - 67) * 128;
      const bf16_t* Bw = g_wt + OFF_PROJ + ((size_t)2 * DI + n0) * DM;
      gemm_tile<1>(p.HR0, DM, p.rw_mix + 3 * DM, m0, DM, Bw, 128, smem,
                   [&](int row, int col, float* v) { *(uint4*)(p.VF + (size_t)row * DI + n0 + col) = pack8(v); });
    }
  }
}

__device__ __forceinline__ void phase_rw_lr2(const Params& p, int j, char* smem) {
  for (int tile = blockIdx.x; tile < MT * 16; tile += gridDim.x) {
    const int mt = tile / 16, nt = tile % 16, m0 = mt * 128;
    const int n0 = nt * 128;
    const bf16_t* Bw = g_wt + OFF_V2 + (size_t)n0 * 32;
    const float* v0 = p.rw_v0 + n0;
    gemm_tile<0>(p.LRV, 32, nullptr, m0, 32, Bw, 128, smem, [&](int row, int col, float* v) {
      const size_t idx = (size_t)row * DI + n0 + col;
      float vv[8], vf[8];
      unpack8(*(const uint4*)(p.V + idx), vv); unpack8(*(const uint4*)(p.VF + idx), vf);
#pragma unroll
      for (int e = 0; e < 8; ++e) vv[e] += (vf[e] - vv[e]) * sigmoidf_(v[e] + v0[col + e]);
      *(uint4*)(p.V + idx) = pack8(vv);
    });
  }
}

constexpr int RCH = 32;
__device__ __forceinline__ int scan_pos(int dir, int s) { return dir == 0 ? s : (s < CTX ? CTX - 1 - s : TT + CTX - 1 - s); }

__device__ __forceinline__ void phase_rw_scan(const Params& p, int j, char* smem) {
  float* op = (float*)smem;
  float* vv = op + RCH * 4 * 64;
  float* sc = vv + RCH * 64;
  float* LWs = sc + RCH * 2;
  float* AAs = LWs + RCH * 64;
  float* yb = AAs;
  bf16_t* LRs = (bf16_t*)(AAs + RCH * 64);
  const int tid = opaque_tid(), lane = tid & 63, w = tid >> 6;
  const int ptau = tid >> 3, pc8 = (tid & 7) * 8;
  const int r2 = lane >> 3, ko = (lane & 7) * 8;
  const int row0 = w * 16 + r2, row1 = row0 + 8;
  for (int unit = blockIdx.x; unit < GB * 64; unit += gridDim.x) {
    const int bl = unit >> 6, h = (unit >> 1) & 31, dir = unit & 1;
    bf16_t* Y = dir == 0 ? p.YF : p.YB;
    float pkk[8], pka[8], prk[8];
#pragma unroll
    for (int e = 0; e < 8; ++e) {
      const int cc = j * DI + h * 64 + pc8 + e;
      pkk[e] = p.rw_kk[cc]; pka[e] = p.rw_ka[cc]; prk[e] = p.rw_rk[cc];
    }
    __syncthreads();
    const int mm = w >> 1, nh = w & 1;
    const float bias = (mm == 0 ? p.rw_w0 : p.rw_a0)[((size_t)j * 2 + dir) * DI + h * 64 + nh * 32 + (lane & 31)];
    bf16x8 wfr[4];
    {
      const bf16_t* w2g = g_wt + (mm == 0 ? OFF_W2 : OFF_A2) + (((size_t)j * 2 + dir) * DI + h * 64 + nh * 32 + (lane & 31)) * 64 + (lane >> 5) * 8;
#pragma unroll
      for (int kk = 0; kk < 4; ++kk) wfr[kk] = *(const bf16x8*)(w2g + kk * 16);
    }
    f2_t S0[4], S1[4];
#pragma unroll
    for (int e = 0; e < 4; ++e) { S0[e] = f2_t{0.f, 0.f}; S1[e] = f2_t{0.f, 0.f}; }
    uint4 gr, gk, gv, gl0, gl1;
    const int lmat = (tid & 7) >> 2, lcol = (tid & 3) * 16;
    auto gload = [&](int chunk) {
      const int pos = scan_pos(dir, chunk * RCH + ptau);
      const size_t tg = (size_t)bl * TT + pos;
      const size_t base = tg * DI + h * 64 + pc8;
      gr = *(const uint4*)(p.R + base); gk = *(const uint4*)(p.K + base); gv = *(const uint4*)(p.V + base);
      const bf16_t* lr = (lmat == 0 ? p.LRW : p.LRA) + tg * 128 + dir * 64 + lcol;
      gl0 = *(const uint4*)(lr); gl1 = *(const uint4*)(lr + 8);
    };
    gload(0);
    for (int chunk = 0; chunk < TT / RCH; ++chunk) {
      *(uint4*)(LRs + (lmat * RCH + ptau) * 72 + lcol) = gl0;
      *(uint4*)(LRs + (lmat * RCH + ptau) * 72 + lcol + 8) = gl1;
      lds_barrier();
      {
        f32x16 acc;
#pragma unroll
        for (int r = 0; r < 16; ++r) acc[r] = 0.f;
#pragma unroll
        for (int kk = 0; kk < 4; ++kk) {
          const bf16x8 af = *(const bf16x8*)(LRs + (mm * RCH + (lane & 31)) * 72 + kk * 16 + (lane >> 5) * 8);
          acc = __builtin_amdgcn_mfma_f32_32x32x16_bf16(af, wfr[kk], acc, 0, 0, 0);
        }
        const int chn = nh * 32 + (lane & 31), hh = lane >> 5;
        if (mm == 0) {
          float lwv[16], pf[16], own[4], oth[4];
#pragma unroll
          for (int r = 0; r < 16; ++r) lwv[r] = -0.60653066f * sigmoidf_(acc[r] + bias);
#pragma unroll
          for (int g = 0; g < 4; ++g) {
            pf[g * 4] = lwv[g * 4];
            pf[g * 4 + 1] = pf[g * 4] + lwv[g * 4 + 1];
            pf[g * 4 + 2] = pf[g * 4 + 1] + lwv[g * 4 + 2];
            pf[g * 4 + 3] = pf[g * 4 + 2] + lwv[g * 4 + 3];
            own[g] = pf[g * 4 + 3];
            oth[g] = __shfl_xor(own[g], 32);
          }
          float base = 0.f;
#pragma unroll
          for (int g = 0; g < 4; ++g) {
            const float off = base + (hh ? oth[g] : 0.f);
#pragma unroll
            for (int q = 0; q < 4; ++q) {
              const int t = q + 8 * g + 4 * hh;
              const float c = off + pf[g * 4 + q];
              LWs[t * 64 + chn] = c;
            }
            base += own[g] + oth[g];
          }
        } else {
#pragma unroll
          for (int r = 0; r < 16; ++r) {
            const int t = (r & 3) + 8 * (r >> 2) + 4 * hh;
            AAs[t * 64 + chn] = sigmoidf_(acc[r] + bias);
          }
        }
      }
      lds_barrier();
      {
        float r[8], k[8], v[8], cm[8], cp[8], a[8];
        unpack8(gr, r); unpack8(gk, k); unpack8(gv, v);
#pragma unroll
        for (int e = 0; e < 8; ++e) {
          cm[e] = LWs[ptau * 64 + pc8 + e]; cp[e] = ptau > 0 ? LWs[(ptau - 1) * 64 + pc8 + e] : 0.f; a[e] = AAs[ptau * 64 + pc8 + e];
        }
        float kkv[8], ss = 0.f;
#pragma unroll
        for (int e = 0; e < 8; ++e) { kkv[e] = k[e] * pkk[e]; ss += kkv[e] * kkv[e]; }
        ss = red8(ss);
        const float inv = rsqrtf(fmaxf(ss, 1e-24f));
        float br = 0.f, kr = 0.f, bon = 0.f;
        float o0[8], o1[8], o2[8], o3[8];
#pragma unroll
        for (int e = 0; e < 8; ++e) {
          const float kkn = kkv[e] * inv;
          const float P = __expf(cm[e]), Pp = __expf(cp[e]);
          const float iP = 1.f / P;
          const float kd = k[e] * (1.f + (a[e] - 1.f) * pka[e]);
          const float bb = kkn * a[e];
          o0[e] = -kkn * Pp; o1[e] = r[e] * P; o2[e] = bb * iP; o3[e] = kd * iP;
          br += bb * r[e]; kr += kd * r[e]; bon += r[e] * kd * prk[e];
        }
        br = red8(br); kr = red8(kr); bon = red8(bon);
        float* od = op + ptau * 256 + pc8;
        *(float4*)(od) = make_float4(o0[0], o0[1], o0[2], o0[3]); *(float4*)(od + 4) = make_float4(o0[4], o0[5], o0[6], o0[7]);
        *(float4*)(od + 64) = make_float4(o1[0], o1[1], o1[2], o1[3]); *(float4*)(od + 68) = make_float4(o1[4], o1[5], o1[6], o1[7]);
        *(float4*)(od + 128) = make_float4(o2[0], o2[1], o2[2], o2[3]); *(float4*)(od + 132) = make_float4(o2[4], o2[5], o2[6], o2[7]);
        *(float4*)(od + 192) = make_float4(o3[0], o3[1], o3[2], o3[3]); *(float4*)(od + 196) = make_float4(o3[4], o3[5], o3[6], o3[7]);
        float* vd = vv + ptau * 64 + pc8;
        *(float4*)(vd) = make_float4(v[0], v[1], v[2], v[3]); *(float4*)(vd + 4) = make_float4(v[4], v[5], v[6], v[7]);
        if ((tid & 7) == 0) {
          sc[ptau * 2] = br; sc[ptau * 2 + 1] = kr;
          const int pos = scan_pos(dir, chunk * RCH + ptau);
          p.BN[((size_t)dir * NTG + (size_t)bl * TT + pos) * 32 + h] = bon;
        }
      }
      lds_barrier();
      if (chunk + 1 < TT / RCH) gload(chunk + 1);
      {
        struct StepOps { float4 n0, n1, q0, q1, b0, b1, k0, k1; float v0, v1; float2 s; };
        auto ldops = [&](StepOps& o, int tau) {
          const float* ob = op + tau * 256 + ko;
          o.n0 = *(const float4*)(ob); o.n1 = *(const float4*)(ob + 4);
          o.q0 = *(const float4*)(ob + 64); o.q1 = *(const float4*)(ob + 68);
          o.b0 = *(const float4*)(ob + 128); o.b1 = *(const float4*)(ob + 132);
          o.k0 = *(const float4*)(ob + 192); o.k1 = *(const float4*)(ob + 196);
          o.v0 = vv[tau * 64 + row0]; o.v1 = vv[tau * 64 + row1];
          o.s = *(const float2*)(sc + tau * 2);
        };
        auto dostep = [&](const StepOps& o, int tau) {
          const float nk[8] = {o.n0.x, o.n0.y, o.n0.z, o.n0.w, o.n1.x, o.n1.y, o.n1.z, o.n1.w};
          const float rr[8] = {o.q0.x, o.q0.y, o.q0.z, o.q0.w, o.q1.x, o.q1.y, o.q1.z, o.q1.w};
          const float bb[8] = {o.b0.x, o.b0.y, o.b0.z, o.b0.w, o.b1.x, o.b1.y, o.b1.z, o.b1.w};
          const float kd[8] = {o.k0.x, o.k0.y, o.k0.z, o.k0.w, o.k1.x, o.k1.y, o.k1.z, o.k1.w};
          f2_t a10 = {0.f, 0.f}, a11 = {0.f, 0.f}, a20 = {0.f, 0.f}, a21 = {0.f, 0.f};
#pragma unroll
          for (int e = 0; e < 4; ++e) {
            const f2_t nk2 = {nk[2 * e], nk[2 * e + 1]}, rr2 = {rr[2 * e], rr[2 * e + 1]};
            a10 = __builtin_elementwise_fma(S0[e], nk2, a10); a11 = __builtin_elementwise_fma(S1[e], nk2, a11);
            a20 = __builtin_elementwise_fma(S0[e], rr2, a20); a21 = __builtin_elementwise_fma(S1[e], rr2, a21);
          }
          float d10 = a10.x + a10.y, d11 = a11.x + a11.y, d20 = a20.x + a20.y, d21 = a21.x + a21.y;
          d10 = red8(d10); d11 = red8(d11); d20 = red8(d20); d21 = red8(d21);
          const float y0 = d20 + d10 * o.s.x + o.v0 * o.s.y;
          const float y1 = d21 + d11 * o.s.x + o.v1 * o.s.y;
          const f2_t sa0 = {d10, d10}, sa1 = {d11, d11}, vv0 = {o.v0, o.v0}, vv1 = {o.v1, o.v1};
#pragma unroll
          for (int e = 0; e < 4; ++e) {
            const f2_t bb2 = {bb[2 * e], bb[2 * e + 1]}, kd2 = {kd[2 * e], kd[2 * e + 1]};
            S0[e] = __builtin_elementwise_fma(sa0, bb2, __builtin_elementwise_fma(vv0, kd2, S0[e]));
            S1[e] = __builtin_elementwise_fma(sa1, bb2, __builtin_elementwise_fma(vv1, kd2, S1[e]));
          }
          if ((lane & 7) == 0) { yb[tau * 64 + row0] = y0; yb[tau * 64 + row1] = y1; }
        };
        StepOps oa, ob2;
        ldops(oa, 0);
#pragma unroll 1
        for (int tau = 0; tau < RCH; tau += 2) {
          ldops(ob2, tau + 1);
          dostep(oa, tau);
          ldops(oa, tau + 2);
          dostep(ob2, tau + 1);
        }
#pragma unroll
        for (int e = 0; e < 4; ++e) {
          const f2_t pc = {__expf(LWs[(RCH - 1) * 64 + ko + 2 * e]), __expf(LWs[(RCH - 1) * 64 + ko + 2 * e + 1])};
          S0[e] *= pc; S1[e] *= pc;
        }
      }
      lds_barrier();
      {
        const int pos = scan_pos(dir, chunk * RCH + ptau);
        const float* ys = yb + ptau * 64 + pc8;
        float yv[8];
#pragma unroll
        for (int e = 0; e < 8; ++e) yv[e] = ys[e];
        *(uint4*)(Y + ((size_t)bl * TT + pos) * DI + h * 64 + pc8) = pack8(yv);
      }
    }
    lds_barrier();
  }
}

__device__ __forceinline__ void phase_rw_gate(const Params& p, int j) {
  const int tid = opaque_tid(), h = tid >> 3;
  const int c0 = tid * 8;
  float lnw[8], lnb[8];
#pragma unroll
  for (int e = 0; e < 8; ++e) { lnw[e] = p.rw_lnw[j * DI + c0 + e]; lnb[e] = p.rw_lnb[j * DI + c0 + e]; }
  for (int tg = blockIdx.x; tg < NTG; tg += gridDim.x) {
    const size_t base = (size_t)tg * DI + c0;
    float yf[8], yb[8], v[8], z[8];
    unpack8(*(const uint4*)(p.YF + base), yf); unpack8(*(const uint4*)(p.YB + base), yb);
    unpack8(*(const uint4*)(p.V + base), v); unpack8(*(const uint4*)(p.Z + base), z);
    const float bon = p.BN[(size_t)tg * 32 + h] + p.BN[((size_t)NTG + tg) * 32 + h];
    float y[8], s = 0.f;
#pragma unroll
    for (int e = 0; e < 8; ++e) { y[e] = yf[e] + yb[e]; s += y[e]; }
    const float mu = red8(s) * (1.f / 64.f);
    float s2 = 0.f;
#pragma unroll
    for (int e = 0; e < 8; ++e) { y[e] -= mu; s2 += y[e] * y[e]; }
    const float rstd = rsqrtf(red8(s2) * (1.f / 64.f) + 64e-5f);
#pragma unroll
    for (int e = 0; e < 8; ++e) y[e] = (y[e] * rstd * lnw[e] + lnb[e] + bon * v[e]) * z[e];
    *(uint4*)(p.YF + base) = pack8(y);
  }
}

__device__ __forceinline__ void phase_out(const Params& p, const bf16_t* wo, char* smem) {
  for (int tile = blockIdx.x; tile < MT * 8; tile += gridDim.x) {
    const int mt = tile / 8, nt = tile % 8, m0 = mt * 128, n0 = nt * 128;
    const bf16_t* Bw = wo + (size_t)n0 * DI;
    gemm_tile<0>(p.YF, DI, nullptr, m0, DI, Bw, 128, smem,
                 [&](int row, int col, float* v) {
      float* o = p.O + (size_t)row * DM + n0 + col;
      *(float4*)o = make_float4(v[0], v[1], v[2], v[3]); *(float4*)(o + 4) = make_float4(v[4], v[5], v[6], v[7]); });
  }
}

__device__ __forceinline__ void phase_hg_proj(const Params& p, int j, char* smem) {
  const int layer = 2 * j + 1;
  for (int tile = blockIdx.x; tile < MT * 80; tile += gridDim.x) {
    const int mt = tile / 80, nt = tile % 80, m0 = mt * 128;
    const int seg = nt >> 4, n0 = (nt & 15) * 128;
    const bf16_t* Bw = g_wt + OFF_HWIN + ((size_t)j * 5 * DI + (size_t)seg * DI + n0) * DM;
    bf16_t* dst = seg == 0 ? p.R : (seg == 1 ? p.K : (seg == 2 ? p.WF : (seg == 3 ? p.V : p.Z)));
    if (seg == 0 || seg == 4) {
      gemm_tile<0>(p.H, DM, nullptr, m0, DM, Bw, 128, smem, [&](int row, int col, float* v) {
#pragma unroll
        for (int e = 0; e < 8; ++e) v[e] = siluf_(v[e]);
        *(uint4*)(dst + (size_t)row * DI + n0 + col) = pack8(v); });
    } else if (seg == 3) {
      gemm_tile<0>(p.H, DM, nullptr, m0, DM, Bw, 128, smem,
                   [&](int row, int col, float* v) { *(uint4*)(dst + (size_t)row * DI + n0 + col) = pack8(v); });
    } else {
      const float* lbp = p.LB + layer * DI + n0;
      gemm_tile<0>(p.H, DM, nullptr, m0, DM, Bw, 128, smem, [&](int row, int col, float* v) {
        const float4 l0 = *(const float4*)(lbp + col), l1 = *(const float4*)(lbp + col + 4);
        const float lb[8] = {l0.x, l0.y, l0.z, l0.w, l1.x, l1.y, l1.z, l1.w};
#pragma unroll
        for (int e = 0; e < 8; ++e) v[e] = __logf(lb[e] + (1.f - lb[e]) * sigmoidf_(v[e]));
        *(uint4*)(dst + (size_t)row * DI + n0 + col) = pack8(v); });
    }
  }
}

constexpr int HC = 32;
constexpr int QS = 136;
constexpr int SS = 40;
__device__ __forceinline__ void phase_hg_scan(const Params& p, int layer, char* smem) {
  bf16_t* qe = (bf16_t*)smem;
  bf16_t* ke = qe + HC * QS;
  bf16_t* kdT = ke + HC * QS;
  bf16_t* vT = kdT + 128 * SS;
  bf16_t* att = vT + 64 * SS;
  bf16_t* ST = att + HC * SS;
  float* dC = (float*)(ST + 64 * QS);
  const int tid = opaque_tid(), lane = tid & 63, w = tid >> 6;
  for (int unit = blockIdx.x; unit < GB * 64; unit += gridDim.x) {
    const int vs = unit & 1, dir = (unit >> 1) & 1, h = (unit >> 2) & 15, bl = unit >> 6;
    const bf16_t* FL = dir == 0 ? p.K : p.WF;
    bf16_t* Y = dir == 0 ? p.YF : p.YB;
    const int st = lane & 31, cg = w * 2 + (lane >> 5), kb = cg * 16, vb = cg * 8;
    f32x16 sacc[2];
#pragma unroll
    for (int r = 0; r < 16; ++r) { sacc[0][r] = 0.f; sacc[1][r] = 0.f; }
    __syncthreads();
    for (int idx = tid; idx < 64 * QS / 2; idx += 256) ((unsigned*)ST)[idx] = 0u;
    uint4 gq0, gq1, gf0, gf1, gvv;
    auto gload = [&](int chunk) {
      const int pos = scan_pos(dir, chunk * HC + st);
      const size_t base = ((size_t)bl * TT + pos) * DI + h * 128;
      gq0 = *(const uint4*)(p.R + base + kb); gq1 = *(const uint4*)(p.R + base + kb + 8);
      gf0 = *(const uint4*)(FL + base + kb); gf1 = *(const uint4*)(FL + base + kb + 8);
      gvv = *(const uint4*)(p.V + base + vs * 64 + vb);
    };
    gload(0);
    for (int chunk = 0; chunk < TT / HC; ++chunk) {
      float q[16], cum[16], one[16];
      {
        unpack8(gq0, q); unpack8(gq1, q + 8); unpack8(gf0, cum); unpack8(gf1, cum + 8);
#pragma unroll
        for (int e = 0; e < 16; ++e) {
          float c = cum[e];
          one[e] = 1.f - __expf(c);
          c += __int_as_float(__builtin_amdgcn_update_dpp(0, __float_as_int(c), 0x111, 0xf, 0xf, false));
          c += __int_as_float(__builtin_amdgcn_update_dpp(0, __float_as_int(c), 0x112, 0xf, 0xf, false));
          c += __int_as_float(__builtin_amdgcn_update_dpp(0, __float_as_int(c), 0x114, 0xf, 0xf, false));
          c += __int_as_float(__builtin_amdgcn_update_dpp(0, __float_as_int(c), 0x118, 0xf, 0xf, false));
          c += __int_as_float(__builtin_amdgcn_update_dpp(0, __float_as_int(c), 0x142, 0xa, 0xf, false));
          cum[e] = c;
        }
      }
      const uint4 vreg = gvv;
      lds_barrier();
      {
        float qo[16], ko[16];
#pragma unroll
        for (int e = 0; e < 16; ++e) {
          const float c31 = __int_as_float(__builtin_amdgcn_readlane(__float_as_int(cum[e]), 31));
          const float c63 = __int_as_float(__builtin_amdgcn_readlane(__float_as_int(cum[e]), 63));
          const float cC = (lane >> 5) ? c63 : c31;
          const float ec = __expf(fmaxf(cum[e], -80.f));
          const float inv = 1.f / ec;
          const float eC = __expf(cC);
          qo[e] = q[e] * ec;
          ko[e] = one[e] * inv;
          kdT[(kb + e) * SS + st] = f2bf(one[e] * inv * eC);
          if (st == 31) dC[kb + e] = eC;
        }
        *(uint4*)(qe + st * QS + kb) = pack8(qo); *(uint4*)(qe + st * QS + kb + 8) = pack8(qo + 8);
        *(uint4*)(ke + st * QS + kb) = pack8(ko); *(uint4*)(ke + st * QS + kb + 8) = pack8(ko + 8);
        const bf16_t* vp = (const bf16_t*)&vreg;
#pragma unroll
        for (int e = 0; e < 8; ++e) vT[(vb + e) * SS + st] = vp[e];
      }
      lds_barrier();
      if (chunk + 1 < TT / HC) gload(chunk + 1);
      {
        const int mi = w >> 1, ni = w & 1;
        f32x4 a4 = {0.f, 0.f, 0.f, 0.f};
#pragma unroll
        for (int kk = 0; kk < 4; ++kk) {
          const bf16x8 af = *(const bf16x8*)(qe + (mi * 16 + (lane & 15)) * QS + kk * 32 + (lane >> 4) * 8);
          const bf16x8 bf = *(const bf16x8*)(ke + (ni * 16 + (lane & 15)) * QS + kk * 32 + (lane >> 4) * 8);
          a4 = __builtin_amdgcn_mfma_f32_16x16x32_bf16(af, bf, a4, 0, 0, 0);
        }
        const int s = ni * 16 + (lane & 15);
#pragma unroll
        for (int r = 0; r < 4; ++r) {
          const int t = mi * 16 + (lane >> 4) * 4 + r;
          att[t * SS + s] = f2bf(s <= t ? a4[r] : 0.f);
        }
      }
      lds_barrier();
      {
#pragma unroll
        for (int mh = 0; mh < 2; ++mh) {
          f32x4 y4 = {0.f, 0.f, 0.f, 0.f};
          {
            const bf16x8 af = *(const bf16x8*)(att + (mh * 16 + (lane & 15)) * SS + (lane >> 4) * 8);
            const bf16x8 bf = *(const bf16x8*)(vT + (w * 16 + (lane & 15)) * SS + (lane >> 4) * 8);
            y4 = __builtin_amdgcn_mfma_f32_16x16x32_bf16(af, bf, y4, 0, 0, 0);
          }
#pragma unroll
          for (int kk = 0; kk < 4; ++kk) {
            const bf16x8 af = *(const bf16x8*)(qe + (mh * 16 + (lane & 15)) * QS + kk * 32 + (lane >> 4) * 8);
            const bf16x8 bf = *(const bf16x8*)(ST + (w * 16 + (lane & 15)) * QS + kk * 32 + (lane >> 4) * 8);
            y4 = __builtin_amdgcn_mfma_f32_16x16x32_bf16(af, bf, y4, 0, 0, 0);
          }
#pragma unroll
          for (int r = 0; r < 4; ++r) {
            const int t = mh * 16 + (lane >> 4) * 4 + r;
            const int pos = scan_pos(dir, chunk * HC + t);
            Y[((size_t)bl * TT + pos) * DI + h * 128 + vs * 64 + w * 16 + (lane & 15)] = f2bf(y4[r]);
          }
        }
      }
      lds_barrier();
      {
        float dk[16];
#pragma unroll
        for (int r = 0; r < 16; ++r) dk[r] = dC[w * 32 + (r & 3) + 8 * (r >> 2) + 4 * (lane >> 5)];
#pragma unroll
        for (int nt = 0; nt < 2; ++nt) {
#pragma unroll
          for (int r = 0; r < 16; ++r) sacc[nt][r] *= dk[r];
#pragma unroll
          for (int ks = 0; ks < 2; ++ks) {
            const bf16x8 af = *(const bf16x8*)(kdT + (w * 32 + (lane & 31)) * SS + ks * 16 + (lane >> 5) * 8);
            const bf16x8 bf = *(const bf16x8*)(vT + (nt * 32 + (lane & 31)) * SS + ks * 16 + (lane >> 5) * 8);
            sacc[nt] = __builtin_amdgcn_mfma_f32_32x32x16_bf16(af, bf, sacc[nt], 0, 0, 0);
          }
#pragma unroll
          for (int gq = 0; gq < 4; ++gq) {
            uint2 u;
            u.x = pack2(sacc[nt][gq * 4 + 0], sacc[nt][gq * 4 + 1]);
            u.y = pack2(sacc[nt][gq * 4 + 2], sacc[nt][gq * 4 + 3]);
            *(uint2*)(ST + (nt * 32 + (lane & 31)) * QS + w * 32 + gq * 8 + (lane >> 5) * 4) = u;
          }
        }
      }
    }
    lds_barrier();
  }
}

__device__ __forceinline__ void phase_hg_gate(const Params& p, int j) {
  const int tid = opaque_tid();
  const int c0 = tid * 8;
  float gn[8];
#pragma unroll
  for (int e = 0; e < 8; ++e) gn[e] = p.hg_gn[j * 128 + ((c0 + e) & 127)];
  for (int tg = blockIdx.x; tg < NTG; tg += gridDim.x) {
    const size_t base = (size_t)tg * DI + c0;
    float yf[8], yb[8], z[8];
    unpack8(*(const uint4*)(p.YF + base), yf); unpack8(*(const uint4*)(p.YB + base), yb);
    unpack8(*(const uint4*)(p.Z + base), z);
    float y[8], s2 = 0.f;
#pragma unroll
    for (int e = 0; e < 8; ++e) { y[e] = yf[e] + yb[e]; s2 += y[e] * y[e]; }
    const float rstd = rsqrtf(red16(s2) * (1.f / 128.f) + EPS);
#pragma unroll
    for (int e = 0; e < 8; ++e) y[e] = y[e] * rstd * gn[e] * z[e];
    *(uint4*)(p.YF + base) = pack8(y);
  }
}

__global__ void __launch_bounds__(256, 2) fwd_megakernel(Params p) {
  cg::grid_group grid = cg::this_grid();
  __shared__ __attribute__((aligned(16))) char smem[78 * 1024];
  __shared__ uint4 xb_words;
  if (threadIdx.x == 0) xb_words = make_uint4(0u, 0u, 0u, 0u);
  __syncthreads();
  XcdBarrier xb = xcd_barrier_post(p.bar, (volatile LAS unsigned*)&xb_words);
  phase_mod(p, smem);
  phase_wconv(p, smem);
  grid.sync();
  for (int g = 0; g < NG; ++g) {
    for (int layer = 0; layer < 4; ++layer) {
      phase_resnorm(p, g, layer - 1, layer);
      xcd_barrier(xb);
      const int j = layer >> 1;
      if ((layer & 1) == 0) {
        phase_rw_proj(p, j, smem, 0, blockIdx.x, gridDim.x);
        xcd_barrier(xb);
        if (j == 1) { phase_rw_lr2(p, j, smem); xcd_barrier(xb); }
        if (gridDim.x >= 2 * GB * 64) {
          if (blockIdx.x < GB * 64) phase_rw_scan(p, j, smem);
          else phase_rw_proj(p, j, smem, 1, blockIdx.x - GB * 64, gridDim.x - GB * 64);
        } else {
          phase_rw_scan(p, j, smem);
          phase_rw_proj(p, j, smem, 1, blockIdx.x, gridDim.x);
        }
        xcd_barrier(xb);
        phase_rw_gate(p, j);
        xcd_barrier(xb);
        phase_out(p, g_wt + OFF_RWO + (size_t)j * DM * DI, smem);
        xcd_barrier(xb);
      } else {
        phase_hg_proj(p, j, smem);
        xcd_barrier(xb);
        phase_hg_scan(p, layer, smem);
        xcd_barrier(xb);
        phase_hg_gate(p, j);
        xcd_barrier(xb);
        phase_out(p, g_wt + OFF_HWO + (size_t)j * DM * DI, smem);
        xcd_barrier(xb);
      }
    }
    phase_resnorm(p, g, 3, -1);
    xcd_barrier(xb);
  }
}

extern "C" void kernel_launch(void* const* d_in, const int* in_sizes, int n_in, void* d_out, int out_size, void* d_ws,
                              size_t ws_size, hipStream_t stream) {
  static int grid_blocks = 0;
  if (!grid_blocks) {
    int dev = 0, cus = 0, per_cu = 0;
    hipGetDevice(&dev);
    hipDeviceGetAttribute(&cus, hipDeviceAttributeMultiprocessorCount, dev);
    hipOccupancyMaxActiveBlocksPerMultiprocessor(&per_cu, fwd_megakernel, 256, 0);
    if (per_cu > 2) per_cu = 2;
    grid_blocks = cus * per_cu;
  }
  Params p{};
  const float** fp = (const float**)&p;
  for (int i = 0; i < 29; ++i) fp[i] = (const float*)d_in[i];
  p.out = (float*)d_out;
  char* w = (char*)d_ws;
  size_t off = 0;
  auto take = [&](size_t bytes) { char* r = w + off; off += (bytes + 255) & ~(size_t)255; return r; };
  const size_t DIW = (size_t)NTG * DI * 2;
  p.R = (bf16_t*)take(DIW); p.K = (bf16_t*)take(DIW); p.V = (bf16_t*)take(DIW); p.Z = (bf16_t*)take(DIW);
  p.WF = (bf16_t*)take(DIW); p.YF = (bf16_t*)take(DIW); p.YB = (bf16_t*)take(DIW);
  p.VF = p.YF;
  p.H = p.YB;
  p.HR = p.WF; p.HR0 = p.WF + (size_t)NTG * DM;
  p.LRW = (bf16_t*)take((size_t)NTG * 128 * 2); p.LRA = (bf16_t*)take((size_t)NTG * 128 * 2);
  p.LRV = (bf16_t*)take((size_t)NTG * 32 * 2);
  p.O = (float*)p.R;
  p.BN = (float*)take((size_t)2 * NTG * 32 * 4);
  p.CTXB = (float*)take((size_t)NB * CTX * DM * 4);
  p.MODV = (float*)take((size_t)4 * 9 * 3 * DM * 4);
  p.LB = (float*)take((size_t)4 * DI * 4);
  p.bar = (unsigned*)take((size_t)XCD_BAR_WORDS * 4);
  if (off > ws_size) { fprintf(stderr, "workspace too small: need %zu have %zu\n", off, ws_size); return; }
  hipMemsetAsync(p.bar, 0, (size_t)XCD_BAR_WORDS * 4, stream);
  void* args[] = {&p};
  hipError_t e = hipLaunchCooperativeKernel((void*)fwd_megakernel, dim3(grid_blocks), dim3(256), args, 0, stream);
  if (e != hipSuccess) fprintf(stderr, "cooperative launch failed: %s (grid %d)\n", hipGetErrorString(e), grid_blocks);
}
```

```cpp
#include <hip/hip_runtime.h>
#include <hip/hip_cooperative_groups.h>
#include <cstdio>
#include <cstdint>
namespace cg = cooperative_groups;

typedef unsigned short bf16_t;
using bf16x8 = __attribute__((ext_vector_type(8))) short;
using f32x16 = __attribute__((ext_vector_type(16))) float;
using f32x4 = __attribute__((ext_vector_type(4))) float;
using f2_t = __attribute__((ext_vector_type(2))) float;

constexpr int NB = 8, SEQ = 4096, CTX = 256, TT = 4352, DM = 1024, DI = 2048;
constexpr int GB = 4, NG = NB / GB, NTG = GB * TT;
constexpr int MT = NTG / 128;
constexpr float EPS = 1e-6f;

constexpr size_t OFF_PROJ = 0;
constexpr size_t OFF_RWO = OFF_PROJ + (size_t)2 * 4 * DI * DM;
constexpr size_t OFF_W1 = OFF_RWO + (size_t)2 * DM * DI;
constexpr size_t OFF_A1 = OFF_W1 + (size_t)2 * 128 * DM;
constexpr size_t OFF_V1 = OFF_A1 + (size_t)2 * 128 * DM;
constexpr size_t OFF_V2 = OFF_V1 + (size_t)32 * DM;
constexpr size_t OFF_HWIN = OFF_V2 + (size_t)DI * 32;
constexpr size_t OFF_HWO = OFF_HWIN + (size_t)2 * 5 * DI * DM;
constexpr size_t OFF_W2 = OFF_HWO + (size_t)2 * DM * DI;
constexpr size_t OFF_A2 = OFF_W2 + (size_t)4 * DI * 64;
constexpr size_t WT_TOTAL = OFF_A2 + (size_t)4 * DI * 64;
__device__ bf16_t g_wt[WT_TOTAL];

struct Params {
  const float *x, *c, *ctx, *c_ctx, *mod_w, *mod_b, *pre_g, *post_g, *rw_mix, *rw_proj, *rw_wo, *rw_w0, *rw_w1,
      *rw_w2, *rw_a0, *rw_a1, *rw_a2, *rw_v0, *rw_v1, *rw_v2, *rw_kk, *rw_ka, *rw_rk, *rw_lnw, *rw_lnb, *hg_win,
      *hg_wo, *hg_gn, *hg_lb;
  float* out;
  bf16_t *R, *K, *V, *Z, *WF, *YF, *YB, *VF, *H, *HR, *HR0, *LRW, *LRA, *LRV;
  float *O, *BN, *CTXB, *MODV, *LB;
  unsigned* bar;
};

typedef __bf16 hwbf2_t __attribute__((ext_vector_type(2)));
typedef float hwf2_t __attribute__((ext_vector_type(2)));
__device__ __forceinline__ unsigned pack2(float a, float b) {
  hwf2_t f = {a, b};
  hwbf2_t h = __builtin_convertvector(f, hwbf2_t);
  return __builtin_bit_cast(unsigned, h);
}
__device__ __forceinline__ bf16_t f2bf(float f) { return (bf16_t)(pack2(f, f) & 0xffffu); }
__device__ __forceinline__ float bf2f(bf16_t h) { return __uint_as_float(((unsigned)h) << 16); }
typedef _Float16 h2_t __attribute__((ext_vector_type(2)));
using f16x8 = __attribute__((ext_vector_type(8))) _Float16;
__device__ __forceinline__ unsigned pack2h(float a, float b) {
  h2_t h = {(_Float16)a, (_Float16)b};
  return __builtin_bit_cast(unsigned, h);
}
__device__ __forceinline__ uint4 pack8h(const float* f) {
  uint4 u; u.x = pack2h(f[0], f[1]); u.y = pack2h(f[2], f[3]); u.z = pack2h(f[4], f[5]); u.w = pack2h(f[6], f[7]);
  return u;
}
__device__ __forceinline__ unsigned mixh2(unsigned h, unsigned n, unsigned m) {
  const h2_t hv = __builtin_bit_cast(h2_t, h), nv = __builtin_bit_cast(h2_t, n), mv = __builtin_bit_cast(h2_t, m);
  const h2_t r = hv + (nv - hv) * mv;
  return __builtin_bit_cast(unsigned, r);
}
__device__ __forceinline__ float lo2f(unsigned u) { return __uint_as_float(u << 16); }
__device__ __forceinline__ float hi2f(unsigned u) { return __uint_as_float(u & 0xffff0000u); }
__device__ __forceinline__ float rcpf_(float x) { return __builtin_amdgcn_rcpf(x); }
__device__ __forceinline__ float sigmoidf_(float x) { return rcpf_(1.f + __expf(-x)); }
__device__ __forceinline__ float siluf_(float x) { return x * rcpf_(1.f + __expf(-x)); }
__device__ __forceinline__ float tanhf_(float x) { return 1.f - 2.f * rcpf_(1.f + __expf(2.f * x)); }

__device__ __forceinline__ void lds_barrier() { asm volatile("s_waitcnt lgkmcnt(0)\n\ts_barrier" ::: "memory"); }

__device__ __forceinline__ int opaque_tid() { int t = threadIdx.x; asm volatile("" : "+v"(t)); return t; }

template <int CTRL>
__device__ __forceinline__ float dppf(float v) {
  return __int_as_float(__builtin_amdgcn_update_dpp(0, __float_as_int(v), CTRL, 0xf, 0xf, true));
}
__device__ __forceinline__ float red4(float v) { v += dppf<0xB1>(v); v += dppf<0x4E>(v); return v; }
__device__ __forceinline__ float red8(float v) { v = red4(v); v += dppf<0x141>(v); return v; }
__device__ __forceinline__ float red16(float v) { v = red8(v); v += dppf<0x140>(v); return v; }
__device__ __forceinline__ float red64(float v) {
  v = red16(v);
  v += __shfl_xor(v, 16);
  v += __shfl_xor(v, 32);
  return v;
}

__device__ __forceinline__ void unpack8(const uint4& u, float* f) {
  f[0] = lo2f(u.x); f[1] = hi2f(u.x); f[2] = lo2f(u.y); f[3] = hi2f(u.y);
  f[4] = lo2f(u.z); f[5] = hi2f(u.z); f[6] = lo2f(u.w); f[7] = hi2f(u.w);
}
__device__ __forceinline__ uint4 pack8(const float* f) {
  uint4 u; u.x = pack2(f[0], f[1]); u.y = pack2(f[2], f[3]); u.z = pack2(f[4], f[5]); u.w = pack2(f[6], f[7]);
  return u;
}


#define XB_TMO      128
#define XB_XCNT(j)  (256  + 64 * (j))
#define XB_XSUB(j)  (1280 + 64 * (j))
#define XB_XGEN(j)  (2304 + 64 * (j))
#define XB_TOP      3328
#define XB_TOPGEN   3392
#define XCD_BAR_WORDS 3456
#define XB_SPIN_CAP (1u << 23)
#define LAS __attribute__((address_space(3)))
__device__ __forceinline__ unsigned xb_ld(unsigned* p)              { return __hip_atomic_load(p, __ATOMIC_RELAXED, __HIP_MEMORY_SCOPE_AGENT); }
__device__ __forceinline__ unsigned xb_add(unsigned* p, unsigned v) { return __hip_atomic_fetch_add(p, v, __ATOMIC_RELAXED, __HIP_MEMORY_SCOPE_AGENT); }
__device__ __forceinline__ unsigned xb_xcc_id() { return (unsigned)__builtin_amdgcn_s_getreg((3 << 11) | 20) & 0xFu; }
#define XB_SPIN(cond, bar) do { unsigned _sp = 0; while (cond) { __builtin_amdgcn_s_sleep(1); \
    if ((++_sp & 255u) == 0u) { if (xb_ld(&(bar)[XB_TMO])) break; if (_sp > XB_SPIN_CAP) { atomicAdd(&(bar)[XB_TMO], 1u); break; } } } } while (0)
struct XcdBarrier { unsigned* bar; unsigned x; volatile LAS unsigned* st; };
__device__ __forceinline__ XcdBarrier xcd_barrier_post(unsigned* bar, volatile LAS unsigned* st) {
  XcdBarrier b; b.bar = bar; b.x = xb_xcc_id(); b.st = st;
  if (threadIdx.x == 0) (void)xb_add(&bar[XB_XCNT(b.x)], 1u);
  return b;
}
__device__ __forceinline__ void xcd_barrier_complete(unsigned* bar, unsigned x, unsigned& nloc, unsigned& nx) {
  const unsigned G = gridDim.x * gridDim.y * gridDim.z;
  unsigned sum, cnt, mine, sp = 0u;
  for (;;) {
    sum = 0u; cnt = 0u; mine = 0u;
#pragma unroll
    for (unsigned j = 0; j < 16; ++j) { const unsigned c = xb_ld(&bar[XB_XCNT(j)]); sum += c; cnt += (c > 0u) ? 1u : 0u; mine = (j == x) ? c : mine; }
    if (sum == G) break;
    __builtin_amdgcn_s_sleep(1);
    if ((++sp & 255u) == 0u) { if (xb_ld(&bar[XB_TMO])) break; if (sp > XB_SPIN_CAP) { atomicAdd(&bar[XB_TMO], 1u); break; } }
  }
  nloc = mine > 0u ? mine : 1u; nx = cnt > 0u ? cnt : 1u;
}
__device__ __forceinline__ void xcd_barrier(const XcdBarrier& b) {
  asm volatile("s_waitcnt vmcnt(0)" ::: "memory");
  __syncthreads();
  if (threadIdx.x == 0) {
    unsigned* bar = b.bar;
    __builtin_amdgcn_s_waitcnt(0);
    unsigned nloc = b.st[0], nx = b.st[1];
    if (nloc == 0u) { xcd_barrier_complete(bar, b.x, nloc, nx); b.st[0] = nloc; b.st[1] = nx; }
    const unsigned old = xb_add(&bar[XB_XSUB(b.x)], 1u);
    const unsigned gen = old / nloc;
    if (old + 1u == (gen + 1u) * nloc) {
      __builtin_amdgcn_fence(__ATOMIC_RELEASE, "agent");
      asm volatile("s_waitcnt vmcnt(0)" ::: "memory");
      const unsigned og = xb_add(&bar[XB_TOP], 1u);
      const unsigned tg = og / nx;
      if (og + 1u == (tg + 1u) * nx) xb_add(&bar[XB_TOPGEN], 1u);
      else XB_SPIN(xb_ld(&bar[XB_TOPGEN]) == tg, bar);
      __builtin_amdgcn_fence(__ATOMIC_ACQUIRE, "agent");
      xb_add(&bar[XB_XGEN(b.x)], 1u);
      asm volatile("s_waitcnt vmcnt(0)" ::: "memory");
    } else {
      XB_SPIN(xb_ld(&bar[XB_XGEN(b.x)]) == gen, bar);
      __builtin_amdgcn_fence(__ATOMIC_ACQUIRE, "agent");
      asm volatile("s_waitcnt vmcnt(0)" ::: "memory");
    }
  }
  __syncthreads();
}

__device__ __forceinline__ const float* row_in(const Params& p, int b, int t) {
  return t < CTX ? p.ctx + ((size_t)b * CTX + t) * DM : p.x + ((size_t)b * SEQ + (t - CTX)) * DM;
}
__device__ __forceinline__ float* row_cur(const Params& p, int b, int t) {
  return t < CTX ? p.CTXB + ((size_t)b * CTX + t) * DM : p.out + ((size_t)b * SEQ + (t - CTX)) * DM;
}

__device__ __forceinline__ void phase_mod(const Params& p, char* smem) {
  float* red = (float*)smem;
  const int tid = opaque_tid(), cl = tid & 63, kp = tid >> 6;
  for (int task = blockIdx.x; task < 4 * 48; task += gridDim.x) {
    const int l = task / 48, col = (task % 48) * 64 + cl;
    float acc[9];
#pragma unroll
    for (int r = 0; r < 9; ++r) acc[r] = 0.f;
    const float* W = p.mod_w + (size_t)l * DM * 3 * DM + col;
    for (int k = kp * 256; k < kp * 256 + 256; ++k) {
      const float w = W[(size_t)k * 3 * DM];
#pragma unroll
      for (int r = 0; r < 9; ++r) {
        const float cv = r < 8 ? p.c[r * DM + k] : p.c_ctx[k];
        acc[r] += siluf_(cv) * w;
      }
    }
    __syncthreads();
#pragma unroll
    for (int r = 0; r < 9; ++r) red[(kp * 9 + r) * 64 + cl] = acc[r];
    __syncthreads();
    for (int idx = tid; idx < 9 * 64; idx += 256) {
      const int r = idx >> 6, c2 = idx & 63;
      float s = 0.f;
      for (int q = 0; q < 4; ++q) s += red[(q * 9 + r) * 64 + c2];
      const int cc = (task % 48) * 64 + c2;
      p.MODV[((size_t)l * 9 + r) * 3 * DM + cc] = s + p.mod_b[l * 3 * DM + cc];
    }
  }
  for (int cidx = blockIdx.x * 256 + tid; cidx < DI; cidx += gridDim.x * 256) {
    float v[4], m = -1e30f;
    for (int l = 0; l < 4; ++l) { v[l] = p.hg_lb[l * DI + cidx]; m = fmaxf(m, v[l]); }
    float s = 0.f;
    for (int l = 0; l < 4; ++l) { v[l] = __expf(v[l] - m); s += v[l]; }
    float cum = 0.f;
    for (int l = 0; l < 4; ++l) { cum += v[l] / s; p.LB[l * DI + cidx] = cum - v[0] / s; }
  }
}

__device__ __forceinline__ void conv_matrix(const float* __restrict__ src, int K, int N, bf16_t* __restrict__ dst, char* smem, bool f16out = false) {
  float* ts = (float*)smem;
  const int tid = opaque_tid();
  const int ntn = N / 32, ntile = (K / 64) * ntn;
  for (int tile = blockIdx.x; tile < ntile; tile += gridDim.x) {
    const int k0 = (tile / ntn) * 64, n0 = (tile % ntn) * 32;
    __syncthreads();
#pragma unroll
    for (int i = 0; i < 2; ++i) {
      const int k = (tid >> 3) + 32 * i, n4 = (tid & 7) * 4;
      const float4 v = *(const float4*)(src + (size_t)(k0 + k) * N + n0 + n4);
      ts[k * 33 + n4 + 0] = v.x; ts[k * 33 + n4 + 1] = v.y; ts[k * 33 + n4 + 2] = v.z; ts[k * 33 + n4 + 3] = v.w;
    }
    __syncthreads();
    const int n = tid >> 3, k8 = (tid & 7) * 8;
    float f[8];
#pragma unroll
    for (int e = 0; e < 8; ++e) f[e] = ts[(k8 + e) * 33 + n];
    *(uint4*)(dst + (size_t)(n0 + n) * K + k0 + k8) = f16out ? pack8h(f) : pack8(f);
  }
}
__device__ __forceinline__ void phase_wconv(const Params& p, char* smem) {
  for (int m = 0; m < 8; ++m) conv_matrix(p.rw_proj + (size_t)m * DM * DI, DM, DI, g_wt + OFF_PROJ + (size_t)m * DI * DM, smem, true);
  for (int j = 0; j < 2; ++j) conv_matrix(p.rw_wo + (size_t)j * DI * DM, DI, DM, g_wt + OFF_RWO + (size_t)j * DM * DI, smem);
  for (int m = 0; m < 4; ++m) {
    conv_matrix(p.rw_w1 + (size_t)m * DM * 64, DM, 64, g_wt + OFF_W1 + (size_t)m * 64 * DM, smem, true);
    conv_matrix(p.rw_a1 + (size_t)m * DM * 64, DM, 64, g_wt + OFF_A1 + (size_t)m * 64 * DM, smem, true);
  }
  conv_matrix(p.rw_v1, DM, 32, g_wt + OFF_V1, smem, true);
  for (int m = 0; m < 4; ++m) {
    conv_matrix(p.rw_w2 + (size_t)m * 64 * DI, 64, DI, g_wt + OFF_W2 + (size_t)m * DI * 64, smem);
    conv_matrix(p.rw_a2 + (size_t)m * 64 * DI, 64, DI, g_wt + OFF_A2 + (size_t)m * DI * 64, smem);
  }
  for (int j = 0; j < 2; ++j) conv_matrix(p.hg_win + (size_t)j * DM * 5 * DI, DM, 5 * DI, g_wt + OFF_HWIN + (size_t)j * 5 * DI * DM, smem);
  for (int j = 0; j < 2; ++j) conv_matrix(p.hg_wo + (size_t)j * DI * DM, DI, DM, g_wt + OFF_HWO + (size_t)j * DM * DI, smem);
  for (int idx = blockIdx.x * 256 + opaque_tid(); idx < DI * 32; idx += gridDim.x * 256) {
    const int n = idx >> 5, k = idx & 31;
    g_wt[OFF_V2 + idx] = f2bf(p.rw_v2[(size_t)k * DI + n]);
  }
}

__device__ __forceinline__ void phase_resnorm(const Params& p, int g, int lu, int ln) {
  const int tid = opaque_tid();
  const int lane = tid & 63;
  const int wv = blockIdx.x * 4 + (tid >> 6), nw = gridDim.x * 4;
  for (int tg = wv; tg < NTG; tg += nw) {
    const int bl = tg / TT, t = tg % TT, b = g * GB + bl;
    const bool isctx = t < CTX;
    const int mrow = isctx ? 8 : b;
    float xv[16];
    const float* src = (lu <= 0) ? row_in(p, b, t) : row_cur(p, b, t);
#pragma unroll
    for (int j = 0; j < 4; ++j) {
      const float4 v4 = *(const float4*)(src + j * 256 + lane * 4);
      xv[j * 4 + 0] = v4.x; xv[j * 4 + 1] = v4.y; xv[j * 4 + 2] = v4.z; xv[j * 4 + 3] = v4.w;
    }
    if (lu >= 0 && !(isctx && lu == 3)) {
      float ov[16], ss = 0.f;
      const float* orow = p.O + (size_t)tg * DM;
#pragma unroll
      for (int j = 0; j < 4; ++j) {
        const float4 v4 = *(const float4*)(orow + j * 256 + lane * 4);
        ov[j * 4 + 0] = v4.x; ov[j * 4 + 1] = v4.y; ov[j * 4 + 2] = v4.z; ov[j * 4 + 3] = v4.w;
      }
#pragma unroll
      for (int e = 0; e < 16; ++e) ss += ov[e] * ov[e];
      ss = red64(ss);
      const float rstd = rsqrtf(ss * (1.f / DM) + EPS);
      const float* gate = p.MODV + ((size_t)lu * 9 + mrow) * 3 * DM + 2 * DM;
      const float* pg = p.post_g + lu * DM;
      float* dst = row_cur(p, b, t);
#pragma unroll
      for (int j = 0; j < 4; ++j) {
        const int cc = j * 256 + lane * 4;
        const float4 g4 = *(const float4*)(gate + cc);
        const float4 p4 = *(const float4*)(pg + cc);
        xv[j * 4 + 0] += g4.x * (ov[j * 4 + 0] * rstd * p4.x);
        xv[j * 4 + 1] += g4.y * (ov[j * 4 + 1] * rstd * p4.y);
        xv[j * 4 + 2] += g4.z * (ov[j * 4 + 2] * rstd * p4.z);
        xv[j * 4 + 3] += g4.w * (ov[j * 4 + 3] * rstd * p4.w);
        *(float4*)(dst + cc) = make_float4(xv[j * 4 + 0], xv[j * 4 + 1], xv[j * 4 + 2], xv[j * 4 + 3]);
      }
    }
    if (ln >= 0) {
      for (int pass = 0; pass < (ln == 2 ? 2 : 1); ++pass) {
        const int lp = pass == 0 ? ln : 0;
        bf16_t* hdst = (pass == 0 ? ((ln & 1) == 0 ? p.HR : p.H) : p.HR0) + (size_t)tg * DM;
        if (pass == 1) {
          const float* s0 = row_in(p, b, t);
#pragma unroll
          for (int j = 0; j < 4; ++j) {
            const float4 v4 = *(const float4*)(s0 + j * 256 + lane * 4);
            xv[j * 4 + 0] = v4.x; xv[j * 4 + 1] = v4.y; xv[j * 4 + 2] = v4.z; xv[j * 4 + 3] = v4.w;
          }
        }
        float ss = 0.f;
#pragma unroll
        for (int e = 0; e < 16; ++e) ss += xv[e] * xv[e];
        ss = red64(ss);
        const float rstd = rsqrtf(ss * (1.f / DM) + EPS);
        const float* mv = p.MODV + ((size_t)lp * 9 + mrow) * 3 * DM;
        const float* pg = p.pre_g + lp * DM;
#pragma unroll
        for (int j = 0; j < 4; ++j) {
          const int cc = j * 256 + lane * 4;
          const float4 sh = *(const float4*)(mv + cc);
          const float4 sc = *(const float4*)(mv + DM + cc);
          const float4 p4 = *(const float4*)(pg + cc);
          const float h0 = xv[j * 4 + 0] * rstd * p4.x * (1.f + sc.x) + sh.x;
          const float h1 = xv[j * 4 + 1] * rstd * p4.y * (1.f + sc.y) + sh.y;
          const float h2 = xv[j * 4 + 2] * rstd * p4.z * (1.f + sc.z) + sh.z;
          const float h3 = xv[j * 4 + 3] * rstd * p4.w * (1.f + sc.w) + sh.w;
          uint2 u;
          if ((ln & 1) == 0) {
            const float L = 60000.f;
            u.x = pack2h(fminf(fmaxf(h0, -L), L), fminf(fmaxf(h1, -L), L));
            u.y = pack2h(fminf(fmaxf(h2, -L), L), fminf(fmaxf(h3, -L), L));
          } else {
            u.x = pack2(h0, h1); u.y = pack2(h2, h3);
          }
          *(uint2*)(hdst + cc) = u;
        }
      }
    }
  }
}

constexpr int LDK = 72;
constexpr int TM = 128;

template <int AMODE, class Epi>
__device__ __forceinline__ void gemm_tile(const bf16_t* __restrict__ A, int lda, const float* __restrict__ mix, int m0,
                                          int K, const bf16_t* __restrict__ Bt, int nvalid, char* smem, Epi epi) {
  bf16_t* As = (bf16_t*)smem;
  bf16_t* Bs = As + 2 * TM * LDK;
  float* mixs = (float*)(Bs + 2 * 128 * LDK);
  const int tid = opaque_tid(), lane = tid & 63, w = tid >> 6, wm = w >> 1, wn = w & 1;
  const int lr = lane >> 3, ch = (lane & 7) * 8;
  const int row0 = w * 32 + lr;
  const bf16_t* Ap = A + (size_t)(m0 + row0) * lda + ch;
  const bf16_t* Bp = Bt + (size_t)row0 * K + ch;
  const size_t astep = (size_t)8 * lda, bstep = (size_t)8 * K;
  const int KT = (K + 63) >> 6;
  const int tbase = m0 % TT;
  const bool isctx = tbase < CTX;
  unsigned vmask = 0;
  if (AMODE == 1) {
#pragma unroll
    for (int i = 0; i < 4; ++i) {
      const int t = tbase + row0 + i * 8;
      unsigned m;
      if (isctx) {
        m = (t >= 1 ? 3u : 0u) | (t + 1 < CTX ? 12u : 0u);
      } else {
        const int tl = t - CTX, row = tl >> 6, col = tl & 63;
        m = (col > 0 ? 1u : 0u) | (col < 63 ? 2u : 0u) | (row > 0 ? 4u : 0u) | (row < 63 ? 8u : 0u);
      }
      vmask |= m << (4 * i);
    }
  }

  __syncthreads();
  if (AMODE == 1) {
    const float4 m4 = *(const float4*)(mix + tid * 4);
    ((uint2*)mixs)[tid] = make_uint2(pack2h(m4.x, m4.y), pack2h(m4.z, m4.w));
  }

  f32x16 acc[2][2];
#pragma unroll
  for (int i = 0; i < 2; ++i)
#pragma unroll
    for (int j = 0; j < 2; ++j)
#pragma unroll
      for (int r = 0; r < 16; ++r) acc[i][j][r] = 0.f;

  uint4 a0, a1, a2, a3, n0, n1, n2, n3, b0, b1, b2, b3;
  auto load_regs = [&](int kt) {
    const int k0 = kt * 64;
    const uint4 z4 = make_uint4(0, 0, 0, 0);
    const bool kval = (k0 + ch) < K;
    const bf16_t* ap = Ap + k0;
    const bf16_t* bp = Bp + k0;
    a0 = z4; if (kval) a0 = *(const uint4*)(ap + 0 * astep);
    a1 = z4; if (kval) a1 = *(const uint4*)(ap + 1 * astep);
    a2 = z4; if (kval) a2 = *(const uint4*)(ap + 2 * astep);
    a3 = z4; if (kval) a3 = *(const uint4*)(ap + 3 * astep);
    b0 = z4; if (kval && (row0 + 0) < nvalid) b0 = *(const uint4*)(bp + 0 * bstep);
    b1 = z4; if (kval && (row0 + 8) < nvalid) b1 = *(const uint4*)(bp + 1 * bstep);
    b2 = z4; if (kval && (row0 + 16) < nvalid) b2 = *(const uint4*)(bp + 2 * bstep);
    b3 = z4; if (kval && (row0 + 24) < nvalid) b3 = *(const uint4*)(bp + 3 * bstep);
    if (AMODE == 1) {
      const int q = k0 >> 8;
      const int nb = isctx ? (q < 2 ? -1 : 1) : (q == 0 ? -1 : (q == 1 ? 1 : (q == 2 ? -64 : 64)));
      const bf16_t* np = ap + (ptrdiff_t)nb * lda;
      const unsigned vm = vmask >> q;
      n0 = z4; if ((vm >> 0) & 1u) n0 = *(const uint4*)(np + 0 * astep);
      n1 = z4; if ((vm >> 4) & 1u) n1 = *(const uint4*)(np + 1 * astep);
      n2 = z4; if ((vm >> 8) & 1u) n2 = *(const uint4*)(np + 2 * astep);
      n3 = z4; if ((vm >> 12) & 1u) n3 = *(const uint4*)(np + 3 * astep);
    }
  };
  auto mix8 = [&](const uint4& hv, const uint4& nv, const uint4& mv) -> uint4 {
    uint4 o;
    o.x = mixh2(hv.x, nv.x, mv.x); o.y = mixh2(hv.y, nv.y, mv.y); o.z = mixh2(hv.z, nv.z, mv.z); o.w = mixh2(hv.w, nv.w, mv.w);
    return o;
  };
  auto store_lds = [&](int kt, int buf) {
    bf16_t* ad = As + (buf * TM + row0) * LDK + ch;
    bf16_t* bd = Bs + (buf * 128 + row0) * LDK + ch;
    if (AMODE == 1) {
      const uint4 mv = *(const uint4*)((const bf16_t*)mixs + kt * 64 + ch);
      *(uint4*)(ad + 0 * LDK) = mix8(a0, n0, mv);
      *(uint4*)(ad + 8 * LDK) = mix8(a1, n1, mv);
      *(uint4*)(ad + 16 * LDK) = mix8(a2, n2, mv);
      *(uint4*)(ad + 24 * LDK) = mix8(a3, n3, mv);
    } else {
      *(uint4*)(ad + 0 * LDK) = a0;
      *(uint4*)(ad + 8 * LDK) = a1;
      *(uint4*)(ad + 16 * LDK) = a2;
      *(uint4*)(ad + 24 * LDK) = a3;
    }
    *(uint4*)(bd + 0 * LDK) = b0;
    *(uint4*)(bd + 8 * LDK) = b1;
    *(uint4*)(bd + 16 * LDK) = b2;
    *(uint4*)(bd + 24 * LDK) = b3;
  };
  auto compute = [&](int buf) {
    const bf16_t* ab = As + (buf * TM + wm * 64 + (lane & 31)) * LDK + (lane >> 5) * 8;
    const bf16_t* bb = Bs + (buf * 128 + wn * 64 + (lane & 31)) * LDK + (lane >> 5) * 8;
#pragma unroll
    for (int kk = 0; kk < 4; ++kk) {
      const bf16x8 af0 = *(const bf16x8*)(ab + kk * 16), af1 = *(const bf16x8*)(ab + 32 * LDK + kk * 16);
      const bf16x8 bf0 = *(const bf16x8*)(bb + kk * 16), bf1 = *(const bf16x8*)(bb + 32 * LDK + kk * 16);
      if (AMODE == 1) {
        const f16x8 ha0 = __builtin_bit_cast(f16x8, af0), ha1 = __builtin_bit_cast(f16x8, af1);
        const f16x8 hb0 = __builtin_bit_cast(f16x8, bf0), hb1 = __builtin_bit_cast(f16x8, bf1);
        acc[0][0] = __builtin_amdgcn_mfma_f32_32x32x16_f16(ha0, hb0, acc[0][0], 0, 0, 0);
        acc[0][1] = __builtin_amdgcn_mfma_f32_32x32x16_f16(ha0, hb1, acc[0][1], 0, 0, 0);
        acc[1][0] = __builtin_amdgcn_mfma_f32_32x32x16_f16(ha1, hb0, acc[1][0], 0, 0, 0);
        acc[1][1] = __builtin_amdgcn_mfma_f32_32x32x16_f16(ha1, hb1, acc[1][1], 0, 0, 0);
      } else {
        acc[0][0] = __builtin_amdgcn_mfma_f32_32x32x16_bf16(af0, bf0, acc[0][0], 0, 0, 0);
        acc[0][1] = __builtin_amdgcn_mfma_f32_32x32x16_bf16(af0, bf1, acc[0][1], 0, 0, 0);
        acc[1][0] = __builtin_amdgcn_mfma_f32_32x32x16_bf16(af1, bf0, acc[1][0], 0, 0, 0);
        acc[1][1] = __builtin_amdgcn_mfma_f32_32x32x16_bf16(af1, bf1, acc[1][1], 0, 0, 0);
      }
    }
  };
  load_regs(0);
  lds_barrier();
  store_lds(0, 0);
  if (KT > 1) load_regs(1);
  lds_barrier();
  for (int kt = 0; kt < KT; ++kt) {
    if (kt + 1 < KT) store_lds(kt + 1, (kt + 1) & 1);
    if (kt + 2 < KT) load_regs(kt + 2);
    compute(kt & 1);
    lds_barrier();
  }
  float* Cs = (float*)smem;
#pragma unroll
  for (int i = 0; i < 2; ++i)
#pragma unroll
    for (int j = 0; j < 2; ++j)
#pragma unroll
      for (int r = 0; r < 16; ++r)
        Cs[(wm * 64 + i * 32 + (r & 3) + 8 * (r >> 2) + 4 * (lane >> 5)) * 132 + wn * 64 + j * 32 + (lane & 31)] = acc[i][j][r];
  lds_barrier();
#pragma unroll 2
  for (int it = 0; it < 8; ++it) {
    const int idx = it * 256 + tid, row = idx >> 4, c8 = (idx & 15) * 8;
    const float4 v0 = *(const float4*)(Cs + row * 132 + c8), v1 = *(const float4*)(Cs + row * 132 + c8 + 4);
    float v[8] = {v0.x, v0.y, v0.z, v0.w, v1.x, v1.y, v1.z, v1.w};
    epi(m0 + row, c8, v);
  }
}

__device__ __forceinline__ void phase_rw_proj(const Params& p, int j, char* smem, int zonly, int bid, int nb) {
  const int ntn = zonly ? 16 : (j == 0 ? 50 : 67);
  const float* mixb = p.rw_mix + (size_t)j * 6 * DM;
  const bool xaware = (nb & 7) == 0;
  const int xcd = xaware ? (bid & 7) : 0, slot = xaware ? (bid >> 3) : bid, nslots = xaware ? (nb >> 3) : nb;
  const int ntx = xaware ? (ntn - xcd + 7) / 8 : ntn;
  for (int li = slot; li < MT * ntx; li += nslots) {
    const int mt = li / ntx, ntl = xaware ? xcd + 8 * (li % ntx) : (li % ntx), m0 = mt * 128;
    const int nt = zonly ? 48 + ntl : (ntl < 48 ? ntl : ntl + 16);
    if (nt < 64) {
      const int pi = nt >> 4, n0 = (nt & 15) * 128;
      const int mi = pi == 0 ? 0 : (pi == 1 ? 2 : (pi == 2 ? 3 : 5));
      const bf16_t* Bw = g_wt + OFF_PROJ + ((size_t)(j * 4 + pi) * DI + n0) * DM;
      bf16_t* dst = pi == 0 ? p.R : (pi == 1 ? p.K : (pi == 2 ? p.V : p.Z));
      if (pi == 3) {
        gemm_tile<1>(p.HR, DM, mixb + mi * DM, m0, DM, Bw, 128, smem,
                     [&](int row, int col, float* v) {
#pragma unroll
        for (int e = 0; e < 8; ++e) v[e] = siluf_(v[e]);
        *(uint4*)(dst + (size_t)row * DI + n0 + col) = pack8(v); });
      } else {
        gemm_tile<1>(p.HR, DM, mixb + mi * DM, m0, DM, Bw, 128, smem,
                     [&](int row, int col, float* v) { *(uint4*)(dst + (size_t)row * DI + n0 + col) = pack8(v); });
      }
    } else if (nt == 64) {
      gemm_tile<1>(p.HR, DM, mixb + 1 * DM, m0, DM, g_wt + OFF_W1 + (size_t)j * 128 * DM, 128, smem,
                   [&](int row, int col, float* v) {
#pragma unroll
        for (int e = 0; e < 8; ++e) v[e] = tanhf_(v[e]);
        *(uint4*)(p.LRW + (size_t)row * 128 + col) = pack8(v); });
    } else if (nt == 65) {
      gemm_tile<1>(p.HR, DM, mixb + 4 * DM, m0, DM, g_wt + OFF_A1 + (size_t)j * 128 * DM, 128, smem,
                   [&](int row, int col, float* v) { *(uint4*)(p.LRA + (size_t)row * 128 + col) = pack8(v); });
    } else if (nt == 66) {
      gemm_tile<1>(p.HR, DM, mixb + 3 * DM, m0, DM, g_wt + OFF_V1, 32, smem, [&](int row, int col, float* v) {
        if (col < 32) *(uint4*)(p.LRV + (size_t)row * 32 + col) = pack8(v);
      });
    } else {
      const int n0 = (nt - 67) * 128;
      const bf16_t* Bw = g_wt + OFF_PROJ + ((size_t)2 * DI + n0) * DM;
      gemm_tile<1>(p.HR0, DM, p.rw_mix + 3 * DM, m0, DM, Bw, 128, smem,
                   [&](int row, int col, float* v) { *(uint4*)(p.VF + (size_t)row * DI + n0 + col) = pack8(v); });
    }
  }
}

__device__ __forceinline__ void phase_rw_lr2(const Params& p, int j, char* smem) {
  for (int tile = blockIdx.x; tile < MT * 16; tile += gridDim.x) {
    const int mt = tile / 16, nt = tile % 16, m0 = mt * 128;
    const int n0 = nt * 128;
    const bf16_t* Bw = g_wt + OFF_V2 + (size_t)n0 * 32;
    const float* v0 = p.rw_v0 + n0;
    gemm_tile<0>(p.LRV, 32, nullptr, m0, 32, Bw, 128, smem, [&](int row, int col, float* v) {
      const size_t idx = (size_t)row * DI + n0 + col;
      float vv[8], vf[8];
      unpack8(*(const uint4*)(p.V + idx), vv); unpack8(*(const uint4*)(p.VF + idx), vf);
#pragma unroll
      for (int e = 0; e < 8; ++e) vv[e] += (vf[e] - vv[e]) * sigmoidf_(v[e] + v0[col + e]);
      *(uint4*)(p.V + idx) = pack8(vv);
    });
  }
}

constexpr int RCH = 32;
__device__ __forceinline__ int scan_pos(int dir, int s) { return dir == 0 ? s : (s < CTX ? CTX - 1 - s : TT + CTX - 1 - s); }

__device__ __forceinline__ void phase_rw_scan(const Params& p, int j, char* smem) {
  float* op = (float*)smem;
  float* vv = op + RCH * 4 * 64;
  float* sc = vv + RCH * 64;
  float* LWs = sc + RCH * 2;
  float* AAs = LWs + RCH * 64;
  float* yb = AAs;
  bf16_t* LRs = (bf16_t*)(AAs + RCH * 64);
  const int tid = opaque_tid(), lane = tid & 63, w = tid >> 6;
  const int ptau = tid >> 3, pc8 = (tid & 7) * 8;
  const int r2 = lane >> 3, ko = (lane & 7) * 8;
  const int row0 = w * 16 + r2, row1 = row0 + 8;
  for (int unit = blockIdx.x; unit < GB * 64; unit += gridDim.x) {
    const int bl = unit >> 6, h = (unit >> 1) & 31, dir = unit & 1;
    bf16_t* Y = dir == 0 ? p.YF : p.YB;
    float pkk[8], pka[8], prk[8];
#pragma unroll
    for (int e = 0; e < 8; ++e) {
      const int cc = j * DI + h * 64 + pc8 + e;
      pkk[e] = p.rw_kk[cc]; pka[e] = p.rw_ka[cc]; prk[e] = p.rw_rk[cc];
    }
    __syncthreads();
    const int mm = w >> 1, nh = w & 1;
    const float bias = (mm == 0 ? p.rw_w0 : p.rw_a0)[((size_t)j * 2 + dir) * DI + h * 64 + nh * 32 + (lane & 31)];
    bf16x8 wfr[4];
    {
      const bf16_t* w2g = g_wt + (mm == 0 ? OFF_W2 : OFF_A2) + (((size_t)j * 2 + dir) * DI + h * 64 + nh * 32 + (lane & 31)) * 64 + (lane >> 5) * 8;
#pragma unroll
      for (int kk = 0; kk < 4; ++kk) wfr[kk] = *(const bf16x8*)(w2g + kk * 16);
    }
    f2_t S0[4], S1[4];
#pragma unroll
    for (int e = 0; e < 4; ++e) { S0[e] = f2_t{0.f, 0.f}; S1[e] = f2_t{0.f, 0.f}; }
    uint4 gr, gk, gv, gl0, gl1;
    const int lmat = (tid & 7) >> 2, lcol = (tid & 3) * 16;
    const size_t ubase = (size_t)bl * TT * DI + h * 64 + pc8;
    const bf16_t* const rp = p.R + ubase;
    const bf16_t* const kp = p.K + ubase;
    const bf16_t* const vp_ = p.V + ubase;
    const bf16_t* const lrp = (lmat == 0 ? p.LRW : p.LRA) + (size_t)bl * TT * 128 + dir * 64 + lcol;
    auto gload = [&](int chunk) {
      const int pos = scan_pos(dir, chunk * RCH + ptau);
      const size_t o = (size_t)pos * DI;
      gr = *(const uint4*)(rp + o); gk = *(const uint4*)(kp + o); gv = *(const uint4*)(vp_ + o);
      const bf16_t* lr = lrp + (size_t)pos * 128;
      gl0 = *(const uint4*)(lr); gl1 = *(const uint4*)(lr + 8);
    };
    gload(0);
    for (int chunk = 0; chunk < TT / RCH; ++chunk) {
      *(uint4*)(LRs + (lmat * RCH + ptau) * 72 + lcol) = gl0;
      *(uint4*)(LRs + (lmat * RCH + ptau) * 72 + lcol + 8) = gl1;
      lds_barrier();
      {
        f32x16 acc;
#pragma unroll
        for (int r = 0; r < 16; ++r) acc[r] = 0.f;
#pragma unroll
        for (int kk = 0; kk < 4; ++kk) {
          const bf16x8 af = *(const bf16x8*)(LRs + (mm * RCH + (lane & 31)) * 72 + kk * 16 + (lane >> 5) * 8);
          acc = __builtin_amdgcn_mfma_f32_32x32x16_bf16(af, wfr[kk], acc, 0, 0, 0);
        }
        const int chn = nh * 32 + (lane & 31), hh = lane >> 5;
        if (mm == 0) {
          float lwv[16], pf[16], own[4], oth[4];
#pragma unroll
          for (int r = 0; r < 16; ++r) lwv[r] = -0.60653066f * sigmoidf_(acc[r] + bias);
#pragma unroll
          for (int g = 0; g < 4; ++g) {
            pf[g * 4] = lwv[g * 4];
            pf[g * 4 + 1] = pf[g * 4] + lwv[g * 4 + 1];
            pf[g * 4 + 2] = pf[g * 4 + 1] + lwv[g * 4 + 2];
            pf[g * 4 + 3] = pf[g * 4 + 2] + lwv[g * 4 + 3];
            own[g] = pf[g * 4 + 3];
            oth[g] = __shfl_xor(own[g], 32);
          }
          float base = 0.f;
#pragma unroll
          for (int g = 0; g < 4; ++g) {
            const float off = base + (hh ? oth[g] : 0.f);
#pragma unroll
            for (int q = 0; q < 4; ++q) {
              const int t = q + 8 * g + 4 * hh;
              const float c = off + pf[g * 4 + q];
              LWs[t * 64 + chn] = c;
            }
            base += own[g] + oth[g];
          }
        } else {
#pragma unroll
          for (int r = 0; r < 16; ++r) {
            const int t = (r & 3) + 8 * (r >> 2) + 4 * hh;
            AAs[t * 64 + chn] = sigmoidf_(acc[r] + bias);
          }
        }
      }
      lds_barrier();
      {
        float r[8], k[8], v[8], cm[8], cp[8], a[8];
        unpack8(gr, r); unpack8(gk, k); unpack8(gv, v);
#pragma unroll
        for (int e = 0; e < 8; ++e) {
          cm[e] = LWs[ptau * 64 + pc8 + e]; cp[e] = ptau > 0 ? LWs[(ptau - 1) * 64 + pc8 + e] : 0.f; a[e] = AAs[ptau * 64 + pc8 + e];
        }
        float kkv[8], ss = 0.f;
#pragma unroll
        for (int e = 0; e < 8; ++e) { kkv[e] = k[e] * pkk[e]; ss += kkv[e] * kkv[e]; }
        ss = red8(ss);
        const float inv = rsqrtf(fmaxf(ss, 1e-24f));
        float br = 0.f, kr = 0.f, bon = 0.f;
        float o0[8], o1[8], o2[8], o3[8];
#pragma unroll
        for (int e = 0; e < 8; ++e) {
          const float kkn = kkv[e] * inv;
          const float P = __expf(cm[e]), Pp = __expf(cp[e]);
          const float iP = rcpf_(P);
          const float kd = k[e] * (1.f + (a[e] - 1.f) * pka[e]);
          const float bb = kkn * a[e];
          o0[e] = -kkn * Pp; o1[e] = r[e] * P; o2[e] = bb * iP; o3[e] = kd * iP;
          br += bb * r[e]; kr += kd * r[e]; bon += r[e] * kd * prk[e];
        }
        br = red8(br); kr = red8(kr); bon = red8(bon);
        float* od = op + ptau * 256 + pc8;
        *(float4*)(od) = make_float4(o0[0], o0[1], o0[2], o0[3]); *(float4*)(od + 4) = make_float4(o0[4], o0[5], o0[6], o0[7]);
        *(float4*)(od + 64) = make_float4(o1[0], o1[1], o1[2], o1[3]); *(float4*)(od + 68) = make_float4(o1[4], o1[5], o1[6], o1[7]);
        *(float4*)(od + 128) = make_float4(o2[0], o2[1], o2[2], o2[3]); *(float4*)(od + 132) = make_float4(o2[4], o2[5], o2[6], o2[7]);
        *(float4*)(od + 192) = make_float4(o3[0], o3[1], o3[2], o3[3]); *(float4*)(od + 196) = make_float4(o3[4], o3[5], o3[6], o3[7]);
        float* vd = vv + ptau * 64 + pc8;
        *(float4*)(vd) = make_float4(v[0], v[1], v[2], v[3]); *(float4*)(vd + 4) = make_float4(v[4], v[5], v[6], v[7]);
        if ((tid & 7) == 0) {
          sc[ptau * 2] = br; sc[ptau * 2 + 1] = kr;
          const int pos = scan_pos(dir, chunk * RCH + ptau);
          p.BN[((size_t)dir * NTG + (size_t)bl * TT + pos) * 32 + h] = bon;
        }
      }
      lds_barrier();
      if (chunk + 1 < TT / RCH) gload(chunk + 1);
      {
        struct StepOps { float4 n0, n1, q0, q1, b0, b1, k0, k1; float v0, v1; float2 s; };
        auto ldops = [&](StepOps& o, int tau) {
          const float* ob = op + tau * 256 + ko;
          o.n0 = *(const float4*)(ob); o.n1 = *(const float4*)(ob + 4);
          o.q0 = *(const float4*)(ob + 64); o.q1 = *(const float4*)(ob + 68);
          o.b0 = *(const float4*)(ob + 128); o.b1 = *(const float4*)(ob + 132);
          o.k0 = *(const float4*)(ob + 192); o.k1 = *(const float4*)(ob + 196);
          o.v0 = vv[tau * 64 + row0]; o.v1 = vv[tau * 64 + row1];
          o.s = *(const float2*)(sc + tau * 2);
        };
        auto dostep = [&](const StepOps& o, int tau) {
          const float nk[8] = {o.n0.x, o.n0.y, o.n0.z, o.n0.w, o.n1.x, o.n1.y, o.n1.z, o.n1.w};
          const float rr[8] = {o.q0.x, o.q0.y, o.q0.z, o.q0.w, o.q1.x, o.q1.y, o.q1.z, o.q1.w};
          const float bb[8] = {o.b0.x, o.b0.y, o.b0.z, o.b0.w, o.b1.x, o.b1.y, o.b1.z, o.b1.w};
          const float kd[8] = {o.k0.x, o.k0.y, o.k0.z, o.k0.w, o.k1.x, o.k1.y, o.k1.z, o.k1.w};
          f2_t a10 = {0.f, 0.f}, a11 = {0.f, 0.f}, a20 = {0.f, 0.f}, a21 = {0.f, 0.f};
#pragma unroll
          for (int e = 0; e < 4; ++e) {
            const f2_t nk2 = {nk[2 * e], nk[2 * e + 1]}, rr2 = {rr[2 * e], rr[2 * e + 1]};
            a10 = __builtin_elementwise_fma(S0[e], nk2, a10); a11 = __builtin_elementwise_fma(S1[e], nk2, a11);
            a20 = __builtin_elementwise_fma(S0[e], rr2, a20); a21 = __builtin_elementwise_fma(S1[e], rr2, a21);
          }
          float d10 = a10.x + a10.y, d11 = a11.x + a11.y, d20 = a20.x + a20.y, d21 = a21.x + a21.y;
          d10 = red8(d10); d11 = red8(d11); d20 = red8(d20); d21 = red8(d21);
          const float y0 = d20 + d10 * o.s.x + o.v0 * o.s.y;
          const float y1 = d21 + d11 * o.s.x + o.v1 * o.s.y;
          const f2_t sa0 = {d10, d10}, sa1 = {d11, d11}, vv0 = {o.v0, o.v0}, vv1 = {o.v1, o.v1};
#pragma unroll
          for (int e = 0; e < 4; ++e) {
            const f2_t bb2 = {bb[2 * e], bb[2 * e + 1]}, kd2 = {kd[2 * e], kd[2 * e + 1]};
            S0[e] = __builtin_elementwise_fma(sa0, bb2, __builtin_elementwise_fma(vv0, kd2, S0[e]));
            S1[e] = __builtin_elementwise_fma(sa1, bb2, __builtin_elementwise_fma(vv1, kd2, S1[e]));
          }
          if ((lane & 7) == 0) { yb[tau * 64 + row0] = y0; yb[tau * 64 + row1] = y1; }
        };
        StepOps oa, ob2;
        ldops(oa, 0);
#pragma unroll 1
        for (int tau = 0; tau < RCH; tau += 2) {
          ldops(ob2, tau + 1);
          dostep(oa, tau);
          ldops(oa, tau + 2);
          dostep(ob2, tau + 1);
        }
#pragma unroll
        for (int e = 0; e < 4; ++e) {
          const f2_t pc = {__expf(LWs[(RCH - 1) * 64 + ko + 2 * e]), __expf(LWs[(RCH - 1) * 64 + ko + 2 * e + 1])};
          S0[e] *= pc; S1[e] *= pc;
        }
      }
      lds_barrier();
      {
        const int pos = scan_pos(dir, chunk * RCH + ptau);
        const float* ys = yb + ptau * 64 + pc8;
        float yv[8];
#pragma unroll
        for (int e = 0; e < 8; ++e) yv[e] = ys[e];
        *(uint4*)(Y + ((size_t)bl * TT + pos) * DI + h * 64 + pc8) = pack8(yv);
      }
    }
    lds_barrier();
  }
}

__device__ __forceinline__ void phase_rw_gate(const Params& p, int j) {
  const int tid = opaque_tid(), h = tid >> 3;
  const int c0 = tid * 8;
  float lnw[8], lnb[8];
#pragma unroll
  for (int e = 0; e < 8; ++e) { lnw[e] = p.rw_lnw[j * DI + c0 + e]; lnb[e] = p.rw_lnb[j * DI + c0 + e]; }
  for (int tg = blockIdx.x; tg < NTG; tg += gridDim.x) {
    const size_t base = (size_t)tg * DI + c0;
    float yf[8], yb[8], v[8], z[8];
    unpack8(*(const uint4*)(p.YF + base), yf); unpack8(*(const uint4*)(p.YB + base), yb);
    unpack8(*(const uint4*)(p.V + base), v); unpack8(*(const uint4*)(p.Z + base), z);
    const float bon = p.BN[(size_t)tg * 32 + h] + p.BN[((size_t)NTG + tg) * 32 + h];
    float y[8], s = 0.f;
#pragma unroll
    for (int e = 0; e < 8; ++e) { y[e] = yf[e] + yb[e]; s += y[e]; }
    const float mu = red8(s) * (1.f / 64.f);
    float s2 = 0.f;
#pragma unroll
    for (int e = 0; e < 8; ++e) { y[e] -= mu; s2 += y[e] * y[e]; }
    const float rstd = rsqrtf(red8(s2) * (1.f / 64.f) + 64e-5f);
#pragma unroll
    for (int e = 0; e < 8; ++e) y[e] = (y[e] * rstd * lnw[e] + lnb[e] + bon * v[e]) * z[e];
    *(uint4*)(p.YF + base) = pack8(y);
  }
}

__device__ __forceinline__ void phase_out(const Params& p, const bf16_t* wo, char* smem) {
  for (int tile = blockIdx.x; tile < MT * 8; tile += gridDim.x) {
    const int mt = tile / 8, nt = tile % 8, m0 = mt * 128, n0 = nt * 128;
    const bf16_t* Bw = wo + (size_t)n0 * DI;
    gemm_tile<0>(p.YF, DI, nullptr, m0, DI, Bw, 128, smem,
                 [&](int row, int col, float* v) {
      float* o = p.O + (size_t)row * DM + n0 + col;
      *(float4*)o = make_float4(v[0], v[1], v[2], v[3]); *(float4*)(o + 4) = make_float4(v[4], v[5], v[6], v[7]); });
  }
}

__device__ __forceinline__ void phase_hg_proj(const Params& p, int j, char* smem) {
  const int layer = 2 * j + 1;
  for (int tile = blockIdx.x; tile < MT * 80; tile += gridDim.x) {
    const int mt = tile / 80, nt = tile % 80, m0 = mt * 128;
    const int seg = nt >> 4, n0 = (nt & 15) * 128;
    const bf16_t* Bw = g_wt + OFF_HWIN + ((size_t)j * 5 * DI + (size_t)seg * DI + n0) * DM;
    bf16_t* dst = seg == 0 ? p.R : (seg == 1 ? p.K : (seg == 2 ? p.WF : (seg == 3 ? p.V : p.Z)));
    if (seg == 0 || seg == 4) {
      gemm_tile<0>(p.H, DM, nullptr, m0, DM, Bw, 128, smem, [&](int row, int col, float* v) {
#pragma unroll
        for (int e = 0; e < 8; ++e) v[e] = siluf_(v[e]);
        *(uint4*)(dst + (size_t)row * DI + n0 + col) = pack8(v); });
    } else if (seg == 3) {
      gemm_tile<0>(p.H, DM, nullptr, m0, DM, Bw, 128, smem,
                   [&](int row, int col, float* v) { *(uint4*)(dst + (size_t)row * DI + n0 + col) = pack8(v); });
    } else {
      const float* lbp = p.LB + layer * DI + n0;
      gemm_tile<0>(p.H, DM, nullptr, m0, DM, Bw, 128, smem, [&](int row, int col, float* v) {
        const float4 l0 = *(const float4*)(lbp + col), l1 = *(const float4*)(lbp + col + 4);
        const float lb[8] = {l0.x, l0.y, l0.z, l0.w, l1.x, l1.y, l1.z, l1.w};
#pragma unroll
        for (int e = 0; e < 8; ++e) v[e] = __logf(lb[e] + (1.f - lb[e]) * sigmoidf_(v[e]));
        *(uint4*)(dst + (size_t)row * DI + n0 + col) = pack8(v); });
    }
  }
}

constexpr int HC = 32;
constexpr int QS = 136;
constexpr int SS = 40;
__device__ __forceinline__ void phase_hg_scan(const Params& p, int layer, char* smem) {
  bf16_t* qe = (bf16_t*)smem;
  bf16_t* ke = qe + HC * QS;
  bf16_t* kdT = ke + HC * QS;
  bf16_t* vT = kdT + 128 * SS;
  bf16_t* att = vT + 64 * SS;
  bf16_t* ST = att + HC * SS;
  float* dC = (float*)(ST + 64 * QS);
  const int tid = opaque_tid(), lane = tid & 63, w = tid >> 6;
  for (int unit = blockIdx.x; unit < GB * 64; unit += gridDim.x) {
    const int vs = unit & 1, dir = (unit >> 1) & 1, h = (unit >> 2) & 15, bl = unit >> 6;
    const bf16_t* FL = dir == 0 ? p.K : p.WF;
    bf16_t* Y = dir == 0 ? p.YF : p.YB;
    const int st = lane & 31, cg = w * 2 + (lane >> 5), kb = cg * 16, vb = cg * 8;
    f32x16 sacc[2];
#pragma unroll
    for (int r = 0; r < 16; ++r) { sacc[0][r] = 0.f; sacc[1][r] = 0.f; }
    __syncthreads();
    for (int idx = tid; idx < 64 * QS / 2; idx += 256) ((unsigned*)ST)[idx] = 0u;
    uint4 gq0, gq1, gf0, gf1, gvv;
    const size_t ubase = (size_t)bl * TT * DI + h * 128;
    const bf16_t* const qp = p.R + ubase + kb;
    const bf16_t* const fp_ = FL + ubase + kb;
    const bf16_t* const ip = p.V + ubase + vs * 64 + vb;
    auto gload = [&](int chunk) {
      const int pos = scan_pos(dir, chunk * HC + st);
      const size_t o = (size_t)pos * DI;
      gq0 = *(const uint4*)(qp + o); gq1 = *(const uint4*)(qp + o + 8);
      gf0 = *(const uint4*)(fp_ + o); gf1 = *(const uint4*)(fp_ + o + 8);
      gvv = *(const uint4*)(ip + o);
    };
    gload(0);
    for (int chunk = 0; chunk < TT / HC; ++chunk) {
      float q[16], cum[16], one[16];
      {
        unpack8(gq0, q); unpack8(gq1, q + 8); unpack8(gf0, cum); unpack8(gf1, cum + 8);
#pragma unroll
        for (int e = 0; e < 16; ++e) {
          float c = cum[e];
          one[e] = 1.f - __expf(c);
          c += __int_as_float(__builtin_amdgcn_update_dpp(0, __float_as_int(c), 0x111, 0xf, 0xf, false));
          c += __int_as_float(__builtin_amdgcn_update_dpp(0, __float_as_int(c), 0x112, 0xf, 0xf, false));
          c += __int_as_float(__builtin_amdgcn_update_dpp(0, __float_as_int(c), 0x114, 0xf, 0xf, false));
          c += __int_as_float(__builtin_amdgcn_update_dpp(0, __float_as_int(c), 0x118, 0xf, 0xf, false));
          c += __int_as_float(__builtin_amdgcn_update_dpp(0, __float_as_int(c), 0x142, 0xa, 0xf, false));
          cum[e] = c;
        }
      }
      const uint4 vreg = gvv;
      lds_barrier();
      {
        float qo[16], ko[16];
#pragma unroll
        for (int e = 0; e < 16; ++e) {
          const float c31 = __int_as_float(__builtin_amdgcn_readlane(__float_as_int(cum[e]), 31));
          const float c63 = __int_as_float(__builtin_amdgcn_readlane(__float_as_int(cum[e]), 63));
          const float cC = (lane >> 5) ? c63 : c31;
          const float ec = __expf(fmaxf(cum[e], -80.f));
          const float inv = rcpf_(ec);
          const float eC = __expf(cC);
          qo[e] = q[e] * ec;
          ko[e] = one[e] * inv;
          kdT[(kb + e) * SS + st] = f2bf(one[e] * inv * eC);
          if (st == 31) dC[kb + e] = eC;
        }
        *(uint4*)(qe + st * QS + kb) = pack8(qo); *(uint4*)(qe + st * QS + kb + 8) = pack8(qo + 8);
        *(uint4*)(ke + st * QS + kb) = pack8(ko); *(uint4*)(ke + st * QS + kb + 8) = pack8(ko + 8);
        const bf16_t* vp = (const bf16_t*)&vreg;
#pragma unroll
        for (int e = 0; e < 8; ++e) vT[(vb + e) * SS + st] = vp[e];
      }
      lds_barrier();
      if (chunk + 1 < TT / HC) gload(chunk + 1);
      {
        const int mi = w >> 1, ni = w & 1;
        f32x4 a4 = {0.f, 0.f, 0.f, 0.f};
#pragma unroll
        for (int kk = 0; kk < 4; ++kk) {
          const bf16x8 af = *(const bf16x8*)(qe + (mi * 16 + (lane & 15)) * QS + kk * 32 + (lane >> 4) * 8);
          const bf16x8 bf = *(const bf16x8*)(ke + (ni * 16 + (lane & 15)) * QS + kk * 32 + (lane >> 4) * 8);
          a4 = __builtin_amdgcn_mfma_f32_16x16x32_bf16(af, bf, a4, 0, 0, 0);
        }
        const int s = ni * 16 + (lane & 15);
#pragma unroll
        for (int r = 0; r < 4; ++r) {
          const int t = mi * 16 + (lane >> 4) * 4 + r;
          att[t * SS + s] = f2bf(s <= t ? a4[r] : 0.f);
        }
      }
      lds_barrier();
      {
#pragma unroll
        for (int mh = 0; mh < 2; ++mh) {
          f32x4 y4 = {0.f, 0.f, 0.f, 0.f};
          {
            const bf16x8 af = *(const bf16x8*)(att + (mh * 16 + (lane & 15)) * SS + (lane >> 4) * 8);
            const bf16x8 bf = *(const bf16x8*)(vT + (w * 16 + (lane & 15)) * SS + (lane >> 4) * 8);
            y4 = __builtin_amdgcn_mfma_f32_16x16x32_bf16(af, bf, y4, 0, 0, 0);
          }
#pragma unroll
          for (int kk = 0; kk < 4; ++kk) {
            const bf16x8 af = *(const bf16x8*)(qe + (mh * 16 + (lane & 15)) * QS + kk * 32 + (lane >> 4) * 8);
            const bf16x8 bf = *(const bf16x8*)(ST + (w * 16 + (lane & 15)) * QS + kk * 32 + (lane >> 4) * 8);
            y4 = __builtin_amdgcn_mfma_f32_16x16x32_bf16(af, bf, y4, 0, 0, 0);
          }
#pragma unroll
          for (int r = 0; r < 4; ++r) {
            const int t = mh * 16 + (lane >> 4) * 4 + r;
            const int pos = scan_pos(dir, chunk * HC + t);
            Y[((size_t)bl * TT + pos) * DI + h * 128 + vs * 64 + w * 16 + (lane & 15)] = f2bf(y4[r]);
          }
        }
      }
      lds_barrier();
      {
        float dk[16];
#pragma unroll
        for (int r = 0; r < 16; ++r) dk[r] = dC[w * 32 + (r & 3) + 8 * (r >> 2) + 4 * (lane >> 5)];
#pragma unroll
        for (int nt = 0; nt < 2; ++nt) {
#pragma unroll
          for (int r = 0; r < 16; ++r) sacc[nt][r] *= dk[r];
#pragma unroll
          for (int ks = 0; ks < 2; ++ks) {
            const bf16x8 af = *(const bf16x8*)(kdT + (w * 32 + (lane & 31)) * SS + ks * 16 + (lane >> 5) * 8);
            const bf16x8 bf = *(const bf16x8*)(vT + (nt * 32 + (lane & 31)) * SS + ks * 16 + (lane >> 5) * 8);
            sacc[nt] = __builtin_amdgcn_mfma_f32_32x32x16_bf16(af, bf, sacc[nt], 0, 0, 0);
          }
#pragma unroll
          for (int gq = 0; gq < 4; ++gq) {
            uint2 u;
            u.x = pack2(sacc[nt][gq * 4 + 0], sacc[nt][gq * 4 + 1]);
            u.y = pack2(sacc[nt][gq * 4 + 2], sacc[nt][gq * 4 + 3]);
            *(uint2*)(ST + (nt * 32 + (lane & 31)) * QS + w * 32 + gq * 8 + (lane >> 5) * 4) = u;
          }
        }
      }
    }
    lds_barrier();
  }
}

__device__ __forceinline__ void phase_hg_gate(const Params& p, int j) {
  const int tid = opaque_tid();
  const int c0 = tid * 8;
  float gn[8];
#pragma unroll
  for (int e = 0; e < 8; ++e) gn[e] = p.hg_gn[j * 128 + ((c0 + e) & 127)];
  for (int tg = blockIdx.x; tg < NTG; tg += gridDim.x) {
    const size_t base = (size_t)tg * DI + c0;
    float yf[8], yb[8], z[8];
    unpack8(*(const uint4*)(p.YF + base), yf); unpack8(*(const uint4*)(p.YB + base), yb);
    unpack8(*(const uint4*)(p.Z + base), z);
    float y[8], s2 = 0.f;
#pragma unroll
    for (int e = 0; e < 8; ++e) { y[e] = yf[e] + yb[e]; s2 += y[e] * y[e]; }
    const float rstd = rsqrtf(red16(s2) * (1.f / 128.f) + EPS);
#pragma unroll
    for (int e = 0; e < 8; ++e) y[e] = y[e] * rstd * gn[e] * z[e];
    *(uint4*)(p.YF + base) = pack8(y);
  }
}

__global__ void __launch_bounds__(256, 2) fwd_megakernel(Params p) {
  cg::grid_group grid = cg::this_grid();
  __shared__ __attribute__((aligned(16))) char smem[78 * 1024];
  __shared__ uint4 xb_words;
  if (threadIdx.x == 0) xb_words = make_uint4(0u, 0u, 0u, 0u);
  __syncthreads();
  XcdBarrier xb = xcd_barrier_post(p.bar, (volatile LAS unsigned*)&xb_words);
  phase_mod(p, smem);
  phase_wconv(p, smem);
  grid.sync();
  for (int g = 0; g < NG; ++g) {
    for (int layer = 0; layer < 4; ++layer) {
      phase_resnorm(p, g, layer - 1, layer);
      xcd_barrier(xb);
      const int j = layer >> 1;
      if ((layer & 1) == 0) {
        phase_rw_proj(p, j, smem, 0, blockIdx.x, gridDim.x);
        xcd_barrier(xb);
        if (j == 1) { phase_rw_lr2(p, j, smem); xcd_barrier(xb); }
        if (gridDim.x >= 2 * GB * 64) {
          if (blockIdx.x < GB * 64) phase_rw_scan(p, j, smem);
          else phase_rw_proj(p, j, smem, 1, blockIdx.x - GB * 64, gridDim.x - GB * 64);
        } else {
          phase_rw_scan(p, j, smem);
          phase_rw_proj(p, j, smem, 1, blockIdx.x, gridDim.x);
        }
        xcd_barrier(xb);
        phase_rw_gate(p, j);
        xcd_barrier(xb);
        phase_out(p, g_wt + OFF_RWO + (size_t)j * DM * DI, smem);
        xcd_barrier(xb);
      } else {
        phase_hg_proj(p, j, smem);
        xcd_barrier(xb);
        phase_hg_scan(p, layer, smem);
        xcd_barrier(xb);
        phase_hg_gate(p, j);
        xcd_barrier(xb);
        phase_out(p, g_wt + OFF_HWO + (size_t)j * DM * DI, smem);
        xcd_barrier(xb);
      }
    }
    phase_resnorm(p, g, 3, -1);
    xcd_barrier(xb);
  }
}

extern "C" void kernel_launch(void* const* d_in, const int* in_sizes, int n_in, void* d_out, int out_size, void* d_ws,
                              size_t ws_size, hipStream_t stream) {
  static int grid_blocks = 0;
  if (!grid_blocks) {
    int dev = 0, cus = 0, per_cu = 0;
    hipGetDevice(&dev);
    hipDeviceGetAttribute(&cus, hipDeviceAttributeMultiprocessorCount, dev);
    hipOccupancyMaxActiveBlocksPerMultiprocessor(&per_cu, fwd_megakernel, 256, 0);
    if (per_cu > 2) per_cu = 2;
    grid_blocks = cus * per_cu;
  }
  Params p{};
  const float** fp = (const float**)&p;
  for (int i = 0; i < 29; ++i) fp[i] = (const float*)d_in[i];
  p.out = (float*)d_out;
  char* w = (char*)d_ws;
  size_t off = 0;
  auto take = [&](size_t bytes) { char* r = w + off; off += (bytes + 255) & ~(size_t)255; return r; };
  const size_t DIW = (size_t)NTG * DI * 2;
  p.R = (bf16_t*)take(DIW); p.K = (bf16_t*)take(DIW); p.V = (bf16_t*)take(DIW); p.Z = (bf16_t*)take(DIW);
  p.WF = (bf16_t*)take(DIW); p.YF = (bf16_t*)take(DIW); p.YB = (bf16_t*)take(DIW);
  p.VF = p.YF;
  p.H = p.YB;
  p.HR = p.WF; p.HR0 = p.WF + (size_t)NTG * DM;
  p.LRW = (bf16_t*)take((size_t)NTG * 128 * 2); p.LRA = (bf16_t*)take((size_t)NTG * 128 * 2);
  p.LRV = (bf16_t*)take((size_t)NTG * 32 * 2);
  p.O = (float*)p.R;
  p.BN = (float*)take((size_t)2 * NTG * 32 * 4);
  p.CTXB = (float*)take((size_t)NB * CTX * DM * 4);
  p.MODV = (float*)take((size_t)4 * 9 * 3 * DM * 4);
  p.LB = (float*)take((size_t)4 * DI * 4);
  p.bar = (unsigned*)take((size_t)XCD_BAR_WORDS * 4);
  if (off > ws_size) { fprintf(stderr, "workspace too small: need %zu have %zu\n", off, ws_size); return; }
  hipMemsetAsync(p.bar, 0, (size_t)XCD_BAR_WORDS * 4, stream);
  void* args[] = {&p};
  hipError_t e = hipLaunchCooperativeKernel((void*)fwd_megakernel, dim3(grid_blocks), dim3(256), args, 0, stream);
  if (e != hipSuccess) fprintf(stderr, "cooperative launch failed: %s (grid %d)\n", hipGetErrorString(e), grid_blocks);
}
```

```cpp
#include <hip/hip_runtime.h>
#include <hip/hip_cooperative_groups.h>
#include <cstdio>
#include <cstdint>
namespace cg = cooperative_groups;

typedef unsigned short bf16_t;
using bf16x8 = __attribute__((ext_vector_type(8))) short;
using f32x16 = __attribute__((ext_vector_type(16))) float;
using f32x4 = __attribute__((ext_vector_type(4))) float;
using f2_t = __attribute__((ext_vector_type(2))) float;

constexpr int NB = 8, SEQ = 4096, CTX = 256, TT = 4352, DM = 1024, DI = 2048;
constexpr int GB = 4, NG = NB / GB, NTG = GB * TT;
constexpr int MT = NTG / 128;
constexpr float EPS = 1e-6f;

constexpr size_t OFF_PROJ = 0;
constexpr size_t OFF_RWO = OFF_PROJ + (size_t)2 * 4 * DI * DM;
constexpr size_t OFF_W1 = OFF_RWO + (size_t)2 * DM * DI;
constexpr size_t OFF_A1 = OFF_W1 + (size_t)2 * 128 * DM;
constexpr size_t OFF_V1 = OFF_A1 + (size_t)2 * 128 * DM;
constexpr size_t OFF_V2 = OFF_V1 + (size_t)32 * DM;
constexpr size_t OFF_HWIN = OFF_V2 + (size_t)DI * 32;
constexpr size_t OFF_HWO = OFF_HWIN + (size_t)2 * 5 * DI * DM;
constexpr size_t OFF_W2 = OFF_HWO + (size_t)2 * DM * DI;
constexpr size_t OFF_A2 = OFF_W2 + (size_t)4 * DI * 64;
constexpr size_t WT_TOTAL = OFF_A2 + (size_t)4 * DI * 64;
__device__ bf16_t g_wt[WT_TOTAL];

struct Params {
  const float *x, *c, *ctx, *c_ctx, *mod_w, *mod_b, *pre_g, *post_g, *rw_mix, *rw_proj, *rw_wo, *rw_w0, *rw_w1,
      *rw_w2, *rw_a0, *rw_a1, *rw_a2, *rw_v0, *rw_v1, *rw_v2, *rw_kk, *rw_ka, *rw_rk, *rw_lnw, *rw_lnb, *hg_win,
      *hg_wo, *hg_gn, *hg_lb;
  float* out;
  bf16_t *R, *K, *V, *Z, *WF, *YF, *YB, *VF, *H, *HR, *HR0, *LRW, *LRA, *LRV;
  float *O, *BN, *CTXB, *MODV, *LB;
  unsigned* bar;
};

typedef __bf16 hwbf2_t __attribute__((ext_vector_type(2)));
typedef float hwf2_t __attribute__((ext_vector_type(2)));
__device__ __forceinline__ unsigned pack2(float a, float b) {
  hwf2_t f = {a, b};
  hwbf2_t h = __builtin_convertvector(f, hwbf2_t);
  return __builtin_bit_cast(unsigned, h);
}
__device__ __forceinline__ bf16_t f2bf(float f) { return (bf16_t)(pack2(f, f) & 0xffffu); }
__device__ __forceinline__ float bf2f(bf16_t h) { return __uint_as_float(((unsigned)h) << 16); }
typedef _Float16 h2_t __attribute__((ext_vector_type(2)));
using f16x8 = __attribute__((ext_vector_type(8))) _Float16;
__device__ __forceinline__ unsigned pack2h(float a, float b) {
  h2_t h = {(_Float16)a, (_Float16)b};
  return __builtin_bit_cast(unsigned, h);
}
__device__ __forceinline__ uint4 pack8h(const float* f) {
  uint4 u; u.x = pack2h(f[0], f[1]); u.y = pack2h(f[2], f[3]); u.z = pack2h(f[4], f[5]); u.w = pack2h(f[6], f[7]);
  return u;
}
__device__ __forceinline__ unsigned mixh2(unsigned h, unsigned n, unsigned m) {
  const h2_t hv = __builtin_bit_cast(h2_t, h), nv = __builtin_bit_cast(h2_t, n), mv = __builtin_bit_cast(h2_t, m);
  const h2_t r = hv + (nv - hv) * mv;
  return __builtin_bit_cast(unsigned, r);
}
__device__ __forceinline__ float lo2f(unsigned u) { return __uint_as_float(u << 16); }
__device__ __forceinline__ float hi2f(unsigned u) { return __uint_as_float(u & 0xffff0000u); }
__device__ __forceinline__ float rcpf_(float x) { return __builtin_amdgcn_rcpf(x); }
__device__ __forceinline__ float sigmoidf_(float x) { return rcpf_(1.f + __expf(-x)); }
__device__ __forceinline__ float siluf_(float x) { return x * rcpf_(1.f + __expf(-x)); }
__device__ __forceinline__ float tanhf_(float x) { return 1.f - 2.f * rcpf_(1.f + __expf(2.f * x)); }

__device__ __forceinline__ void lds_barrier() { asm volatile("s_waitcnt lgkmcnt(0)\n\ts_barrier" ::: "memory"); }

__device__ __forceinline__ int opaque_tid() { int t = threadIdx.x; asm volatile("" : "+v"(t)); return t; }

template <int CTRL>
__device__ __forceinline__ float dppf(float v) {
  return __int_as_float(__builtin_amdgcn_update_dpp(0, __float_as_int(v), CTRL, 0xf, 0xf, true));
}
__device__ __forceinline__ float red4(float v) { v += dppf<0xB1>(v); v += dppf<0x4E>(v); return v; }
__device__ __forceinline__ float red8(float v) { v = red4(v); v += dppf<0x141>(v); return v; }
__device__ __forceinline__ float red16(float v) { v = red8(v); v += dppf<0x140>(v); return v; }
__device__ __forceinline__ float red64(float v) {
  v = red16(v);
  v += __shfl_xor(v, 16);
  v += __shfl_xor(v, 32);
  return v;
}

__device__ __forceinline__ void unpack8(const uint4& u, float* f) {
  f[0] = lo2f(u.x); f[1] = hi2f(u.x); f[2] = lo2f(u.y); f[3] = hi2f(u.y);
  f[4] = lo2f(u.z); f[5] = hi2f(u.z); f[6] = lo2f(u.w); f[7] = hi2f(u.w);
}
__device__ __forceinline__ uint4 pack8(const float* f) {
  uint4 u; u.x = pack2(f[0], f[1]); u.y = pack2(f[2], f[3]); u.z = pack2(f[4], f[5]); u.w = pack2(f[6], f[7]);
  return u;
}


#define XB_TMO      128
#define XB_XCNT(j)  (256  + 64 * (j))
#define XB_XSUB(j)  (1280 + 64 * (j))
#define XB_XGEN(j)  (2304 + 64 * (j))
#define XB_TOP      3328
#define XB_TOPGEN   3392
#define XCD_BAR_WORDS 3456
#define XB_SPIN_CAP (1u << 23)
#define LAS __attribute__((address_space(3)))
__device__ __forceinline__ unsigned xb_ld(unsigned* p)              { return __hip_atomic_load(p, __ATOMIC_RELAXED, __HIP_MEMORY_SCOPE_AGENT); }
__device__ __forceinline__ unsigned xb_add(unsigned* p, unsigned v) { return __hip_atomic_fetch_add(p, v, __ATOMIC_RELAXED, __HIP_MEMORY_SCOPE_AGENT); }
__device__ __forceinline__ unsigned xb_xcc_id() { return (unsigned)__builtin_amdgcn_s_getreg((3 << 11) | 20) & 0xFu; }
#define XB_SPIN(cond, bar) do { unsigned _sp = 0; while (cond) { __builtin_amdgcn_s_sleep(1); \
    if ((++_sp & 255u) == 0u) { if (xb_ld(&(bar)[XB_TMO])) break; if (_sp > XB_SPIN_CAP) { atomicAdd(&(bar)[XB_TMO], 1u); break; } } } } while (0)
struct XcdBarrier { unsigned* bar; unsigned x; volatile LAS unsigned* st; };
__device__ __forceinline__ XcdBarrier xcd_barrier_post(unsigned* bar, volatile LAS unsigned* st) {
  XcdBarrier b; b.bar = bar; b.x = xb_xcc_id(); b.st = st;
  if (threadIdx.x == 0) (void)xb_add(&bar[XB_XCNT(b.x)], 1u);
  return b;
}
__device__ __forceinline__ void xcd_barrier_complete(unsigned* bar, unsigned x, unsigned& nloc, unsigned& nx) {
  const unsigned G = gridDim.x * gridDim.y * gridDim.z;
  unsigned sum, cnt, mine, sp = 0u;
  for (;;) {
    sum = 0u; cnt = 0u; mine = 0u;
#pragma unroll
    for (unsigned j = 0; j < 16; ++j) { const unsigned c = xb_ld(&bar[XB_XCNT(j)]); sum += c; cnt += (c > 0u) ? 1u : 0u; mine = (j == x) ? c : mine; }
    if (sum == G) break;
    __builtin_amdgcn_s_sleep(1);
    if ((++sp & 255u) == 0u) { if (xb_ld(&bar[XB_TMO])) break; if (sp > XB_SPIN_CAP) { atomicAdd(&bar[XB_TMO], 1u); break; } }
  }
  nloc = mine > 0u ? mine : 1u; nx = cnt > 0u ? cnt : 1u;
}
__device__ __forceinline__ void xcd_barrier(const XcdBarrier& b) {
  asm volatile("s_waitcnt vmcnt(0)" ::: "memory");
  __syncthreads();
  if (threadIdx.x == 0) {
    unsigned* bar = b.bar;
    __builtin_amdgcn_s_waitcnt(0);
    unsigned nloc = b.st[0], nx = b.st[1];
    if (nloc == 0u) { xcd_barrier_complete(bar, b.x, nloc, nx); b.st[0] = nloc; b.st[1] = nx; }
    const unsigned old = xb_add(&bar[XB_XSUB(b.x)], 1u);
    const unsigned gen = old / nloc;
    if (old + 1u == (gen + 1u) * nloc) {
      __builtin_amdgcn_fence(__ATOMIC_RELEASE, "agent");
      asm volatile("s_waitcnt vmcnt(0)" ::: "memory");
      const unsigned og = xb_add(&bar[XB_TOP], 1u);
      const unsigned tg = og / nx;
      if (og + 1u == (tg + 1u) * nx) xb_add(&bar[XB_TOPGEN], 1u);
      else XB_SPIN(xb_ld(&bar[XB_TOPGEN]) == tg, bar);
      __builtin_amdgcn_fence(__ATOMIC_ACQUIRE, "agent");
      xb_add(&bar[XB_XGEN(b.x)], 1u);
      asm volatile("s_waitcnt vmcnt(0)" ::: "memory");
    } else {
      XB_SPIN(xb_ld(&bar[XB_XGEN(b.x)]) == gen, bar);
      __builtin_amdgcn_fence(__ATOMIC_ACQUIRE, "agent");
      asm volatile("s_waitcnt vmcnt(0)" ::: "memory");
    }
  }
  __syncthreads();
}

__device__ __forceinline__ const float* row_in(const Params& p, int b, int t) {
  return t < CTX ? p.ctx + ((size_t)b * CTX + t) * DM : p.x + ((size_t)b * SEQ + (t - CTX)) * DM;
}
__device__ __forceinline__ float* row_cur(const Params& p, int b, int t) {
  return t < CTX ? p.CTXB + ((size_t)b * CTX + t) * DM : p.out + ((size_t)b * SEQ + (t - CTX)) * DM;
}

__device__ __forceinline__ void phase_mod(const Params& p, char* smem) {
  float* ssil = (float*)smem;
  float* red = ssil + 9 * DM;
  const int tid = opaque_tid(), cl = tid & 63, kp = tid >> 6;
  if (blockIdx.x < 4 * 48) {
    for (int idx = tid; idx < 9 * DM; idx += 256) {
      const int r = idx >> 10, k = idx & 1023;
      ssil[idx] = siluf_(r < 8 ? p.c[r * DM + k] : p.c_ctx[k]);
    }
    __syncthreads();
  }
  for (int task = blockIdx.x; task < 4 * 48; task += gridDim.x) {
    const int l = task / 48, col = (task % 48) * 64 + cl;
    float acc[9];
#pragma unroll
    for (int r = 0; r < 9; ++r) acc[r] = 0.f;
    const float* W = p.mod_w + (size_t)l * DM * 3 * DM + col;
#pragma unroll 4
    for (int k = kp * 256; k < kp * 256 + 256; ++k) {
      const float w = W[(size_t)k * 3 * DM];
#pragma unroll
      for (int r = 0; r < 9; ++r) acc[r] += ssil[r * DM + k] * w;
    }
    __syncthreads();
#pragma unroll
    for (int r = 0; r < 9; ++r) red[(kp * 9 + r) * 64 + cl] = acc[r];
    __syncthreads();
    for (int idx = tid; idx < 9 * 64; idx += 256) {
      const int r = idx >> 6, c2 = idx & 63;
      float s = 0.f;
      for (int q = 0; q < 4; ++q) s += red[(q * 9 + r) * 64 + c2];
      const int cc = (task % 48) * 64 + c2;
      p.MODV[((size_t)l * 9 + r) * 3 * DM + cc] = s + p.mod_b[l * 3 * DM + cc];
    }
  }
  for (int cidx = blockIdx.x * 256 + tid; cidx < DI; cidx += gridDim.x * 256) {
    float v[4], m = -1e30f;
    for (int l = 0; l < 4; ++l) { v[l] = p.hg_lb[l * DI + cidx]; m = fmaxf(m, v[l]); }
    float s = 0.f;
    for (int l = 0; l < 4; ++l) { v[l] = __expf(v[l] - m); s += v[l]; }
    float cum = 0.f;
    for (int l = 0; l < 4; ++l) { cum += v[l] / s; p.LB[l * DI + cidx] = cum - v[0] / s; }
  }
}

__device__ __forceinline__ void conv_matrix(const float* __restrict__ src, int K, int N, bf16_t* __restrict__ dst, char* smem, bool f16out = false) {
  float* ts = (float*)smem;
  const int tid = opaque_tid();
  const int ntn = N / 32, ntile = (K / 64) * ntn;
  for (int tile = blockIdx.x; tile < ntile; tile += gridDim.x) {
    const int k0 = (tile / ntn) * 64, n0 = (tile % ntn) * 32;
    __syncthreads();
#pragma unroll
    for (int i = 0; i < 2; ++i) {
      const int k = (tid >> 3) + 32 * i, n4 = (tid & 7) * 4;
      const float4 v = *(const float4*)(src + (size_t)(k0 + k) * N + n0 + n4);
      ts[k * 33 + n4 + 0] = v.x; ts[k * 33 + n4 + 1] = v.y; ts[k * 33 + n4 + 2] = v.z; ts[k * 33 + n4 + 3] = v.w;
    }
    __syncthreads();
    const int n = tid >> 3, k8 = (tid & 7) * 8;
    float f[8];
#pragma unroll
    for (int e = 0; e < 8; ++e) f[e] = ts[(k8 + e) * 33 + n];
    *(uint4*)(dst + (size_t)(n0 + n) * K + k0 + k8) = f16out ? pack8h(f) : pack8(f);
  }
}
__device__ __forceinline__ void phase_wconv(const Params& p, char* smem) {
  for (int m = 0; m < 8; ++m) conv_matrix(p.rw_proj + (size_t)m * DM * DI, DM, DI, g_wt + OFF_PROJ + (size_t)m * DI * DM, smem, true);
  for (int j = 0; j < 2; ++j) conv_matrix(p.rw_wo + (size_t)j * DI * DM, DI, DM, g_wt + OFF_RWO + (size_t)j * DM * DI, smem);
  for (int m = 0; m < 4; ++m) {
    conv_matrix(p.rw_w1 + (size_t)m * DM * 64, DM, 64, g_wt + OFF_W1 + (size_t)m * 64 * DM, smem, true);
    conv_matrix(p.rw_a1 + (size_t)m * DM * 64, DM, 64, g_wt + OFF_A1 + (size_t)m * 64 * DM, smem, true);
  }
  conv_matrix(p.rw_v1, DM, 32, g_wt + OFF_V1, smem, true);
  for (int m = 0; m < 4; ++m) {
    conv_matrix(p.rw_w2 + (size_t)m * 64 * DI, 64, DI, g_wt + OFF_W2 + (size_t)m * DI * 64, smem);
    conv_matrix(p.rw_a2 + (size_t)m * 64 * DI, 64, DI, g_wt + OFF_A2 + (size_t)m * DI * 64, smem);
  }
  for (int j = 0; j < 2; ++j) conv_matrix(p.hg_win + (size_t)j * DM * 5 * DI, DM, 5 * DI, g_wt + OFF_HWIN + (size_t)j * 5 * DI * DM, smem);
  for (int j = 0; j < 2; ++j) conv_matrix(p.hg_wo + (size_t)j * DI * DM, DI, DM, g_wt + OFF_HWO + (size_t)j * DM * DI, smem);
  for (int idx = blockIdx.x * 256 + opaque_tid(); idx < DI * 32; idx += gridDim.x * 256) {
    const int n = idx >> 5, k = idx & 31;
    g_wt[OFF_V2 + idx] = f2bf(p.rw_v2[(size_t)k * DI + n]);
  }
}

__device__ __forceinline__ void phase_resnorm(const Params& p, int g, int lu, int ln) {
  const int tid = opaque_tid();
  const int lane = tid & 63;
  const int wv = blockIdx.x * 4 + (tid >> 6), nw = gridDim.x * 4;
  for (int tg = wv; tg < NTG; tg += nw) {
    const int bl = tg / TT, t = tg % TT, b = g * GB + bl;
    const bool isctx = t < CTX;
    const int mrow = isctx ? 8 : b;
    float xv[16];
    const float* src = (lu <= 0) ? row_in(p, b, t) : row_cur(p, b, t);
#pragma unroll
    for (int j = 0; j < 4; ++j) {
      const float4 v4 = *(const float4*)(src + j * 256 + lane * 4);
      xv[j * 4 + 0] = v4.x; xv[j * 4 + 1] = v4.y; xv[j * 4 + 2] = v4.z; xv[j * 4 + 3] = v4.w;
    }
    if (lu >= 0 && !(isctx && lu == 3)) {
      float ov[16], ss = 0.f;
      const float* orow = p.O + (size_t)tg * DM;
#pragma unroll
      for (int j = 0; j < 4; ++j) {
        const float4 v4 = *(const float4*)(orow + j * 256 + lane * 4);
        ov[j * 4 + 0] = v4.x; ov[j * 4 + 1] = v4.y; ov[j * 4 + 2] = v4.z; ov[j * 4 + 3] = v4.w;
      }
#pragma unroll
      for (int e = 0; e < 16; ++e) ss += ov[e] * ov[e];
      ss = red64(ss);
      const float rstd = rsqrtf(ss * (1.f / DM) + EPS);
      const float* gate = p.MODV + ((size_t)lu * 9 + mrow) * 3 * DM + 2 * DM;
      const float* pg = p.post_g + lu * DM;
      float* dst = row_cur(p, b, t);
#pragma unroll
      for (int j = 0; j < 4; ++j) {
        const int cc = j * 256 + lane * 4;
        const float4 g4 = *(const float4*)(gate + cc);
        const float4 p4 = *(const float4*)(pg + cc);
        xv[j * 4 + 0] += g4.x * (ov[j * 4 + 0] * rstd * p4.x);
        xv[j * 4 + 1] += g4.y * (ov[j * 4 + 1] * rstd * p4.y);
        xv[j * 4 + 2] += g4.z * (ov[j * 4 + 2] * rstd * p4.z);
        xv[j * 4 + 3] += g4.w * (ov[j * 4 + 3] * rstd * p4.w);
        *(float4*)(dst + cc) = make_float4(xv[j * 4 + 0], xv[j * 4 + 1], xv[j * 4 + 2], xv[j * 4 + 3]);
      }
    }
    if (ln >= 0) {
      for (int pass = 0; pass < (ln == 2 ? 2 : 1); ++pass) {
        const int lp = pass == 0 ? ln : 0;
        bf16_t* hdst = (pass == 0 ? ((ln & 1) == 0 ? p.HR : p.H) : p.HR0) + (size_t)tg * DM;
        if (pass == 1) {
          const float* s0 = row_in(p, b, t);
#pragma unroll
          for (int j = 0; j < 4; ++j) {
            const float4 v4 = *(const float4*)(s0 + j * 256 + lane * 4);
            xv[j * 4 + 0] = v4.x; xv[j * 4 + 1] = v4.y; xv[j * 4 + 2] = v4.z; xv[j * 4 + 3] = v4.w;
          }
        }
        float ss = 0.f;
#pragma unroll
        for (int e = 0; e < 16; ++e) ss += xv[e] * xv[e];
        ss = red64(ss);
        const float rstd = rsqrtf(ss * (1.f / DM) + EPS);
        const float* mv = p.MODV + ((size_t)lp * 9 + mrow) * 3 * DM;
        const float* pg = p.pre_g + lp * DM;
#pragma unroll
        for (int j = 0; j < 4; ++j) {
          const int cc = j * 256 + lane * 4;
          const float4 sh = *(const float4*)(mv + cc);
          const float4 sc = *(const float4*)(mv + DM + cc);
          const float4 p4 = *(const float4*)(pg + cc);
          const float h0 = xv[j * 4 + 0] * rstd * p4.x * (1.f + sc.x) + sh.x;
          const float h1 = xv[j * 4 + 1] * rstd * p4.y * (1.f + sc.y) + sh.y;
          const float h2 = xv[j * 4 + 2] * rstd * p4.z * (1.f + sc.z) + sh.z;
          const float h3 = xv[j * 4 + 3] * rstd * p4.w * (1.f + sc.w) + sh.w;
          uint2 u;
          if ((ln & 1) == 0) {
            const float L = 60000.f;
            u.x = pack2h(fminf(fmaxf(h0, -L), L), fminf(fmaxf(h1, -L), L));
            u.y = pack2h(fminf(fmaxf(h2, -L), L), fminf(fmaxf(h3, -L), L));
          } else {
            u.x = pack2(h0, h1); u.y = pack2(h2, h3);
          }
          *(uint2*)(hdst + cc) = u;
        }
      }
    }
  }
}

constexpr int LDK = 72;
constexpr int TM = 128;

template <int AMODE, class Epi>
__device__ __forceinline__ void gemm_tile(const bf16_t* __restrict__ A, int lda, const float* __restrict__ mix, int m0,
                                          int K, const bf16_t* __restrict__ Bt, int nvalid, char* smem, Epi epi) {
  bf16_t* As = (bf16_t*)smem;
  bf16_t* Bs = As + 2 * TM * LDK;
  float* mixs = (float*)(Bs + 2 * 128 * LDK);
  const int tid = opaque_tid(), lane = tid & 63, w = tid >> 6, wm = w >> 1, wn = w & 1;
  const int lr = lane >> 3, ch = (lane & 7) * 8;
  const int row0 = w * 32 + lr;
  const bf16_t* Ap = A + (size_t)(m0 + row0) * lda + ch;
  const bf16_t* Bp = Bt + (size_t)row0 * K + ch;
  const size_t astep = (size_t)8 * lda, bstep = (size_t)8 * K;
  const int KT = (K + 63) >> 6;
  const int tbase = m0 % TT;
  const bool isctx = tbase < CTX;
  unsigned vmask = 0;
  if (AMODE == 1) {
#pragma unroll
    for (int i = 0; i < 4; ++i) {
      const int t = tbase + row0 + i * 8;
      unsigned m;
      if (isctx) {
        m = (t >= 1 ? 3u : 0u) | (t + 1 < CTX ? 12u : 0u);
      } else {
        const int tl = t - CTX, row = tl >> 6, col = tl & 63;
        m = (col > 0 ? 1u : 0u) | (col < 63 ? 2u : 0u) | (row > 0 ? 4u : 0u) | (row < 63 ? 8u : 0u);
      }
      vmask |= m << (4 * i);
    }
  }

  __syncthreads();
  if (AMODE == 1) {
    const float4 m4 = *(const float4*)(mix + tid * 4);
    ((uint2*)mixs)[tid] = make_uint2(pack2h(m4.x, m4.y), pack2h(m4.z, m4.w));
  }

  f32x16 acc[2][2];
#pragma unroll
  for (int i = 0; i < 2; ++i)
#pragma unroll
    for (int j = 0; j < 2; ++j)
#pragma unroll
      for (int r = 0; r < 16; ++r) acc[i][j][r] = 0.f;

  uint4 a0, a1, a2, a3, n0, n1, n2, n3, b0, b1, b2, b3;
  auto load_regs = [&](int kt) {
    const int k0 = kt * 64;
    const uint4 z4 = make_uint4(0, 0, 0, 0);
    const bool kval = (k0 + ch) < K;
    const bf16_t* ap = Ap + k0;
    const bf16_t* bp = Bp + k0;
    a0 = z4; if (kval) a0 = *(const uint4*)(ap + 0 * astep);
    a1 = z4; if (kval) a1 = *(const uint4*)(ap + 1 * astep);
    a2 = z4; if (kval) a2 = *(const uint4*)(ap + 2 * astep);
    a3 = z4; if (kval) a3 = *(const uint4*)(ap + 3 * astep);
    b0 = z4; if (kval && (row0 + 0) < nvalid) b0 = *(const uint4*)(bp + 0 * bstep);
    b1 = z4; if (kval && (row0 + 8) < nvalid) b1 = *(const uint4*)(bp + 1 * bstep);
    b2 = z4; if (kval && (row0 + 16) < nvalid) b2 = *(const uint4*)(bp + 2 * bstep);
    b3 = z4; if (kval && (row0 + 24) < nvalid) b3 = *(const uint4*)(bp + 3 * bstep);
    if (AMODE == 1) {
      const int q = k0 >> 8;
      const int nb = isctx ? (q < 2 ? -1 : 1) : (q == 0 ? -1 : (q == 1 ? 1 : (q == 2 ? -64 : 64)));
      const bf16_t* np = ap + (ptrdiff_t)nb * lda;
      const unsigned vm = vmask >> q;
      n0 = z4; if ((vm >> 0) & 1u) n0 = *(const uint4*)(np + 0 * astep);
      n1 = z4; if ((vm >> 4) & 1u) n1 = *(const uint4*)(np + 1 * astep);
      n2 = z4; if ((vm >> 8) & 1u) n2 = *(const uint4*)(np + 2 * astep);
      n3 = z4; if ((vm >> 12) & 1u) n3 = *(const uint4*)(np + 3 * astep);
    }
  };
  auto mix8 = [&](const uint4& hv, const uint4& nv, const uint4& mv) -> uint4 {
    uint4 o;
    o.x = mixh2(hv.x, nv.x, mv.x); o.y = mixh2(hv.y, nv.y, mv.y); o.z = mixh2(hv.z, nv.z, mv.z); o.w = mixh2(hv.w, nv.w, mv.w);
    return o;
  };
  auto store_lds = [&](int kt, int buf) {
    bf16_t* ad = As + (buf * TM + row0) * LDK + ch;
    bf16_t* bd = Bs + (buf * 128 + row0) * LDK + ch;
    if (AMODE == 1) {
      const uint4 mv = *(const uint4*)((const bf16_t*)mixs + kt * 64 + ch);
      *(uint4*)(ad + 0 * LDK) = mix8(a0, n0, mv);
      *(uint4*)(ad + 8 * LDK) = mix8(a1, n1, mv);
      *(uint4*)(ad + 16 * LDK) = mix8(a2, n2, mv);
      *(uint4*)(ad + 24 * LDK) = mix8(a3, n3, mv);
    } else {
      *(uint4*)(ad + 0 * LDK) = a0;
      *(uint4*)(ad + 8 * LDK) = a1;
      *(uint4*)(ad + 16 * LDK) = a2;
      *(uint4*)(ad + 24 * LDK) = a3;
    }
    *(uint4*)(bd + 0 * LDK) = b0;
    *(uint4*)(bd + 8 * LDK) = b1;
    *(uint4*)(bd + 16 * LDK) = b2;
    *(uint4*)(bd + 24 * LDK) = b3;
  };
  auto compute = [&](int buf) {
    const bf16_t* ab = As + (buf * TM + wm * 64 + (lane & 31)) * LDK + (lane >> 5) * 8;
    const bf16_t* bb = Bs + (buf * 128 + wn * 64 + (lane & 31)) * LDK + (lane >> 5) * 8;
#pragma unroll
    for (int kk = 0; kk < 4; ++kk) {
      const bf16x8 af0 = *(const bf16x8*)(ab + kk * 16), af1 = *(const bf16x8*)(ab + 32 * LDK + kk * 16);
      const bf16x8 bf0 = *(const bf16x8*)(bb + kk * 16), bf1 = *(const bf16x8*)(bb + 32 * LDK + kk * 16);
      if (AMODE == 1) {
        const f16x8 ha0 = __builtin_bit_cast(f16x8, af0), ha1 = __builtin_bit_cast(f16x8, af1);
        const f16x8 hb0 = __builtin_bit_cast(f16x8, bf0), hb1 = __builtin_bit_cast(f16x8, bf1);
        acc[0][0] = __builtin_amdgcn_mfma_f32_32x32x16_f16(ha0, hb0, acc[0][0], 0, 0, 0);
        acc[0][1] = __builtin_amdgcn_mfma_f32_32x32x16_f16(ha0, hb1, acc[0][1], 0, 0, 0);
        acc[1][0] = __builtin_amdgcn_mfma_f32_32x32x16_f16(ha1, hb0, acc[1][0], 0, 0, 0);
        acc[1][1] = __builtin_amdgcn_mfma_f32_32x32x16_f16(ha1, hb1, acc[1][1], 0, 0, 0);
      } else {
        acc[0][0] = __builtin_amdgcn_mfma_f32_32x32x16_bf16(af0, bf0, acc[0][0], 0, 0, 0);
        acc[0][1] = __builtin_amdgcn_mfma_f32_32x32x16_bf16(af0, bf1, acc[0][1], 0, 0, 0);
        acc[1][0] = __builtin_amdgcn_mfma_f32_32x32x16_bf16(af1, bf0, acc[1][0], 0, 0, 0);
        acc[1][1] = __builtin_amdgcn_mfma_f32_32x32x16_bf16(af1, bf1, acc[1][1], 0, 0, 0);
      }
    }
  };
  load_regs(0);
  lds_barrier();
  store_lds(0, 0);
  if (KT > 1) load_regs(1);
  lds_barrier();
  for (int kt = 0; kt < KT; ++kt) {
    if (kt + 1 < KT) store_lds(kt + 1, (kt + 1) & 1);
    if (kt + 2 < KT) load_regs(kt + 2);
    compute(kt & 1);
    lds_barrier();
  }
  float* Cs = (float*)smem;
#pragma unroll
  for (int i = 0; i < 2; ++i)
#pragma unroll
    for (int j = 0; j < 2; ++j)
#pragma unroll
      for (int r = 0; r < 16; ++r)
        Cs[(wm * 64 + i * 32 + (r & 3) + 8 * (r >> 2) + 4 * (lane >> 5)) * 132 + wn * 64 + j * 32 + (lane & 31)] = acc[i][j][r];
  lds_barrier();
#pragma unroll 2
  for (int it = 0; it < 8; ++it) {
    const int idx = it * 256 + tid, row = idx >> 4, c8 = (idx & 15) * 8;
    const float4 v0 = *(const float4*)(Cs + row * 132 + c8), v1 = *(const float4*)(Cs + row * 132 + c8 + 4);
    float v[8] = {v0.x, v0.y, v0.z, v0.w, v1.x, v1.y, v1.z, v1.w};
    epi(m0 + row, c8, v);
  }
}

__device__ __forceinline__ void phase_rw_proj(const Params& p, int j, char* smem, int zonly, int bid, int nb) {
  const int ntn = zonly ? 16 : (j == 0 ? 50 : 67);
  const float* mixb = p.rw_mix + (size_t)j * 6 * DM;
  const bool xaware = (nb & 7) == 0;
  const int xcd = xaware ? (bid & 7) : 0, slot = xaware ? (bid >> 3) : bid, nslots = xaware ? (nb >> 3) : nb;
  const int ntx = xaware ? (ntn - xcd + 7) / 8 : ntn;
  for (int li = slot; li < MT * ntx; li += nslots) {
    const int mt = li / ntx, ntl = xaware ? xcd + 8 * (li % ntx) : (li % ntx), m0 = mt * 128;
    const int nt = zonly ? 48 + ntl : (ntl < 48 ? ntl : ntl + 16);
    if (nt < 64) {
      const int pi = nt >> 4, n0 = (nt & 15) * 128;
      const int mi = pi == 0 ? 0 : (pi == 1 ? 2 : (pi == 2 ? 3 : 5));
      const bf16_t* Bw = g_wt + OFF_PROJ + ((size_t)(j * 4 + pi) * DI + n0) * DM;
      bf16_t* dst = pi == 0 ? p.R : (pi == 1 ? p.K : (pi == 2 ? p.V : p.Z));
      if (pi == 3) {
        gemm_tile<1>(p.HR, DM, mixb + mi * DM, m0, DM, Bw, 128, smem,
                     [&](int row, int col, float* v) {
#pragma unroll
        for (int e = 0; e < 8; ++e) v[e] = siluf_(v[e]);
        *(uint4*)(dst + (size_t)row * DI + n0 + col) = pack8(v); });
      } else {
        gemm_tile<1>(p.HR, DM, mixb + mi * DM, m0, DM, Bw, 128, smem,
                     [&](int row, int col, float* v) { *(uint4*)(dst + (size_t)row * DI + n0 + col) = pack8(v); });
      }
    } else if (nt == 64) {
      gemm_tile<1>(p.HR, DM, mixb + 1 * DM, m0, DM, g_wt + OFF_W1 + (size_t)j * 128 * DM, 128, smem,
                   [&](int row, int col, float* v) {
#pragma unroll
        for (int e = 0; e < 8; ++e) v[e] = tanhf_(v[e]);
        *(uint4*)(p.LRW + (size_t)row * 128 + col) = pack8(v); });
    } else if (nt == 65) {
      gemm_tile<1>(p.HR, DM, mixb + 4 * DM, m0, DM, g_wt + OFF_A1 + (size_t)j * 128 * DM, 128, smem,
                   [&](int row, int col, float* v) { *(uint4*)(p.LRA + (size_t)row * 128 + col) = pack8(v); });
    } else if (nt == 66) {
      gemm_tile<1>(p.HR, DM, mixb + 3 * DM, m0, DM, g_wt + OFF_V1, 32, smem, [&](int row, int col, float* v) {
        if (col < 32) *(uint4*)(p.LRV + (size_t)row * 32 + col) = pack8(v);
      });
    } else {
      const int n0 = (nt - 67) * 128;
      const bf16_t* Bw = g_wt + OFF_PROJ + ((size_t)2 * DI + n0) * DM;
      gemm_tile<1>(p.HR0, DM, p.rw_mix + 3 * DM, m0, DM, Bw, 128, smem,
                   [&](int row, int col, float* v) { *(uint4*)(p.VF + (size_t)row * DI + n0 + col) = pack8(v); });
    }
  }
}

__device__ __forceinline__ void phase_rw_lr2(const Params& p, int j, char* smem) {
  for (int tile = blockIdx.x; tile < MT * 16; tile += gridDim.x) {
    const int mt = tile / 16, nt = tile % 16, m0 = mt * 128;
    const int n0 = nt * 128;
    const bf16_t* Bw = g_wt + OFF_V2 + (size_t)n0 * 32;
    const float* v0 = p.rw_v0 + n0;
    gemm_tile<0>(p.LRV, 32, nullptr, m0, 32, Bw, 128, smem, [&](int row, int col, float* v) {
      const size_t idx = (size_t)row * DI + n0 + col;
      float vv[8], vf[8];
      unpack8(*(const uint4*)(p.V + idx), vv); unpack8(*(const uint4*)(p.VF + idx), vf);
#pragma unroll
      for (int e = 0; e < 8; ++e) vv[e] += (vf[e] - vv[e]) * sigmoidf_(v[e] + v0[col + e]);
      *(uint4*)(p.V + idx) = pack8(vv);
    });
  }
}

constexpr int RCH = 32;
__device__ __forceinline__ int scan_pos(int dir, int s) { return dir == 0 ? s : (s < CTX ? CTX - 1 - s : TT + CTX - 1 - s); }

__device__ __forceinline__ void phase_rw_scan(const Params& p, int j, char* smem) {
  float* op = (float*)smem;
  float* vv = op + RCH * 4 * 64;
  float* sc = vv + RCH * 64;
  float* LWs = sc + RCH * 2;
  float* AAs = LWs + RCH * 64;
  float* yb = AAs;
  bf16_t* LRs = (bf16_t*)(AAs + RCH * 64);
  const int tid = opaque_tid(), lane = tid & 63, w = tid >> 6;
  const int ptau = tid >> 3, pc8 = (tid & 7) * 8;
  const int r2 = lane >> 3, ko = (lane & 7) * 8;
  const int row0 = w * 16 + r2, row1 = row0 + 8;
  for (int unit = blockIdx.x; unit < GB * 64; unit += gridDim.x) {
    const int bl = unit >> 6, h = (unit >> 1) & 31, dir = unit & 1;
    bf16_t* Y = dir == 0 ? p.YF : p.YB;
    float pkk[8], pka[8], prk[8];
#pragma unroll
    for (int e = 0; e < 8; ++e) {
      const int cc = j * DI + h * 64 + pc8 + e;
      pkk[e] = p.rw_kk[cc]; pka[e] = p.rw_ka[cc]; prk[e] = p.rw_rk[cc];
    }
    __syncthreads();
    const int mm = w >> 1, nh = w & 1;
    const float bias = (mm == 0 ? p.rw_w0 : p.rw_a0)[((size_t)j * 2 + dir) * DI + h * 64 + nh * 32 + (lane & 31)];
    bf16x8 wfr[4];
    {
      const bf16_t* w2g = g_wt + (mm == 0 ? OFF_W2 : OFF_A2) + (((size_t)j * 2 + dir) * DI + h * 64 + nh * 32 + (lane & 31)) * 64 + (lane >> 5) * 8;
#pragma unroll
      for (int kk = 0; kk < 4; ++kk) wfr[kk] = *(const bf16x8*)(w2g + kk * 16);
    }
    f2_t S0[4], S1[4];
#pragma unroll
    for (int e = 0; e < 4; ++e) { S0[e] = f2_t{0.f, 0.f}; S1[e] = f2_t{0.f, 0.f}; }
    uint4 gr, gk, gv, gl0, gl1;
    const int lmat = (tid & 7) >> 2, lcol = (tid & 3) * 16;
    const size_t ubase = (size_t)bl * TT * DI + h * 64 + pc8;
    const bf16_t* const rp = p.R + ubase;
    const bf16_t* const kp = p.K + ubase;
    const bf16_t* const vp_ = p.V + ubase;
    const bf16_t* const lrp = (lmat == 0 ? p.LRW : p.LRA) + (size_t)bl * TT * 128 + dir * 64 + lcol;
    auto gload = [&](int chunk) {
      const int pos = scan_pos(dir, chunk * RCH + ptau);
      const size_t o = (size_t)pos * DI;
      gr = *(const uint4*)(rp + o); gk = *(const uint4*)(kp + o); gv = *(const uint4*)(vp_ + o);
      const bf16_t* lr = lrp + (size_t)pos * 128;
      gl0 = *(const uint4*)(lr); gl1 = *(const uint4*)(lr + 8);
    };
    gload(0);
    for (int chunk = 0; chunk < TT / RCH; ++chunk) {
      *(uint4*)(LRs + (lmat * RCH + ptau) * 72 + lcol) = gl0;
      *(uint4*)(LRs + (lmat * RCH + ptau) * 72 + lcol + 8) = gl1;
      lds_barrier();
      {
        f32x16 acc;
#pragma unroll
        for (int r = 0; r < 16; ++r) acc[r] = 0.f;
#pragma unroll
        for (int kk = 0; kk < 4; ++kk) {
          const bf16x8 af = *(const bf16x8*)(LRs + (mm * RCH + (lane & 31)) * 72 + kk * 16 + (lane >> 5) * 8);
          acc = __builtin_amdgcn_mfma_f32_32x32x16_bf16(af, wfr[kk], acc, 0, 0, 0);
        }
        const int chn = nh * 32 + (lane & 31), hh = lane >> 5;
        if (mm == 0) {
          float lwv[16], pf[16], own[4], oth[4];
#pragma unroll
          for (int r = 0; r < 16; ++r) lwv[r] = -0.60653066f * sigmoidf_(acc[r] + bias);
#pragma unroll
          for (int g = 0; g < 4; ++g) {
            pf[g * 4] = lwv[g * 4];
            pf[g * 4 + 1] = pf[g * 4] + lwv[g * 4 + 1];
            pf[g * 4 + 2] = pf[g * 4 + 1] + lwv[g * 4 + 2];
            pf[g * 4 + 3] = pf[g * 4 + 2] + lwv[g * 4 + 3];
            own[g] = pf[g * 4 + 3];
            oth[g] = __shfl_xor(own[g], 32);
          }
          float base = 0.f;
#pragma unroll
          for (int g = 0; g < 4; ++g) {
            const float off = base + (hh ? oth[g] : 0.f);
#pragma unroll
            for (int q = 0; q < 4; ++q) {
              const int t = q + 8 * g + 4 * hh;
              const float c = off + pf[g * 4 + q];
              LWs[t * 64 + chn] = c;
            }
            base += own[g] + oth[g];
          }
        } else {
#pragma unroll
          for (int r = 0; r < 16; ++r) {
            const int t = (r & 3) + 8 * (r >> 2) + 4 * hh;
            AAs[t * 64 + chn] = sigmoidf_(acc[r] + bias);
          }
        }
      }
      lds_barrier();
      {
        float r[8], k[8], v[8], cm[8], cp[8], a[8];
        unpack8(gr, r); unpack8(gk, k); unpack8(gv, v);
#pragma unroll
        for (int e = 0; e < 8; ++e) {
          cm[e] = LWs[ptau * 64 + pc8 + e]; cp[e] = ptau > 0 ? LWs[(ptau - 1) * 64 + pc8 + e] : 0.f; a[e] = AAs[ptau * 64 + pc8 + e];
        }
        float kkv[8], ss = 0.f;
#pragma unroll
        for (int e = 0; e < 8; ++e) { kkv[e] = k[e] * pkk[e]; ss += kkv[e] * kkv[e]; }
        ss = red8(ss);
        const float inv = rsqrtf(fmaxf(ss, 1e-24f));
        float br = 0.f, kr = 0.f, bon = 0.f;
        float o0[8], o1[8], o2[8], o3[8];
#pragma unroll
        for (int e = 0; e < 8; ++e) {
          const float kkn = kkv[e] * inv;
          const float P = __expf(cm[e]), Pp = __expf(cp[e]);
          const float iP = rcpf_(P);
          const float kd = k[e] * (1.f + (a[e] - 1.f) * pka[e]);
          const float bb = kkn * a[e];
          o0[e] = -kkn * Pp; o1[e] = r[e] * P; o2[e] = bb * iP; o3[e] = kd * iP;
          br += bb * r[e]; kr += kd * r[e]; bon += r[e] * kd * prk[e];
        }
        br = red8(br); kr = red8(kr); bon = red8(bon);
        float* od = op + ptau * 256 + pc8;
        *(float4*)(od) = make_float4(o0[0], o0[1], o0[2], o0[3]); *(float4*)(od + 4) = make_float4(o0[4], o0[5], o0[6], o0[7]);
        *(float4*)(od + 64) = make_float4(o1[0], o1[1], o1[2], o1[3]); *(float4*)(od + 68) = make_float4(o1[4], o1[5], o1[6], o1[7]);
        *(float4*)(od + 128) = make_float4(o2[0], o2[1], o2[2], o2[3]); *(float4*)(od + 132) = make_float4(o2[4], o2[5], o2[6], o2[7]);
        *(float4*)(od + 192) = make_float4(o3[0], o3[1], o3[2], o3[3]); *(float4*)(od + 196) = make_float4(o3[4], o3[5], o3[6], o3[7]);
        float* vd = vv + ptau * 64 + pc8;
        *(float4*)(vd) = make_float4(v[0], v[1], v[2], v[3]); *(float4*)(vd + 4) = make_float4(v[4], v[5], v[6], v[7]);
        if ((tid & 7) == 0) {
          sc[ptau * 2] = br; sc[ptau * 2 + 1] = kr;
          const int pos = scan_pos(dir, chunk * RCH + ptau);
          p.BN[((size_t)dir * NTG + (size_t)bl * TT + pos) * 32 + h] = bon;
        }
      }
      lds_barrier();
      if (chunk + 1 < TT / RCH) gload(chunk + 1);
      {
        struct StepOps { float4 n0, n1, q0, q1, b0, b1, k0, k1; float v0, v1; float2 s; };
        auto ldops = [&](StepOps& o, int tau) {
          const float* ob = op + tau * 256 + ko;
          o.n0 = *(const float4*)(ob); o.n1 = *(const float4*)(ob + 4);
          o.q0 = *(const float4*)(ob + 64); o.q1 = *(const float4*)(ob + 68);
          o.b0 = *(const float4*)(ob + 128); o.b1 = *(const float4*)(ob + 132);
          o.k0 = *(const float4*)(ob + 192); o.k1 = *(const float4*)(ob + 196);
          o.v0 = vv[tau * 64 + row0]; o.v1 = vv[tau * 64 + row1];
          o.s = *(const float2*)(sc + tau * 2);
        };
        auto dostep = [&](const StepOps& o, int tau) {
          const float nk[8] = {o.n0.x, o.n0.y, o.n0.z, o.n0.w, o.n1.x, o.n1.y, o.n1.z, o.n1.w};
          const float rr[8] = {o.q0.x, o.q0.y, o.q0.z, o.q0.w, o.q1.x, o.q1.y, o.q1.z, o.q1.w};
          const float bb[8] = {o.b0.x, o.b0.y, o.b0.z, o.b0.w, o.b1.x, o.b1.y, o.b1.z, o.b1.w};
          const float kd[8] = {o.k0.x, o.k0.y, o.k0.z, o.k0.w, o.k1.x, o.k1.y, o.k1.z, o.k1.w};
          f2_t a10 = {0.f, 0.f}, a11 = {0.f, 0.f}, a20 = {0.f, 0.f}, a21 = {0.f, 0.f};
#pragma unroll
          for (int e = 0; e < 4; ++e) {
            const f2_t nk2 = {nk[2 * e], nk[2 * e + 1]}, rr2 = {rr[2 * e], rr[2 * e + 1]};
            a10 = __builtin_elementwise_fma(S0[e], nk2, a10); a11 = __builtin_elementwise_fma(S1[e], nk2, a11);
            a20 = __builtin_elementwise_fma(S0[e], rr2, a20); a21 = __builtin_elementwise_fma(S1[e], rr2, a21);
          }
          float d10 = a10.x + a10.y, d11 = a11.x + a11.y, d20 = a20.x + a20.y, d21 = a21.x + a21.y;
          d10 = red8(d10); d11 = red8(d11); d20 = red8(d20); d21 = red8(d21);
          const float y0 = d20 + d10 * o.s.x + o.v0 * o.s.y;
          const float y1 = d21 + d11 * o.s.x + o.v1 * o.s.y;
          const f2_t sa0 = {d10, d10}, sa1 = {d11, d11}, vv0 = {o.v0, o.v0}, vv1 = {o.v1, o.v1};
#pragma unroll
          for (int e = 0; e < 4; ++e) {
            const f2_t bb2 = {bb[2 * e], bb[2 * e + 1]}, kd2 = {kd[2 * e], kd[2 * e + 1]};
            S0[e] = __builtin_elementwise_fma(sa0, bb2, __builtin_elementwise_fma(vv0, kd2, S0[e]));
            S1[e] = __builtin_elementwise_fma(sa1, bb2, __builtin_elementwise_fma(vv1, kd2, S1[e]));
          }
          if ((lane & 7) == 0) { yb[tau * 64 + row0] = y0; yb[tau * 64 + row1] = y1; }
        };
        StepOps oa, ob2;
        ldops(oa, 0);
#pragma unroll 1
        for (int tau = 0; tau < RCH; tau += 2) {
          ldops(ob2, tau + 1);
          dostep(oa, tau);
          ldops(oa, tau + 2);
          dostep(ob2, tau + 1);
        }
#pragma unroll
        for (int e = 0; e < 4; ++e) {
          const f2_t pc = {__expf(LWs[(RCH - 1) * 64 + ko + 2 * e]), __expf(LWs[(RCH - 1) * 64 + ko + 2 * e + 1])};
          S0[e] *= pc; S1[e] *= pc;
        }
      }
      lds_barrier();
      {
        const int pos = scan_pos(dir, chunk * RCH + ptau);
        const float* ys = yb + ptau * 64 + pc8;
        float yv[8];
#pragma unroll
        for (int e = 0; e < 8; ++e) yv[e] = ys[e];
        *(uint4*)(Y + ((size_t)bl * TT + pos) * DI + h * 64 + pc8) = pack8(yv);
      }
    }
    lds_barrier();
  }
}

__device__ __forceinline__ void phase_rw_gate(const Params& p, int j) {
  const int tid = opaque_tid(), h = tid >> 3;
  const int c0 = tid * 8;
  float lnw[8], lnb[8];
#pragma unroll
  for (int e = 0; e < 8; ++e) { lnw[e] = p.rw_lnw[j * DI + c0 + e]; lnb[e] = p.rw_lnb[j * DI + c0 + e]; }
  for (int tg = blockIdx.x; tg < NTG; tg += gridDim.x) {
    const size_t base = (size_t)tg * DI + c0;
    float yf[8], yb[8], v[8], z[8];
    unpack8(*(const uint4*)(p.YF + base), yf); unpack8(*(const uint4*)(p.YB + base), yb);
    unpack8(*(const uint4*)(p.V + base), v); unpack8(*(const uint4*)(p.Z + base), z);
    const float bon = p.BN[(size_t)tg * 32 + h] + p.BN[((size_t)NTG + tg) * 32 + h];
    float y[8], s = 0.f;
#pragma unroll
    for (int e = 0; e < 8; ++e) { y[e] = yf[e] + yb[e]; s += y[e]; }
    const float mu = red8(s) * (1.f / 64.f);
    float s2 = 0.f;
#pragma unroll
    for (int e = 0; e < 8; ++e) { y[e] -= mu; s2 += y[e] * y[e]; }
    const float rstd = rsqrtf(red8(s2) * (1.f / 64.f) + 64e-5f);
#pragma unroll
    for (int e = 0; e < 8; ++e) y[e] = (y[e] * rstd * lnw[e] + lnb[e] + bon * v[e]) * z[e];
    *(uint4*)(p.YF + base) = pack8(y);
  }
}

__device__ __forceinline__ void phase_out(const Params& p, const bf16_t* wo, char* smem) {
  for (int tile = blockIdx.x; tile < MT * 8; tile += gridDim.x) {
    const int mt = tile / 8, nt = tile % 8, m0 = mt * 128, n0 = nt * 128;
    const bf16_t* Bw = wo + (size_t)n0 * DI;
    gemm_tile<0>(p.YF, DI, nullptr, m0, DI, Bw, 128, smem,
                 [&](int row, int col, float* v) {
      float* o = p.O + (size_t)row * DM + n0 + col;
      *(float4*)o = make_float4(v[0], v[1], v[2], v[3]); *(float4*)(o + 4) = make_float4(v[4], v[5], v[6], v[7]); });
  }
}

__device__ __forceinline__ void phase_hg_proj(const Params& p, int j, char* smem) {
  const int layer = 2 * j + 1;
  for (int tile = blockIdx.x; tile < MT * 80; tile += gridDim.x) {
    const int mt = tile / 80, nt = tile % 80, m0 = mt * 128;
    const int seg = nt >> 4, n0 = (nt & 15) * 128;
    const bf16_t* Bw = g_wt + OFF_HWIN + ((size_t)j * 5 * DI + (size_t)seg * DI + n0) * DM;
    bf16_t* dst = seg == 0 ? p.R : (seg == 1 ? p.K : (seg == 2 ? p.WF : (seg == 3 ? p.V : p.Z)));
    if (seg == 0 || seg == 4) {
      gemm_tile<0>(p.H, DM, nullptr, m0, DM, Bw, 128, smem, [&](int row, int col, float* v) {
#pragma unroll
        for (int e = 0; e < 8; ++e) v[e] = siluf_(v[e]);
        *(uint4*)(dst + (size_t)row * DI + n0 + col) = pack8(v); });
    } else if (seg == 3) {
      gemm_tile<0>(p.H, DM, nullptr, m0, DM, Bw, 128, smem,
                   [&](int row, int col, float* v) { *(uint4*)(dst + (size_t)row * DI + n0 + col) = pack8(v); });
    } else {
      const float* lbp = p.LB + layer * DI + n0;
      gemm_tile<0>(p.H, DM, nullptr, m0, DM, Bw, 128, smem, [&](int row, int col, float* v) {
        const float4 l0 = *(const float4*)(lbp + col), l1 = *(const float4*)(lbp + col + 4);
        const float lb[8] = {l0.x, l0.y, l0.z, l0.w, l1.x, l1.y, l1.z, l1.w};
#pragma unroll
        for (int e = 0; e < 8; ++e) v[e] = __logf(lb[e] + (1.f - lb[e]) * sigmoidf_(v[e]));
        *(uint4*)(dst + (size_t)row * DI + n0 + col) = pack8(v); });
    }
  }
}

constexpr int HC = 32;
constexpr int QS = 136;
constexpr int SS = 40;
__device__ __forceinline__ void phase_hg_scan(const Params& p, int layer, char* smem) {
  bf16_t* qe = (bf16_t*)smem;
  bf16_t* ke = qe + HC * QS;
  bf16_t* kdT = ke + HC * QS;
  bf16_t* vT = kdT + 128 * SS;
  bf16_t* att = vT + 64 * SS;
  bf16_t* ST = att + HC * SS;
  float* dC = (float*)(ST + 64 * QS);
  const int tid = opaque_tid(), lane = tid & 63, w = tid >> 6;
  for (int unit = blockIdx.x; unit < GB * 64; unit += gridDim.x) {
    const int vs = unit & 1, dir = (unit >> 1) & 1, h = (unit >> 2) & 15, bl = unit >> 6;
    const bf16_t* FL = dir == 0 ? p.K : p.WF;
    bf16_t* Y = dir == 0 ? p.YF : p.YB;
    const int st = lane & 31, cg = w * 2 + (lane >> 5), kb = cg * 16, vb = cg * 8;
    f32x16 sacc[2];
#pragma unroll
    for (int r = 0; r < 16; ++r) { sacc[0][r] = 0.f; sacc[1][r] = 0.f; }
    __syncthreads();
    for (int idx = tid; idx < 64 * QS / 2; idx += 256) ((unsigned*)ST)[idx] = 0u;
    uint4 gq0, gq1, gf0, gf1, gvv;
    const size_t ubase = (size_t)bl * TT * DI + h * 128;
    const bf16_t* const qp = p.R + ubase + kb;
    const bf16_t* const fp_ = FL + ubase + kb;
    const bf16_t* const ip = p.V + ubase + vs * 64 + vb;
    auto gload = [&](int chunk) {
      const int pos = scan_pos(dir, chunk * HC + st);
      const size_t o = (size_t)pos * DI;
      gq0 = *(const uint4*)(qp + o); gq1 = *(const uint4*)(qp + o + 8);
      gf0 = *(const uint4*)(fp_ + o); gf1 = *(const uint4*)(fp_ + o + 8);
      gvv = *(const uint4*)(ip + o);
    };
    gload(0);
    for (int chunk = 0; chunk < TT / HC; ++chunk) {
      float q[16], cum[16], one[16];
      {
        unpack8(gq0, q); unpack8(gq1, q + 8); unpack8(gf0, cum); unpack8(gf1, cum + 8);
#pragma unroll
        for (int e = 0; e < 16; ++e) {
          float c = cum[e];
          one[e] = 1.f - __expf(c);
          c += __int_as_float(__builtin_amdgcn_update_dpp(0, __float_as_int(c), 0x111, 0xf, 0xf, false));
          c += __int_as_float(__builtin_amdgcn_update_dpp(0, __float_as_int(c), 0x112, 0xf, 0xf, false));
          c += __int_as_float(__builtin_amdgcn_update_dpp(0, __float_as_int(c), 0x114, 0xf, 0xf, false));
          c += __int_as_float(__builtin_amdgcn_update_dpp(0, __float_as_int(c), 0x118, 0xf, 0xf, false));
          c += __int_as_float(__builtin_amdgcn_update_dpp(0, __float_as_int(c), 0x142, 0xa, 0xf, false));
          cum[e] = c;
        }
      }
      const uint4 vreg = gvv;
      lds_barrier();
      {
        float qo[16], ko[16];
#pragma unroll
        for (int e = 0; e < 16; ++e) {
          const float c31 = __int_as_float(__builtin_amdgcn_readlane(__float_as_int(cum[e]), 31));
          const float c63 = __int_as_float(__builtin_amdgcn_readlane(__float_as_int(cum[e]), 63));
          const float cC = (lane >> 5) ? c63 : c31;
          const float ec = __expf(fmaxf(cum[e], -80.f));
          const float inv = rcpf_(ec);
          const float eC = __expf(cC);
          qo[e] = q[e] * ec;
          ko[e] = one[e] * inv;
          kdT[(kb + e) * SS + st] = f2bf(one[e] * inv * eC);
          if (st == 31) dC[kb + e] = eC;
        }
        *(uint4*)(qe + st * QS + kb) = pack8(qo); *(uint4*)(qe + st * QS + kb + 8) = pack8(qo + 8);
        *(uint4*)(ke + st * QS + kb) = pack8(ko); *(uint4*)(ke + st * QS + kb + 8) = pack8(ko + 8);
        const bf16_t* vp = (const bf16_t*)&vreg;
#pragma unroll
        for (int e = 0; e < 8; ++e) vT[(vb + e) * SS + st] = vp[e];
      }
      lds_barrier();
      if (chunk + 1 < TT / HC) gload(chunk + 1);
      {
        const int mi = w >> 1, ni = w & 1;
        f32x4 a4 = {0.f, 0.f, 0.f, 0.f};
#pragma unroll
        for (int kk = 0; kk < 4; ++kk) {
          const bf16x8 af = *(const bf16x8*)(qe + (mi * 16 + (lane & 15)) * QS + kk * 32 + (lane >> 4) * 8);
          const bf16x8 bf = *(const bf16x8*)(ke + (ni * 16 + (lane & 15)) * QS + kk * 32 + (lane >> 4) * 8);
          a4 = __builtin_amdgcn_mfma_f32_16x16x32_bf16(af, bf, a4, 0, 0, 0);
        }
        const int s = ni * 16 + (lane & 15);
#pragma unroll
        for (int r = 0; r < 4; ++r) {
          const int t = mi * 16 + (lane >> 4) * 4 + r;
          att[t * SS + s] = f2bf(s <= t ? a4[r] : 0.f);
        }
      }
      lds_barrier();
      {
#pragma unroll
        for (int mh = 0; mh < 2; ++mh) {
          f32x4 y4 = {0.f, 0.f, 0.f, 0.f};
          {
            const bf16x8 af = *(const bf16x8*)(att + (mh * 16 + (lane & 15)) * SS + (lane >> 4) * 8);
            const bf16x8 bf = *(const bf16x8*)(vT + (w * 16 + (lane & 15)) * SS + (lane >> 4) * 8);
            y4 = __builtin_amdgcn_mfma_f32_16x16x32_bf16(af, bf, y4, 0, 0, 0);
          }
#pragma unroll
          for (int kk = 0; kk < 4; ++kk) {
            const bf16x8 af = *(const bf16x8*)(qe + (mh * 16 + (lane & 15)) * QS + kk * 32 + (lane >> 4) * 8);
            const bf16x8 bf = *(const bf16x8*)(ST + (w * 16 + (lane & 15)) * QS + kk * 32 + (lane >> 4) * 8);
            y4 = __builtin_amdgcn_mfma_f32_16x16x32_bf16(af, bf, y4, 0, 0, 0);
          }
#pragma unroll
          for (int r = 0; r < 4; ++r) {
            const int t = mh * 16 + (lane >> 4) * 4 + r;
            const int pos = scan_pos(dir, chunk * HC + t);
            Y[((size_t)bl * TT + pos) * DI + h * 128 + vs * 64 + w * 16 + (lane & 15)] = f2bf(y4[r]);
          }
        }
      }
      lds_barrier();
      {
        float dk[16];
#pragma unroll
        for (int r = 0; r < 16; ++r) dk[r] = dC[w * 32 + (r & 3) + 8 * (r >> 2) + 4 * (lane >> 5)];
#pragma unroll
        for (int nt = 0; nt < 2; ++nt) {
#pragma unroll
          for (int r = 0; r < 16; ++r) sacc[nt][r] *= dk[r];
#pragma unroll
          for (int ks = 0; ks < 2; ++ks) {
            const bf16x8 af = *(const bf16x8*)(kdT + (w * 32 + (lane & 31)) * SS + ks * 16 + (lane >> 5) * 8);
            const bf16x8 bf = *(const bf16x8*)(vT + (nt * 32 + (lane & 31)) * SS + ks * 16 + (lane >> 5) * 8);
            sacc[nt] = __builtin_amdgcn_mfma_f32_32x32x16_bf16(af, bf, sacc[nt], 0, 0, 0);
          }
#pragma unroll
          for (int gq = 0; gq < 4; ++gq) {
            uint2 u;
            u.x = pack2(sacc[nt][gq * 4 + 0], sacc[nt][gq * 4 + 1]);
            u.y = pack2(sacc[nt][gq * 4 + 2], sacc[nt][gq * 4 + 3]);
            *(uint2*)(ST + (nt * 32 + (lane & 31)) * QS + w * 32 + gq * 8 + (lane >> 5) * 4) = u;
          }
        }
      }
    }
    lds_barrier();
  }
}

__device__ __forceinline__ void phase_hg_gate(const Params& p, int j) {
  const int tid = opaque_tid();
  const int c0 = tid * 8;
  float gn[8];
#pragma unroll
  for (int e = 0; e < 8; ++e) gn[e] = p.hg_gn[j * 128 + ((c0 + e) & 127)];
  for (int tg = blockIdx.x; tg < NTG; tg += gridDim.x) {
    const size_t base = (size_t)tg * DI + c0;
    float yf[8], yb[8], z[8];
    unpack8(*(const uint4*)(p.YF + base), yf); unpack8(*(const uint4*)(p.YB + base), yb);
    unpack8(*(const uint4*)(p.Z + base), z);
    float y[8], s2 = 0.f;
#pragma unroll
    for (int e = 0; e < 8; ++e) { y[e] = yf[e] + yb[e]; s2 += y[e] * y[e]; }
    const float rstd = rsqrtf(red16(s2) * (1.f / 128.f) + EPS);
#pragma unroll
    for (int e = 0; e < 8; ++e) y[e] = y[e] * rstd * gn[e] * z[e];
    *(uint4*)(p.YF + base) = pack8(y);
  }
}

__global__ void __launch_bounds__(256, 2) fwd_megakernel(Params p) {
  cg::grid_group grid = cg::this_grid();
  __shared__ __attribute__((aligned(16))) char smem[78 * 1024];
  __shared__ uint4 xb_words;
  if (threadIdx.x == 0) xb_words = make_uint4(0u, 0u, 0u, 0u);
  __syncthreads();
  XcdBarrier xb = xcd_barrier_post(p.bar, (volatile LAS unsigned*)&xb_words);
  phase_mod(p, smem);
  phase_wconv(p, smem);
  grid.sync();
  for (int g = 0; g < NG; ++g) {
    for (int layer = 0; layer < 4; ++layer) {
      phase_resnorm(p, g, layer - 1, layer);
      xcd_barrier(xb);
      const int j = layer >> 1;
      if ((layer & 1) == 0) {
        phase_rw_proj(p, j, smem, 0, blockIdx.x, gridDim.x);
        xcd_barrier(xb);
        if (j == 1) { phase_rw_lr2(p, j, smem); xcd_barrier(xb); }
        if (gridDim.x >= 2 * GB * 64) {
          if (blockIdx.x < GB * 64) phase_rw_scan(p, j, smem);
          else phase_rw_proj(p, j, smem, 1, blockIdx.x - GB * 64, gridDim.x - GB * 64);
        } else {
          phase_rw_scan(p, j, smem);
          phase_rw_proj(p, j, smem, 1, blockIdx.x, gridDim.x);
        }
        xcd_barrier(xb);
        phase_rw_gate(p, j);
        xcd_barrier(xb);
        phase_out(p, g_wt + OFF_RWO + (size_t)j * DM * DI, smem);
        xcd_barrier(xb);
      } else {
        phase_hg_proj(p, j, smem);
        xcd_barrier(xb);
        phase_hg_scan(p, layer, smem);
        xcd_barrier(xb);
        phase_hg_gate(p, j);
        xcd_barrier(xb);
        phase_out(p, g_wt + OFF_HWO + (size_t)j * DM * DI, smem);
        xcd_barrier(xb);
      }
    }
    phase_resnorm(p, g, 3, -1);
    xcd_barrier(xb);
  }
}

extern "C" void kernel_launch(void* const* d_in, const int* in_sizes, int n_in, void* d_out, int out_size, void* d_ws,
                              size_t ws_size, hipStream_t stream) {
  static int grid_blocks = 0;
  if (!grid_blocks) {
    int dev = 0, cus = 0, per_cu = 0;
    hipGetDevice(&dev);
    hipDeviceGetAttribute(&cus, hipDeviceAttributeMultiprocessorCount, dev);
    hipOccupancyMaxActiveBlocksPerMultiprocessor(&per_cu, fwd_megakernel, 256, 0);
    if (per_cu > 2) per_cu = 2;
    grid_blocks = cus * per_cu;
  }
  Params p{};
  const float** fp = (const float**)&p;
  for (int i = 0; i < 29; ++i) fp[i] = (const float*)d_in[i];
  p.out = (float*)d_out;
  char* w = (char*)d_ws;
  size_t off = 0;
  auto take = [&](size_t bytes) { char* r = w + off; off += (bytes + 255) & ~(size_t)255; return r; };
  const size_t DIW = (size_t)NTG * DI * 2;
  p.R = (bf16_t*)take(DIW); p.K = (bf16_t*)take(DIW); p.V = (bf16_t*)take(DIW); p.Z = (bf16_t*)take(DIW);
  p.WF = (bf16_t*)take(DIW); p.YF = (bf16_t*)take(DIW); p.YB = (bf16_t*)take(DIW);
  p.VF = p.YF;
  p.H = p.YB;
  p.HR = p.WF; p.HR0 = p.WF + (size_t)NTG * DM;
  p.LRW = (bf16_t*)take((size_t)NTG * 128 * 2); p.LRA = (bf16_t*)take((size_t)NTG * 128 * 2);
  p.LRV = (bf16_t*)take((size_t)NTG * 32 * 2);
  p.O = (float*)p.R;
  p.BN = (float*)take((size_t)2 * NTG * 32 * 4);
  p.CTXB = (float*)take((size_t)NB * CTX * DM * 4);
  p.MODV = (float*)take((size_t)4 * 9 * 3 * DM * 4);
  p.LB = (float*)take((size_t)4 * DI * 4);
  p.bar = (unsigned*)take((size_t)XCD_BAR_WORDS * 4);
  if (off > ws_size) { fprintf(stderr, "workspace too small: need %zu have %zu\n", off, ws_size); return; }
  hipMemsetAsync(p.bar, 0, (size_t)XCD_BAR_WORDS * 4, stream);
  void* args[] = {&p};
  hipError_t e = hipLaunchCooperativeKernel((void*)fwd_megakernel, dim3(grid_blocks), dim3(256), args, 0, stream);
  if (e != hipSuccess) fprintf(stderr, "cooperative launch failed: %s (grid %d)\n", hipGetErrorString(e), grid_blocks);
}
```

```cpp
#include <hip/hip_runtime.h>
#include <hip/hip_cooperative_groups.h>
#include <cstdio>
#include <cstdint>
namespace cg = cooperative_groups;

typedef unsigned short bf16_t;
using bf16x8 = __attribute__((ext_vector_type(8))) short;
using f32x16 = __attribute__((ext_vector_type(16))) float;
using f32x4 = __attribute__((ext_vector_type(4))) float;
using f2_t = __attribute__((ext_vector_type(2))) float;

constexpr int NB = 8, SEQ = 4096, CTX = 256, TT = 4352, DM = 1024, DI = 2048;
constexpr int GB = 4, NG = NB / GB, NTG = GB * TT;
constexpr int MT = NTG / 128;
constexpr float EPS = 1e-6f;

constexpr size_t OFF_PROJ = 0;
constexpr size_t OFF_RWO = OFF_PROJ + (size_t)2 * 4 * DI * DM;
constexpr size_t OFF_W1 = OFF_RWO + (size_t)2 * DM * DI;
constexpr size_t OFF_A1 = OFF_W1 + (size_t)2 * 128 * DM;
constexpr size_t OFF_V1 = OFF_A1 + (size_t)2 * 128 * DM;
constexpr size_t OFF_V2 = OFF_V1 + (size_t)32 * DM;
constexpr size_t OFF_HWIN = OFF_V2 + (size_t)DI * 32;
constexpr size_t OFF_HWO = OFF_HWIN + (size_t)2 * 5 * DI * DM;
constexpr size_t OFF_W2 = OFF_HWO + (size_t)2 * DM * DI;
constexpr size_t OFF_A2 = OFF_W2 + (size_t)4 * DI * 64;
constexpr size_t WT_TOTAL = OFF_A2 + (size_t)4 * DI * 64;
__device__ bf16_t g_wt[WT_TOTAL];

struct Params {
  const float *x, *c, *ctx, *c_ctx, *mod_w, *mod_b, *pre_g, *post_g, *rw_mix, *rw_proj, *rw_wo, *rw_w0, *rw_w1,
      *rw_w2, *rw_a0, *rw_a1, *rw_a2, *rw_v0, *rw_v1, *rw_v2, *rw_kk, *rw_ka, *rw_rk, *rw_lnw, *rw_lnb, *hg_win,
      *hg_wo, *hg_gn, *hg_lb;
  float* out;
  bf16_t *R, *K, *V, *Z, *WF, *YF, *YB, *VF, *H, *HR, *HR0, *LRW, *LRA, *LRV;
  float *O, *BN, *CTXB, *MODV, *LB;
  unsigned* bar;
};

typedef __bf16 hwbf2_t __attribute__((ext_vector_type(2)));
typedef float hwf2_t __attribute__((ext_vector_type(2)));
__device__ __forceinline__ unsigned pack2(float a, float b) {
  hwf2_t f = {a, b};
  hwbf2_t h = __builtin_convertvector(f, hwbf2_t);
  return __builtin_bit_cast(unsigned, h);
}
__device__ __forceinline__ bf16_t f2bf(float f) { return (bf16_t)(pack2(f, f) & 0xffffu); }
__device__ __forceinline__ float bf2f(bf16_t h) { return __uint_as_float(((unsigned)h) << 16); }
typedef _Float16 h2_t __attribute__((ext_vector_type(2)));
using f16x8 = __attribute__((ext_vector_type(8))) _Float16;
__device__ __forceinline__ unsigned pack2h(float a, float b) {
  h2_t h = {(_Float16)a, (_Float16)b};
  return __builtin_bit_cast(unsigned, h);
}
__device__ __forceinline__ uint4 pack8h(const float* f) {
  uint4 u; u.x = pack2h(f[0], f[1]); u.y = pack2h(f[2], f[3]); u.z = pack2h(f[4], f[5]); u.w = pack2h(f[6], f[7]);
  return u;
}
__device__ __forceinline__ unsigned mixh2(unsigned h, unsigned n, unsigned m) {
  const h2_t hv = __builtin_bit_cast(h2_t, h), nv = __builtin_bit_cast(h2_t, n), mv = __builtin_bit_cast(h2_t, m);
  const h2_t r = hv + (nv - hv) * mv;
  return __builtin_bit_cast(unsigned, r);
}
__device__ __forceinline__ float lo2f(unsigned u) { return __uint_as_float(u << 16); }
__device__ __forceinline__ float hi2f(unsigned u) { return __uint_as_float(u & 0xffff0000u); }
__device__ __forceinline__ float rcpf_(float x) { return __builtin_amdgcn_rcpf(x); }
__device__ __forceinline__ float sigmoidf_(float x) { return rcpf_(1.f + __expf(-x)); }
__device__ __forceinline__ float siluf_(float x) { return x * rcpf_(1.f + __expf(-x)); }
__device__ __forceinline__ float tanhf_(float x) { return 1.f - 2.f * rcpf_(1.f + __expf(2.f * x)); }

__device__ __forceinline__ void lds_barrier() { asm volatile("s_waitcnt lgkmcnt(0)\n\ts_barrier" ::: "memory"); }

__device__ __forceinline__ int opaque_tid() { int t = threadIdx.x; asm volatile("" : "+v"(t)); return t; }

template <int CTRL>
__device__ __forceinline__ float dppf(float v) {
  return __int_as_float(__builtin_amdgcn_update_dpp(0, __float_as_int(v), CTRL, 0xf, 0xf, true));
}
__device__ __forceinline__ float red4(float v) { v += dppf<0xB1>(v); v += dppf<0x4E>(v); return v; }
__device__ __forceinline__ float red8(float v) { v = red4(v); v += dppf<0x141>(v); return v; }
__device__ __forceinline__ float red16(float v) { v = red8(v); v += dppf<0x140>(v); return v; }
__device__ __forceinline__ float red64(float v) {
  v = red16(v);
  v += __shfl_xor(v, 16);
  v += __shfl_xor(v, 32);
  return v;
}

__device__ __forceinline__ void unpack8(const uint4& u, float* f) {
  f[0] = lo2f(u.x); f[1] = hi2f(u.x); f[2] = lo2f(u.y); f[3] = hi2f(u.y);
  f[4] = lo2f(u.z); f[5] = hi2f(u.z); f[6] = lo2f(u.w); f[7] = hi2f(u.w);
}
__device__ __forceinline__ uint4 pack8(const float* f) {
  uint4 u; u.x = pack2(f[0], f[1]); u.y = pack2(f[2], f[3]); u.z = pack2(f[4], f[5]); u.w = pack2(f[6], f[7]);
  return u;
}


#define XB_TMO      128
#define XB_XCNT(j)  (256  + 64 * (j))
#define XB_XSUB(j)  (1280 + 64 * (j))
#define XB_XGEN(j)  (2304 + 64 * (j))
#define XB_TOP      3328
#define XB_TOPGEN   3392
#define XCD_BAR_WORDS 3456
#define XB_SPIN_CAP (1u << 23)
#define LAS __attribute__((address_space(3)))
__device__ __forceinline__ unsigned xb_ld(unsigned* p)              { return __hip_atomic_load(p, __ATOMIC_RELAXED, __HIP_MEMORY_SCOPE_AGENT); }
__device__ __forceinline__ unsigned xb_add(unsigned* p, unsigned v) { return __hip_atomic_fetch_add(p, v, __ATOMIC_RELAXED, __HIP_MEMORY_SCOPE_AGENT); }
__device__ __forceinline__ unsigned xb_xcc_id() { return (unsigned)__builtin_amdgcn_s_getreg((3 << 11) | 20) & 0xFu; }
#define XB_SPIN(cond, bar) do { unsigned _sp = 0; while (cond) { __builtin_amdgcn_s_sleep(1); \
    if ((++_sp & 255u) == 0u) { if (xb_ld(&(bar)[XB_TMO])) break; if (_sp > XB_SPIN_CAP) { atomicAdd(&(bar)[XB_TMO], 1u); break; } } } } while (0)
struct XcdBarrier { unsigned* bar; unsigned x; volatile LAS unsigned* st; };
__device__ __forceinline__ XcdBarrier xcd_barrier_post(unsigned* bar, volatile LAS unsigned* st) {
  XcdBarrier b; b.bar = bar; b.x = xb_xcc_id(); b.st = st;
  if (threadIdx.x == 0) (void)xb_add(&bar[XB_XCNT(b.x)], 1u);
  return b;
}
__device__ __forceinline__ void xcd_barrier_complete(unsigned* bar, unsigned x, unsigned& nloc, unsigned& nx) {
  const unsigned G = gridDim.x * gridDim.y * gridDim.z;
  unsigned sum, cnt, mine, sp = 0u;
  for (;;) {
    sum = 0u; cnt = 0u; mine = 0u;
#pragma unroll
    for (unsigned j = 0; j < 16; ++j) { const unsigned c = xb_ld(&bar[XB_XCNT(j)]); sum += c; cnt += (c > 0u) ? 1u : 0u; mine = (j == x) ? c : mine; }
    if (sum == G) break;
    __builtin_amdgcn_s_sleep(1);
    if ((++sp & 255u) == 0u) { if (xb_ld(&bar[XB_TMO])) break; if (sp > XB_SPIN_CAP) { atomicAdd(&bar[XB_TMO], 1u); break; } }
  }
  nloc = mine > 0u ? mine : 1u; nx = cnt > 0u ? cnt : 1u;
}
__device__ __forceinline__ void xcd_barrier(const XcdBarrier& b) {
  asm volatile("s_waitcnt vmcnt(0)" ::: "memory");
  __syncthreads();
  if (threadIdx.x == 0) {
    unsigned* bar = b.bar;
    __builtin_amdgcn_s_waitcnt(0);
    unsigned nloc = b.st[0], nx = b.st[1];
    if (nloc == 0u) { xcd_barrier_complete(bar, b.x, nloc, nx); b.st[0] = nloc; b.st[1] = nx; }
    const unsigned old = xb_add(&bar[XB_XSUB(b.x)], 1u);
    const unsigned gen = old / nloc;
    if (old + 1u == (gen + 1u) * nloc) {
      __builtin_amdgcn_fence(__ATOMIC_RELEASE, "agent");
      asm volatile("s_waitcnt vmcnt(0)" ::: "memory");
      const unsigned og = xb_add(&bar[XB_TOP], 1u);
      const unsigned tg = og / nx;
      if (og + 1u == (tg + 1u) * nx) xb_add(&bar[XB_TOPGEN], 1u);
      else XB_SPIN(xb_ld(&bar[XB_TOPGEN]) == tg, bar);
      __builtin_amdgcn_fence(__ATOMIC_ACQUIRE, "agent");
      xb_add(&bar[XB_XGEN(b.x)], 1u);
      asm volatile("s_waitcnt vmcnt(0)" ::: "memory");
    } else {
      XB_SPIN(xb_ld(&bar[XB_XGEN(b.x)]) == gen, bar);
      __builtin_amdgcn_fence(__ATOMIC_ACQUIRE, "agent");
      asm volatile("s_waitcnt vmcnt(0)" ::: "memory");
    }
  }
  __syncthreads();
}

__device__ __forceinline__ const float* row_in(const Params& p, int b, int t) {
  return t < CTX ? p.ctx + ((size_t)b * CTX + t) * DM : p.x + ((size_t)b * SEQ + (t - CTX)) * DM;
}
__device__ __forceinline__ float* row_cur(const Params& p, int b, int t) {
  return t < CTX ? p.CTXB + ((size_t)b * CTX + t) * DM : p.out + ((size_t)b * SEQ + (t - CTX)) * DM;
}

__device__ __forceinline__ void phase_mod(const Params& p, char* smem) {
  float* ssil = (float*)smem;
  float* red = ssil + 9 * DM;
  const int tid = opaque_tid(), cl = tid & 63, kp = tid >> 6;
  if (blockIdx.x < 4 * 48) {
    for (int idx = tid; idx < 9 * DM; idx += 256) {
      const int r = idx >> 10, k = idx & 1023;
      ssil[idx] = siluf_(r < 8 ? p.c[r * DM + k] : p.c_ctx[k]);
    }
    __syncthreads();
  }
  for (int task = blockIdx.x; task < 4 * 48; task += gridDim.x) {
    const int l = task / 48, col = (task % 48) * 64 + cl;
    float acc[9];
#pragma unroll
    for (int r = 0; r < 9; ++r) acc[r] = 0.f;
    const float* W = p.mod_w + (size_t)l * DM * 3 * DM + col;
#pragma unroll 4
    for (int k = kp * 256; k < kp * 256 + 256; ++k) {
      const float w = W[(size_t)k * 3 * DM];
#pragma unroll
      for (int r = 0; r < 9; ++r) acc[r] += ssil[r * DM + k] * w;
    }
    __syncthreads();
#pragma unroll
    for (int r = 0; r < 9; ++r) red[(kp * 9 + r) * 64 + cl] = acc[r];
    __syncthreads();
    for (int idx = tid; idx < 9 * 64; idx += 256) {
      const int r = idx >> 6, c2 = idx & 63;
      float s = 0.f;
      for (int q = 0; q < 4; ++q) s += red[(q * 9 + r) * 64 + c2];
      const int cc = (task % 48) * 64 + c2;
      p.MODV[((size_t)l * 9 + r) * 3 * DM + cc] = s + p.mod_b[l * 3 * DM + cc];
    }
  }
  for (int cidx = blockIdx.x * 256 + tid; cidx < DI; cidx += gridDim.x * 256) {
    float v[4], m = -1e30f;
    for (int l = 0; l < 4; ++l) { v[l] = p.hg_lb[l * DI + cidx]; m = fmaxf(m, v[l]); }
    float s = 0.f;
    for (int l = 0; l < 4; ++l) { v[l] = __expf(v[l] - m); s += v[l]; }
    float cum = 0.f;
    for (int l = 0; l < 4; ++l) { cum += v[l] / s; p.LB[l * DI + cidx] = cum - v[0] / s; }
  }
}

__device__ __forceinline__ void conv_matrix(const float* __restrict__ src, int K, int N, bf16_t* __restrict__ dst, char* smem, bool f16out = false) {
  float* ts = (float*)smem;
  const int tid = opaque_tid();
  const int ntn = N / 32, ntile = (K / 64) * ntn;
  for (int tile = blockIdx.x; tile < ntile; tile += gridDim.x) {
    const int k0 = (tile / ntn) * 64, n0 = (tile % ntn) * 32;
    __syncthreads();
#pragma unroll
    for (int i = 0; i < 2; ++i) {
      const int k = (tid >> 3) + 32 * i, n4 = (tid & 7) * 4;
      const float4 v = *(const float4*)(src + (size_t)(k0 + k) * N + n0 + n4);
      ts[k * 33 + n4 + 0] = v.x; ts[k * 33 + n4 + 1] = v.y; ts[k * 33 + n4 + 2] = v.z; ts[k * 33 + n4 + 3] = v.w;
    }
    __syncthreads();
    const int n = tid >> 3, k8 = (tid & 7) * 8;
    float f[8];
#pragma unroll
    for (int e = 0; e < 8; ++e) f[e] = ts[(k8 + e) * 33 + n];
    *(uint4*)(dst + (size_t)(n0 + n) * K + k0 + k8) = f16out ? pack8h(f) : pack8(f);
  }
}
__device__ __forceinline__ void phase_wconv(const Params& p, char* smem) {
  for (int m = 0; m < 8; ++m) conv_matrix(p.rw_proj + (size_t)m * DM * DI, DM, DI, g_wt + OFF_PROJ + (size_t)m * DI * DM, smem, true);
  for (int j = 0; j < 2; ++j) conv_matrix(p.rw_wo + (size_t)j * DI * DM, DI, DM, g_wt + OFF_RWO + (size_t)j * DM * DI, smem);
  for (int m = 0; m < 4; ++m) {
    conv_matrix(p.rw_w1 + (size_t)m * DM * 64, DM, 64, g_wt + OFF_W1 + (size_t)m * 64 * DM, smem, true);
    conv_matrix(p.rw_a1 + (size_t)m * DM * 64, DM, 64, g_wt + OFF_A1 + (size_t)m * 64 * DM, smem, true);
  }
  conv_matrix(p.rw_v1, DM, 32, g_wt + OFF_V1, smem, true);
  for (int m = 0; m < 4; ++m) {
    conv_matrix(p.rw_w2 + (size_t)m * 64 * DI, 64, DI, g_wt + OFF_W2 + (size_t)m * DI * 64, smem);
    conv_matrix(p.rw_a2 + (size_t)m * 64 * DI, 64, DI, g_wt + OFF_A2 + (size_t)m * DI * 64, smem);
  }
  for (int j = 0; j < 2; ++j) conv_matrix(p.hg_win + (size_t)j * DM * 5 * DI, DM, 5 * DI, g_wt + OFF_HWIN + (size_t)j * 5 * DI * DM, smem);
  for (int j = 0; j < 2; ++j) conv_matrix(p.hg_wo + (size_t)j * DI * DM, DI, DM, g_wt + OFF_HWO + (size_t)j * DM * DI, smem);
  for (int idx = blockIdx.x * 256 + opaque_tid(); idx < DI * 32; idx += gridDim.x * 256) {
    const int n = idx >> 5, k = idx & 31;
    g_wt[OFF_V2 + idx] = f2bf(p.rw_v2[(size_t)k * DI + n]);
  }
}

__device__ __forceinline__ void phase_resnorm(const Params& p, int g, int lu, int ln) {
  const int tid = opaque_tid();
  const int lane = tid & 63;
  const int wv = blockIdx.x * 4 + (tid >> 6), nw = gridDim.x * 4;
  for (int tg = wv; tg < NTG; tg += nw) {
    const int bl = tg / TT, t = tg % TT, b = g * GB + bl;
    const bool isctx = t < CTX;
    const int mrow = isctx ? 8 : b;
    float xv[16];
    const float* src = (lu <= 0) ? row_in(p, b, t) : row_cur(p, b, t);
#pragma unroll
    for (int j = 0; j < 4; ++j) {
      const float4 v4 = *(const float4*)(src + j * 256 + lane * 4);
      xv[j * 4 + 0] = v4.x; xv[j * 4 + 1] = v4.y; xv[j * 4 + 2] = v4.z; xv[j * 4 + 3] = v4.w;
    }
    if (lu >= 0 && !(isctx && lu == 3)) {
      float ov[16], ss = 0.f;
      const float* orow = p.O + (size_t)tg * DM;
#pragma unroll
      for (int j = 0; j < 4; ++j) {
        const float4 v4 = *(const float4*)(orow + j * 256 + lane * 4);
        ov[j * 4 + 0] = v4.x; ov[j * 4 + 1] = v4.y; ov[j * 4 + 2] = v4.z; ov[j * 4 + 3] = v4.w;
      }
#pragma unroll
      for (int e = 0; e < 16; ++e) ss += ov[e] * ov[e];
      ss = red64(ss);
      const float rstd = rsqrtf(ss * (1.f / DM) + EPS);
      const float* gate = p.MODV + ((size_t)lu * 9 + mrow) * 3 * DM + 2 * DM;
      const float* pg = p.post_g + lu * DM;
      float* dst = row_cur(p, b, t);
#pragma unroll
      for (int j = 0; j < 4; ++j) {
        const int cc = j * 256 + lane * 4;
        const float4 g4 = *(const float4*)(gate + cc);
        const float4 p4 = *(const float4*)(pg + cc);
        xv[j * 4 + 0] += g4.x * (ov[j * 4 + 0] * rstd * p4.x);
        xv[j * 4 + 1] += g4.y * (ov[j * 4 + 1] * rstd * p4.y);
        xv[j * 4 + 2] += g4.z * (ov[j * 4 + 2] * rstd * p4.z);
        xv[j * 4 + 3] += g4.w * (ov[j * 4 + 3] * rstd * p4.w);
        *(float4*)(dst + cc) = make_float4(xv[j * 4 + 0], xv[j * 4 + 1], xv[j * 4 + 2], xv[j * 4 + 3]);
      }
    }
    if (ln >= 0) {
      for (int pass = 0; pass < (ln == 2 ? 2 : 1); ++pass) {
        const int lp = pass == 0 ? ln : 0;
        bf16_t* hdst = (pass == 0 ? ((ln & 1) == 0 ? p.HR : p.H) : p.HR0) + (size_t)tg * DM;
        if (pass == 1) {
          const float* s0 = row_in(p, b, t);
#pragma unroll
          for (int j = 0; j < 4; ++j) {
            const float4 v4 = *(const float4*)(s0 + j * 256 + lane * 4);
            xv[j * 4 + 0] = v4.x; xv[j * 4 + 1] = v4.y; xv[j * 4 + 2] = v4.z; xv[j * 4 + 3] = v4.w;
          }
        }
        float ss = 0.f;
#pragma unroll
        for (int e = 0; e < 16; ++e) ss += xv[e] * xv[e];
        ss = red64(ss);
        const float rstd = rsqrtf(ss * (1.f / DM) + EPS);
        const float* mv = p.MODV + ((size_t)lp * 9 + mrow) * 3 * DM;
        const float* pg = p.pre_g + lp * DM;
#pragma unroll
        for (int j = 0; j < 4; ++j) {
          const int cc = j * 256 + lane * 4;
          const float4 sh = *(const float4*)(mv + cc);
          const float4 sc = *(const float4*)(mv + DM + cc);
          const float4 p4 = *(const float4*)(pg + cc);
          const float h0 = xv[j * 4 + 0] * rstd * p4.x * (1.f + sc.x) + sh.x;
          const float h1 = xv[j * 4 + 1] * rstd * p4.y * (1.f + sc.y) + sh.y;
          const float h2 = xv[j * 4 + 2] * rstd * p4.z * (1.f + sc.z) + sh.z;
          const float h3 = xv[j * 4 + 3] * rstd * p4.w * (1.f + sc.w) + sh.w;
          uint2 u;
          if ((ln & 1) == 0) {
            const float L = 60000.f;
            u.x = pack2h(fminf(fmaxf(h0, -L), L), fminf(fmaxf(h1, -L), L));
            u.y = pack2h(fminf(fmaxf(h2, -L), L), fminf(fmaxf(h3, -L), L));
          } else {
            u.x = pack2(h0, h1); u.y = pack2(h2, h3);
          }
          *(uint2*)(hdst + cc) = u;
        }
      }
    }
  }
}

constexpr int LDK = 72;
constexpr int TM = 128;

template <int AMODE, class Epi>
__device__ __forceinline__ void gemm_tile(const bf16_t* __restrict__ A, int lda, const float* __restrict__ mix, int m0,
                                          int K, const bf16_t* __restrict__ Bt, int nvalid, char* smem, Epi epi) {
  bf16_t* As = (bf16_t*)smem;
  bf16_t* Bs = As + 2 * TM * LDK;
  float* mixs = (float*)(Bs + 2 * 128 * LDK);
  const int tid = opaque_tid(), lane = tid & 63, w = tid >> 6, wm = w >> 1, wn = w & 1;
  const int lr = lane >> 3, ch = (lane & 7) * 8;
  const int row0 = w * 32 + lr;
  const bf16_t* Ap = A + (size_t)(m0 + row0) * lda + ch;
  const bf16_t* Bp = Bt + (size_t)row0 * K + ch;
  const size_t astep = (size_t)8 * lda, bstep = (size_t)8 * K;
  const int KT = (K + 63) >> 6;
  const int tbase = m0 % TT;
  const bool isctx = tbase < CTX;
  unsigned vmask = 0;
  if (AMODE == 1) {
#pragma unroll
    for (int i = 0; i < 4; ++i) {
      const int t = tbase + row0 + i * 8;
      unsigned m;
      if (isctx) {
        m = (t >= 1 ? 3u : 0u) | (t + 1 < CTX ? 12u : 0u);
      } else {
        const int tl = t - CTX, row = tl >> 6, col = tl & 63;
        m = (col > 0 ? 1u : 0u) | (col < 63 ? 2u : 0u) | (row > 0 ? 4u : 0u) | (row < 63 ? 8u : 0u);
      }
      vmask |= m << (4 * i);
    }
  }

  __syncthreads();
  if (AMODE == 1) {
    const float4 m4 = *(const float4*)(mix + tid * 4);
    ((uint2*)mixs)[tid] = make_uint2(pack2h(m4.x, m4.y), pack2h(m4.z, m4.w));
  }

  f32x16 acc[2][2];
#pragma unroll
  for (int i = 0; i < 2; ++i)
#pragma unroll
    for (int j = 0; j < 2; ++j)
#pragma unroll
      for (int r = 0; r < 16; ++r) acc[i][j][r] = 0.f;

  uint4 a0, a1, a2, a3, n0, n1, n2, n3, b0, b1, b2, b3;
  auto load_regs = [&](int kt) {
    const int k0 = kt * 64;
    const uint4 z4 = make_uint4(0, 0, 0, 0);
    const bool kval = (k0 + ch) < K;
    const bf16_t* ap = Ap + k0;
    const bf16_t* bp = Bp + k0;
    a0 = z4; if (kval) a0 = *(const uint4*)(ap + 0 * astep);
    a1 = z4; if (kval) a1 = *(const uint4*)(ap + 1 * astep);
    a2 = z4; if (kval) a2 = *(const uint4*)(ap + 2 * astep);
    a3 = z4; if (kval) a3 = *(const uint4*)(ap + 3 * astep);
    b0 = z4; if (kval && (row0 + 0) < nvalid) b0 = *(const uint4*)(bp + 0 * bstep);
    b1 = z4; if (kval && (row0 + 8) < nvalid) b1 = *(const uint4*)(bp + 1 * bstep);
    b2 = z4; if (kval && (row0 + 16) < nvalid) b2 = *(const uint4*)(bp + 2 * bstep);
    b3 = z4; if (kval && (row0 + 24) < nvalid) b3 = *(const uint4*)(bp + 3 * bstep);
    if (AMODE == 1) {
      const int q = k0 >> 8;
      const int nb = isctx ? (q < 2 ? -1 : 1) : (q == 0 ? -1 : (q == 1 ? 1 : (q == 2 ? -64 : 64)));
      const bf16_t* np = ap + (ptrdiff_t)nb * lda;
      const unsigned vm = vmask >> q;
      n0 = z4; if ((vm >> 0) & 1u) n0 = *(const uint4*)(np + 0 * astep);
      n1 = z4; if ((vm >> 4) & 1u) n1 = *(const uint4*)(np + 1 * astep);
      n2 = z4; if ((vm >> 8) & 1u) n2 = *(const uint4*)(np + 2 * astep);
      n3 = z4; if ((vm >> 12) & 1u) n3 = *(const uint4*)(np + 3 * astep);
    }
  };
  auto mix8 = [&](const uint4& hv, const uint4& nv, const uint4& mv) -> uint4 {
    uint4 o;
    o.x = mixh2(hv.x, nv.x, mv.x); o.y = mixh2(hv.y, nv.y, mv.y); o.z = mixh2(hv.z, nv.z, mv.z); o.w = mixh2(hv.w, nv.w, mv.w);
    return o;
  };
  auto store_lds = [&](int kt, int buf) {
    bf16_t* ad = As + (buf * TM + row0) * LDK + ch;
    bf16_t* bd = Bs + (buf * 128 + row0) * LDK + ch;
    if (AMODE == 1) {
      const uint4 mv = *(const uint4*)((const bf16_t*)mixs + kt * 64 + ch);
      *(uint4*)(ad + 0 * LDK) = mix8(a0, n0, mv);
      *(uint4*)(ad + 8 * LDK) = mix8(a1, n1, mv);
      *(uint4*)(ad + 16 * LDK) = mix8(a2, n2, mv);
      *(uint4*)(ad + 24 * LDK) = mix8(a3, n3, mv);
    } else {
      *(uint4*)(ad + 0 * LDK) = a0;
      *(uint4*)(ad + 8 * LDK) = a1;
      *(uint4*)(ad + 16 * LDK) = a2;
      *(uint4*)(ad + 24 * LDK) = a3;
    }
    *(uint4*)(bd + 0 * LDK) = b0;
    *(uint4*)(bd + 8 * LDK) = b1;
    *(uint4*)(bd + 16 * LDK) = b2;
    *(uint4*)(bd + 24 * LDK) = b3;
  };
  auto compute = [&](int buf) {
    const bf16_t* ab = As + (buf * TM + wm * 64 + (lane & 31)) * LDK + (lane >> 5) * 8;
    const bf16_t* bb = Bs + (buf * 128 + wn * 64 + (lane & 31)) * LDK + (lane >> 5) * 8;
#pragma unroll
    for (int kk = 0; kk < 4; ++kk) {
      const bf16x8 af0 = *(const bf16x8*)(ab + kk * 16), af1 = *(const bf16x8*)(ab + 32 * LDK + kk * 16);
      const bf16x8 bf0 = *(const bf16x8*)(bb + kk * 16), bf1 = *(const bf16x8*)(bb + 32 * LDK + kk * 16);
      if (AMODE == 1) {
        const f16x8 ha0 = __builtin_bit_cast(f16x8, af0), ha1 = __builtin_bit_cast(f16x8, af1);
        const f16x8 hb0 = __builtin_bit_cast(f16x8, bf0), hb1 = __builtin_bit_cast(f16x8, bf1);
        acc[0][0] = __builtin_amdgcn_mfma_f32_32x32x16_f16(ha0, hb0, acc[0][0], 0, 0, 0);
        acc[0][1] = __builtin_amdgcn_mfma_f32_32x32x16_f16(ha0, hb1, acc[0][1], 0, 0, 0);
        acc[1][0] = __builtin_amdgcn_mfma_f32_32x32x16_f16(ha1, hb0, acc[1][0], 0, 0, 0);
        acc[1][1] = __builtin_amdgcn_mfma_f32_32x32x16_f16(ha1, hb1, acc[1][1], 0, 0, 0);
      } else {
        acc[0][0] = __builtin_amdgcn_mfma_f32_32x32x16_bf16(af0, bf0, acc[0][0], 0, 0, 0);
        acc[0][1] = __builtin_amdgcn_mfma_f32_32x32x16_bf16(af0, bf1, acc[0][1], 0, 0, 0);
        acc[1][0] = __builtin_amdgcn_mfma_f32_32x32x16_bf16(af1, bf0, acc[1][0], 0, 0, 0);
        acc[1][1] = __builtin_amdgcn_mfma_f32_32x32x16_bf16(af1, bf1, acc[1][1], 0, 0, 0);
      }
    }
  };
  load_regs(0);
  lds_barrier();
  store_lds(0, 0);
  if (KT > 1) load_regs(1);
  lds_barrier();
  for (int kt = 0; kt < KT; ++kt) {
    compute(kt & 1);
    if (kt + 1 < KT) store_lds(kt + 1, (kt + 1) & 1);
    if (kt + 2 < KT) load_regs(kt + 2);
    lds_barrier();
  }
  float* Cs = (float*)smem;
#pragma unroll
  for (int i = 0; i < 2; ++i)
#pragma unroll
    for (int j = 0; j < 2; ++j)
#pragma unroll
      for (int r = 0; r < 16; ++r)
        Cs[(wm * 64 + i * 32 + (r & 3) + 8 * (r >> 2) + 4 * (lane >> 5)) * 132 + wn * 64 + j * 32 + (lane & 31)] = acc[i][j][r];
  lds_barrier();
#pragma unroll 2
  for (int it = 0; it < 8; ++it) {
    const int idx = it * 256 + tid, row = idx >> 4, c8 = (idx & 15) * 8;
    const float4 v0 = *(const float4*)(Cs + row * 132 + c8), v1 = *(const float4*)(Cs + row * 132 + c8 + 4);
    float v[8] = {v0.x, v0.y, v0.z, v0.w, v1.x, v1.y, v1.z, v1.w};
    epi(m0 + row, c8, v);
  }
}

__device__ __forceinline__ void phase_rw_proj(const Params& p, int j, char* smem, int zonly, int bid, int nb) {
  const int ntn = zonly ? 16 : (j == 0 ? 50 : 67);
  const float* mixb = p.rw_mix + (size_t)j * 6 * DM;
  const bool xaware = (nb & 7) == 0;
  const int xcd = xaware ? (bid & 7) : 0, slot = xaware ? (bid >> 3) : bid, nslots = xaware ? (nb >> 3) : nb;
  const int ntx = xaware ? (ntn - xcd + 7) / 8 : ntn;
  for (int li = slot; li < MT * ntx; li += nslots) {
    const int mt = li / ntx, ntl = xaware ? xcd + 8 * (li % ntx) : (li % ntx), m0 = mt * 128;
    const int nt = zonly ? 48 + ntl : (ntl < 48 ? ntl : ntl + 16);
    if (nt < 64) {
      const int pi = nt >> 4, n0 = (nt & 15) * 128;
      const int mi = pi == 0 ? 0 : (pi == 1 ? 2 : (pi == 2 ? 3 : 5));
      const bf16_t* Bw = g_wt + OFF_PROJ + ((size_t)(j * 4 + pi) * DI + n0) * DM;
      bf16_t* dst = pi == 0 ? p.R : (pi == 1 ? p.K : (pi == 2 ? p.V : p.Z));
      if (pi == 3) {
        gemm_tile<1>(p.HR, DM, mixb + mi * DM, m0, DM, Bw, 128, smem,
                     [&](int row, int col, float* v) {
#pragma unroll
        for (int e = 0; e < 8; ++e) v[e] = siluf_(v[e]);
        *(uint4*)(dst + (size_t)row * DI + n0 + col) = pack8(v); });
      } else {
        gemm_tile<1>(p.HR, DM, mixb + mi * DM, m0, DM, Bw, 128, smem,
                     [&](int row, int col, float* v) { *(uint4*)(dst + (size_t)row * DI + n0 + col) = pack8(v); });
      }
    } else if (nt == 64) {
      gemm_tile<1>(p.HR, DM, mixb + 1 * DM, m0, DM, g_wt + OFF_W1 + (size_t)j * 128 * DM, 128, smem,
                   [&](int row, int col, float* v) {
#pragma unroll
        for (int e = 0; e < 8; ++e) v[e] = tanhf_(v[e]);
        *(uint4*)(p.LRW + (size_t)row * 128 + col) = pack8(v); });
    } else if (nt == 65) {
      gemm_tile<1>(p.HR, DM, mixb + 4 * DM, m0, DM, g_wt + OFF_A1 + (size_t)j * 128 * DM, 128, smem,
                   [&](int row, int col, float* v) { *(uint4*)(p.LRA + (size_t)row * 128 + col) = pack8(v); });
    } else if (nt == 66) {
      gemm_tile<1>(p.HR, DM, mixb + 3 * DM, m0, DM, g_wt + OFF_V1, 32, smem, [&](int row, int col, float* v) {
        if (col < 32) *(uint4*)(p.LRV + (size_t)row * 32 + col) = pack8(v);
      });
    } else {
      const int n0 = (nt - 67) * 128;
      const bf16_t* Bw = g_wt + OFF_PROJ + ((size_t)2 * DI + n0) * DM;
      gemm_tile<1>(p.HR0, DM, p.rw_mix + 3 * DM, m0, DM, Bw, 128, smem,
                   [&](int row, int col, float* v) { *(uint4*)(p.VF + (size_t)row * DI + n0 + col) = pack8(v); });
    }
  }
}

__device__ __forceinline__ void phase_rw_lr2(const Params& p, int j, char* smem) {
  for (int tile = blockIdx.x; tile < MT * 16; tile += gridDim.x) {
    const int mt = tile / 16, nt = tile % 16, m0 = mt * 128;
    const int n0 = nt * 128;
    const bf16_t* Bw = g_wt + OFF_V2 + (size_t)n0 * 32;
    const float* v0 = p.rw_v0 + n0;
    gemm_tile<0>(p.LRV, 32, nullptr, m0, 32, Bw, 128, smem, [&](int row, int col, float* v) {
      const size_t idx = (size_t)row * DI + n0 + col;
      float vv[8], vf[8];
      unpack8(*(const uint4*)(p.V + idx), vv); unpack8(*(const uint4*)(p.VF + idx), vf);
#pragma unroll
      for (int e = 0; e < 8; ++e) vv[e] += (vf[e] - vv[e]) * sigmoidf_(v[e] + v0[col + e]);
      *(uint4*)(p.V + idx) = pack8(vv);
    });
  }
}

constexpr int RCH = 32;
__device__ __forceinline__ int scan_pos(int dir, int s) { return dir == 0 ? s : (s < CTX ? CTX - 1 - s : TT + CTX - 1 - s); }

__device__ __forceinline__ void phase_rw_scan(const Params& p, int j, char* smem) {
  float* op = (float*)smem;
  float* vv = op + RCH * 4 * 64;
  float* sc = vv + RCH * 64;
  float* LWs = sc + RCH * 2;
  float* AAs = LWs + RCH * 64;
  float* yb = AAs;
  bf16_t* LRs = (bf16_t*)(AAs + RCH * 64);
  const int tid = opaque_tid(), lane = tid & 63, w = tid >> 6;
  const int ptau = tid >> 3, pc8 = (tid & 7) * 8;
  const int r2 = lane >> 3, ko = (lane & 7) * 8;
  const int row0 = w * 16 + r2, row1 = row0 + 8;
  for (int unit = blockIdx.x; unit < GB * 64; unit += gridDim.x) {
    const int bl = unit >> 6, h = (unit >> 1) & 31, dir = unit & 1;
    bf16_t* Y = dir == 0 ? p.YF : p.YB;
    float pkk[8], pka[8], prk[8];
#pragma unroll
    for (int e = 0; e < 8; ++e) {
      const int cc = j * DI + h * 64 + pc8 + e;
      pkk[e] = p.rw_kk[cc]; pka[e] = p.rw_ka[cc]; prk[e] = p.rw_rk[cc];
    }
    __syncthreads();
    const int mm = w >> 1, nh = w & 1;
    const float bias = (mm == 0 ? p.rw_w0 : p.rw_a0)[((size_t)j * 2 + dir) * DI + h * 64 + nh * 32 + (lane & 31)];
    bf16x8 wfr[4];
    {
      const bf16_t* w2g = g_wt + (mm == 0 ? OFF_W2 : OFF_A2) + (((size_t)j * 2 + dir) * DI + h * 64 + nh * 32 + (lane & 31)) * 64 + (lane >> 5) * 8;
#pragma unroll
      for (int kk = 0; kk < 4; ++kk) wfr[kk] = *(const bf16x8*)(w2g + kk * 16);
    }
    f2_t S0[4], S1[4];
#pragma unroll
    for (int e = 0; e < 4; ++e) { S0[e] = f2_t{0.f, 0.f}; S1[e] = f2_t{0.f, 0.f}; }
    uint4 gr, gk, gv, gl0, gl1;
    const int lmat = (tid & 7) >> 2, lcol = (tid & 3) * 16;
    const size_t ubase = (size_t)bl * TT * DI + h * 64 + pc8;
    const bf16_t* const rp = p.R + ubase;
    const bf16_t* const kp = p.K + ubase;
    const bf16_t* const vp_ = p.V + ubase;
    const bf16_t* const lrp = (lmat == 0 ? p.LRW : p.LRA) + (size_t)bl * TT * 128 + dir * 64 + lcol;
    auto gload = [&](int chunk) {
      const int pos = scan_pos(dir, chunk * RCH + ptau);
      const size_t o = (size_t)pos * DI;
      gr = *(const uint4*)(rp + o); gk = *(const uint4*)(kp + o); gv = *(const uint4*)(vp_ + o);
      const bf16_t* lr = lrp + (size_t)pos * 128;
      gl0 = *(const uint4*)(lr); gl1 = *(const uint4*)(lr + 8);
    };
    gload(0);
    for (int chunk = 0; chunk < TT / RCH; ++chunk) {
      *(uint4*)(LRs + (lmat * RCH + ptau) * 72 + lcol) = gl0;
      *(uint4*)(LRs + (lmat * RCH + ptau) * 72 + lcol + 8) = gl1;
      lds_barrier();
      {
        f32x16 acc;
#pragma unroll
        for (int r = 0; r < 16; ++r) acc[r] = 0.f;
#pragma unroll
        for (int kk = 0; kk < 4; ++kk) {
          const bf16x8 af = *(const bf16x8*)(LRs + (mm * RCH + (lane & 31)) * 72 + kk * 16 + (lane >> 5) * 8);
          acc = __builtin_amdgcn_mfma_f32_32x32x16_bf16(af, wfr[kk], acc, 0, 0, 0);
        }
        const int chn = nh * 32 + (lane & 31), hh = lane >> 5;
        if (mm == 0) {
          float lwv[16], pf[16], own[4], oth[4];
#pragma unroll
          for (int r = 0; r < 16; ++r) lwv[r] = -0.60653066f * sigmoidf_(acc[r] + bias);
#pragma unroll
          for (int g = 0; g < 4; ++g) {
            pf[g * 4] = lwv[g * 4];
            pf[g * 4 + 1] = pf[g * 4] + lwv[g * 4 + 1];
            pf[g * 4 + 2] = pf[g * 4 + 1] + lwv[g * 4 + 2];
            pf[g * 4 + 3] = pf[g * 4 + 2] + lwv[g * 4 + 3];
            own[g] = pf[g * 4 + 3];
            oth[g] = __shfl_xor(own[g], 32);
          }
          float base = 0.f;
#pragma unroll
          for (int g = 0; g < 4; ++g) {
            const float off = base + (hh ? oth[g] : 0.f);
#pragma unroll
            for (int q = 0; q < 4; ++q) {
              const int t = q + 8 * g + 4 * hh;
              const float c = off + pf[g * 4 + q];
              LWs[t * 64 + chn] = c;
            }
            base += own[g] + oth[g];
          }
        } else {
#pragma unroll
          for (int r = 0; r < 16; ++r) {
            const int t = (r & 3) + 8 * (r >> 2) + 4 * hh;
            AAs[t * 64 + chn] = sigmoidf_(acc[r] + bias);
          }
        }
      }
      lds_barrier();
      {
        float r[8], k[8], v[8], cm[8], cp[8], a[8];
        unpack8(gr, r); unpack8(gk, k); unpack8(gv, v);
#pragma unroll
        for (int e = 0; e < 8; ++e) {
          cm[e] = LWs[ptau * 64 + pc8 + e]; cp[e] = ptau > 0 ? LWs[(ptau - 1) * 64 + pc8 + e] : 0.f; a[e] = AAs[ptau * 64 + pc8 + e];
        }
        float kkv[8], ss = 0.f;
#pragma unroll
        for (int e = 0; e < 8; ++e) { kkv[e] = k[e] * pkk[e]; ss += kkv[e] * kkv[e]; }
        ss = red8(ss);
        const float inv = rsqrtf(fmaxf(ss, 1e-24f));
        float br = 0.f, kr = 0.f, bon = 0.f;
        float o0[8], o1[8], o2[8], o3[8];
#pragma unroll
        for (int e = 0; e < 8; ++e) {
          const float kkn = kkv[e] * inv;
          const float P = __expf(cm[e]), Pp = __expf(cp[e]);
          const float iP = rcpf_(P);
          const float kd = k[e] * (1.f + (a[e] - 1.f) * pka[e]);
          const float bb = kkn * a[e];
          o0[e] = -kkn * Pp; o1[e] = r[e] * P; o2[e] = bb * iP; o3[e] = kd * iP;
          br += bb * r[e]; kr += kd * r[e]; bon += r[e] * kd * prk[e];
        }
        br = red8(br); kr = red8(kr); bon = red8(bon);
        float* od = op + ptau * 256 + pc8;
        *(float4*)(od) = make_float4(o0[0], o0[1], o0[2], o0[3]); *(float4*)(od + 4) = make_float4(o0[4], o0[5], o0[6], o0[7]);
        *(float4*)(od + 64) = make_float4(o1[0], o1[1], o1[2], o1[3]); *(float4*)(od + 68) = make_float4(o1[4], o1[5], o1[6], o1[7]);
        *(float4*)(od + 128) = make_float4(o2[0], o2[1], o2[2], o2[3]); *(float4*)(od + 132) = make_float4(o2[4], o2[5], o2[6], o2[7]);
        *(float4*)(od + 192) = make_float4(o3[0], o3[1], o3[2], o3[3]); *(float4*)(od + 196) = make_float4(o3[4], o3[5], o3[6], o3[7]);
        float* vd = vv + ptau * 64 + pc8;
        *(float4*)(vd) = make_float4(v[0], v[1], v[2], v[3]); *(float4*)(vd + 4) = make_float4(v[4], v[5], v[6], v[7]);
        if ((tid & 7) == 0) {
          sc[ptau * 2] = br; sc[ptau * 2 + 1] = kr;
          const int pos = scan_pos(dir, chunk * RCH + ptau);
          p.BN[((size_t)dir * NTG + (size_t)bl * TT + pos) * 32 + h] = bon;
        }
      }
      lds_barrier();
      if (chunk + 1 < TT / RCH) gload(chunk + 1);
      {
        struct StepOps { float4 n0, n1, q0, q1, b0, b1, k0, k1; float v0, v1; float2 s; };
        auto ldops = [&](StepOps& o, int tau) {
          const float* ob = op + tau * 256 + ko;
          o.n0 = *(const float4*)(ob); o.n1 = *(const float4*)(ob + 4);
          o.q0 = *(const float4*)(ob + 64); o.q1 = *(const float4*)(ob + 68);
          o.b0 = *(const float4*)(ob + 128); o.b1 = *(const float4*)(ob + 132);
          o.k0 = *(const float4*)(ob + 192); o.k1 = *(const float4*)(ob + 196);
          o.v0 = vv[tau * 64 + row0]; o.v1 = vv[tau * 64 + row1];
          o.s = *(const float2*)(sc + tau * 2);
        };
        auto dostep = [&](const StepOps& o, int tau) {
          const float nk[8] = {o.n0.x, o.n0.y, o.n0.z, o.n0.w, o.n1.x, o.n1.y, o.n1.z, o.n1.w};
          const float rr[8] = {o.q0.x, o.q0.y, o.q0.z, o.q0.w, o.q1.x, o.q1.y, o.q1.z, o.q1.w};
          const float bb[8] = {o.b0.x, o.b0.y, o.b0.z, o.b0.w, o.b1.x, o.b1.y, o.b1.z, o.b1.w};
          const float kd[8] = {o.k0.x, o.k0.y, o.k0.z, o.k0.w, o.k1.x, o.k1.y, o.k1.z, o.k1.w};
          f2_t a10 = {0.f, 0.f}, a11 = {0.f, 0.f}, a20 = {0.f, 0.f}, a21 = {0.f, 0.f};
#pragma unroll
          for (int e = 0; e < 4; ++e) {
            const f2_t nk2 = {nk[2 * e], nk[2 * e + 1]}, rr2 = {rr[2 * e], rr[2 * e + 1]};
            a10 = __builtin_elementwise_fma(S0[e], nk2, a10); a11 = __builtin_elementwise_fma(S1[e], nk2, a11);
            a20 = __builtin_elementwise_fma(S0[e], rr2, a20); a21 = __builtin_elementwise_fma(S1[e], rr2, a21);
          }
          float d10 = a10.x + a10.y, d11 = a11.x + a11.y, d20 = a20.x + a20.y, d21 = a21.x + a21.y;
          d10 = red8(d10); d11 = red8(d11); d20 = red8(d20); d21 = red8(d21);
          const float y0 = d20 + d10 * o.s.x + o.v0 * o.s.y;
          const float y1 = d21 + d11 * o.s.x + o.v1 * o.s.y;
          const f2_t sa0 = {d10, d10}, sa1 = {d11, d11}, vv0 = {o.v0, o.v0}, vv1 = {o.v1, o.v1};
#pragma unroll
          for (int e = 0; e < 4; ++e) {
            const f2_t bb2 = {bb[2 * e], bb[2 * e + 1]}, kd2 = {kd[2 * e], kd[2 * e + 1]};
            S0[e] = __builtin_elementwise_fma(sa0, bb2, __builtin_elementwise_fma(vv0, kd2, S0[e]));
            S1[e] = __builtin_elementwise_fma(sa1, bb2, __builtin_elementwise_fma(vv1, kd2, S1[e]));
          }
          if ((lane & 7) == 0) { yb[tau * 64 + row0] = y0; yb[tau * 64 + row1] = y1; }
        };
        StepOps oa, ob2;
        ldops(oa, 0);
#pragma unroll 1
        for (int tau = 0; tau < RCH; tau += 2) {
          ldops(ob2, tau + 1);
          dostep(oa, tau);
          ldops(oa, tau + 2);
          dostep(ob2, tau + 1);
        }
#pragma unroll
        for (int e = 0; e < 4; ++e) {
          const f2_t pc = {__expf(LWs[(RCH - 1) * 64 + ko + 2 * e]), __expf(LWs[(RCH - 1) * 64 + ko + 2 * e + 1])};
          S0[e] *= pc; S1[e] *= pc;
        }
      }
      lds_barrier();
      {
        const int pos = scan_pos(dir, chunk * RCH + ptau);
        const float* ys = yb + ptau * 64 + pc8;
        float yv[8];
#pragma unroll
        for (int e = 0; e < 8; ++e) yv[e] = ys[e];
        *(uint4*)(Y + ((size_t)bl * TT + pos) * DI + h * 64 + pc8) = pack8(yv);
      }
    }
    lds_barrier();
  }
}

__device__ __forceinline__ void phase_rw_gate(const Params& p, int j) {
  const int tid = opaque_tid(), h = tid >> 3;
  const int c0 = tid * 8;
  float lnw[8], lnb[8];
#pragma unroll
  for (int e = 0; e < 8; ++e) { lnw[e] = p.rw_lnw[j * DI + c0 + e]; lnb[e] = p.rw_lnb[j * DI + c0 + e]; }
  for (int tg = blockIdx.x; tg < NTG; tg += gridDim.x) {
    const size_t base = (size_t)tg * DI + c0;
    float yf[8], yb[8], v[8], z[8];
    unpack8(*(const uint4*)(p.YF + base), yf); unpack8(*(const uint4*)(p.YB + base), yb);
    unpack8(*(const uint4*)(p.V + base), v); unpack8(*(const uint4*)(p.Z + base), z);
    const float bon = p.BN[(size_t)tg * 32 + h] + p.BN[((size_t)NTG + tg) * 32 + h];
    float y[8], s = 0.f;
#pragma unroll
    for (int e = 0; e < 8; ++e) { y[e] = yf[e] + yb[e]; s += y[e]; }
    const float mu = red8(s) * (1.f / 64.f);
    float s2 = 0.f;
#pragma unroll
    for (int e = 0; e < 8; ++e) { y[e] -= mu; s2 += y[e] * y[e]; }
    const float rstd = rsqrtf(red8(s2) * (1.f / 64.f) + 64e-5f);
#pragma unroll
    for (int e = 0; e < 8; ++e) y[e] = (y[e] * rstd * lnw[e] + lnb[e] + bon * v[e]) * z[e];
    *(uint4*)(p.YF + base) = pack8(y);
  }
}

__device__ __forceinline__ void phase_out(const Params& p, const bf16_t* wo, char* smem) {
  for (int tile = blockIdx.x; tile < MT * 8; tile += gridDim.x) {
    const int mt = tile / 8, nt = tile % 8, m0 = mt * 128, n0 = nt * 128;
    const bf16_t* Bw = wo + (size_t)n0 * DI;
    gemm_tile<0>(p.YF, DI, nullptr, m0, DI, Bw, 128, smem,
                 [&](int row, int col, float* v) {
      float* o = p.O + (size_t)row * DM + n0 + col;
      *(float4*)o = make_float4(v[0], v[1], v[2], v[3]); *(float4*)(o + 4) = make_float4(v[4], v[5], v[6], v[7]); });
  }
}

__device__ __forceinline__ void phase_hg_proj(const Params& p, int j, char* smem) {
  const int layer = 2 * j + 1;
  for (int tile = blockIdx.x; tile < MT * 80; tile += gridDim.x) {
    const int mt = tile / 80, nt = tile % 80, m0 = mt * 128;
    const int seg = nt >> 4, n0 = (nt & 15) * 128;
    const bf16_t* Bw = g_wt + OFF_HWIN + ((size_t)j * 5 * DI + (size_t)seg * DI + n0) * DM;
    bf16_t* dst = seg == 0 ? p.R : (seg == 1 ? p.K : (seg == 2 ? p.WF : (seg == 3 ? p.V : p.Z)));
    if (seg == 0 || seg == 4) {
      gemm_tile<0>(p.H, DM, nullptr, m0, DM, Bw, 128, smem, [&](int row, int col, float* v) {
#pragma unroll
        for (int e = 0; e < 8; ++e) v[e] = siluf_(v[e]);
        *(uint4*)(dst + (size_t)row * DI + n0 + col) = pack8(v); });
    } else if (seg == 3) {
      gemm_tile<0>(p.H, DM, nullptr, m0, DM, Bw, 128, smem,
                   [&](int row, int col, float* v) { *(uint4*)(dst + (size_t)row * DI + n0 + col) = pack8(v); });
    } else {
      const float* lbp = p.LB + layer * DI + n0;
      gemm_tile<0>(p.H, DM, nullptr, m0, DM, Bw, 128, smem, [&](int row, int col, float* v) {
        const float4 l0 = *(const float4*)(lbp + col), l1 = *(const float4*)(lbp + col + 4);
        const float lb[8] = {l0.x, l0.y, l0.z, l0.w, l1.x, l1.y, l1.z, l1.w};
#pragma unroll
        for (int e = 0; e < 8; ++e) v[e] = __logf(lb[e] + (1.f - lb[e]) * sigmoidf_(v[e]));
        *(uint4*)(dst + (size_t)row * DI + n0 + col) = pack8(v); });
    }
  }
}

constexpr int HC = 32;
constexpr int QS = 136;
constexpr int SS = 40;
__device__ __forceinline__ void phase_hg_scan(const Params& p, int layer, char* smem) {
  bf16_t* qe = (bf16_t*)smem;
  bf16_t* ke = qe + HC * QS;
  bf16_t* kdT = ke + HC * QS;
  bf16_t* vT = kdT + 128 * SS;
  bf16_t* att = vT + 64 * SS;
  bf16_t* ST = att + HC * SS;
  float* dC = (float*)(ST + 64 * QS);
  const int tid = opaque_tid(), lane = tid & 63, w = tid >> 6;
  for (int unit = blockIdx.x; unit < GB * 64; unit += gridDim.x) {
    const int vs = unit & 1, dir = (unit >> 1) & 1, h = (unit >> 2) & 15, bl = unit >> 6;
    const bf16_t* FL = dir == 0 ? p.K : p.WF;
    bf16_t* Y = dir == 0 ? p.YF : p.YB;
    const int st = lane & 31, cg = w * 2 + (lane >> 5), kb = cg * 16, vb = cg * 8;
    f32x16 sacc[2];
#pragma unroll
    for (int r = 0; r < 16; ++r) { sacc[0][r] = 0.f; sacc[1][r] = 0.f; }
    __syncthreads();
    for (int idx = tid; idx < 64 * QS / 2; idx += 256) ((unsigned*)ST)[idx] = 0u;
    uint4 gq0, gq1, gf0, gf1, gvv;
    const size_t ubase = (size_t)bl * TT * DI + h * 128;
    const bf16_t* const qp = p.R + ubase + kb;
    const bf16_t* const fp_ = FL + ubase + kb;
    const bf16_t* const ip = p.V + ubase + vs * 64 + vb;
    auto gload = [&](int chunk) {
      const int pos = scan_pos(dir, chunk * HC + st);
      const size_t o = (size_t)pos * DI;
      gq0 = *(const uint4*)(qp + o); gq1 = *(const uint4*)(qp + o + 8);
      gf0 = *(const uint4*)(fp_ + o); gf1 = *(const uint4*)(fp_ + o + 8);
      gvv = *(const uint4*)(ip + o);
    };
    gload(0);
    for (int chunk = 0; chunk < TT / HC; ++chunk) {
      float q[16], cum[16], one[16];
      {
        unpack8(gq0, q); unpack8(gq1, q + 8); unpack8(gf0, cum); unpack8(gf1, cum + 8);
#pragma unroll
        for (int e = 0; e < 16; ++e) {
          float c = cum[e];
          one[e] = 1.f - __expf(c);
          c += __int_as_float(__builtin_amdgcn_update_dpp(0, __float_as_int(c), 0x111, 0xf, 0xf, false));
          c += __int_as_float(__builtin_amdgcn_update_dpp(0, __float_as_int(c), 0x112, 0xf, 0xf, false));
          c += __int_as_float(__builtin_amdgcn_update_dpp(0, __float_as_int(c), 0x114, 0xf, 0xf, false));
          c += __int_as_float(__builtin_amdgcn_update_dpp(0, __float_as_int(c), 0x118, 0xf, 0xf, false));
          c += __int_as_float(__builtin_amdgcn_update_dpp(0, __float_as_int(c), 0x142, 0xa, 0xf, false));
          cum[e] = c;
        }
      }
      const uint4 vreg = gvv;
      lds_barrier();
      {
        float qo[16], ko[16];
#pragma unroll
        for (int e = 0; e < 16; ++e) {
          const float c31 = __int_as_float(__builtin_amdgcn_readlane(__float_as_int(cum[e]), 31));
          const float c63 = __int_as_float(__builtin_amdgcn_readlane(__float_as_int(cum[e]), 63));
          const float cC = (lane >> 5) ? c63 : c31;
          const float ec = __expf(fmaxf(cum[e], -80.f));
          const float inv = rcpf_(ec);
          const float eC = __expf(cC);
          qo[e] = q[e] * ec;
          ko[e] = one[e] * inv;
          kdT[(kb + e) * SS + st] = f2bf(one[e] * inv * eC);
          if (st == 31) dC[kb + e] = eC;
        }
        *(uint4*)(qe + st * QS + kb) = pack8(qo); *(uint4*)(qe + st * QS + kb + 8) = pack8(qo + 8);
        *(uint4*)(ke + st * QS + kb) = pack8(ko); *(uint4*)(ke + st * QS + kb + 8) = pack8(ko + 8);
        const bf16_t* vp = (const bf16_t*)&vreg;
#pragma unroll
        for (int e = 0; e < 8; ++e) vT[(vb + e) * SS + st] = vp[e];
      }
      lds_barrier();
      if (chunk + 1 < TT / HC) gload(chunk + 1);
      {
        const int mi = w >> 1, ni = w & 1;
        f32x4 a4 = {0.f, 0.f, 0.f, 0.f};
#pragma unroll
        for (int kk = 0; kk < 4; ++kk) {
          const bf16x8 af = *(const bf16x8*)(qe + (mi * 16 + (lane & 15)) * QS + kk * 32 + (lane >> 4) * 8);
          const bf16x8 bf = *(const bf16x8*)(ke + (ni * 16 + (lane & 15)) * QS + kk * 32 + (lane >> 4) * 8);
          a4 = __builtin_amdgcn_mfma_f32_16x16x32_bf16(af, bf, a4, 0, 0, 0);
        }
        const int s = ni * 16 + (lane & 15);
#pragma unroll
        for (int r = 0; r < 4; ++r) {
          const int t = mi * 16 + (lane >> 4) * 4 + r;
          att[t * SS + s] = f2bf(s <= t ? a4[r] : 0.f);
        }
      }
      lds_barrier();
      {
#pragma unroll
        for (int mh = 0; mh < 2; ++mh) {
          f32x4 y4 = {0.f, 0.f, 0.f, 0.f};
          {
            const bf16x8 af = *(const bf16x8*)(att + (mh * 16 + (lane & 15)) * SS + (lane >> 4) * 8);
            const bf16x8 bf = *(const bf16x8*)(vT + (w * 16 + (lane & 15)) * SS + (lane >> 4) * 8);
            y4 = __builtin_amdgcn_mfma_f32_16x16x32_bf16(af, bf, y4, 0, 0, 0);
          }
#pragma unroll
          for (int kk = 0; kk < 4; ++kk) {
            const bf16x8 af = *(const bf16x8*)(qe + (mh * 16 + (lane & 15)) * QS + kk * 32 + (lane >> 4) * 8);
            const bf16x8 bf = *(const bf16x8*)(ST + (w * 16 + (lane & 15)) * QS + kk * 32 + (lane >> 4) * 8);
            y4 = __builtin_amdgcn_mfma_f32_16x16x32_bf16(af, bf, y4, 0, 0, 0);
          }
#pragma unroll
          for (int r = 0; r < 4; ++r) {
            const int t = mh * 16 + (lane >> 4) * 4 + r;
            const int pos = scan_pos(dir, chunk * HC + t);
            Y[((size_t)bl * TT + pos) * DI + h * 128 + vs * 64 + w * 16 + (lane & 15)] = f2bf(y4[r]);
          }
        }
      }
      lds_barrier();
      {
        float dk[16];
#pragma unroll
        for (int r = 0; r < 16; ++r) dk[r] = dC[w * 32 + (r & 3) + 8 * (r >> 2) + 4 * (lane >> 5)];
#pragma unroll
        for (int nt = 0; nt < 2; ++nt) {
#pragma unroll
          for (int r = 0; r < 16; ++r) sacc[nt][r] *= dk[r];
#pragma unroll
          for (int ks = 0; ks < 2; ++ks) {
            const bf16x8 af = *(const bf16x8*)(kdT + (w * 32 + (lane & 31)) * SS + ks * 16 + (lane >> 5) * 8);
            const bf16x8 bf = *(const bf16x8*)(vT + (nt * 32 + (lane & 31)) * SS + ks * 16 + (lane >> 5) * 8);
            sacc[nt] = __builtin_amdgcn_mfma_f32_32x32x16_bf16(af, bf, sacc[nt], 0, 0, 0);
          }
#pragma unroll
          for (int gq = 0; gq < 4; ++gq) {
            uint2 u;
            u.x = pack2(sacc[nt][gq * 4 + 0], sacc[nt][gq * 4 + 1]);
            u.y = pack2(sacc[nt][gq * 4 + 2], sacc[nt][gq * 4 + 3]);
            *(uint2*)(ST + (nt * 32 + (lane & 31)) * QS + w * 32 + gq * 8 + (lane >> 5) * 4) = u;
          }
        }
      }
    }
    lds_barrier();
  }
}

__device__ __forceinline__ void phase_hg_gate(const Params& p, int j) {
  const int tid = opaque_tid();
  const int c0 = tid * 8;
  float gn[8];
#pragma unroll
  for (int e = 0; e < 8; ++e) gn[e] = p.hg_gn[j * 128 + ((c0 + e) & 127)];
  for (int tg = blockIdx.x; tg < NTG; tg += gridDim.x) {
    const size_t base = (size_t)tg * DI + c0;
    float yf[8], yb[8], z[8];
    unpack8(*(const uint4*)(p.YF + base), yf); unpack8(*(const uint4*)(p.YB + base), yb);
    unpack8(*(const uint4*)(p.Z + base), z);
    float y[8], s2 = 0.f;
#pragma unroll
    for (int e = 0; e < 8; ++e) { y[e] = yf[e] + yb[e]; s2 += y[e] * y[e]; }
    const float rstd = rsqrtf(red16(s2) * (1.f / 128.f) + EPS);
#pragma unroll
    for (int e = 0; e < 8; ++e) y[e] = y[e] * rstd * gn[e] * z[e];
    *(uint4*)(p.YF + base) = pack8(y);
  }
}

__global__ void __launch_bounds__(256, 2) fwd_megakernel(Params p) {
  cg::grid_group grid = cg::this_grid();
  __shared__ __attribute__((aligned(16))) char smem[78 * 1024];
  __shared__ uint4 xb_words;
  if (threadIdx.x == 0) xb_words = make_uint4(0u, 0u, 0u, 0u);
  __syncthreads();
  XcdBarrier xb = xcd_barrier_post(p.bar, (volatile LAS unsigned*)&xb_words);
  phase_mod(p, smem);
  phase_wconv(p, smem);
  grid.sync();
  for (int g = 0; g < NG; ++g) {
    for (int layer = 0; layer < 4; ++layer) {
      phase_resnorm(p, g, layer - 1, layer);
      xcd_barrier(xb);
      const int j = layer >> 1;
      if ((layer & 1) == 0) {
        phase_rw_proj(p, j, smem, 0, blockIdx.x, gridDim.x);
        xcd_barrier(xb);
        if (j == 1) { phase_rw_lr2(p, j, smem); xcd_barrier(xb); }
        if (gridDim.x >= 2 * GB * 64) {
          if (blockIdx.x < GB * 64) phase_rw_scan(p, j, smem);
          else phase_rw_proj(p, j, smem, 1, blockIdx.x - GB * 64, gridDim.x - GB * 64);
        } else {
          phase_rw_scan(p, j, smem);
          phase_rw_proj(p, j, smem, 1, blockIdx.x, gridDim.x);
        }
        xcd_barrier(xb);
        phase_rw_gate(p, j);
        xcd_barrier(xb);
        phase_out(p, g_wt + OFF_RWO + (size_t)j * DM * DI, smem);
        xcd_barrier(xb);
      } else {
        phase_hg_proj(p, j, smem);
        xcd_barrier(xb);
        phase_hg_scan(p, layer, smem);
        xcd_barrier(xb);
        phase_hg_gate(p, j);
        xcd_barrier(xb);
        phase_out(p, g_wt + OFF_HWO + (size_t)j * DM * DI, smem);
        xcd_barrier(xb);
      }
    }
    phase_resnorm(p, g, 3, -1);
    xcd_barrier(xb);
  }
}

extern "C" void kernel_launch(void* const* d_in, const int* in_sizes, int n_in, void* d_out, int out_size, void* d_ws,
                              size_t ws_size, hipStream_t stream) {
  static int grid_blocks = 0;
  if (!grid_blocks) {
    int dev = 0, cus = 0, per_cu = 0;
    hipGetDevice(&dev);
    hipDeviceGetAttribute(&cus, hipDeviceAttributeMultiprocessorCount, dev);
    hipOccupancyMaxActiveBlocksPerMultiprocessor(&per_cu, fwd_megakernel, 256, 0);
    if (per_cu > 2) per_cu = 2;
    grid_blocks = cus * per_cu;
  }
  Params p{};
  const float** fp = (const float**)&p;
  for (int i = 0; i < 29; ++i) fp[i] = (const float*)d_in[i];
  p.out = (float*)d_out;
  char* w = (char*)d_ws;
  size_t off = 0;
  auto take = [&](size_t bytes) { char* r = w + off; off += (bytes + 255) & ~(size_t)255; return r; };
  const size_t DIW = (size_t)NTG * DI * 2;
  p.R = (bf16_t*)take(DIW); p.K = (bf16_t*)take(DIW); p.V = (bf16_t*)take(DIW); p.Z = (bf16_t*)take(DIW);
  p.WF = (bf16_t*)take(DIW); p.YF = (bf16_t*)take(DIW); p.YB = (bf16_t*)take(DIW);
  p.VF = p.YF;
  p.H = p.YB;
  p.HR = p.WF; p.HR0 = p.WF + (size_t)NTG * DM;
  p.LRW = (bf16_t*)take((size_t)NTG * 128 * 2); p.LRA = (bf16_t*)take((size_t)NTG * 128 * 2);
  p.LRV = (bf16_t*)take((size_t)NTG * 32 * 2);
  p.O = (float*)p.R;
  p.BN = (float*)take((size_t)2 * NTG * 32 * 4);
  p.CTXB = (float*)take((size_t)NB * CTX * DM * 4);
  p.MODV = (float*)take((size_t)4 * 9 * 3 * DM * 4);
  p.LB = (float*)take((size_t)4 * DI * 4);
  p.bar = (unsigned*)take((size_t)XCD_BAR_WORDS * 4);
  if (off > ws_size) { fprintf(stderr, "workspace too small: need %zu have %zu\n", off, ws_size); return; }
  hipMemsetAsync(p.bar, 0, (size_t)XCD_BAR_WORDS * 4, stream);
  void* args[] = {&p};
  hipError_t e = hipLaunchCooperativeKernel((void*)fwd_megakernel, dim3(grid_blocks), dim3(256), args, 0, stream);
  if (e != hipSuccess) fprintf(stderr, "cooperative launch failed: %s (grid %d)\n", hipGetErrorString(e), grid_blocks);
}
```

```cpp
#include <hip/hip_runtime.h>
#include <hip/hip_cooperative_groups.h>
#include <cstdio>
#include <cstdint>
namespace cg = cooperative_groups;

typedef unsigned short bf16_t;
using bf16x8 = __attribute__((ext_vector_type(8))) short;
using f32x16 = __attribute__((ext_vector_type(16))) float;
using f32x4 = __attribute__((ext_vector_type(4))) float;
using f2_t = __attribute__((ext_vector_type(2))) float;

constexpr int NB = 8, SEQ = 4096, CTX = 256, TT = 4352, DM = 1024, DI = 2048;
constexpr int GB = 4, NG = NB / GB, NTG = GB * TT;
constexpr int MT = NTG / 128;
constexpr float EPS = 1e-6f;

constexpr size_t OFF_PROJ = 0;
constexpr size_t OFF_RWO = OFF_PROJ + (size_t)2 * 4 * DI * DM;
constexpr size_t OFF_W1 = OFF_RWO + (size_t)2 * DM * DI;
constexpr size_t OFF_A1 = OFF_W1 + (size_t)2 * 128 * DM;
constexpr size_t OFF_V1 = OFF_A1 + (size_t)2 * 128 * DM;
constexpr size_t OFF_V2 = OFF_V1 + (size_t)32 * DM;
constexpr size_t OFF_HWIN = OFF_V2 + (size_t)DI * 32;
constexpr size_t OFF_HWO = OFF_HWIN + (size_t)2 * 5 * DI * DM;
constexpr size_t OFF_W2 = OFF_HWO + (size_t)2 * DM * DI;
constexpr size_t OFF_A2 = OFF_W2 + (size_t)4 * DI * 64;
constexpr size_t WT_TOTAL = OFF_A2 + (size_t)4 * DI * 64;
__device__ bf16_t g_wt[WT_TOTAL];

struct Params {
  const float *x, *c, *ctx, *c_ctx, *mod_w, *mod_b, *pre_g, *post_g, *rw_mix, *rw_proj, *rw_wo, *rw_w0, *rw_w1,
      *rw_w2, *rw_a0, *rw_a1, *rw_a2, *rw_v0, *rw_v1, *rw_v2, *rw_kk, *rw_ka, *rw_rk, *rw_lnw, *rw_lnb, *hg_win,
      *hg_wo, *hg_gn, *hg_lb;
  float* out;
  bf16_t *R, *K, *V, *Z, *WF, *YF, *YB, *VF, *H, *HR, *HR0, *LRW, *LRA, *LRV;
  float *O, *BN, *CTXB, *MODV, *LB;
  unsigned* bar;
};

typedef __bf16 hwbf2_t __attribute__((ext_vector_type(2)));
typedef float hwf2_t __attribute__((ext_vector_type(2)));
__device__ __forceinline__ unsigned pack2(float a, float b) {
  hwf2_t f = {a, b};
  hwbf2_t h = __builtin_convertvector(f, hwbf2_t);
  return __builtin_bit_cast(unsigned, h);
}
__device__ __forceinline__ bf16_t f2bf(float f) { return (bf16_t)(pack2(f, f) & 0xffffu); }
__device__ __forceinline__ float bf2f(bf16_t h) { return __uint_as_float(((unsigned)h) << 16); }
typedef _Float16 h2_t __attribute__((ext_vector_type(2)));
using f16x8 = __attribute__((ext_vector_type(8))) _Float16;
__device__ __forceinline__ unsigned pack2h(float a, float b) {
  h2_t h = {(_Float16)a, (_Float16)b};
  return __builtin_bit_cast(unsigned, h);
}
__device__ __forceinline__ uint4 pack8h(const float* f) {
  uint4 u; u.x = pack2h(f[0], f[1]); u.y = pack2h(f[2], f[3]); u.z = pack2h(f[4], f[5]); u.w = pack2h(f[6], f[7]);
  return u;
}
__device__ __forceinline__ unsigned mixh2(unsigned h, unsigned n, unsigned m) {
  const h2_t hv = __builtin_bit_cast(h2_t, h), nv = __builtin_bit_cast(h2_t, n), mv = __builtin_bit_cast(h2_t, m);
  const h2_t r = hv + (nv - hv) * mv;
  return __builtin_bit_cast(unsigned, r);
}
__device__ __forceinline__ float lo2f(unsigned u) { return __uint_as_float(u << 16); }
__device__ __forceinline__ float hi2f(unsigned u) { return __uint_as_float(u & 0xffff0000u); }
__device__ __forceinline__ float rcpf_(float x) { return __builtin_amdgcn_rcpf(x); }
__device__ __forceinline__ float sigmoidf_(float x) { return rcpf_(1.f + __expf(-x)); }
__device__ __forceinline__ float siluf_(float x) { return x * rcpf_(1.f + __expf(-x)); }
__device__ __forceinline__ float tanhf_(float x) { return 1.f - 2.f * rcpf_(1.f + __expf(2.f * x)); }

__device__ __forceinline__ void lds_barrier() { asm volatile("s_waitcnt lgkmcnt(0)\n\ts_barrier" ::: "memory"); }

__device__ __forceinline__ int opaque_tid() { int t = threadIdx.x; asm volatile("" : "+v"(t)); return t; }

template <int CTRL>
__device__ __forceinline__ float dppf(float v) {
  return __int_as_float(__builtin_amdgcn_update_dpp(0, __float_as_int(v), CTRL, 0xf, 0xf, true));
}
__device__ __forceinline__ float red4(float v) { v += dppf<0xB1>(v); v += dppf<0x4E>(v); return v; }
__device__ __forceinline__ float red8(float v) { v = red4(v); v += dppf<0x141>(v); return v; }
__device__ __forceinline__ float red16(float v) { v = red8(v); v += dppf<0x140>(v); return v; }
__device__ __forceinline__ float red64(float v) {
  v = red16(v);
  v += __shfl_xor(v, 16);
  v += __shfl_xor(v, 32);
  return v;
}

__device__ __forceinline__ void unpack8(const uint4& u, float* f) {
  f[0] = lo2f(u.x); f[1] = hi2f(u.x); f[2] = lo2f(u.y); f[3] = hi2f(u.y);
  f[4] = lo2f(u.z); f[5] = hi2f(u.z); f[6] = lo2f(u.w); f[7] = hi2f(u.w);
}
__device__ __forceinline__ uint4 pack8(const float* f) {
  uint4 u; u.x = pack2(f[0], f[1]); u.y = pack2(f[2], f[3]); u.z = pack2(f[4], f[5]); u.w = pack2(f[6], f[7]);
  return u;
}


#define XB_TMO      128
#define XB_XCNT(j)  (256  + 64 * (j))
#define XB_XSUB(j)  (1280 + 64 * (j))
#define XB_XGEN(j)  (2304 + 64 * (j))
#define XB_TOP      3328
#define XB_TOPGEN   3392
#define XCD_BAR_WORDS 3456
#define XB_SPIN_CAP (1u << 23)
#define LAS __attribute__((address_space(3)))
__device__ __forceinline__ unsigned xb_ld(unsigned* p)              { return __hip_atomic_load(p, __ATOMIC_RELAXED, __HIP_MEMORY_SCOPE_AGENT); }
__device__ __forceinline__ unsigned xb_add(unsigned* p, unsigned v) { return __hip_atomic_fetch_add(p, v, __ATOMIC_RELAXED, __HIP_MEMORY_SCOPE_AGENT); }
__device__ __forceinline__ unsigned xb_xcc_id() { return (unsigned)__builtin_amdgcn_s_getreg((3 << 11) | 20) & 0xFu; }
#define XB_SPIN(cond, bar) do { unsigned _sp = 0; while (cond) { if (_sp < 128u) __builtin_amdgcn_s_sleep(1); else __builtin_amdgcn_s_sleep(20); \
    if ((++_sp & 255u) == 0u) { if (xb_ld(&(bar)[XB_TMO])) break; if (_sp > XB_SPIN_CAP) { atomicAdd(&(bar)[XB_TMO], 1u); break; } } } } while (0)
struct XcdBarrier { unsigned* bar; unsigned x; volatile LAS unsigned* st; };
__device__ __forceinline__ XcdBarrier xcd_barrier_post(unsigned* bar, volatile LAS unsigned* st) {
  XcdBarrier b; b.bar = bar; b.x = xb_xcc_id(); b.st = st;
  if (threadIdx.x == 0) (void)xb_add(&bar[XB_XCNT(b.x)], 1u);
  return b;
}
__device__ __forceinline__ void xcd_barrier_complete(unsigned* bar, unsigned x, unsigned& nloc, unsigned& nx) {
  const unsigned G = gridDim.x * gridDim.y * gridDim.z;
  unsigned sum, cnt, mine, sp = 0u;
  for (;;) {
    sum = 0u; cnt = 0u; mine = 0u;
#pragma unroll
    for (unsigned j = 0; j < 16; ++j) { const unsigned c = xb_ld(&bar[XB_XCNT(j)]); sum += c; cnt += (c > 0u) ? 1u : 0u; mine = (j == x) ? c : mine; }
    if (sum == G) break;
    __builtin_amdgcn_s_sleep(1);
    if ((++sp & 255u) == 0u) { if (xb_ld(&bar[XB_TMO])) break; if (sp > XB_SPIN_CAP) { atomicAdd(&bar[XB_TMO], 1u); break; } }
  }
  nloc = mine > 0u ? mine : 1u; nx = cnt > 0u ? cnt : 1u;
}
__device__ __forceinline__ void xcd_barrier(const XcdBarrier& b) {
  asm volatile("s_waitcnt vmcnt(0)" ::: "memory");
  __syncthreads();
  if (threadIdx.x == 0) {
    unsigned* bar = b.bar;
    __builtin_amdgcn_s_waitcnt(0);
    unsigned nloc = b.st[0], nx = b.st[1];
    if (nloc == 0u) { xcd_barrier_complete(bar, b.x, nloc, nx); b.st[0] = nloc; b.st[1] = nx; }
    const unsigned old = xb_add(&bar[XB_XSUB(b.x)], 1u);
    const unsigned gen = old / nloc;
    if (old + 1u == (gen + 1u) * nloc) {
      __builtin_amdgcn_fence(__ATOMIC_RELEASE, "agent");
      asm volatile("s_waitcnt vmcnt(0)" ::: "memory");
      const unsigned og = xb_add(&bar[XB_TOP], 1u);
      const unsigned tg = og / nx;
      if (og + 1u == (tg + 1u) * nx) xb_add(&bar[XB_TOPGEN], 1u);
      else XB_SPIN(xb_ld(&bar[XB_TOPGEN]) == tg, bar);
      __builtin_amdgcn_fence(__ATOMIC_ACQUIRE, "agent");
      xb_add(&bar[XB_XGEN(b.x)], 1u);
      asm volatile("s_waitcnt vmcnt(0)" ::: "memory");
    } else {
      XB_SPIN(xb_ld(&bar[XB_XGEN(b.x)]) == gen, bar);
      __builtin_amdgcn_fence(__ATOMIC_ACQUIRE, "agent");
      asm volatile("s_waitcnt vmcnt(0)" ::: "memory");
    }
  }
  __syncthreads();
}

__device__ __forceinline__ const float* row_in(const Params& p, int b, int t) {
  return t < CTX ? p.ctx + ((size_t)b * CTX + t) * DM : p.x + ((size_t)b * SEQ + (t - CTX)) * DM;
}
__device__ __forceinline__ float* row_cur(const Params& p, int b, int t) {
  return t < CTX ? p.CTXB + ((size_t)b * CTX + t) * DM : p.out + ((size_t)b * SEQ + (t - CTX)) * DM;
}

__device__ __forceinline__ void phase_mod(const Params& p, char* smem) {
  float* ssil = (float*)smem;
  float* red = ssil + 9 * DM;
  const int tid = opaque_tid(), cl = tid & 63, kp = tid >> 6;
  if (blockIdx.x < 4 * 48) {
    for (int idx = tid; idx < 9 * DM; idx += 256) {
      const int r = idx >> 10, k = idx & 1023;
      ssil[idx] = siluf_(r < 8 ? p.c[r * DM + k] : p.c_ctx[k]);
    }
    __syncthreads();
  }
  for (int task = blockIdx.x; task < 4 * 48; task += gridDim.x) {
    const int l = task / 48, col = (task % 48) * 64 + cl;
    float acc[9];
#pragma unroll
    for (int r = 0; r < 9; ++r) acc[r] = 0.f;
    const float* W = p.mod_w + (size_t)l * DM * 3 * DM + col;
#pragma unroll 4
    for (int k = kp * 256; k < kp * 256 + 256; ++k) {
      const float w = W[(size_t)k * 3 * DM];
#pragma unroll
      for (int r = 0; r < 9; ++r) acc[r] += ssil[r * DM + k] * w;
    }
    __syncthreads();
#pragma unroll
    for (int r = 0; r < 9; ++r) red[(kp * 9 + r) * 64 + cl] = acc[r];
    __syncthreads();
    for (int idx = tid; idx < 9 * 64; idx += 256) {
      const int r = idx >> 6, c2 = idx & 63;
      float s = 0.f;
      for (int q = 0; q < 4; ++q) s += red[(q * 9 + r) * 64 + c2];
      const int cc = (task % 48) * 64 + c2;
      p.MODV[((size_t)l * 9 + r) * 3 * DM + cc] = s + p.mod_b[l * 3 * DM + cc];
    }
  }
  for (int cidx = blockIdx.x * 256 + tid; cidx < DI; cidx += gridDim.x * 256) {
    float v[4], m = -1e30f;
    for (int l = 0; l < 4; ++l) { v[l] = p.hg_lb[l * DI + cidx]; m = fmaxf(m, v[l]); }
    float s = 0.f;
    for (int l = 0; l < 4; ++l) { v[l] = __expf(v[l] - m); s += v[l]; }
    float cum = 0.f;
    for (int l = 0; l < 4; ++l) { cum += v[l] / s; p.LB[l * DI + cidx] = cum - v[0] / s; }
  }
}

__device__ __forceinline__ void conv_matrix(const float* __restrict__ src, int K, int N, bf16_t* __restrict__ dst, char* smem, bool f16out = false) {
  float* ts = (float*)smem;
  const int tid = opaque_tid();
  const int ntn = N / 32, ntile = (K / 64) * ntn;
  for (int tile = blockIdx.x; tile < ntile; tile += gridDim.x) {
    const int k0 = (tile / ntn) * 64, n0 = (tile % ntn) * 32;
    __syncthreads();
#pragma unroll
    for (int i = 0; i < 2; ++i) {
      const int k = (tid >> 3) + 32 * i, n4 = (tid & 7) * 4;
      const float4 v = *(const float4*)(src + (size_t)(k0 + k) * N + n0 + n4);
      ts[k * 33 + n4 + 0] = v.x; ts[k * 33 + n4 + 1] = v.y; ts[k * 33 + n4 + 2] = v.z; ts[k * 33 + n4 + 3] = v.w;
    }
    __syncthreads();
    const int n = tid >> 3, k8 = (tid & 7) * 8;
    float f[8];
#pragma unroll
    for (int e = 0; e < 8; ++e) f[e] = ts[(k8 + e) * 33 + n];
    *(uint4*)(dst + (size_t)(n0 + n) * K + k0 + k8) = f16out ? pack8h(f) : pack8(f);
  }
}
__device__ __forceinline__ void phase_wconv(const Params& p, char* smem) {
  for (int m = 0; m < 8; ++m) conv_matrix(p.rw_proj + (size_t)m * DM * DI, DM, DI, g_wt + OFF_PROJ + (size_t)m * DI * DM, smem, true);
  for (int j = 0; j < 2; ++j) conv_matrix(p.rw_wo + (size_t)j * DI * DM, DI, DM, g_wt + OFF_RWO + (size_t)j * DM * DI, smem);
  for (int m = 0; m < 4; ++m) {
    conv_matrix(p.rw_w1 + (size_t)m * DM * 64, DM, 64, g_wt + OFF_W1 + (size_t)m * 64 * DM, smem, true);
    conv_matrix(p.rw_a1 + (size_t)m * DM * 64, DM, 64, g_wt + OFF_A1 + (size_t)m * 64 * DM, smem, true);
  }
  conv_matrix(p.rw_v1, DM, 32, g_wt + OFF_V1, smem, true);
  for (int m = 0; m < 4; ++m) {
    conv_matrix(p.rw_w2 + (size_t)m * 64 * DI, 64, DI, g_wt + OFF_W2 + (size_t)m * DI * 64, smem);
    conv_matrix(p.rw_a2 + (size_t)m * 64 * DI, 64, DI, g_wt + OFF_A2 + (size_t)m * DI * 64, smem);
  }
  for (int j = 0; j < 2; ++j) conv_matrix(p.hg_win + (size_t)j * DM * 5 * DI, DM, 5 * DI, g_wt + OFF_HWIN + (size_t)j * 5 * DI * DM, smem);
  for (int j = 0; j < 2; ++j) conv_matrix(p.hg_wo + (size_t)j * DI * DM, DI, DM, g_wt + OFF_HWO + (size_t)j * DM * DI, smem);
  for (int idx = blockIdx.x * 256 + opaque_tid(); idx < DI * 32; idx += gridDim.x * 256) {
    const int n = idx >> 5, k = idx & 31;
    g_wt[OFF_V2 + idx] = f2bf(p.rw_v2[(size_t)k * DI + n]);
  }
}

__device__ __forceinline__ void phase_resnorm(const Params& p, int g, int lu, int ln) {
  const int tid = opaque_tid();
  const int lane = tid & 63;
  const int wv = blockIdx.x * 4 + (tid >> 6), nw = gridDim.x * 4;
  for (int tg = wv; tg < NTG; tg += nw) {
    const int bl = tg / TT, t = tg % TT, b = g * GB + bl;
    const bool isctx = t < CTX;
    const int mrow = isctx ? 8 : b;
    float xv[16];
    const float* src = (lu <= 0) ? row_in(p, b, t) : row_cur(p, b, t);
#pragma unroll
    for (int j = 0; j < 4; ++j) {
      const float4 v4 = *(const float4*)(src + j * 256 + lane * 4);
      xv[j * 4 + 0] = v4.x; xv[j * 4 + 1] = v4.y; xv[j * 4 + 2] = v4.z; xv[j * 4 + 3] = v4.w;
    }
    if (lu >= 0 && !(isctx && lu == 3)) {
      float ov[16], ss = 0.f;
      const float* orow = p.O + (size_t)tg * DM;
#pragma unroll
      for (int j = 0; j < 4; ++j) {
        const float4 v4 = *(const float4*)(orow + j * 256 + lane * 4);
        ov[j * 4 + 0] = v4.x; ov[j * 4 + 1] = v4.y; ov[j * 4 + 2] = v4.z; ov[j * 4 + 3] = v4.w;
      }
#pragma unroll
      for (int e = 0; e < 16; ++e) ss += ov[e] * ov[e];
      ss = red64(ss);
      const float rstd = rsqrtf(ss * (1.f / DM) + EPS);
      const float* gate = p.MODV + ((size_t)lu * 9 + mrow) * 3 * DM + 2 * DM;
      const float* pg = p.post_g + lu * DM;
      float* dst = row_cur(p, b, t);
#pragma unroll
      for (int j = 0; j < 4; ++j) {
        const int cc = j * 256 + lane * 4;
        const float4 g4 = *(const float4*)(gate + cc);
        const float4 p4 = *(const float4*)(pg + cc);
        xv[j * 4 + 0] += g4.x * (ov[j * 4 + 0] * rstd * p4.x);
        xv[j * 4 + 1] += g4.y * (ov[j * 4 + 1] * rstd * p4.y);
        xv[j * 4 + 2] += g4.z * (ov[j * 4 + 2] * rstd * p4.z);
        xv[j * 4 + 3] += g4.w * (ov[j * 4 + 3] * rstd * p4.w);
        *(float4*)(dst + cc) = make_float4(xv[j * 4 + 0], xv[j * 4 + 1], xv[j * 4 + 2], xv[j * 4 + 3]);
      }
    }
    if (ln >= 0) {
      for (int pass = 0; pass < (ln == 2 ? 2 : 1); ++pass) {
        const int lp = pass == 0 ? ln : 0;
        bf16_t* hdst = (pass == 0 ? ((ln & 1) == 0 ? p.HR : p.H) : p.HR0) + (size_t)tg * DM;
        if (pass == 1) {
          const float* s0 = row_in(p, b, t);
#pragma unroll
          for (int j = 0; j < 4; ++j) {
            const float4 v4 = *(const float4*)(s0 + j * 256 + lane * 4);
            xv[j * 4 + 0] = v4.x; xv[j * 4 + 1] = v4.y; xv[j * 4 + 2] = v4.z; xv[j * 4 + 3] = v4.w;
          }
        }
        float ss = 0.f;
#pragma unroll
        for (int e = 0; e < 16; ++e) ss += xv[e] * xv[e];
        ss = red64(ss);
        const float rstd = rsqrtf(ss * (1.f / DM) + EPS);
        const float* mv = p.MODV + ((size_t)lp * 9 + mrow) * 3 * DM;
        const float* pg = p.pre_g + lp * DM;
#pragma unroll
        for (int j = 0; j < 4; ++j) {
          const int cc = j * 256 + lane * 4;
          const float4 sh = *(const float4*)(mv + cc);
          const float4 sc = *(const float4*)(mv + DM + cc);
          const float4 p4 = *(const float4*)(pg + cc);
          const float h0 = xv[j * 4 + 0] * rstd * p4.x * (1.f + sc.x) + sh.x;
          const float h1 = xv[j * 4 + 1] * rstd * p4.y * (1.f + sc.y) + sh.y;
          const float h2 = xv[j * 4 + 2] * rstd * p4.z * (1.f + sc.z) + sh.z;
          const float h3 = xv[j * 4 + 3] * rstd * p4.w * (1.f + sc.w) + sh.w;
          uint2 u;
          if ((ln & 1) == 0) {
            const float L = 60000.f;
            u.x = pack2h(fminf(fmaxf(h0, -L), L), fminf(fmaxf(h1, -L), L));
            u.y = pack2h(fminf(fmaxf(h2, -L), L), fminf(fmaxf(h3, -L), L));
          } else {
            u.x = pack2(h0, h1); u.y = pack2(h2, h3);
          }
          *(uint2*)(hdst + cc) = u;
        }
      }
    }
  }
}

constexpr int LDK = 72;
constexpr int TM = 128;

template <int AMODE, class Epi>
__device__ __forceinline__ void gemm_tile(const bf16_t* __restrict__ A, int lda, const float* __restrict__ mix, int m0,
                                          int K, const bf16_t* __restrict__ Bt, int nvalid, char* smem, Epi epi) {
  bf16_t* As = (bf16_t*)smem;
  bf16_t* Bs = As + 2 * TM * LDK;
  float* mixs = (float*)(Bs + 2 * 128 * LDK);
  const int tid = opaque_tid(), lane = tid & 63, w = tid >> 6, wm = w >> 1, wn = w & 1;
  const int lr = lane >> 3, ch = (lane & 7) * 8;
  const int row0 = w * 32 + lr;
  const bf16_t* Ap = A + (size_t)(m0 + row0) * lda + ch;
  const bf16_t* Bp = Bt + (size_t)row0 * K + ch;
  const size_t astep = (size_t)8 * lda, bstep = (size_t)8 * K;
  const int KT = (K + 63) >> 6;
  const int tbase = m0 % TT;
  const bool isctx = tbase < CTX;
  unsigned vmask = 0;
  if (AMODE == 1) {
#pragma unroll
    for (int i = 0; i < 4; ++i) {
      const int t = tbase + row0 + i * 8;
      unsigned m;
      if (isctx) {
        m = (t >= 1 ? 3u : 0u) | (t + 1 < CTX ? 12u : 0u);
      } else {
        const int tl = t - CTX, row = tl >> 6, col = tl & 63;
        m = (col > 0 ? 1u : 0u) | (col < 63 ? 2u : 0u) | (row > 0 ? 4u : 0u) | (row < 63 ? 8u : 0u);
      }
      vmask |= m << (4 * i);
    }
  }

  __syncthreads();
  if (AMODE == 1) {
    const float4 m4 = *(const float4*)(mix + tid * 4);
    ((uint2*)mixs)[tid] = make_uint2(pack2h(m4.x, m4.y), pack2h(m4.z, m4.w));
  }

  f32x16 acc[2][2];
#pragma unroll
  for (int i = 0; i < 2; ++i)
#pragma unroll
    for (int j = 0; j < 2; ++j)
#pragma unroll
      for (int r = 0; r < 16; ++r) acc[i][j][r] = 0.f;

  uint4 a0, a1, a2, a3, n0, n1, n2, n3, b0, b1, b2, b3;
  auto load_regs = [&](int kt) {
    const int k0 = kt * 64;
    const uint4 z4 = make_uint4(0, 0, 0, 0);
    const bool kval = (k0 + ch) < K;
    const bf16_t* ap = Ap + k0;
    const bf16_t* bp = Bp + k0;
    a0 = z4; if (kval) a0 = *(const uint4*)(ap + 0 * astep);
    a1 = z4; if (kval) a1 = *(const uint4*)(ap + 1 * astep);
    a2 = z4; if (kval) a2 = *(const uint4*)(ap + 2 * astep);
    a3 = z4; if (kval) a3 = *(const uint4*)(ap + 3 * astep);
    b0 = z4; if (kval && (row0 + 0) < nvalid) b0 = *(const uint4*)(bp + 0 * bstep);
    b1 = z4; if (kval && (row0 + 8) < nvalid) b1 = *(const uint4*)(bp + 1 * bstep);
    b2 = z4; if (kval && (row0 + 16) < nvalid) b2 = *(const uint4*)(bp + 2 * bstep);
    b3 = z4; if (kval && (row0 + 24) < nvalid) b3 = *(const uint4*)(bp + 3 * bstep);
    if (AMODE == 1) {
      const int q = k0 >> 8;
      const int nb = isctx ? (q < 2 ? -1 : 1) : (q == 0 ? -1 : (q == 1 ? 1 : (q == 2 ? -64 : 64)));
      const bf16_t* np = ap + (ptrdiff_t)nb * lda;
      const unsigned vm = vmask >> q;
      n0 = z4; if ((vm >> 0) & 1u) n0 = *(const uint4*)(np + 0 * astep);
      n1 = z4; if ((vm >> 4) & 1u) n1 = *(const uint4*)(np + 1 * astep);
      n2 = z4; if ((vm >> 8) & 1u) n2 = *(const uint4*)(np + 2 * astep);
      n3 = z4; if ((vm >> 12) & 1u) n3 = *(const uint4*)(np + 3 * astep);
    }
  };
  auto mix8 = [&](const uint4& hv, const uint4& nv, const uint4& mv) -> uint4 {
    uint4 o;
    o.x = mixh2(hv.x, nv.x, mv.x); o.y = mixh2(hv.y, nv.y, mv.y); o.z = mixh2(hv.z, nv.z, mv.z); o.w = mixh2(hv.w, nv.w, mv.w);
    return o;
  };
  auto store_lds = [&](int kt, int buf) {
    bf16_t* ad = As + (buf * TM + row0) * LDK + ch;
    bf16_t* bd = Bs + (buf * 128 + row0) * LDK + ch;
    if (AMODE == 1) {
      const uint4 mv = *(const uint4*)((const bf16_t*)mixs + kt * 64 + ch);
      *(uint4*)(ad + 0 * LDK) = mix8(a0, n0, mv);
      *(uint4*)(ad + 8 * LDK) = mix8(a1, n1, mv);
      *(uint4*)(ad + 16 * LDK) = mix8(a2, n2, mv);
      *(uint4*)(ad + 24 * LDK) = mix8(a3, n3, mv);
    } else {
      *(uint4*)(ad + 0 * LDK) = a0;
      *(uint4*)(ad + 8 * LDK) = a1;
      *(uint4*)(ad + 16 * LDK) = a2;
      *(uint4*)(ad + 24 * LDK) = a3;
    }
    *(uint4*)(bd + 0 * LDK) = b0;
    *(uint4*)(bd + 8 * LDK) = b1;
    *(uint4*)(bd + 16 * LDK) = b2;
    *(uint4*)(bd + 24 * LDK) = b3;
  };
  auto compute = [&](int buf) {
    const bf16_t* ab = As + (buf * TM + wm * 64 + (lane & 31)) * LDK + (lane >> 5) * 8;
    const bf16_t* bb = Bs + (buf * 128 + wn * 64 + (lane & 31)) * LDK + (lane >> 5) * 8;
#pragma unroll
    for (int kk = 0; kk < 4; ++kk) {
      const bf16x8 af0 = *(const bf16x8*)(ab + kk * 16), af1 = *(const bf16x8*)(ab + 32 * LDK + kk * 16);
      const bf16x8 bf0 = *(const bf16x8*)(bb + kk * 16), bf1 = *(const bf16x8*)(bb + 32 * LDK + kk * 16);
      if (AMODE == 1) {
        const f16x8 ha0 = __builtin_bit_cast(f16x8, af0), ha1 = __builtin_bit_cast(f16x8, af1);
        const f16x8 hb0 = __builtin_bit_cast(f16x8, bf0), hb1 = __builtin_bit_cast(f16x8, bf1);
        acc[0][0] = __builtin_amdgcn_mfma_f32_32x32x16_f16(ha0, hb0, acc[0][0], 0, 0, 0);
        acc[0][1] = __builtin_amdgcn_mfma_f32_32x32x16_f16(ha0, hb1, acc[0][1], 0, 0, 0);
        acc[1][0] = __builtin_amdgcn_mfma_f32_32x32x16_f16(ha1, hb0, acc[1][0], 0, 0, 0);
        acc[1][1] = __builtin_amdgcn_mfma_f32_32x32x16_f16(ha1, hb1, acc[1][1], 0, 0, 0);
      } else {
        acc[0][0] = __builtin_amdgcn_mfma_f32_32x32x16_bf16(af0, bf0, acc[0][0], 0, 0, 0);
        acc[0][1] = __builtin_amdgcn_mfma_f32_32x32x16_bf16(af0, bf1, acc[0][1], 0, 0, 0);
        acc[1][0] = __builtin_amdgcn_mfma_f32_32x32x16_bf16(af1, bf0, acc[1][0], 0, 0, 0);
        acc[1][1] = __builtin_amdgcn_mfma_f32_32x32x16_bf16(af1, bf1, acc[1][1], 0, 0, 0);
      }
    }
  };
  load_regs(0);
  lds_barrier();
  store_lds(0, 0);
  if (KT > 1) load_regs(1);
  lds_barrier();
  for (int kt = 0; kt < KT; ++kt) {
    compute(kt & 1);
    if (kt + 1 < KT) store_lds(kt + 1, (kt + 1) & 1);
    if (kt + 2 < KT) load_regs(kt + 2);
    lds_barrier();
  }
  float* Cs = (float*)smem;
#pragma unroll
  for (int i = 0; i < 2; ++i)
#pragma unroll
    for (int j = 0; j < 2; ++j)
#pragma unroll
      for (int r = 0; r < 16; ++r)
        Cs[(wm * 64 + i * 32 + (r & 3) + 8 * (r >> 2) + 4 * (lane >> 5)) * 132 + wn * 64 + j * 32 + (lane & 31)] = acc[i][j][r];
  lds_barrier();
#pragma unroll 2
  for (int it = 0; it < 8; ++it) {
    const int idx = it * 256 + tid, row = idx >> 4, c8 = (idx & 15) * 8;
    const float4 v0 = *(const float4*)(Cs + row * 132 + c8), v1 = *(const float4*)(Cs + row * 132 + c8 + 4);
    float v[8] = {v0.x, v0.y, v0.z, v0.w, v1.x, v1.y, v1.z, v1.w};
    epi(m0 + row, c8, v);
  }
}

__device__ __forceinline__ void phase_rw_proj(const Params& p, int j, char* smem, int zonly, int bid, int nb) {
  const int ntn = zonly ? 16 : (j == 0 ? 50 : 67);
  const float* mixb = p.rw_mix + (size_t)j * 6 * DM;
  const bool xaware = (nb & 7) == 0;
  const int xcd = xaware ? (bid & 7) : 0, slot = xaware ? (bid >> 3) : bid, nslots = xaware ? (nb >> 3) : nb;
  const int ntx = xaware ? (ntn - xcd + 7) / 8 : ntn;
  for (int li = slot; li < MT * ntx; li += nslots) {
    const int mt = li / ntx, ntl = xaware ? xcd + 8 * (li % ntx) : (li % ntx), m0 = mt * 128;
    const int nt = zonly ? 48 + ntl : (ntl < 48 ? ntl : ntl + 16);
    if (nt < 64) {
      const int pi = nt >> 4, n0 = (nt & 15) * 128;
      const int mi = pi == 0 ? 0 : (pi == 1 ? 2 : (pi == 2 ? 3 : 5));
      const bf16_t* Bw = g_wt + OFF_PROJ + ((size_t)(j * 4 + pi) * DI + n0) * DM;
      bf16_t* dst = pi == 0 ? p.R : (pi == 1 ? p.K : (pi == 2 ? p.V : p.Z));
      if (pi == 3) {
        gemm_tile<1>(p.HR, DM, mixb + mi * DM, m0, DM, Bw, 128, smem,
                     [&](int row, int col, float* v) {
#pragma unroll
        for (int e = 0; e < 8; ++e) v[e] = siluf_(v[e]);
        *(uint4*)(dst + (size_t)row * DI + n0 + col) = pack8(v); });
      } else {
        gemm_tile<1>(p.HR, DM, mixb + mi * DM, m0, DM, Bw, 128, smem,
                     [&](int row, int col, float* v) { *(uint4*)(dst + (size_t)row * DI + n0 + col) = pack8(v); });
      }
    } else if (nt == 64) {
      gemm_tile<1>(p.HR, DM, mixb + 1 * DM, m0, DM, g_wt + OFF_W1 + (size_t)j * 128 * DM, 128, smem,
                   [&](int row, int col, float* v) {
#pragma unroll
        for (int e = 0; e < 8; ++e) v[e] = tanhf_(v[e]);
        *(uint4*)(p.LRW + (size_t)row * 128 + col) = pack8(v); });
    } else if (nt == 65) {
      gemm_tile<1>(p.HR, DM, mixb + 4 * DM, m0, DM, g_wt + OFF_A1 + (size_t)j * 128 * DM, 128, smem,
                   [&](int row, int col, float* v) { *(uint4*)(p.LRA + (size_t)row * 128 + col) = pack8(v); });
    } else if (nt == 66) {
      gemm_tile<1>(p.HR, DM, mixb + 3 * DM, m0, DM, g_wt + OFF_V1, 32, smem, [&](int row, int col, float* v) {
        if (col < 32) *(uint4*)(p.LRV + (size_t)row * 32 + col) = pack8(v);
      });
    } else {
      const int n0 = (nt - 67) * 128;
      const bf16_t* Bw = g_wt + OFF_PROJ + ((size_t)2 * DI + n0) * DM;
      gemm_tile<1>(p.HR0, DM, p.rw_mix + 3 * DM, m0, DM, Bw, 128, smem,
                   [&](int row, int col, float* v) { *(uint4*)(p.VF + (size_t)row * DI + n0 + col) = pack8(v); });
    }
  }
}

__device__ __forceinline__ void phase_rw_lr2(const Params& p, int j, char* smem) {
  for (int tile = blockIdx.x; tile < MT * 16; tile += gridDim.x) {
    const int mt = tile / 16, nt = tile % 16, m0 = mt * 128;
    const int n0 = nt * 128;
    const bf16_t* Bw = g_wt + OFF_V2 + (size_t)n0 * 32;
    const float* v0 = p.rw_v0 + n0;
    gemm_tile<0>(p.LRV, 32, nullptr, m0, 32, Bw, 128, smem, [&](int row, int col, float* v) {
      const size_t idx = (size_t)row * DI + n0 + col;
      float vv[8], vf[8];
      unpack8(*(const uint4*)(p.V + idx), vv); unpack8(*(const uint4*)(p.VF + idx), vf);
#pragma unroll
      for (int e = 0; e < 8; ++e) vv[e] += (vf[e] - vv[e]) * sigmoidf_(v[e] + v0[col + e]);
      *(uint4*)(p.V + idx) = pack8(vv);
    });
  }
}

constexpr int RCH = 32;
__device__ __forceinline__ int scan_pos(int dir, int s) { return dir == 0 ? s : (s < CTX ? CTX - 1 - s : TT + CTX - 1 - s); }

__device__ __forceinline__ void phase_rw_scan(const Params& p, int j, char* smem) {
  float* op = (float*)smem;
  float* vv = op + RCH * 4 * 64;
  float* sc = vv + RCH * 64;
  float* LWs = sc + RCH * 2;
  float* AAs = LWs + RCH * 64;
  float* yb = AAs;
  bf16_t* LRs = (bf16_t*)(AAs + RCH * 64);
  const int tid = opaque_tid(), lane = tid & 63, w = tid >> 6;
  const int ptau = tid >> 3, pc8 = (tid & 7) * 8;
  const int r2 = lane >> 3, ko = (lane & 7) * 8;
  const int row0 = w * 16 + r2, row1 = row0 + 8;
  for (int unit = blockIdx.x; unit < GB * 64; unit += gridDim.x) {
    const int bl = unit >> 6, h = (unit >> 1) & 31, dir = unit & 1;
    bf16_t* Y = dir == 0 ? p.YF : p.YB;
    float pkk[8], pka[8], prk[8];
#pragma unroll
    for (int e = 0; e < 8; ++e) {
      const int cc = j * DI + h * 64 + pc8 + e;
      pkk[e] = p.rw_kk[cc]; pka[e] = p.rw_ka[cc]; prk[e] = p.rw_rk[cc];
    }
    __syncthreads();
    const int mm = w >> 1, nh = w & 1;
    const float bias = (mm == 0 ? p.rw_w0 : p.rw_a0)[((size_t)j * 2 + dir) * DI + h * 64 + nh * 32 + (lane & 31)];
    bf16x8 wfr[4];
    {
      const bf16_t* w2g = g_wt + (mm == 0 ? OFF_W2 : OFF_A2) + (((size_t)j * 2 + dir) * DI + h * 64 + nh * 32 + (lane & 31)) * 64 + (lane >> 5) * 8;
#pragma unroll
      for (int kk = 0; kk < 4; ++kk) wfr[kk] = *(const bf16x8*)(w2g + kk * 16);
    }
    f2_t S0[4], S1[4];
#pragma unroll
    for (int e = 0; e < 4; ++e) { S0[e] = f2_t{0.f, 0.f}; S1[e] = f2_t{0.f, 0.f}; }
    uint4 gr, gk, gv, gl0, gl1;
    const int lmat = (tid & 7) >> 2, lcol = (tid & 3) * 16;
    const size_t ubase = (size_t)bl * TT * DI + h * 64 + pc8;
    const bf16_t* const rp = p.R + ubase;
    const bf16_t* const kp = p.K + ubase;
    const bf16_t* const vp_ = p.V + ubase;
    const bf16_t* const lrp = (lmat == 0 ? p.LRW : p.LRA) + (size_t)bl * TT * 128 + dir * 64 + lcol;
    auto gload = [&](int chunk) {
      const int pos = scan_pos(dir, chunk * RCH + ptau);
      const size_t o = (size_t)pos * DI;
      gr = *(const uint4*)(rp + o); gk = *(const uint4*)(kp + o); gv = *(const uint4*)(vp_ + o);
      const bf16_t* lr = lrp + (size_t)pos * 128;
      gl0 = *(const uint4*)(lr); gl1 = *(const uint4*)(lr + 8);
    };
    gload(0);
    for (int chunk = 0; chunk < TT / RCH; ++chunk) {
      *(uint4*)(LRs + (lmat * RCH + ptau) * 72 + lcol) = gl0;
      *(uint4*)(LRs + (lmat * RCH + ptau) * 72 + lcol + 8) = gl1;
      lds_barrier();
      {
        f32x16 acc;
#pragma unroll
        for (int r = 0; r < 16; ++r) acc[r] = 0.f;
#pragma unroll
        for (int kk = 0; kk < 4; ++kk) {
          const bf16x8 af = *(const bf16x8*)(LRs + (mm * RCH + (lane & 31)) * 72 + kk * 16 + (lane >> 5) * 8);
          acc = __builtin_amdgcn_mfma_f32_32x32x16_bf16(af, wfr[kk], acc, 0, 0, 0);
        }
        const int chn = nh * 32 + (lane & 31), hh = lane >> 5;
        if (mm == 0) {
          float lwv[16], pf[16], own[4], oth[4];
#pragma unroll
          for (int r = 0; r < 16; ++r) lwv[r] = -0.60653066f * sigmoidf_(acc[r] + bias);
#pragma unroll
          for (int g = 0; g < 4; ++g) {
            pf[g * 4] = lwv[g * 4];
            pf[g * 4 + 1] = pf[g * 4] + lwv[g * 4 + 1];
            pf[g * 4 + 2] = pf[g * 4 + 1] + lwv[g * 4 + 2];
            pf[g * 4 + 3] = pf[g * 4 + 2] + lwv[g * 4 + 3];
            own[g] = pf[g * 4 + 3];
            oth[g] = __shfl_xor(own[g], 32);
          }
          float base = 0.f;
#pragma unroll
          for (int g = 0; g < 4; ++g) {
            const float off = base + (hh ? oth[g] : 0.f);
#pragma unroll
            for (int q = 0; q < 4; ++q) {
              const int t = q + 8 * g + 4 * hh;
              const float c = off + pf[g * 4 + q];
              LWs[t * 64 + chn] = c;
            }
            base += own[g] + oth[g];
          }
        } else {
#pragma unroll
          for (int r = 0; r < 16; ++r) {
            const int t = (r & 3) + 8 * (r >> 2) + 4 * hh;
            AAs[t * 64 + chn] = sigmoidf_(acc[r] + bias);
          }
        }
      }
      lds_barrier();
      {
        float r[8], k[8], v[8], cm[8], cp[8], a[8];
        unpack8(gr, r); unpack8(gk, k); unpack8(gv, v);
#pragma unroll
        for (int e = 0; e < 8; ++e) {
          cm[e] = LWs[ptau * 64 + pc8 + e]; cp[e] = ptau > 0 ? LWs[(ptau - 1) * 64 + pc8 + e] : 0.f; a[e] = AAs[ptau * 64 + pc8 + e];
        }
        float kkv[8], ss = 0.f;
#pragma unroll
        for (int e = 0; e < 8; ++e) { kkv[e] = k[e] * pkk[e]; ss += kkv[e] * kkv[e]; }
        ss = red8(ss);
        const float inv = rsqrtf(fmaxf(ss, 1e-24f));
        float br = 0.f, kr = 0.f, bon = 0.f;
        float o0[8], o1[8], o2[8], o3[8];
#pragma unroll
        for (int e = 0; e < 8; ++e) {
          const float kkn = kkv[e] * inv;
          const float P = __expf(cm[e]), Pp = __expf(cp[e]);
          const float iP = rcpf_(P);
          const float kd = k[e] * (1.f + (a[e] - 1.f) * pka[e]);
          const float bb = kkn * a[e];
          o0[e] = -kkn * Pp; o1[e] = r[e] * P; o2[e] = bb * iP; o3[e] = kd * iP;
          br += bb * r[e]; kr += kd * r[e]; bon += r[e] * kd * prk[e];
        }
        br = red8(br); kr = red8(kr); bon = red8(bon);
        float* od = op + ptau * 256 + pc8;
        *(float4*)(od) = make_float4(o0[0], o0[1], o0[2], o0[3]); *(float4*)(od + 4) = make_float4(o0[4], o0[5], o0[6], o0[7]);
        *(float4*)(od + 64) = make_float4(o1[0], o1[1], o1[2], o1[3]); *(float4*)(od + 68) = make_float4(o1[4], o1[5], o1[6], o1[7]);
        *(float4*)(od + 128) = make_float4(o2[0], o2[1], o2[2], o2[3]); *(float4*)(od + 132) = make_float4(o2[4], o2[5], o2[6], o2[7]);
        *(float4*)(od + 192) = make_float4(o3[0], o3[1], o3[2], o3[3]); *(float4*)(od + 196) = make_float4(o3[4], o3[5], o3[6], o3[7]);
        float* vd = vv + ptau * 64 + pc8;
        *(float4*)(vd) = make_float4(v[0], v[1], v[2], v[3]); *(float4*)(vd + 4) = make_float4(v[4], v[5], v[6], v[7]);
        if ((tid & 7) == 0) {
          sc[ptau * 2] = br; sc[ptau * 2 + 1] = kr;
          const int pos = scan_pos(dir, chunk * RCH + ptau);
          p.BN[((size_t)dir * NTG + (size_t)bl * TT + pos) * 32 + h] = bon;
        }
      }
      lds_barrier();
      if (chunk + 1 < TT / RCH) gload(chunk + 1);
      {
        struct StepOps { float4 n0, n1, q0, q1, b0, b1, k0, k1; float v0, v1; float2 s; };
        auto ldops = [&](StepOps& o, int tau) {
          const float* ob = op + tau * 256 + ko;
          o.n0 = *(const float4*)(ob); o.n1 = *(const float4*)(ob + 4);
          o.q0 = *(const float4*)(ob + 64); o.q1 = *(const float4*)(ob + 68);
          o.b0 = *(const float4*)(ob + 128); o.b1 = *(const float4*)(ob + 132);
          o.k0 = *(const float4*)(ob + 192); o.k1 = *(const float4*)(ob + 196);
          o.v0 = vv[tau * 64 + row0]; o.v1 = vv[tau * 64 + row1];
          o.s = *(const float2*)(sc + tau * 2);
        };
        auto dostep = [&](const StepOps& o, int tau) {
          const float nk[8] = {o.n0.x, o.n0.y, o.n0.z, o.n0.w, o.n1.x, o.n1.y, o.n1.z, o.n1.w};
          const float rr[8] = {o.q0.x, o.q0.y, o.q0.z, o.q0.w, o.q1.x, o.q1.y, o.q1.z, o.q1.w};
          const float bb[8] = {o.b0.x, o.b0.y, o.b0.z, o.b0.w, o.b1.x, o.b1.y, o.b1.z, o.b1.w};
          const float kd[8] = {o.k0.x, o.k0.y, o.k0.z, o.k0.w, o.k1.x, o.k1.y, o.k1.z, o.k1.w};
          f2_t a10 = {0.f, 0.f}, a11 = {0.f, 0.f}, a20 = {0.f, 0.f}, a21 = {0.f, 0.f};
#pragma unroll
          for (int e = 0; e < 4; ++e) {
            const f2_t nk2 = {nk[2 * e], nk[2 * e + 1]}, rr2 = {rr[2 * e], rr[2 * e + 1]};
            a10 = __builtin_elementwise_fma(S0[e], nk2, a10); a11 = __builtin_elementwise_fma(S1[e], nk2, a11);
            a20 = __builtin_elementwise_fma(S0[e], rr2, a20); a21 = __builtin_elementwise_fma(S1[e], rr2, a21);
          }
          float d10 = a10.x + a10.y, d11 = a11.x + a11.y, d20 = a20.x + a20.y, d21 = a21.x + a21.y;
          d10 = red8(d10); d11 = red8(d11); d20 = red8(d20); d21 = red8(d21);
          const float y0 = d20 + d10 * o.s.x + o.v0 * o.s.y;
          const float y1 = d21 + d11 * o.s.x + o.v1 * o.s.y;
          const f2_t sa0 = {d10, d10}, sa1 = {d11, d11}, vv0 = {o.v0, o.v0}, vv1 = {o.v1, o.v1};
#pragma unroll
          for (int e = 0; e < 4; ++e) {
            const f2_t bb2 = {bb[2 * e], bb[2 * e + 1]}, kd2 = {kd[2 * e], kd[2 * e + 1]};
            S0[e] = __builtin_elementwise_fma(sa0, bb2, __builtin_elementwise_fma(vv0, kd2, S0[e]));
            S1[e] = __builtin_elementwise_fma(sa1, bb2, __builtin_elementwise_fma(vv1, kd2, S1[e]));
          }
          if ((lane & 7) == 0) { yb[tau * 64 + row0] = y0; yb[tau * 64 + row1] = y1; }
        };
        StepOps oa, ob2;
        ldops(oa, 0);
#pragma unroll 1
        for (int tau = 0; tau < RCH; tau += 2) {
          ldops(ob2, tau + 1);
          dostep(oa, tau);
          ldops(oa, tau + 2);
          dostep(ob2, tau + 1);
        }
#pragma unroll
        for (int e = 0; e < 4; ++e) {
          const f2_t pc = {__expf(LWs[(RCH - 1) * 64 + ko + 2 * e]), __expf(LWs[(RCH - 1) * 64 + ko + 2 * e + 1])};
          S0[e] *= pc; S1[e] *= pc;
        }
      }
      lds_barrier();
      {
        const int pos = scan_pos(dir, chunk * RCH + ptau);
        const float* ys = yb + ptau * 64 + pc8;
        float yv[8];
#pragma unroll
        for (int e = 0; e < 8; ++e) yv[e] = ys[e];
        *(uint4*)(Y + ((size_t)bl * TT + pos) * DI + h * 64 + pc8) = pack8(yv);
      }
    }
    lds_barrier();
  }
}

__device__ __forceinline__ void phase_rw_gate(const Params& p, int j) {
  const int tid = opaque_tid(), h = tid >> 3;
  const int c0 = tid * 8;
  float lnw[8], lnb[8];
#pragma unroll
  for (int e = 0; e < 8; ++e) { lnw[e] = p.rw_lnw[j * DI + c0 + e]; lnb[e] = p.rw_lnb[j * DI + c0 + e]; }
  for (int tg = blockIdx.x; tg < NTG; tg += gridDim.x) {
    const size_t base = (size_t)tg * DI + c0;
    float yf[8], yb[8], v[8], z[8];
    unpack8(*(const uint4*)(p.YF + base), yf); unpack8(*(const uint4*)(p.YB + base), yb);
    unpack8(*(const uint4*)(p.V + base), v); unpack8(*(const uint4*)(p.Z + base), z);
    const float bon = p.BN[(size_t)tg * 32 + h] + p.BN[((size_t)NTG + tg) * 32 + h];
    float y[8], s = 0.f;
#pragma unroll
    for (int e = 0; e < 8; ++e) { y[e] = yf[e] + yb[e]; s += y[e]; }
    const float mu = red8(s) * (1.f / 64.f);
    float s2 = 0.f;
#pragma unroll
    for (int e = 0; e < 8; ++e) { y[e] -= mu; s2 += y[e] * y[e]; }
    const float rstd = rsqrtf(red8(s2) * (1.f / 64.f) + 64e-5f);
#pragma unroll
    for (int e = 0; e < 8; ++e) y[e] = (y[e] * rstd * lnw[e] + lnb[e] + bon * v[e]) * z[e];
    *(uint4*)(p.YF + base) = pack8(y);
  }
}

__device__ __forceinline__ void phase_out(const Params& p, const bf16_t* wo, char* smem) {
  for (int tile = blockIdx.x; tile < MT * 8; tile += gridDim.x) {
    const int mt = tile / 8, nt = tile % 8, m0 = mt * 128, n0 = nt * 128;
    const bf16_t* Bw = wo + (size_t)n0 * DI;
    gemm_tile<0>(p.YF, DI, nullptr, m0, DI, Bw, 128, smem,
                 [&](int row, int col, float* v) {
      float* o = p.O + (size_t)row * DM + n0 + col;
      *(float4*)o = make_float4(v[0], v[1], v[2], v[3]); *(float4*)(o + 4) = make_float4(v[4], v[5], v[6], v[7]); });
  }
}

__device__ __forceinline__ void phase_hg_proj(const Params& p, int j, char* smem) {
  const int layer = 2 * j + 1;
  for (int tile = blockIdx.x; tile < MT * 80; tile += gridDim.x) {
    const int mt = tile / 80, nt = tile % 80, m0 = mt * 128;
    const int seg = nt >> 4, n0 = (nt & 15) * 128;
    const bf16_t* Bw = g_wt + OFF_HWIN + ((size_t)j * 5 * DI + (size_t)seg * DI + n0) * DM;
    bf16_t* dst = seg == 0 ? p.R : (seg == 1 ? p.K : (seg == 2 ? p.WF : (seg == 3 ? p.V : p.Z)));
    if (seg == 0 || seg == 4) {
      gemm_tile<0>(p.H, DM, nullptr, m0, DM, Bw, 128, smem, [&](int row, int col, float* v) {
#pragma unroll
        for (int e = 0; e < 8; ++e) v[e] = siluf_(v[e]);
        *(uint4*)(dst + (size_t)row * DI + n0 + col) = pack8(v); });
    } else if (seg == 3) {
      gemm_tile<0>(p.H, DM, nullptr, m0, DM, Bw, 128, smem,
                   [&](int row, int col, float* v) { *(uint4*)(dst + (size_t)row * DI + n0 + col) = pack8(v); });
    } else {
      const float* lbp = p.LB + layer * DI + n0;
      gemm_tile<0>(p.H, DM, nullptr, m0, DM, Bw, 128, smem, [&](int row, int col, float* v) {
        const float4 l0 = *(const float4*)(lbp + col), l1 = *(const float4*)(lbp + col + 4);
        const float lb[8] = {l0.x, l0.y, l0.z, l0.w, l1.x, l1.y, l1.z, l1.w};
#pragma unroll
        for (int e = 0; e < 8; ++e) v[e] = __logf(lb[e] + (1.f - lb[e]) * sigmoidf_(v[e]));
        *(uint4*)(dst + (size_t)row * DI + n0 + col) = pack8(v); });
    }
  }
}

constexpr int HC = 32;
constexpr int QS = 136;
constexpr int SS = 40;
__device__ __forceinline__ void phase_hg_scan(const Params& p, int layer, char* smem) {
  bf16_t* qe = (bf16_t*)smem;
  bf16_t* ke = qe + HC * QS;
  bf16_t* kdT = ke + HC * QS;
  bf16_t* vT = kdT + 128 * SS;
  bf16_t* att = vT + 64 * SS;
  bf16_t* ST = att + HC * SS;
  float* dC = (float*)(ST + 64 * QS);
  const int tid = opaque_tid(), lane = tid & 63, w = tid >> 6;
  for (int unit = blockIdx.x; unit < GB * 64; unit += gridDim.x) {
    const int vs = unit & 1, dir = (unit >> 1) & 1, h = (unit >> 2) & 15, bl = unit >> 6;
    const bf16_t* FL = dir == 0 ? p.K : p.WF;
    bf16_t* Y = dir == 0 ? p.YF : p.YB;
    const int st = lane & 31, cg = w * 2 + (lane >> 5), kb = cg * 16, vb = cg * 8;
    f32x16 sacc[2];
#pragma unroll
    for (int r = 0; r < 16; ++r) { sacc[0][r] = 0.f; sacc[1][r] = 0.f; }
    __syncthreads();
    for (int idx = tid; idx < 64 * QS / 2; idx += 256) ((unsigned*)ST)[idx] = 0u;
    uint4 gq0, gq1, gf0, gf1, gvv;
    const size_t ubase = (size_t)bl * TT * DI + h * 128;
    const bf16_t* const qp = p.R + ubase + kb;
    const bf16_t* const fp_ = FL + ubase + kb;
    const bf16_t* const ip = p.V + ubase + vs * 64 + vb;
    auto gload = [&](int chunk) {
      const int pos = scan_pos(dir, chunk * HC + st);
      const size_t o = (size_t)pos * DI;
      gq0 = *(const uint4*)(qp + o); gq1 = *(const uint4*)(qp + o + 8);
      gf0 = *(const uint4*)(fp_ + o); gf1 = *(const uint4*)(fp_ + o + 8);
      gvv = *(const uint4*)(ip + o);
    };
    gload(0);
    for (int chunk = 0; chunk < TT / HC; ++chunk) {
      float q[16], cum[16], one[16];
      {
        unpack8(gq0, q); unpack8(gq1, q + 8); unpack8(gf0, cum); unpack8(gf1, cum + 8);
#pragma unroll
        for (int e = 0; e < 16; ++e) {
          float c = cum[e];
          one[e] = 1.f - __expf(c);
          c += __int_as_float(__builtin_amdgcn_update_dpp(0, __float_as_int(c), 0x111, 0xf, 0xf, false));
          c += __int_as_float(__builtin_amdgcn_update_dpp(0, __float_as_int(c), 0x112, 0xf, 0xf, false));
          c += __int_as_float(__builtin_amdgcn_update_dpp(0, __float_as_int(c), 0x114, 0xf, 0xf, false));
          c += __int_as_float(__builtin_amdgcn_update_dpp(0, __float_as_int(c), 0x118, 0xf, 0xf, false));
          c += __int_as_float(__builtin_amdgcn_update_dpp(0, __float_as_int(c), 0x142, 0xa, 0xf, false));
          cum[e] = c;
        }
      }
      const uint4 vreg = gvv;
      lds_barrier();
      {
        float qo[16], ko[16];
#pragma unroll
        for (int e = 0; e < 16; ++e) {
          const float c31 = __int_as_float(__builtin_amdgcn_readlane(__float_as_int(cum[e]), 31));
          const float c63 = __int_as_float(__builtin_amdgcn_readlane(__float_as_int(cum[e]), 63));
          const float cC = (lane >> 5) ? c63 : c31;
          const float ec = __expf(fmaxf(cum[e], -80.f));
          const float inv = rcpf_(ec);
          const float eC = __expf(cC);
          qo[e] = q[e] * ec;
          ko[e] = one[e] * inv;
          kdT[(kb + e) * SS + st] = f2bf(one[e] * inv * eC);
          if (st == 31) dC[kb + e] = eC;
        }
        *(uint4*)(qe + st * QS + kb) = pack8(qo); *(uint4*)(qe + st * QS + kb + 8) = pack8(qo + 8);
        *(uint4*)(ke + st * QS + kb) = pack8(ko); *(uint4*)(ke + st * QS + kb + 8) = pack8(ko + 8);
        const bf16_t* vp = (const bf16_t*)&vreg;
#pragma unroll
        for (int e = 0; e < 8; ++e) vT[(vb + e) * SS + st] = vp[e];
      }
      lds_barrier();
      if (chunk + 1 < TT / HC) gload(chunk + 1);
      {
        const int mi = w >> 1, ni = w & 1;
        f32x4 a4 = {0.f, 0.f, 0.f, 0.f};
#pragma unroll
        for (int kk = 0; kk < 4; ++kk) {
          const bf16x8 af = *(const bf16x8*)(qe + (mi * 16 + (lane & 15)) * QS + kk * 32 + (lane >> 4) * 8);
          const bf16x8 bf = *(const bf16x8*)(ke + (ni * 16 + (lane & 15)) * QS + kk * 32 + (lane >> 4) * 8);
          a4 = __builtin_amdgcn_mfma_f32_16x16x32_bf16(af, bf, a4, 0, 0, 0);
        }
        const int s = ni * 16 + (lane & 15);
#pragma unroll
        for (int r = 0; r < 4; ++r) {
          const int t = mi * 16 + (lane >> 4) * 4 + r;
          att[t * SS + s] = f2bf(s <= t ? a4[r] : 0.f);
        }
      }
      lds_barrier();
      {
#pragma unroll
        for (int mh = 0; mh < 2; ++mh) {
          f32x4 y4 = {0.f, 0.f, 0.f, 0.f};
          {
            const bf16x8 af = *(const bf16x8*)(att + (mh * 16 + (lane & 15)) * SS + (lane >> 4) * 8);
            const bf16x8 bf = *(const bf16x8*)(vT + (w * 16 + (lane & 15)) * SS + (lane >> 4) * 8);
            y4 = __builtin_amdgcn_mfma_f32_16x16x32_bf16(af, bf, y4, 0, 0, 0);
          }
#pragma unroll
          for (int kk = 0; kk < 4; ++kk) {
            const bf16x8 af = *(const bf16x8*)(qe + (mh * 16 + (lane & 15)) * QS + kk * 32 + (lane >> 4) * 8);
            const bf16x8 bf = *(const bf16x8*)(ST + (w * 16 + (lane & 15)) * QS + kk * 32 + (lane >> 4) * 8);
            y4 = __builtin_amdgcn_mfma_f32_16x16x32_bf16(af, bf, y4, 0, 0, 0);
          }
#pragma unroll
          for (int r = 0; r < 4; ++r) {
            const int t = mh * 16 + (lane >> 4) * 4 + r;
            const int pos = scan_pos(dir, chunk * HC + t);
            Y[((size_t)bl * TT + pos) * DI + h * 128 + vs * 64 + w * 16 + (lane & 15)] = f2bf(y4[r]);
          }
        }
      }
      lds_barrier();
      {
        float dk[16];
#pragma unroll
        for (int r = 0; r < 16; ++r) dk[r] = dC[w * 32 + (r & 3) + 8 * (r >> 2) + 4 * (lane >> 5)];
#pragma unroll
        for (int nt = 0; nt < 2; ++nt) {
#pragma unroll
          for (int r = 0; r < 16; ++r) sacc[nt][r] *= dk[r];
#pragma unroll
          for (int ks = 0; ks < 2; ++ks) {
            const bf16x8 af = *(const bf16x8*)(kdT + (w * 32 + (lane & 31)) * SS + ks * 16 + (lane >> 5) * 8);
            const bf16x8 bf = *(const bf16x8*)(vT + (nt * 32 + (lane & 31)) * SS + ks * 16 + (lane >> 5) * 8);
            sacc[nt] = __builtin_amdgcn_mfma_f32_32x32x16_bf16(af, bf, sacc[nt], 0, 0, 0);
          }
#pragma unroll
          for (int gq = 0; gq < 4; ++gq) {
            uint2 u;
            u.x = pack2(sacc[nt][gq * 4 + 0], sacc[nt][gq * 4 + 1]);
            u.y = pack2(sacc[nt][gq * 4 + 2], sacc[nt][gq * 4 + 3]);
            *(uint2*)(ST + (nt * 32 + (lane & 31)) * QS + w * 32 + gq * 8 + (lane >> 5) * 4) = u;
          }
        }
      }
    }
    lds_barrier();
  }
}

__device__ __forceinline__ void phase_hg_gate(const Params& p, int j) {
  const int tid = opaque_tid();
  const int c0 = tid * 8;
  float gn[8];
#pragma unroll
  for (int e = 0; e < 8; ++e) gn[e] = p.hg_gn[j * 128 + ((c0 + e) & 127)];
  for (int tg = blockIdx.x; tg < NTG; tg += gridDim.x) {
    const size_t base = (size_t)tg * DI + c0;
    float yf[8], yb[8], z[8];
    unpack8(*(const uint4*)(p.YF + base), yf); unpack8(*(const uint4*)(p.YB + base), yb);
    unpack8(*(const uint4*)(p.Z + base), z);
    float y[8], s2 = 0.f;
#pragma unroll
    for (int e = 0; e < 8; ++e) { y[e] = yf[e] + yb[e]; s2 += y[e] * y[e]; }
    const float rstd = rsqrtf(red16(s2) * (1.f / 128.f) + EPS);
#pragma unroll
    for (int e = 0; e < 8; ++e) y[e] = y[e] * rstd * gn[e] * z[e];
    *(uint4*)(p.YF + base) = pack8(y);
  }
}

__global__ void __launch_bounds__(256, 2) fwd_megakernel(Params p) {
  cg::grid_group grid = cg::this_grid();
  __shared__ __attribute__((aligned(16))) char smem[78 * 1024];
  __shared__ uint4 xb_words;
  if (threadIdx.x == 0) xb_words = make_uint4(0u, 0u, 0u, 0u);
  __syncthreads();
  XcdBarrier xb = xcd_barrier_post(p.bar, (volatile LAS unsigned*)&xb_words);
  phase_mod(p, smem);
  phase_wconv(p, smem);
  grid.sync();
  for (int g = 0; g < NG; ++g) {
    for (int layer = 0; layer < 4; ++layer) {
      phase_resnorm(p, g, layer - 1, layer);
      xcd_barrier(xb);
      const int j = layer >> 1;
      if ((layer & 1) == 0) {
        phase_rw_proj(p, j, smem, 0, blockIdx.x, gridDim.x);
        xcd_barrier(xb);
        if (j == 1) { phase_rw_lr2(p, j, smem); xcd_barrier(xb); }
        if (gridDim.x >= 2 * GB * 64) {
          if (blockIdx.x < GB * 64) phase_rw_scan(p, j, smem);
          else phase_rw_proj(p, j, smem, 1, blockIdx.x - GB * 64, gridDim.x - GB * 64);
        } else {
          phase_rw_scan(p, j, smem);
          phase_rw_proj(p, j, smem, 1, blockIdx.x, gridDim.x);
        }
        xcd_barrier(xb);
        phase_rw_gate(p, j);
        xcd_barrier(xb);
        phase_out(p, g_wt + OFF_RWO + (size_t)j * DM * DI, smem);
        xcd_barrier(xb);
      } else {
        phase_hg_proj(p, j, smem);
        xcd_barrier(xb);
        phase_hg_scan(p, layer, smem);
        xcd_barrier(xb);
        phase_hg_gate(p, j);
        xcd_barrier(xb);
        phase_out(p, g_wt + OFF_HWO + (size_t)j * DM * DI, smem);
        xcd_barrier(xb);
      }
    }
    phase_resnorm(p, g, 3, -1);
    xcd_barrier(xb);
  }
}

extern "C" void kernel_launch(void* const* d_in, const int* in_sizes, int n_in, void* d_out, int out_size, void* d_ws,
                              size_t ws_size, hipStream_t stream) {
  static int grid_blocks = 0;
  if (!grid_blocks) {
    int dev = 0, cus = 0, per_cu = 0;
    hipGetDevice(&dev);
    hipDeviceGetAttribute(&cus, hipDeviceAttributeMultiprocessorCount, dev);
    hipOccupancyMaxActiveBlocksPerMultiprocessor(&per_cu, fwd_megakernel, 256, 0);
    if (per_cu > 2) per_cu = 2;
    grid_blocks = cus * per_cu;
  }
  Params p{};
  const float** fp = (const float**)&p;
  for (int i = 0; i < 29; ++i) fp[i] = (const float*)d_in[i];
  p.out = (float*)d_out;
  char* w = (char*)d_ws;
  size_t off = 0;
  auto take = [&](size_t bytes) { char* r = w + off; off += (bytes + 255) & ~(size_t)255; return r; };
  const size_t DIW = (size_t)NTG * DI * 2;
  p.R = (bf16_t*)take(DIW); p.K = (bf16_t*)take(DIW); p.V = (bf16_t*)take(DIW); p.Z = (bf16_t*)take(DIW);
  p.WF = (bf16_t*)take(DIW); p.YF = (bf16_t*)take(DIW); p.YB = (bf16_t*)take(DIW);
  p.VF = p.YF;
  p.H = p.YB;
  p.HR = p.WF; p.HR0 = p.WF + (size_t)NTG * DM;
  p.LRW = (bf16_t*)take((size_t)NTG * 128 * 2); p.LRA = (bf16_t*)take((size_t)NTG * 128 * 2);
  p.LRV = (bf16_t*)take((size_t)NTG * 32 * 2);
  p.O = (float*)p.R;
  p.BN = (float*)take((size_t)2 * NTG * 32 * 4);
  p.CTXB = (float*)take((size_t)NB * CTX * DM * 4);
  p.MODV = (float*)take((size_t)4 * 9 * 3 * DM * 4);
  p.LB = (float*)take((size_t)4 * DI * 4);
  p.bar = (unsigned*)take((size_t)XCD_BAR_WORDS * 4);
  if (off > ws_size) { fprintf(stderr, "workspace too small: need %zu have %zu\n", off, ws_size); return; }
  hipMemsetAsync(p.bar, 0, (size_t)XCD_BAR_WORDS * 4, stream);
  void* args[] = {&p};
  hipError_t e = hipLaunchCooperativeKernel((void*)fwd_megakernel, dim3(grid_blocks), dim3(256), args, 0, stream);
  if (e != hipSuccess) fprintf(stderr, "cooperative launch failed: %s (grid %d)\n", hipGetErrorString(e), grid_blocks);
}
```

```cpp
#include <hip/hip_runtime.h>
#include <hip/hip_cooperative_groups.h>
#include <cstdio>
#include <cstdint>
namespace cg = cooperative_groups;

typedef unsigned short bf16_t;
using bf16x8 = __attribute__((ext_vector_type(8))) short;
using f32x16 = __attribute__((ext_vector_type(16))) float;
using f32x4 = __attribute__((ext_vector_type(4))) float;
using f2_t = __attribute__((ext_vector_type(2))) float;

constexpr int NB = 8, SEQ = 4096, CTX = 256, TT = 4352, DM = 1024, DI = 2048;
constexpr int GB = 4, NG = NB / GB, NTG = GB * TT;
constexpr int MT = NTG / 128;
constexpr float EPS = 1e-6f;

constexpr size_t OFF_PROJ = 0;
constexpr size_t OFF_RWO = OFF_PROJ + (size_t)2 * 4 * DI * DM;
constexpr size_t OFF_W1 = OFF_RWO + (size_t)2 * DM * DI;
constexpr size_t OFF_A1 = OFF_W1 + (size_t)2 * 128 * DM;
constexpr size_t OFF_V1 = OFF_A1 + (size_t)2 * 128 * DM;
constexpr size_t OFF_V2 = OFF_V1 + (size_t)32 * DM;
constexpr size_t OFF_HWIN = OFF_V2 + (size_t)DI * 32;
constexpr size_t OFF_HWO = OFF_HWIN + (size_t)2 * 5 * DI * DM;
constexpr size_t OFF_W2 = OFF_HWO + (size_t)2 * DM * DI;
constexpr size_t OFF_A2 = OFF_W2 + (size_t)4 * DI * 64;
constexpr size_t WT_TOTAL = OFF_A2 + (size_t)4 * DI * 64;
__device__ bf16_t g_wt[WT_TOTAL];

struct Params {
  const float *x, *c, *ctx, *c_ctx, *mod_w, *mod_b, *pre_g, *post_g, *rw_mix, *rw_proj, *rw_wo, *rw_w0, *rw_w1,
      *rw_w2, *rw_a0, *rw_a1, *rw_a2, *rw_v0, *rw_v1, *rw_v2, *rw_kk, *rw_ka, *rw_rk, *rw_lnw, *rw_lnb, *hg_win,
      *hg_wo, *hg_gn, *hg_lb;
  float* out;
  bf16_t *R, *K, *V, *Z, *WF, *YF, *YB, *VF, *H, *HR, *HR0, *LRW, *LRA, *LRV;
  float *O, *BN, *CTXB, *MODV, *LB;
  unsigned* bar;
};

typedef __bf16 hwbf2_t __attribute__((ext_vector_type(2)));
typedef float hwf2_t __attribute__((ext_vector_type(2)));
__device__ __forceinline__ unsigned pack2(float a, float b) {
  hwf2_t f = {a, b};
  hwbf2_t h = __builtin_convertvector(f, hwbf2_t);
  return __builtin_bit_cast(unsigned, h);
}
__device__ __forceinline__ bf16_t f2bf(float f) { return (bf16_t)(pack2(f, f) & 0xffffu); }
__device__ __forceinline__ float bf2f(bf16_t h) { return __uint_as_float(((unsigned)h) << 16); }
typedef _Float16 h2_t __attribute__((ext_vector_type(2)));
using f16x8 = __attribute__((ext_vector_type(8))) _Float16;
__device__ __forceinline__ unsigned pack2h(float a, float b) {
  h2_t h = {(_Float16)a, (_Float16)b};
  return __builtin_bit_cast(unsigned, h);
}
__device__ __forceinline__ uint4 pack8h(const float* f) {
  uint4 u; u.x = pack2h(f[0], f[1]); u.y = pack2h(f[2], f[3]); u.z = pack2h(f[4], f[5]); u.w = pack2h(f[6], f[7]);
  return u;
}
__device__ __forceinline__ unsigned mixh2(unsigned h, unsigned n, unsigned m) {
  const h2_t hv = __builtin_bit_cast(h2_t, h), nv = __builtin_bit_cast(h2_t, n), mv = __builtin_bit_cast(h2_t, m);
  const h2_t r = hv + (nv - hv) * mv;
  return __builtin_bit_cast(unsigned, r);
}
__device__ __forceinline__ float lo2f(unsigned u) { return __uint_as_float(u << 16); }
__device__ __forceinline__ float hi2f(unsigned u) { return __uint_as_float(u & 0xffff0000u); }
__device__ __forceinline__ float rcpf_(float x) { return __builtin_amdgcn_rcpf(x); }
__device__ __forceinline__ float sigmoidf_(float x) { return rcpf_(1.f + __expf(-x)); }
__device__ __forceinline__ float siluf_(float x) { return x * rcpf_(1.f + __expf(-x)); }
__device__ __forceinline__ float tanhf_(float x) { return 1.f - 2.f * rcpf_(1.f + __expf(2.f * x)); }

__device__ __forceinline__ void lds_barrier() { asm volatile("s_waitcnt lgkmcnt(0)\n\ts_barrier" ::: "memory"); }

__device__ __forceinline__ int opaque_tid() { int t = threadIdx.x; asm volatile("" : "+v"(t)); return t; }

template <int CTRL>
__device__ __forceinline__ float dppf(float v) {
  return __int_as_float(__builtin_amdgcn_update_dpp(0, __float_as_int(v), CTRL, 0xf, 0xf, true));
}
__device__ __forceinline__ float red4(float v) { v += dppf<0xB1>(v); v += dppf<0x4E>(v); return v; }
__device__ __forceinline__ float red8(float v) { v = red4(v); v += dppf<0x141>(v); return v; }
__device__ __forceinline__ float red16(float v) { v = red8(v); v += dppf<0x140>(v); return v; }
__device__ __forceinline__ float red64(float v) {
  v = red16(v);
  v += __shfl_xor(v, 16);
  v += __shfl_xor(v, 32);
  return v;
}

__device__ __forceinline__ void unpack8(const uint4& u, float* f) {
  f[0] = lo2f(u.x); f[1] = hi2f(u.x); f[2] = lo2f(u.y); f[3] = hi2f(u.y);
  f[4] = lo2f(u.z); f[5] = hi2f(u.z); f[6] = lo2f(u.w); f[7] = hi2f(u.w);
}
__device__ __forceinline__ uint4 pack8(const float* f) {
  uint4 u; u.x = pack2(f[0], f[1]); u.y = pack2(f[2], f[3]); u.z = pack2(f[4], f[5]); u.w = pack2(f[6], f[7]);
  return u;
}


#define XB_TMO      128
#define XB_XCNT(j)  (256  + 64 * (j))
#define XB_XSUB(j)  (1280 + 64 * (j))
#define XB_XGEN(j)  (2304 + 64 * (j))
#define XB_TOP      3328
#define XB_TOPGEN   3392
#define XCD_BAR_WORDS 3456
#define XB_SPIN_CAP (1u << 23)
#define LAS __attribute__((address_space(3)))
__device__ __forceinline__ unsigned xb_ld(unsigned* p)              { return __hip_atomic_load(p, __ATOMIC_RELAXED, __HIP_MEMORY_SCOPE_AGENT); }
__device__ __forceinline__ unsigned xb_add(unsigned* p, unsigned v) { return __hip_atomic_fetch_add(p, v, __ATOMIC_RELAXED, __HIP_MEMORY_SCOPE_AGENT); }
__device__ __forceinline__ unsigned xb_xcc_id() { return (unsigned)__builtin_amdgcn_s_getreg((3 << 11) | 20) & 0xFu; }
#define XB_SPIN(cond, bar) do { unsigned _sp = 0; while (cond) { if (_sp < 128u) __builtin_amdgcn_s_sleep(1); else __builtin_amdgcn_s_sleep(20); \
    if ((++_sp & 255u) == 0u) { if (xb_ld(&(bar)[XB_TMO])) break; if (_sp > XB_SPIN_CAP) { atomicAdd(&(bar)[XB_TMO], 1u); break; } } } } while (0)
struct XcdBarrier { unsigned* bar; unsigned x; volatile LAS unsigned* st; };
__device__ __forceinline__ XcdBarrier xcd_barrier_post(unsigned* bar, volatile LAS unsigned* st) {
  XcdBarrier b; b.bar = bar; b.x = xb_xcc_id(); b.st = st;
  if (threadIdx.x == 0) (void)xb_add(&bar[XB_XCNT(b.x)], 1u);
  return b;
}
__device__ __forceinline__ void xcd_barrier_complete(unsigned* bar, unsigned x, unsigned& nloc, unsigned& nx) {
  const unsigned G = gridDim.x * gridDim.y * gridDim.z;
  unsigned sum, cnt, mine, sp = 0u;
  for (;;) {
    sum = 0u; cnt = 0u; mine = 0u;
#pragma unroll
    for (unsigned j = 0; j < 16; ++j) { const unsigned c = xb_ld(&bar[XB_XCNT(j)]); sum += c; cnt += (c > 0u) ? 1u : 0u; mine = (j == x) ? c : mine; }
    if (sum == G) break;
    __builtin_amdgcn_s_sleep(1);
    if ((++sp & 255u) == 0u) { if (xb_ld(&bar[XB_TMO])) break; if (sp > XB_SPIN_CAP) { atomicAdd(&bar[XB_TMO], 1u); break; } }
  }
  nloc = mine > 0u ? mine : 1u; nx = cnt > 0u ? cnt : 1u;
}
__device__ __forceinline__ void xcd_barrier(const XcdBarrier& b) {
  asm volatile("s_waitcnt vmcnt(0)" ::: "memory");
  __syncthreads();
  if (threadIdx.x == 0) {
    unsigned* bar = b.bar;
    __builtin_amdgcn_s_waitcnt(0);
    unsigned nloc = b.st[0], nx = b.st[1];
    if (nloc == 0u) { xcd_barrier_complete(bar, b.x, nloc, nx); b.st[0] = nloc; b.st[1] = nx; }
    const unsigned old = xb_add(&bar[XB_XSUB(b.x)], 1u);
    const unsigned gen = old / nloc;
    if (old + 1u == (gen + 1u) * nloc) {
      __builtin_amdgcn_fence(__ATOMIC_RELEASE, "agent");
      asm volatile("s_waitcnt vmcnt(0)" ::: "memory");
      const unsigned og = xb_add(&bar[XB_TOP], 1u);
      const unsigned tg = og / nx;
      if (og + 1u == (tg + 1u) * nx) xb_add(&bar[XB_TOPGEN], 1u);
      else XB_SPIN(xb_ld(&bar[XB_TOPGEN]) == tg, bar);
      __builtin_amdgcn_fence(__ATOMIC_ACQUIRE, "agent");
      xb_add(&bar[XB_XGEN(b.x)], 1u);
      asm volatile("s_waitcnt vmcnt(0)" ::: "memory");
    } else {
      XB_SPIN(xb_ld(&bar[XB_XGEN(b.x)]) == gen, bar);
      __builtin_amdgcn_fence(__ATOMIC_ACQUIRE, "agent");
      asm volatile("s_waitcnt vmcnt(0)" ::: "memory");
    }
  }
  __syncthreads();
}

__device__ __forceinline__ const float* row_in(const Params& p, int b, int t) {
  return t < CTX ? p.ctx + ((size_t)b * CTX + t) * DM : p.x + ((size_t)b * SEQ + (t - CTX)) * DM;
}
__device__ __forceinline__ float* row_cur(const Params& p, int b, int t) {
  return t < CTX ? p.CTXB + ((size_t)b * CTX + t) * DM : p.out + ((size_t)b * SEQ + (t - CTX)) * DM;
}

__device__ __forceinline__ void phase_mod(const Params& p, char* smem) {
  float* ssil = (float*)smem;
  float* red = ssil + 9 * DM;
  const int tid = opaque_tid(), cl = tid & 63, kp = tid >> 6;
  if (blockIdx.x < 4 * 48) {
    for (int idx = tid; idx < 9 * DM; idx += 256) {
      const int r = idx >> 10, k = idx & 1023;
      ssil[idx] = siluf_(r < 8 ? p.c[r * DM + k] : p.c_ctx[k]);
    }
    __syncthreads();
  }
  for (int task = blockIdx.x; task < 4 * 48; task += gridDim.x) {
    const int l = task / 48, col = (task % 48) * 64 + cl;
    float acc[9];
#pragma unroll
    for (int r = 0; r < 9; ++r) acc[r] = 0.f;
    const float* W = p.mod_w + (size_t)l * DM * 3 * DM + col;
#pragma unroll 4
    for (int k = kp * 256; k < kp * 256 + 256; ++k) {
      const float w = W[(size_t)k * 3 * DM];
#pragma unroll
      for (int r = 0; r < 9; ++r) acc[r] += ssil[r * DM + k] * w;
    }
    __syncthreads();
#pragma unroll
    for (int r = 0; r < 9; ++r) red[(kp * 9 + r) * 64 + cl] = acc[r];
    __syncthreads();
    for (int idx = tid; idx < 9 * 64; idx += 256) {
      const int r = idx >> 6, c2 = idx & 63;
      float s = 0.f;
      for (int q = 0; q < 4; ++q) s += red[(q * 9 + r) * 64 + c2];
      const int cc = (task % 48) * 64 + c2;
      p.MODV[((size_t)l * 9 + r) * 3 * DM + cc] = s + p.mod_b[l * 3 * DM + cc];
    }
  }
  for (int cidx = blockIdx.x * 256 + tid; cidx < DI; cidx += gridDim.x * 256) {
    float v[4], m = -1e30f;
    for (int l = 0; l < 4; ++l) { v[l] = p.hg_lb[l * DI + cidx]; m = fmaxf(m, v[l]); }
    float s = 0.f;
    for (int l = 0; l < 4; ++l) { v[l] = __expf(v[l] - m); s += v[l]; }
    float cum = 0.f;
    for (int l = 0; l < 4; ++l) { cum += v[l] / s; p.LB[l * DI + cidx] = cum - v[0] / s; }
  }
}

__device__ __forceinline__ void conv_matrix(const float* __restrict__ src, int K, int N, bf16_t* __restrict__ dst, char* smem, bool f16out = false) {
  float* ts = (float*)smem;
  const int tid = opaque_tid();
  const int ntn = N / 32, ntile = (K / 64) * ntn;
  for (int tile = blockIdx.x; tile < ntile; tile += gridDim.x) {
    const int k0 = (tile / ntn) * 64, n0 = (tile % ntn) * 32;
    __syncthreads();
#pragma unroll
    for (int i = 0; i < 2; ++i) {
      const int k = (tid >> 3) + 32 * i, n4 = (tid & 7) * 4;
      const float4 v = *(const float4*)(src + (size_t)(k0 + k) * N + n0 + n4);
      ts[k * 33 + n4 + 0] = v.x; ts[k * 33 + n4 + 1] = v.y; ts[k * 33 + n4 + 2] = v.z; ts[k * 33 + n4 + 3] = v.w;
    }
    __syncthreads();
    const int n = tid >> 3, k8 = (tid & 7) * 8;
    float f[8];
#pragma unroll
    for (int e = 0; e < 8; ++e) f[e] = ts[(k8 + e) * 33 + n];
    *(uint4*)(dst + (size_t)(n0 + n) * K + k0 + k8) = f16out ? pack8h(f) : pack8(f);
  }
}
__device__ __forceinline__ void phase_wconv(const Params& p, char* smem) {
  for (int m = 0; m < 8; ++m) conv_matrix(p.rw_proj + (size_t)m * DM * DI, DM, DI, g_wt + OFF_PROJ + (size_t)m * DI * DM, smem, true);
  for (int j = 0; j < 2; ++j) conv_matrix(p.rw_wo + (size_t)j * DI * DM, DI, DM, g_wt + OFF_RWO + (size_t)j * DM * DI, smem);
  for (int m = 0; m < 4; ++m) {
    conv_matrix(p.rw_w1 + (size_t)m * DM * 64, DM, 64, g_wt + OFF_W1 + (size_t)m * 64 * DM, smem, true);
    conv_matrix(p.rw_a1 + (size_t)m * DM * 64, DM, 64, g_wt + OFF_A1 + (size_t)m * 64 * DM, smem, true);
  }
  conv_matrix(p.rw_v1, DM, 32, g_wt + OFF_V1, smem, true);
  for (int m = 0; m < 4; ++m) {
    conv_matrix(p.rw_w2 + (size_t)m * 64 * DI, 64, DI, g_wt + OFF_W2 + (size_t)m * DI * 64, smem);
    conv_matrix(p.rw_a2 + (size_t)m * 64 * DI, 64, DI, g_wt + OFF_A2 + (size_t)m * DI * 64, smem);
  }
  for (int j = 0; j < 2; ++j) conv_matrix(p.hg_win + (size_t)j * DM * 5 * DI, DM, 5 * DI, g_wt + OFF_HWIN + (size_t)j * 5 * DI * DM, smem);
  for (int j = 0; j < 2; ++j) conv_matrix(p.hg_wo + (size_t)j * DI * DM, DI, DM, g_wt + OFF_HWO + (size_t)j * DM * DI, smem);
  for (int idx = blockIdx.x * 256 + opaque_tid(); idx < DI * 32; idx += gridDim.x * 256) {
    const int n = idx >> 5, k = idx & 31;
    g_wt[OFF_V2 + idx] = f2bf(p.rw_v2[(size_t)k * DI + n]);
  }
}

__device__ __forceinline__ void phase_resnorm(const Params& p, int g, int lu, int ln) {
  const int tid = opaque_tid();
  const int lane = tid & 63;
  const int wv = blockIdx.x * 4 + (tid >> 6), nw = gridDim.x * 4;
  for (int tg = wv; tg < NTG; tg += nw) {
    const int bl = tg / TT, t = tg % TT, b = g * GB + bl;
    const bool isctx = t < CTX;
    const int mrow = isctx ? 8 : b;
    float xv[16];
    const float* src = (lu <= 0) ? row_in(p, b, t) : row_cur(p, b, t);
#pragma unroll
    for (int j = 0; j < 4; ++j) {
      const float4 v4 = *(const float4*)(src + j * 256 + lane * 4);
      xv[j * 4 + 0] = v4.x; xv[j * 4 + 1] = v4.y; xv[j * 4 + 2] = v4.z; xv[j * 4 + 3] = v4.w;
    }
    if (lu >= 0 && !(isctx && lu == 3)) {
      float ov[16], ss = 0.f;
      const float* orow = p.O + (size_t)tg * DM;
#pragma unroll
      for (int j = 0; j < 4; ++j) {
        const float4 v4 = *(const float4*)(orow + j * 256 + lane * 4);
        ov[j * 4 + 0] = v4.x; ov[j * 4 + 1] = v4.y; ov[j * 4 + 2] = v4.z; ov[j * 4 + 3] = v4.w;
      }
#pragma unroll
      for (int e = 0; e < 16; ++e) ss += ov[e] * ov[e];
      ss = red64(ss);
      const float rstd = rsqrtf(ss * (1.f / DM) + EPS);
      const float* gate = p.MODV + ((size_t)lu * 9 + mrow) * 3 * DM + 2 * DM;
      const float* pg = p.post_g + lu * DM;
      float* dst = row_cur(p, b, t);
#pragma unroll
      for (int j = 0; j < 4; ++j) {
        const int cc = j * 256 + lane * 4;
        const float4 g4 = *(const float4*)(gate + cc);
        const float4 p4 = *(const float4*)(pg + cc);
        xv[j * 4 + 0] += g4.x * (ov[j * 4 + 0] * rstd * p4.x);
        xv[j * 4 + 1] += g4.y * (ov[j * 4 + 1] * rstd * p4.y);
        xv[j * 4 + 2] += g4.z * (ov[j * 4 + 2] * rstd * p4.z);
        xv[j * 4 + 3] += g4.w * (ov[j * 4 + 3] * rstd * p4.w);
        *(float4*)(dst + cc) = make_float4(xv[j * 4 + 0], xv[j * 4 + 1], xv[j * 4 + 2], xv[j * 4 + 3]);
      }
    }
    if (ln >= 0) {
      for (int pass = 0; pass < (ln == 2 ? 2 : 1); ++pass) {
        const int lp = pass == 0 ? ln : 0;
        bf16_t* hdst = (pass == 0 ? ((ln & 1) == 0 ? p.HR : p.H) : p.HR0) + (size_t)tg * DM;
        if (pass == 1) {
          const float* s0 = row_in(p, b, t);
#pragma unroll
          for (int j = 0; j < 4; ++j) {
            const float4 v4 = *(const float4*)(s0 + j * 256 + lane * 4);
            xv[j * 4 + 0] = v4.x; xv[j * 4 + 1] = v4.y; xv[j * 4 + 2] = v4.z; xv[j * 4 + 3] = v4.w;
          }
        }
        float ss = 0.f;
#pragma unroll
        for (int e = 0; e < 16; ++e) ss += xv[e] * xv[e];
        ss = red64(ss);
        const float rstd = rsqrtf(ss * (1.f / DM) + EPS);
        const float* mv = p.MODV + ((size_t)lp * 9 + mrow) * 3 * DM;
        const float* pg = p.pre_g + lp * DM;
#pragma unroll
        for (int j = 0; j < 4; ++j) {
          const int cc = j * 256 + lane * 4;
          const float4 sh = *(const float4*)(mv + cc);
          const float4 sc = *(const float4*)(mv + DM + cc);
          const float4 p4 = *(const float4*)(pg + cc);
          const float h0 = xv[j * 4 + 0] * rstd * p4.x * (1.f + sc.x) + sh.x;
          const float h1 = xv[j * 4 + 1] * rstd * p4.y * (1.f + sc.y) + sh.y;
          const float h2 = xv[j * 4 + 2] * rstd * p4.z * (1.f + sc.z) + sh.z;
          const float h3 = xv[j * 4 + 3] * rstd * p4.w * (1.f + sc.w) + sh.w;
          uint2 u;
          if ((ln & 1) == 0) {
            const float L = 60000.f;
            u.x = pack2h(fminf(fmaxf(h0, -L), L), fminf(fmaxf(h1, -L), L));
            u.y = pack2h(fminf(fmaxf(h2, -L), L), fminf(fmaxf(h3, -L), L));
          } else {
            u.x = pack2(h0, h1); u.y = pack2(h2, h3);
          }
          *(uint2*)(hdst + cc) = u;
        }
      }
    }
  }
}

constexpr int LDK = 72;
constexpr int TM = 128;

template <int AMODE, class Epi>
__device__ __forceinline__ void gemm_tile(const bf16_t* __restrict__ A, int lda, const float* __restrict__ mix, int m0,
                                          int K, const bf16_t* __restrict__ Bt, int nvalid, char* smem, Epi epi) {
  bf16_t* As = (bf16_t*)smem;
  bf16_t* Bs = As + 2 * TM * LDK;
  float* mixs = (float*)(Bs + 2 * 128 * LDK);
  const int tid = opaque_tid(), lane = tid & 63, w = tid >> 6, wm = w >> 1, wn = w & 1;
  const int lr = lane >> 3, ch = (lane & 7) * 8;
  const int row0 = w * 32 + lr;
  const bf16_t* Ap = A + (size_t)(m0 + row0) * lda + ch;
  const bf16_t* Bp = Bt + (size_t)row0 * K + ch;
  const size_t astep = (size_t)8 * lda, bstep = (size_t)8 * K;
  const int KT = (K + 63) >> 6;
  const int tbase = m0 % TT;
  const bool isctx = tbase < CTX;
  unsigned vmask = 0;
  if (AMODE == 1) {
#pragma unroll
    for (int i = 0; i < 4; ++i) {
      const int t = tbase + row0 + i * 8;
      unsigned m;
      if (isctx) {
        m = (t >= 1 ? 3u : 0u) | (t + 1 < CTX ? 12u : 0u);
      } else {
        const int tl = t - CTX, row = tl >> 6, col = tl & 63;
        m = (col > 0 ? 1u : 0u) | (col < 63 ? 2u : 0u) | (row > 0 ? 4u : 0u) | (row < 63 ? 8u : 0u);
      }
      vmask |= m << (4 * i);
    }
  }

  __syncthreads();
  if (AMODE == 1) {
    const float4 m4 = *(const float4*)(mix + tid * 4);
    ((uint2*)mixs)[tid] = make_uint2(pack2h(m4.x, m4.y), pack2h(m4.z, m4.w));
  }

  f32x16 acc[2][2];
#pragma unroll
  for (int i = 0; i < 2; ++i)
#pragma unroll
    for (int j = 0; j < 2; ++j)
#pragma unroll
      for (int r = 0; r < 16; ++r) acc[i][j][r] = 0.f;

  uint4 a0, a1, a2, a3, n0, n1, n2, n3, b0, b1, b2, b3;
  auto load_regs = [&](int kt) {
    const int k0 = kt * 64;
    const uint4 z4 = make_uint4(0, 0, 0, 0);
    const bool kval = (k0 + ch) < K;
    const bf16_t* ap = Ap + k0;
    const bf16_t* bp = Bp + k0;
    a0 = z4; if (kval) a0 = *(const uint4*)(ap + 0 * astep);
    a1 = z4; if (kval) a1 = *(const uint4*)(ap + 1 * astep);
    a2 = z4; if (kval) a2 = *(const uint4*)(ap + 2 * astep);
    a3 = z4; if (kval) a3 = *(const uint4*)(ap + 3 * astep);
    b0 = z4; if (kval && (row0 + 0) < nvalid) b0 = *(const uint4*)(bp + 0 * bstep);
    b1 = z4; if (kval && (row0 + 8) < nvalid) b1 = *(const uint4*)(bp + 1 * bstep);
    b2 = z4; if (kval && (row0 + 16) < nvalid) b2 = *(const uint4*)(bp + 2 * bstep);
    b3 = z4; if (kval && (row0 + 24) < nvalid) b3 = *(const uint4*)(bp + 3 * bstep);
    if (AMODE == 1) {
      const int q = k0 >> 8;
      const int nb = isctx ? (q < 2 ? -1 : 1) : (q == 0 ? -1 : (q == 1 ? 1 : (q == 2 ? -64 : 64)));
      const bf16_t* np = ap + (ptrdiff_t)nb * lda;
      const unsigned vm = vmask >> q;
      n0 = z4; if ((vm >> 0) & 1u) n0 = *(const uint4*)(np + 0 * astep);
      n1 = z4; if ((vm >> 4) & 1u) n1 = *(const uint4*)(np + 1 * astep);
      n2 = z4; if ((vm >> 8) & 1u) n2 = *(const uint4*)(np + 2 * astep);
      n3 = z4; if ((vm >> 12) & 1u) n3 = *(const uint4*)(np + 3 * astep);
    }
  };
  auto mix8 = [&](const uint4& hv, const uint4& nv, const uint4& mv) -> uint4 {
    uint4 o;
    o.x = mixh2(hv.x, nv.x, mv.x); o.y = mixh2(hv.y, nv.y, mv.y); o.z = mixh2(hv.z, nv.z, mv.z); o.w = mixh2(hv.w, nv.w, mv.w);
    return o;
  };
  auto store_lds = [&](int kt, int buf) {
    bf16_t* ad = As + (buf * TM + row0) * LDK + ch;
    bf16_t* bd = Bs + (buf * 128 + row0) * LDK + ch;
    if (AMODE == 1) {
      const uint4 mv = *(const uint4*)((const bf16_t*)mixs + kt * 64 + ch);
      *(uint4*)(ad + 0 * LDK) = mix8(a0, n0, mv);
      *(uint4*)(ad + 8 * LDK) = mix8(a1, n1, mv);
      *(uint4*)(ad + 16 * LDK) = mix8(a2, n2, mv);
      *(uint4*)(ad + 24 * LDK) = mix8(a3, n3, mv);
    } else {
      *(uint4*)(ad + 0 * LDK) = a0;
      *(uint4*)(ad + 8 * LDK) = a1;
      *(uint4*)(ad + 16 * LDK) = a2;
      *(uint4*)(ad + 24 * LDK) = a3;
    }
    *(uint4*)(bd + 0 * LDK) = b0;
    *(uint4*)(bd + 8 * LDK) = b1;
    *(uint4*)(bd + 16 * LDK) = b2;
    *(uint4*)(bd + 24 * LDK) = b3;
  };
  auto compute = [&](int buf) {
    const bf16_t* ab = As + (buf * TM + wm * 64 + (lane & 31)) * LDK + (lane >> 5) * 8;
    const bf16_t* bb = Bs + (buf * 128 + wn * 64 + (lane & 31)) * LDK + (lane >> 5) * 8;
#pragma unroll
    for (int kk = 0; kk < 4; ++kk) {
      const bf16x8 af0 = *(const bf16x8*)(ab + kk * 16), af1 = *(const bf16x8*)(ab + 32 * LDK + kk * 16);
      const bf16x8 bf0 = *(const bf16x8*)(bb + kk * 16), bf1 = *(const bf16x8*)(bb + 32 * LDK + kk * 16);
      if (AMODE == 1) {
        const f16x8 ha0 = __builtin_bit_cast(f16x8, af0), ha1 = __builtin_bit_cast(f16x8, af1);
        const f16x8 hb0 = __builtin_bit_cast(f16x8, bf0), hb1 = __builtin_bit_cast(f16x8, bf1);
        acc[0][0] = __builtin_amdgcn_mfma_f32_32x32x16_f16(ha0, hb0, acc[0][0], 0, 0, 0);
        acc[0][1] = __builtin_amdgcn_mfma_f32_32x32x16_f16(ha0, hb1, acc[0][1], 0, 0, 0);
        acc[1][0] = __builtin_amdgcn_mfma_f32_32x32x16_f16(ha1, hb0, acc[1][0], 0, 0, 0);
        acc[1][1] = __builtin_amdgcn_mfma_f32_32x32x16_f16(ha1, hb1, acc[1][1], 0, 0, 0);
      } else {
        acc[0][0] = __builtin_amdgcn_mfma_f32_32x32x16_bf16(af0, bf0, acc[0][0], 0, 0, 0);
        acc[0][1] = __builtin_amdgcn_mfma_f32_32x32x16_bf16(af0, bf1, acc[0][1], 0, 0, 0);
        acc[1][0] = __builtin_amdgcn_mfma_f32_32x32x16_bf16(af1, bf0, acc[1][0], 0, 0, 0);
        acc[1][1] = __builtin_amdgcn_mfma_f32_32x32x16_bf16(af1, bf1, acc[1][1], 0, 0, 0);
      }
    }
  };
  load_regs(0);
  lds_barrier();
  store_lds(0, 0);
  if (KT > 1) load_regs(1);
  lds_barrier();
  for (int kt = 0; kt < KT; ++kt) {
    compute(kt & 1);
    if (kt + 1 < KT) store_lds(kt + 1, (kt + 1) & 1);
    if (kt + 2 < KT) load_regs(kt + 2);
    lds_barrier();
  }
  float* Cs = (float*)smem;
#pragma unroll
  for (int i = 0; i < 2; ++i)
#pragma unroll
    for (int j = 0; j < 2; ++j)
#pragma unroll
      for (int r = 0; r < 16; ++r)
        Cs[(wm * 64 + i * 32 + (r & 3) + 8 * (r >> 2) + 4 * (lane >> 5)) * 132 + wn * 64 + j * 32 + (lane & 31)] = acc[i][j][r];
  lds_barrier();
#pragma unroll 2
  for (int it = 0; it < 8; ++it) {
    const int idx = it * 256 + tid, row = idx >> 4, c8 = (idx & 15) * 8;
    const float4 v0 = *(const float4*)(Cs + row * 132 + c8), v1 = *(const float4*)(Cs + row * 132 + c8 + 4);
    float v[8] = {v0.x, v0.y, v0.z, v0.w, v1.x, v1.y, v1.z, v1.w};
    epi(m0 + row, c8, v);
  }
}

__device__ __forceinline__ void phase_rw_proj(const Params& p, int j, char* smem, int zonly, int bid, int nb) {
  const int ntn = zonly ? 16 : (j == 0 ? 50 : 67);
  const float* mixb = p.rw_mix + (size_t)j * 6 * DM;
  const bool xaware = (nb & 7) == 0;
  const int xcd = xaware ? (bid & 7) : 0, slot = xaware ? (bid >> 3) : bid, nslots = xaware ? (nb >> 3) : nb;
  const int ntx = xaware ? (ntn - xcd + 7) / 8 : ntn;
  for (int li = slot; li < MT * ntx; li += nslots) {
    const int mt = li / ntx, ntl = xaware ? xcd + 8 * (li % ntx) : (li % ntx), m0 = mt * 128;
    const int nt = zonly ? 48 + ntl : (ntl < 48 ? ntl : ntl + 16);
    if (nt < 64) {
      const int pi = nt >> 4, n0 = (nt & 15) * 128;
      const int mi = pi == 0 ? 0 : (pi == 1 ? 2 : (pi == 2 ? 3 : 5));
      const bf16_t* Bw = g_wt + OFF_PROJ + ((size_t)(j * 4 + pi) * DI + n0) * DM;
      bf16_t* dst = pi == 0 ? p.R : (pi == 1 ? p.K : (pi == 2 ? p.V : p.Z));
      if (pi == 3) {
        gemm_tile<1>(p.HR, DM, mixb + mi * DM, m0, DM, Bw, 128, smem,
                     [&](int row, int col, float* v) {
#pragma unroll
        for (int e = 0; e < 8; ++e) v[e] = siluf_(v[e]);
        *(uint4*)(dst + (size_t)row * DI + n0 + col) = pack8(v); });
      } else {
        gemm_tile<1>(p.HR, DM, mixb + mi * DM, m0, DM, Bw, 128, smem,
                     [&](int row, int col, float* v) { *(uint4*)(dst + (size_t)row * DI + n0 + col) = pack8(v); });
      }
    } else if (nt == 64) {
      gemm_tile<1>(p.HR, DM, mixb + 1 * DM, m0, DM, g_wt + OFF_W1 + (size_t)j * 128 * DM, 128, smem,
                   [&](int row, int col, float* v) {
#pragma unroll
        for (int e = 0; e < 8; ++e) v[e] = tanhf_(v[e]);
        *(uint4*)(p.LRW + (size_t)row * 128 + col) = pack8(v); });
    } else if (nt == 65) {
      gemm_tile<1>(p.HR, DM, mixb + 4 * DM, m0, DM, g_wt + OFF_A1 + (size_t)j * 128 * DM, 128, smem,
                   [&](int row, int col, float* v) { *(uint4*)(p.LRA + (size_t)row * 128 + col) = pack8(v); });
    } else if (nt == 66) {
      gemm_tile<1>(p.HR, DM, mixb + 3 * DM, m0, DM, g_wt + OFF_V1, 32, smem, [&](int row, int col, float* v) {
        if (col < 32) *(uint4*)(p.LRV + (size_t)row * 32 + col) = pack8(v);
      });
    } else {
      const int n0 = (nt - 67) * 128;
      const bf16_t* Bw = g_wt + OFF_PROJ + ((size_t)2 * DI + n0) * DM;
      gemm_tile<1>(p.HR0, DM, p.rw_mix + 3 * DM, m0, DM, Bw, 128, smem,
                   [&](int row, int col, float* v) { *(uint4*)(p.VF + (size_t)row * DI + n0 + col) = pack8(v); });
    }
  }
}

__device__ __forceinline__ void phase_rw_lr2(const Params& p, int j, char* smem) {
  for (int tile = blockIdx.x; tile < MT * 16; tile += gridDim.x) {
    const int mt = tile / 16, nt = tile % 16, m0 = mt * 128;
    const int n0 = nt * 128;
    const bf16_t* Bw = g_wt + OFF_V2 + (size_t)n0 * 32;
    const float* v0 = p.rw_v0 + n0;
    gemm_tile<0>(p.LRV, 32, nullptr, m0, 32, Bw, 128, smem, [&](int row, int col, float* v) {
      const size_t idx = (size_t)row * DI + n0 + col;
      float vv[8], vf[8];
      unpack8(*(const uint4*)(p.V + idx), vv); unpack8(*(const uint4*)(p.VF + idx), vf);
#pragma unroll
      for (int e = 0; e < 8; ++e) vv[e] += (vf[e] - vv[e]) * sigmoidf_(v[e] + v0[col + e]);
      *(uint4*)(p.V + idx) = pack8(vv);
    });
  }
}

constexpr int RCH = 32;
__device__ __forceinline__ int scan_pos(int dir, int s) { return dir == 0 ? s : (s < CTX ? CTX - 1 - s : TT + CTX - 1 - s); }

__device__ __forceinline__ void phase_rw_scan(const Params& p, int j, char* smem) {
  float* op = (float*)smem;
  float* vv = op + RCH * 4 * 64;
  float* sc = vv + RCH * 64;
  float* LWs = sc + RCH * 2;
  float* AAs = LWs + RCH * 64;
  float* yb = AAs;
  bf16_t* LRs = (bf16_t*)(AAs + RCH * 64);
  const int tid = opaque_tid(), lane = tid & 63, w = tid >> 6;
  const int ptau = tid >> 3, pc8 = (tid & 7) * 8;
  const int r2 = lane >> 3, ko = (lane & 7) * 8;
  const int row0 = w * 16 + r2, row1 = row0 + 8;
  for (int unit = blockIdx.x; unit < GB * 64; unit += gridDim.x) {
    const int bl = unit >> 6, h = (unit >> 1) & 31, dir = unit & 1;
    bf16_t* Y = dir == 0 ? p.YF : p.YB;
    float pkk[8], pka[8], prk[8];
#pragma unroll
    for (int e = 0; e < 8; ++e) {
      const int cc = j * DI + h * 64 + pc8 + e;
      pkk[e] = p.rw_kk[cc]; pka[e] = p.rw_ka[cc]; prk[e] = p.rw_rk[cc];
    }
    __syncthreads();
    const int mm = w >> 1, nh = w & 1;
    const float bias = (mm == 0 ? p.rw_w0 : p.rw_a0)[((size_t)j * 2 + dir) * DI + h * 64 + nh * 32 + (lane & 31)];
    bf16x8 wfr[4];
    {
      const bf16_t* w2g = g_wt + (mm == 0 ? OFF_W2 : OFF_A2) + (((size_t)j * 2 + dir) * DI + h * 64 + nh * 32 + (lane & 31)) * 64 + (lane >> 5) * 8;
#pragma unroll
      for (int kk = 0; kk < 4; ++kk) wfr[kk] = *(const bf16x8*)(w2g + kk * 16);
    }
    f2_t S0[4], S1[4];
#pragma unroll
    for (int e = 0; e < 4; ++e) { S0[e] = f2_t{0.f, 0.f}; S1[e] = f2_t{0.f, 0.f}; }
    uint4 gr, gk, gv, gl0, gl1;
    const int lmat = (tid & 7) >> 2, lcol = (tid & 3) * 16;
    const size_t ubase = (size_t)bl * TT * DI + h * 64 + pc8;
    const bf16_t* const rp = p.R + ubase;
    const bf16_t* const kp = p.K + ubase;
    const bf16_t* const vp_ = p.V + ubase;
    const bf16_t* const lrp = (lmat == 0 ? p.LRW : p.LRA) + (size_t)bl * TT * 128 + dir * 64 + lcol;
    auto gload = [&](int chunk) {
      const int pos = scan_pos(dir, chunk * RCH + ptau);
      const size_t o = (size_t)pos * DI;
      gr = *(const uint4*)(rp + o); gk = *(const uint4*)(kp + o); gv = *(const uint4*)(vp_ + o);
      const bf16_t* lr = lrp + (size_t)pos * 128;
      gl0 = *(const uint4*)(lr); gl1 = *(const uint4*)(lr + 8);
    };
    gload(0);
    for (int chunk = 0; chunk < TT / RCH; ++chunk) {
      *(uint4*)(LRs + (lmat * RCH + ptau) * 72 + lcol) = gl0;
      *(uint4*)(LRs + (lmat * RCH + ptau) * 72 + lcol + 8) = gl1;
      lds_barrier();
      {
        f32x16 acc;
#pragma unroll
        for (int r = 0; r < 16; ++r) acc[r] = 0.f;
#pragma unroll
        for (int kk = 0; kk < 4; ++kk) {
          const bf16x8 af = *(const bf16x8*)(LRs + (mm * RCH + (lane & 31)) * 72 + kk * 16 + (lane >> 5) * 8);
          acc = __builtin_amdgcn_mfma_f32_32x32x16_bf16(af, wfr[kk], acc, 0, 0, 0);
        }
        const int chn = nh * 32 + (lane & 31), hh = lane >> 5;
        if (mm == 0) {
          float lwv[16], pf[16], own[4], oth[4];
#pragma unroll
          for (int r = 0; r < 16; ++r) lwv[r] = -0.60653066f * sigmoidf_(acc[r] + bias);
#pragma unroll
          for (int g = 0; g < 4; ++g) {
            pf[g * 4] = lwv[g * 4];
            pf[g * 4 + 1] = pf[g * 4] + lwv[g * 4 + 1];
            pf[g * 4 + 2] = pf[g * 4 + 1] + lwv[g * 4 + 2];
            pf[g * 4 + 3] = pf[g * 4 + 2] + lwv[g * 4 + 3];
            own[g] = pf[g * 4 + 3];
            oth[g] = __shfl_xor(own[g], 32);
          }
          float base = 0.f;
#pragma unroll
          for (int g = 0; g < 4; ++g) {
            const float off = base + (hh ? oth[g] : 0.f);
#pragma unroll
            for (int q = 0; q < 4; ++q) {
              const int t = q + 8 * g + 4 * hh;
              const float c = off + pf[g * 4 + q];
              LWs[t * 64 + chn] = c;
            }
            base += own[g] + oth[g];
          }
        } else {
#pragma unroll
          for (int r = 0; r < 16; ++r) {
            const int t = (r & 3) + 8 * (r >> 2) + 4 * hh;
            AAs[t * 64 + chn] = sigmoidf_(acc[r] + bias);
          }
        }
      }
      lds_barrier();
      {
        float r[8], k[8], v[8], cm[8], cp[8], a[8];
        unpack8(gr, r); unpack8(gk, k); unpack8(gv, v);
#pragma unroll
        for (int e = 0; e < 8; ++e) {
          cm[e] = LWs[ptau * 64 + pc8 + e]; cp[e] = ptau > 0 ? LWs[(ptau - 1) * 64 + pc8 + e] : 0.f; a[e] = AAs[ptau * 64 + pc8 + e];
        }
        float kkv[8], ss = 0.f;
#pragma unroll
        for (int e = 0; e < 8; ++e) { kkv[e] = k[e] * pkk[e]; ss += kkv[e] * kkv[e]; }
        ss = red8(ss);
        const float inv = rsqrtf(fmaxf(ss, 1e-24f));
        float br = 0.f, kr = 0.f, bon = 0.f;
        float o0[8], o1[8], o2[8], o3[8];
#pragma unroll
        for (int e = 0; e < 8; ++e) {
          const float kkn = kkv[e] * inv;
          const float P = __expf(cm[e]), Pp = __expf(cp[e]);
          const float iP = rcpf_(P);
          const float kd = k[e] * (1.f + (a[e] - 1.f) * pka[e]);
          const float bb = kkn * a[e];
          o0[e] = -kkn * Pp; o1[e] = r[e] * P; o2[e] = bb * iP; o3[e] = kd * iP;
          br += bb * r[e]; kr += kd * r[e]; bon += r[e] * kd * prk[e];
        }
        br = red8(br); kr = red8(kr); bon = red8(bon);
        float* od = op + ptau * 256 + pc8;
        *(float4*)(od) = make_float4(o0[0], o0[1], o0[2], o0[3]); *(float4*)(od + 4) = make_float4(o0[4], o0[5], o0[6], o0[7]);
        *(float4*)(od + 64) = make_float4(o1[0], o1[1], o1[2], o1[3]); *(float4*)(od + 68) = make_float4(o1[4], o1[5], o1[6], o1[7]);
        *(float4*)(od + 128) = make_float4(o2[0], o2[1], o2[2], o2[3]); *(float4*)(od + 132) = make_float4(o2[4], o2[5], o2[6], o2[7]);
        *(float4*)(od + 192) = make_float4(o3[0], o3[1], o3[2], o3[3]); *(float4*)(od + 196) = make_float4(o3[4], o3[5], o3[6], o3[7]);
        float* vd = vv + ptau * 64 + pc8;
        *(float4*)(vd) = make_float4(v[0], v[1], v[2], v[3]); *(float4*)(vd + 4) = make_float4(v[4], v[5], v[6], v[7]);
        if ((tid & 7) == 0) {
          sc[ptau * 2] = br; sc[ptau * 2 + 1] = kr;
          const int pos = scan_pos(dir, chunk * RCH + ptau);
          p.BN[((size_t)dir * NTG + (size_t)bl * TT + pos) * 32 + h] = bon;
        }
      }
      lds_barrier();
      if (chunk + 1 < TT / RCH) gload(chunk + 1);
      {
        struct StepOps { float4 n0, n1, q0, q1, b0, b1, k0, k1; float v0, v1; float2 s; };
        auto ldops = [&](StepOps& o, int tau) {
          const float* ob = op + tau * 256 + ko;
          o.n0 = *(const float4*)(ob); o.n1 = *(const float4*)(ob + 4);
          o.q0 = *(const float4*)(ob + 64); o.q1 = *(const float4*)(ob + 68);
          o.b0 = *(const float4*)(ob + 128); o.b1 = *(const float4*)(ob + 132);
          o.k0 = *(const float4*)(ob + 192); o.k1 = *(const float4*)(ob + 196);
          o.v0 = vv[tau * 64 + row0]; o.v1 = vv[tau * 64 + row1];
          o.s = *(const float2*)(sc + tau * 2);
        };
        auto dostep = [&](const StepOps& o, int tau) {
          const float nk[8] = {o.n0.x, o.n0.y, o.n0.z, o.n0.w, o.n1.x, o.n1.y, o.n1.z, o.n1.w};
          const float rr[8] = {o.q0.x, o.q0.y, o.q0.z, o.q0.w, o.q1.x, o.q1.y, o.q1.z, o.q1.w};
          const float bb[8] = {o.b0.x, o.b0.y, o.b0.z, o.b0.w, o.b1.x, o.b1.y, o.b1.z, o.b1.w};
          const float kd[8] = {o.k0.x, o.k0.y, o.k0.z, o.k0.w, o.k1.x, o.k1.y, o.k1.z, o.k1.w};
          f2_t a10 = {0.f, 0.f}, a11 = {0.f, 0.f}, a20 = {0.f, 0.f}, a21 = {0.f, 0.f};
#pragma unroll
          for (int e = 0; e < 4; ++e) {
            const f2_t nk2 = {nk[2 * e], nk[2 * e + 1]}, rr2 = {rr[2 * e], rr[2 * e + 1]};
            a10 = __builtin_elementwise_fma(S0[e], nk2, a10); a11 = __builtin_elementwise_fma(S1[e], nk2, a11);
            a20 = __builtin_elementwise_fma(S0[e], rr2, a20); a21 = __builtin_elementwise_fma(S1[e], rr2, a21);
          }
          float d10 = a10.x + a10.y, d11 = a11.x + a11.y, d20 = a20.x + a20.y, d21 = a21.x + a21.y;
          d10 = red8(d10); d11 = red8(d11); d20 = red8(d20); d21 = red8(d21);
          const float y0 = d20 + d10 * o.s.x + o.v0 * o.s.y;
          const float y1 = d21 + d11 * o.s.x + o.v1 * o.s.y;
          const f2_t sa0 = {d10, d10}, sa1 = {d11, d11}, vv0 = {o.v0, o.v0}, vv1 = {o.v1, o.v1};
#pragma unroll
          for (int e = 0; e < 4; ++e) {
            const f2_t bb2 = {bb[2 * e], bb[2 * e + 1]}, kd2 = {kd[2 * e], kd[2 * e + 1]};
            S0[e] = __builtin_elementwise_fma(sa0, bb2, __builtin_elementwise_fma(vv0, kd2, S0[e]));
            S1[e] = __builtin_elementwise_fma(sa1, bb2, __builtin_elementwise_fma(vv1, kd2, S1[e]));
          }
          if ((lane & 7) == 0) { yb[tau * 64 + row0] = y0; yb[tau * 64 + row1] = y1; }
        };
        StepOps oa, ob2;
        ldops(oa, 0);
#pragma unroll 1
        for (int tau = 0; tau < RCH; tau += 2) {
          ldops(ob2, tau + 1);
          dostep(oa, tau);
          ldops(oa, tau + 2);
          dostep(ob2, tau + 1);
        }
#pragma unroll
        for (int e = 0; e < 4; ++e) {
          const f2_t pc = {__expf(LWs[(RCH - 1) * 64 + ko + 2 * e]), __expf(LWs[(RCH - 1) * 64 + ko + 2 * e + 1])};
          S0[e] *= pc; S1[e] *= pc;
        }
      }
      lds_barrier();
      {
        const int pos = scan_pos(dir, chunk * RCH + ptau);
        const float* ys = yb + ptau * 64 + pc8;
        float yv[8];
#pragma unroll
        for (int e = 0; e < 8; ++e) yv[e] = ys[e];
        *(uint4*)(Y + ((size_t)bl * TT + pos) * DI + h * 64 + pc8) = pack8(yv);
      }
    }
    lds_barrier();
  }
}

__device__ __forceinline__ void phase_rw_gate(const Params& p, int j) {
  const int tid = opaque_tid(), h = tid >> 3;
  const int c0 = tid * 8;
  float lnw[8], lnb[8];
#pragma unroll
  for (int e = 0; e < 8; ++e) { lnw[e] = p.rw_lnw[j * DI + c0 + e]; lnb[e] = p.rw_lnb[j * DI + c0 + e]; }
  for (int tg = blockIdx.x; tg < NTG; tg += gridDim.x) {
    const size_t base = (size_t)tg * DI + c0;
    float yf[8], yb[8], v[8], z[8];
    unpack8(*(const uint4*)(p.YF + base), yf); unpack8(*(const uint4*)(p.YB + base), yb);
    unpack8(*(const uint4*)(p.V + base), v); unpack8(*(const uint4*)(p.Z + base), z);
    const float bon = p.BN[(size_t)tg * 32 + h] + p.BN[((size_t)NTG + tg) * 32 + h];
    float y[8], s = 0.f;
#pragma unroll
    for (int e = 0; e < 8; ++e) { y[e] = yf[e] + yb[e]; s += y[e]; }
    const float mu = red8(s) * (1.f / 64.f);
    float s2 = 0.f;
#pragma unroll
    for (int e = 0; e < 8; ++e) { y[e] -= mu; s2 += y[e] * y[e]; }
    const float rstd = rsqrtf(red8(s2) * (1.f / 64.f) + 64e-5f);
#pragma unroll
    for (int e = 0; e < 8; ++e) y[e] = (y[e] * rstd * lnw[e] + lnb[e] + bon * v[e]) * z[e];
    *(uint4*)(p.YF + base) = pack8(y);
  }
}

__device__ __forceinline__ void phase_out(const Params& p, const bf16_t* wo, char* smem, bool skipctx = false) {
  const int mtn = skipctx ? GB * (SEQ / 128) : MT;
  for (int tile = blockIdx.x; tile < mtn * 8; tile += gridDim.x) {
    const int mtl = tile / 8, nt = tile % 8;
    const int mt = skipctx ? (mtl / (SEQ / 128)) * (TT / 128) + CTX / 128 + mtl % (SEQ / 128) : mtl;
    const int m0 = mt * 128, n0 = nt * 128;
    const bf16_t* Bw = wo + (size_t)n0 * DI;
    gemm_tile<0>(p.YF, DI, nullptr, m0, DI, Bw, 128, smem,
                 [&](int row, int col, float* v) {
      float* o = p.O + (size_t)row * DM + n0 + col;
      *(float4*)o = make_float4(v[0], v[1], v[2], v[3]); *(float4*)(o + 4) = make_float4(v[4], v[5], v[6], v[7]); });
  }
}

__device__ __forceinline__ void phase_hg_proj(const Params& p, int j, char* smem) {
  const int layer = 2 * j + 1;
  for (int tile = blockIdx.x; tile < MT * 80; tile += gridDim.x) {
    const int mt = tile / 80, nt = tile % 80, m0 = mt * 128;
    const int seg = nt >> 4, n0 = (nt & 15) * 128;
    const bf16_t* Bw = g_wt + OFF_HWIN + ((size_t)j * 5 * DI + (size_t)seg * DI + n0) * DM;
    bf16_t* dst = seg == 0 ? p.R : (seg == 1 ? p.K : (seg == 2 ? p.WF : (seg == 3 ? p.V : p.Z)));
    if (seg == 0 || seg == 4) {
      gemm_tile<0>(p.H, DM, nullptr, m0, DM, Bw, 128, smem, [&](int row, int col, float* v) {
#pragma unroll
        for (int e = 0; e < 8; ++e) v[e] = siluf_(v[e]);
        *(uint4*)(dst + (size_t)row * DI + n0 + col) = pack8(v); });
    } else if (seg == 3) {
      gemm_tile<0>(p.H, DM, nullptr, m0, DM, Bw, 128, smem,
                   [&](int row, int col, float* v) { *(uint4*)(dst + (size_t)row * DI + n0 + col) = pack8(v); });
    } else {
      const float* lbp = p.LB + layer * DI + n0;
      gemm_tile<0>(p.H, DM, nullptr, m0, DM, Bw, 128, smem, [&](int row, int col, float* v) {
        const float4 l0 = *(const float4*)(lbp + col), l1 = *(const float4*)(lbp + col + 4);
        const float lb[8] = {l0.x, l0.y, l0.z, l0.w, l1.x, l1.y, l1.z, l1.w};
#pragma unroll
        for (int e = 0; e < 8; ++e) v[e] = __logf(lb[e] + (1.f - lb[e]) * sigmoidf_(v[e]));
        *(uint4*)(dst + (size_t)row * DI + n0 + col) = pack8(v); });
    }
  }
}

constexpr int HC = 32;
constexpr int QS = 136;
constexpr int SS = 40;
__device__ __forceinline__ void phase_hg_scan(const Params& p, int layer, char* smem) {
  bf16_t* qe = (bf16_t*)smem;
  bf16_t* ke = qe + HC * QS;
  bf16_t* kdT = ke + HC * QS;
  bf16_t* vT = kdT + 128 * SS;
  bf16_t* att = vT + 64 * SS;
  bf16_t* ST = att + HC * SS;
  float* dC = (float*)(ST + 64 * QS);
  const int tid = opaque_tid(), lane = tid & 63, w = tid >> 6;
  for (int unit = blockIdx.x; unit < GB * 64; unit += gridDim.x) {
    const int vs = unit & 1, dir = (unit >> 1) & 1, h = (unit >> 2) & 15, bl = unit >> 6;
    const bf16_t* FL = dir == 0 ? p.K : p.WF;
    bf16_t* Y = dir == 0 ? p.YF : p.YB;
    const int st = lane & 31, cg = w * 2 + (lane >> 5), kb = cg * 16, vb = cg * 8;
    f32x16 sacc[2];
#pragma unroll
    for (int r = 0; r < 16; ++r) { sacc[0][r] = 0.f; sacc[1][r] = 0.f; }
    __syncthreads();
    for (int idx = tid; idx < 64 * QS / 2; idx += 256) ((unsigned*)ST)[idx] = 0u;
    uint4 gq0, gq1, gf0, gf1, gvv;
    const size_t ubase = (size_t)bl * TT * DI + h * 128;
    const bf16_t* const qp = p.R + ubase + kb;
    const bf16_t* const fp_ = FL + ubase + kb;
    const bf16_t* const ip = p.V + ubase + vs * 64 + vb;
    auto gload = [&](int chunk) {
      const int pos = scan_pos(dir, chunk * HC + st);
      const size_t o = (size_t)pos * DI;
      gq0 = *(const uint4*)(qp + o); gq1 = *(const uint4*)(qp + o + 8);
      gf0 = *(const uint4*)(fp_ + o); gf1 = *(const uint4*)(fp_ + o + 8);
      gvv = *(const uint4*)(ip + o);
    };
    gload(0);
    for (int chunk = 0; chunk < TT / HC; ++chunk) {
      float q[16], cum[16], one[16];
      {
        unpack8(gq0, q); unpack8(gq1, q + 8); unpack8(gf0, cum); unpack8(gf1, cum + 8);
#pragma unroll
        for (int e = 0; e < 16; ++e) {
          float c = cum[e];
          one[e] = 1.f - __expf(c);
          c += __int_as_float(__builtin_amdgcn_update_dpp(0, __float_as_int(c), 0x111, 0xf, 0xf, false));
          c += __int_as_float(__builtin_amdgcn_update_dpp(0, __float_as_int(c), 0x112, 0xf, 0xf, false));
          c += __int_as_float(__builtin_amdgcn_update_dpp(0, __float_as_int(c), 0x114, 0xf, 0xf, false));
          c += __int_as_float(__builtin_amdgcn_update_dpp(0, __float_as_int(c), 0x118, 0xf, 0xf, false));
          c += __int_as_float(__builtin_amdgcn_update_dpp(0, __float_as_int(c), 0x142, 0xa, 0xf, false));
          cum[e] = c;
        }
      }
      const uint4 vreg = gvv;
      lds_barrier();
      {
        float qo[16], ko[16];
#pragma unroll
        for (int e = 0; e < 16; ++e) {
          const float c31 = __int_as_float(__builtin_amdgcn_readlane(__float_as_int(cum[e]), 31));
          const float c63 = __int_as_float(__builtin_amdgcn_readlane(__float_as_int(cum[e]), 63));
          const float cC = (lane >> 5) ? c63 : c31;
          const float ec = __expf(fmaxf(cum[e], -80.f));
          const float inv = rcpf_(ec);
          const float eC = __expf(cC);
          qo[e] = q[e] * ec;
          ko[e] = one[e] * inv;
          kdT[(kb + e) * SS + st] = f2bf(one[e] * inv * eC);
          if (st == 31) dC[kb + e] = eC;
        }
        *(uint4*)(qe + st * QS + kb) = pack8(qo); *(uint4*)(qe + st * QS + kb + 8) = pack8(qo + 8);
        *(uint4*)(ke + st * QS + kb) = pack8(ko); *(uint4*)(ke + st * QS + kb + 8) = pack8(ko + 8);
        const bf16_t* vp = (const bf16_t*)&vreg;
#pragma unroll
        for (int e = 0; e < 8; ++e) vT[(vb + e) * SS + st] = vp[e];
      }
      lds_barrier();
      if (chunk + 1 < TT / HC) gload(chunk + 1);
      {
        const int mi = w >> 1, ni = w & 1;
        f32x4 a4 = {0.f, 0.f, 0.f, 0.f};
#pragma unroll
        for (int kk = 0; kk < 4; ++kk) {
          const bf16x8 af = *(const bf16x8*)(qe + (mi * 16 + (lane & 15)) * QS + kk * 32 + (lane >> 4) * 8);
          const bf16x8 bf = *(const bf16x8*)(ke + (ni * 16 + (lane & 15)) * QS + kk * 32 + (lane >> 4) * 8);
          a4 = __builtin_amdgcn_mfma_f32_16x16x32_bf16(af, bf, a4, 0, 0, 0);
        }
        const int s = ni * 16 + (lane & 15);
#pragma unroll
        for (int r = 0; r < 4; ++r) {
          const int t = mi * 16 + (lane >> 4) * 4 + r;
          att[t * SS + s] = f2bf(s <= t ? a4[r] : 0.f);
        }
      }
      lds_barrier();
      {
#pragma unroll
        for (int mh = 0; mh < 2; ++mh) {
          f32x4 y4 = {0.f, 0.f, 0.f, 0.f};
          {
            const bf16x8 af = *(const bf16x8*)(att + (mh * 16 + (lane & 15)) * SS + (lane >> 4) * 8);
            const bf16x8 bf = *(const bf16x8*)(vT + (w * 16 + (lane & 15)) * SS + (lane >> 4) * 8);
            y4 = __builtin_amdgcn_mfma_f32_16x16x32_bf16(af, bf, y4, 0, 0, 0);
          }
#pragma unroll
          for (int kk = 0; kk < 4; ++kk) {
            const bf16x8 af = *(const bf16x8*)(qe + (mh * 16 + (lane & 15)) * QS + kk * 32 + (lane >> 4) * 8);
            const bf16x8 bf = *(const bf16x8*)(ST + (w * 16 + (lane & 15)) * QS + kk * 32 + (lane >> 4) * 8);
            y4 = __builtin_amdgcn_mfma_f32_16x16x32_bf16(af, bf, y4, 0, 0, 0);
          }
#pragma unroll
          for (int r = 0; r < 4; ++r) {
            const int t = mh * 16 + (lane >> 4) * 4 + r;
            const int pos = scan_pos(dir, chunk * HC + t);
            Y[((size_t)bl * TT + pos) * DI + h * 128 + vs * 64 + w * 16 + (lane & 15)] = f2bf(y4[r]);
          }
        }
      }
      lds_barrier();
      {
        float dk[16];
#pragma unroll
        for (int r = 0; r < 16; ++r) dk[r] = dC[w * 32 + (r & 3) + 8 * (r >> 2) + 4 * (lane >> 5)];
#pragma unroll
        for (int nt = 0; nt < 2; ++nt) {
#pragma unroll
          for (int r = 0; r < 16; ++r) sacc[nt][r] *= dk[r];
#pragma unroll
          for (int ks = 0; ks < 2; ++ks) {
            const bf16x8 af = *(const bf16x8*)(kdT + (w * 32 + (lane & 31)) * SS + ks * 16 + (lane >> 5) * 8);
            const bf16x8 bf = *(const bf16x8*)(vT + (nt * 32 + (lane & 31)) * SS + ks * 16 + (lane >> 5) * 8);
            sacc[nt] = __builtin_amdgcn_mfma_f32_32x32x16_bf16(af, bf, sacc[nt], 0, 0, 0);
          }
#pragma unroll
          for (int gq = 0; gq < 4; ++gq) {
            uint2 u;
            u.x = pack2(sacc[nt][gq * 4 + 0], sacc[nt][gq * 4 + 1]);
            u.y = pack2(sacc[nt][gq * 4 + 2], sacc[nt][gq * 4 + 3]);
            *(uint2*)(ST + (nt * 32 + (lane & 31)) * QS + w * 32 + gq * 8 + (lane >> 5) * 4) = u;
          }
        }
      }
    }
    lds_barrier();
  }
}

__device__ __forceinline__ void phase_hg_gate(const Params& p, int j) {
  const int tid = opaque_tid();
  const int c0 = tid * 8;
  float gn[8];
#pragma unroll
  for (int e = 0; e < 8; ++e) gn[e] = p.hg_gn[j * 128 + ((c0 + e) & 127)];
  for (int tg = blockIdx.x; tg < NTG; tg += gridDim.x) {
    const size_t base = (size_t)tg * DI + c0;
    float yf[8], yb[8], z[8];
    unpack8(*(const uint4*)(p.YF + base), yf); unpack8(*(const uint4*)(p.YB + base), yb);
    unpack8(*(const uint4*)(p.Z + base), z);
    float y[8], s2 = 0.f;
#pragma unroll
    for (int e = 0; e < 8; ++e) { y[e] = yf[e] + yb[e]; s2 += y[e] * y[e]; }
    const float rstd = rsqrtf(red16(s2) * (1.f / 128.f) + EPS);
#pragma unroll
    for (int e = 0; e < 8; ++e) y[e] = y[e] * rstd * gn[e] * z[e];
    *(uint4*)(p.YF + base) = pack8(y);
  }
}

__global__ void __launch_bounds__(256, 2) fwd_megakernel(Params p) {
  cg::grid_group grid = cg::this_grid();
  __shared__ __attribute__((aligned(16))) char smem[78 * 1024];
  __shared__ uint4 xb_words;
  if (threadIdx.x == 0) xb_words = make_uint4(0u, 0u, 0u, 0u);
  __syncthreads();
  XcdBarrier xb = xcd_barrier_post(p.bar, (volatile LAS unsigned*)&xb_words);
  phase_mod(p, smem);
  phase_wconv(p, smem);
  grid.sync();
  for (int g = 0; g < NG; ++g) {
    for (int layer = 0; layer < 4; ++layer) {
      phase_resnorm(p, g, layer - 1, layer);
      xcd_barrier(xb);
      const int j = layer >> 1;
      if ((layer & 1) == 0) {
        phase_rw_proj(p, j, smem, 0, blockIdx.x, gridDim.x);
        xcd_barrier(xb);
        if (j == 1) { phase_rw_lr2(p, j, smem); xcd_barrier(xb); }
        if (gridDim.x >= 2 * GB * 64) {
          if (blockIdx.x < GB * 64) phase_rw_scan(p, j, smem);
          else phase_rw_proj(p, j, smem, 1, blockIdx.x - GB * 64, gridDim.x - GB * 64);
        } else {
          phase_rw_scan(p, j, smem);
          phase_rw_proj(p, j, smem, 1, blockIdx.x, gridDim.x);
        }
        xcd_barrier(xb);
        phase_rw_gate(p, j);
        xcd_barrier(xb);
        phase_out(p, g_wt + OFF_RWO + (size_t)j * DM * DI, smem);
        xcd_barrier(xb);
      } else {
        phase_hg_proj(p, j, smem);
        xcd_barrier(xb);
        phase_hg_scan(p, layer, smem);
        xcd_barrier(xb);
        phase_hg_gate(p, j);
        xcd_barrier(xb);
        phase_out(p, g_wt + OFF_HWO + (size_t)j * DM * DI, smem, layer == 3);
        xcd_barrier(xb);
      }
    }
    phase_resnorm(p, g, 3, -1);
    xcd_barrier(xb);
  }
}

extern "C" void kernel_launch(void* const* d_in, const int* in_sizes, int n_in, void* d_out, int out_size, void* d_ws,
                              size_t ws_size, hipStream_t stream) {
  static int grid_blocks = 0;
  if (!grid_blocks) {
    int dev = 0, cus = 0, per_cu = 0;
    hipGetDevice(&dev);
    hipDeviceGetAttribute(&cus, hipDeviceAttributeMultiprocessorCount, dev);
    hipOccupancyMaxActiveBlocksPerMultiprocessor(&per_cu, fwd_megakernel, 256, 0);
    if (per_cu > 2) per_cu = 2;
    grid_blocks = cus * per_cu;
  }
  Params p{};
  const float** fp = (const float**)&p;
  for (int i = 0; i < 29; ++i) fp[i] = (const float*)d_in[i];
  p.out = (float*)d_out;
  char* w = (char*)d_ws;
  size_t off = 0;
  auto take = [&](size_t bytes) { char* r = w + off; off += (bytes + 255) & ~(size_t)255; return r; };
  const size_t DIW = (size_t)NTG * DI * 2;
  p.R = (bf16_t*)take(DIW); p.K = (bf16_t*)take(DIW); p.V = (bf16_t*)take(DIW); p.Z = (bf16_t*)take(DIW);
  p.WF = (bf16_t*)take(DIW); p.YF = (bf16_t*)take(DIW); p.YB = (bf16_t*)take(DIW);
  p.VF = p.YF;
  p.H = p.YB;
  p.HR = p.WF; p.HR0 = p.WF + (size_t)NTG * DM;
  p.LRW = (bf16_t*)take((size_t)NTG * 128 * 2); p.LRA = (bf16_t*)take((size_t)NTG * 128 * 2);
  p.LRV = (bf16_t*)take((size_t)NTG * 32 * 2);
  p.O = (float*)p.R;
  p.BN = (float*)take((size_t)2 * NTG * 32 * 4);
  p.CTXB = (float*)take((size_t)NB * CTX * DM * 4);
  p.MODV = (float*)take((size_t)4 * 9 * 3 * DM * 4);
  p.LB = (float*)take((size_t)4 * DI * 4);
  p.bar = (unsigned*)take((size_t)XCD_BAR_WORDS * 4);
  if (off > ws_size) { fprintf(stderr, "workspace too small: need %zu have %zu\n", off, ws_size); return; }
  hipMemsetAsync(p.bar, 0, (size_t)XCD_BAR_WORDS * 4, stream);
  void* args[] = {&p};
  hipError_t e = hipLaunchCooperativeKernel((void*)fwd_megakernel, dim3(grid_blocks), dim3(256), args, 0, stream);
  if (e != hipSuccess) fprintf(stderr, "cooperative launch failed: %s (grid %d)\n", hipGetErrorString(e), grid_blocks);
}
```

```cpp
#include <hip/hip_runtime.h>
#include <hip/hip_cooperative_groups.h>
#include <cstdio>
#include <cstdint>
namespace cg = cooperative_groups;

typedef unsigned short bf16_t;
using bf16x8 = __attribute__((ext_vector_type(8))) short;
using f32x16 = __attribute__((ext_vector_type(16))) float;
using f32x4 = __attribute__((ext_vector_type(4))) float;
using f2_t = __attribute__((ext_vector_type(2))) float;

constexpr int NB = 8, SEQ = 4096, CTX = 256, TT = 4352, DM = 1024, DI = 2048;
constexpr int GB = 4, NG = NB / GB, NTG = GB * TT;
constexpr int MT = NTG / 128;
constexpr float EPS = 1e-6f;

constexpr size_t OFF_PROJ = 0;
constexpr size_t OFF_RWO = OFF_PROJ + (size_t)2 * 4 * DI * DM;
constexpr size_t OFF_W1 = OFF_RWO + (size_t)2 * DM * DI;
constexpr size_t OFF_A1 = OFF_W1 + (size_t)2 * 128 * DM;
constexpr size_t OFF_V1 = OFF_A1 + (size_t)2 * 128 * DM;
constexpr size_t OFF_V2 = OFF_V1 + (size_t)32 * DM;
constexpr size_t OFF_HWIN = OFF_V2 + (size_t)DI * 32;
constexpr size_t OFF_HWO = OFF_HWIN + (size_t)2 * 5 * DI * DM;
constexpr size_t OFF_W2 = OFF_HWO + (size_t)2 * DM * DI;
constexpr size_t OFF_A2 = OFF_W2 + (size_t)4 * DI * 64;
constexpr size_t WT_TOTAL = OFF_A2 + (size_t)4 * DI * 64;
__device__ bf16_t g_wt[WT_TOTAL];

struct Params {
  const float *x, *c, *ctx, *c_ctx, *mod_w, *mod_b, *pre_g, *post_g, *rw_mix, *rw_proj, *rw_wo, *rw_w0, *rw_w1,
      *rw_w2, *rw_a0, *rw_a1, *rw_a2, *rw_v0, *rw_v1, *rw_v2, *rw_kk, *rw_ka, *rw_rk, *rw_lnw, *rw_lnb, *hg_win,
      *hg_wo, *hg_gn, *hg_lb;
  float* out;
  bf16_t *R, *K, *V, *Z, *WF, *YF, *YB, *VF, *H, *HR, *HR0, *LRW, *LRA, *LRV;
  float *O, *BN, *CTXB, *MODV, *LB;
  unsigned* bar;
};

typedef __bf16 hwbf2_t __attribute__((ext_vector_type(2)));
typedef float hwf2_t __attribute__((ext_vector_type(2)));
__device__ __forceinline__ unsigned pack2(float a, float b) {
  hwf2_t f = {a, b};
  hwbf2_t h = __builtin_convertvector(f, hwbf2_t);
  return __builtin_bit_cast(unsigned, h);
}
__device__ __forceinline__ bf16_t f2bf(float f) { return (bf16_t)(pack2(f, f) & 0xffffu); }
__device__ __forceinline__ float bf2f(bf16_t h) { return __uint_as_float(((unsigned)h) << 16); }
typedef _Float16 h2_t __attribute__((ext_vector_type(2)));
using f16x8 = __attribute__((ext_vector_type(8))) _Float16;
__device__ __forceinline__ unsigned pack2h(float a, float b) {
  h2_t h = {(_Float16)a, (_Float16)b};
  return __builtin_bit_cast(unsigned, h);
}
__device__ __forceinline__ uint4 pack8h(const float* f) {
  uint4 u; u.x = pack2h(f[0], f[1]); u.y = pack2h(f[2], f[3]); u.z = pack2h(f[4], f[5]); u.w = pack2h(f[6], f[7]);
  return u;
}
__device__ __forceinline__ unsigned mixh2(unsigned h, unsigned n, unsigned m) {
  const h2_t hv = __builtin_bit_cast(h2_t, h), nv = __builtin_bit_cast(h2_t, n), mv = __builtin_bit_cast(h2_t, m);
  const h2_t r = hv + (nv - hv) * mv;
  return __builtin_bit_cast(unsigned, r);
}
__device__ __forceinline__ float lo2f(unsigned u) { return __uint_as_float(u << 16); }
__device__ __forceinline__ float hi2f(unsigned u) { return __uint_as_float(u & 0xffff0000u); }
__device__ __forceinline__ float rcpf_(float x) { return __builtin_amdgcn_rcpf(x); }
__device__ __forceinline__ float sigmoidf_(float x) { return rcpf_(1.f + __expf(-x)); }
__device__ __forceinline__ float siluf_(float x) { return x * rcpf_(1.f + __expf(-x)); }
__device__ __forceinline__ float tanhf_(float x) { return 1.f - 2.f * rcpf_(1.f + __expf(2.f * x)); }

__device__ __forceinline__ void lds_barrier() { asm volatile("s_waitcnt lgkmcnt(0)\n\ts_barrier" ::: "memory"); }

__device__ __forceinline__ int opaque_tid() { int t = threadIdx.x; asm volatile("" : "+v"(t)); return t; }

template <int CTRL>
__device__ __forceinline__ float dppf(float v) {
  return __int_as_float(__builtin_amdgcn_update_dpp(0, __float_as_int(v), CTRL, 0xf, 0xf, true));
}
__device__ __forceinline__ float red4(float v) { v += dppf<0xB1>(v); v += dppf<0x4E>(v); return v; }
__device__ __forceinline__ float red8(float v) { v = red4(v); v += dppf<0x141>(v); return v; }
__device__ __forceinline__ float red16(float v) { v = red8(v); v += dppf<0x140>(v); return v; }
__device__ __forceinline__ float red64(float v) {
  v = red16(v);
  v += __shfl_xor(v, 16);
  v += __shfl_xor(v, 32);
  return v;
}

__device__ __forceinline__ void unpack8(const uint4& u, float* f) {
  f[0] = lo2f(u.x); f[1] = hi2f(u.x); f[2] = lo2f(u.y); f[3] = hi2f(u.y);
  f[4] = lo2f(u.z); f[5] = hi2f(u.z); f[6] = lo2f(u.w); f[7] = hi2f(u.w);
}
__device__ __forceinline__ uint4 pack8(const float* f) {
  uint4 u; u.x = pack2(f[0], f[1]); u.y = pack2(f[2], f[3]); u.z = pack2(f[4], f[5]); u.w = pack2(f[6], f[7]);
  return u;
}


#define XB_TMO      128
#define XB_XCNT(j)  (256  + 64 * (j))
#define XB_XSUB(j)  (1280 + 64 * (j))
#define XB_XGEN(j)  (2304 + 64 * (j))
#define XB_TOP      3328
#define XB_TOPGEN   3392
#define XCD_BAR_WORDS 3456
#define XB_SPIN_CAP (1u << 23)
#define LAS __attribute__((address_space(3)))
__device__ __forceinline__ unsigned xb_ld(unsigned* p)              { return __hip_atomic_load(p, __ATOMIC_RELAXED, __HIP_MEMORY_SCOPE_AGENT); }
__device__ __forceinline__ unsigned xb_add(unsigned* p, unsigned v) { return __hip_atomic_fetch_add(p, v, __ATOMIC_RELAXED, __HIP_MEMORY_SCOPE_AGENT); }
__device__ __forceinline__ unsigned xb_xcc_id() { return (unsigned)__builtin_amdgcn_s_getreg((3 << 11) | 20) & 0xFu; }
#define XB_SPIN(cond, bar) do { unsigned _sp = 0; while (cond) { if (_sp < 128u) __builtin_amdgcn_s_sleep(1); else __builtin_amdgcn_s_sleep(20); \
    if ((++_sp & 255u) == 0u) { if (xb_ld(&(bar)[XB_TMO])) break; if (_sp > XB_SPIN_CAP) { atomicAdd(&(bar)[XB_TMO], 1u); break; } } } } while (0)
struct XcdBarrier { unsigned* bar; unsigned x; volatile LAS unsigned* st; };
__device__ __forceinline__ XcdBarrier xcd_barrier_post(unsigned* bar, volatile LAS unsigned* st) {
  XcdBarrier b; b.bar = bar; b.x = xb_xcc_id(); b.st = st;
  if (threadIdx.x == 0) (void)xb_add(&bar[XB_XCNT(b.x)], 1u);
  return b;
}
__device__ __forceinline__ void xcd_barrier_complete(unsigned* bar, unsigned x, unsigned& nloc, unsigned& nx) {
  const unsigned G = gridDim.x * gridDim.y * gridDim.z;
  unsigned sum, cnt, mine, sp = 0u;
  for (;;) {
    sum = 0u; cnt = 0u; mine = 0u;
#pragma unroll
    for (unsigned j = 0; j < 16; ++j) { const unsigned c = xb_ld(&bar[XB_XCNT(j)]); sum += c; cnt += (c > 0u) ? 1u : 0u; mine = (j == x) ? c : mine; }
    if (sum == G) break;
    __builtin_amdgcn_s_sleep(1);
    if ((++sp & 255u) == 0u) { if (xb_ld(&bar[XB_TMO])) break; if (sp > XB_SPIN_CAP) { atomicAdd(&bar[XB_TMO], 1u); break; } }
  }
  nloc = mine > 0u ? mine : 1u; nx = cnt > 0u ? cnt : 1u;
}
__device__ __forceinline__ void xcd_barrier(const XcdBarrier& b) {
  asm volatile("s_waitcnt vmcnt(0)" ::: "memory");
  __syncthreads();
  if (threadIdx.x == 0) {
    unsigned* bar = b.bar;
    __builtin_amdgcn_s_waitcnt(0);
    unsigned nloc = b.st[0], nx = b.st[1];
    if (nloc == 0u) { xcd_barrier_complete(bar, b.x, nloc, nx); b.st[0] = nloc; b.st[1] = nx; }
    const unsigned old = xb_add(&bar[XB_XSUB(b.x)], 1u);
    const unsigned gen = old / nloc;
    if (old + 1u == (gen + 1u) * nloc) {
      __builtin_amdgcn_fence(__ATOMIC_RELEASE, "agent");
      asm volatile("s_waitcnt vmcnt(0)" ::: "memory");
      const unsigned og = xb_add(&bar[XB_TOP], 1u);
      const unsigned tg = og / nx;
      if (og + 1u == (tg + 1u) * nx) xb_add(&bar[XB_TOPGEN], 1u);
      else XB_SPIN(xb_ld(&bar[XB_TOPGEN]) == tg, bar);
      __builtin_amdgcn_fence(__ATOMIC_ACQUIRE, "agent");
      xb_add(&bar[XB_XGEN(b.x)], 1u);
      asm volatile("s_waitcnt vmcnt(0)" ::: "memory");
    } else {
      XB_SPIN(xb_ld(&bar[XB_XGEN(b.x)]) == gen, bar);
      __builtin_amdgcn_fence(__ATOMIC_ACQUIRE, "agent");
      asm volatile("s_waitcnt vmcnt(0)" ::: "memory");
    }
  }
  __syncthreads();
}

__device__ __forceinline__ const float* row_in(const Params& p, int b, int t) {
  return t < CTX ? p.ctx + ((size_t)b * CTX + t) * DM : p.x + ((size_t)b * SEQ + (t - CTX)) * DM;
}
__device__ __forceinline__ float* row_cur(const Params& p, int b, int t) {
  return t < CTX ? p.CTXB + ((size_t)b * CTX + t) * DM : p.out + ((size_t)b * SEQ + (t - CTX)) * DM;
}

__device__ __forceinline__ void phase_mod(const Params& p, char* smem) {
  float* ssil = (float*)smem;
  float* red = ssil + 9 * DM;
  const int tid = opaque_tid(), cl = tid & 63, kp = tid >> 6;
  if (blockIdx.x < 4 * 48) {
    for (int idx = tid; idx < 9 * DM; idx += 256) {
      const int r = idx >> 10, k = idx & 1023;
      ssil[idx] = siluf_(r < 8 ? p.c[r * DM + k] : p.c_ctx[k]);
    }
    __syncthreads();
  }
  for (int task = blockIdx.x; task < 4 * 48; task += gridDim.x) {
    const int l = task / 48, col = (task % 48) * 64 + cl;
    float acc[9];
#pragma unroll
    for (int r = 0; r < 9; ++r) acc[r] = 0.f;
    const float* W = p.mod_w + (size_t)l * DM * 3 * DM + col;
#pragma unroll 4
    for (int k = kp * 256; k < kp * 256 + 256; ++k) {
      const float w = W[(size_t)k * 3 * DM];
#pragma unroll
      for (int r = 0; r < 9; ++r) acc[r] += ssil[r * DM + k] * w;
    }
    __syncthreads();
#pragma unroll
    for (int r = 0; r < 9; ++r) red[(kp * 9 + r) * 64 + cl] = acc[r];
    __syncthreads();
    for (int idx = tid; idx < 9 * 64; idx += 256) {
      const int r = idx >> 6, c2 = idx & 63;
      float s = 0.f;
      for (int q = 0; q < 4; ++q) s += red[(q * 9 + r) * 64 + c2];
      const int cc = (task % 48) * 64 + c2;
      p.MODV[((size_t)l * 9 + r) * 3 * DM + cc] = s + p.mod_b[l * 3 * DM + cc];
    }
  }
  for (int cidx = blockIdx.x * 256 + tid; cidx < DI; cidx += gridDim.x * 256) {
    float v[4], m = -1e30f;
    for (int l = 0; l < 4; ++l) { v[l] = p.hg_lb[l * DI + cidx]; m = fmaxf(m, v[l]); }
    float s = 0.f;
    for (int l = 0; l < 4; ++l) { v[l] = __expf(v[l] - m); s += v[l]; }
    float cum = 0.f;
    for (int l = 0; l < 4; ++l) { cum += v[l] / s; p.LB[l * DI + cidx] = cum - v[0] / s; }
  }
}

__device__ __forceinline__ void conv_matrix(const float* __restrict__ src, int K, int N, bf16_t* __restrict__ dst, char* smem, bool f16out = false) {
  float* ts = (float*)smem;
  const int tid = opaque_tid();
  const int ntn = N / 32, ntile = (K / 64) * ntn;
  for (int tile = blockIdx.x; tile < ntile; tile += gridDim.x) {
    const int k0 = (tile / ntn) * 64, n0 = (tile % ntn) * 32;
    __syncthreads();
#pragma unroll
    for (int i = 0; i < 2; ++i) {
      const int k = (tid >> 3) + 32 * i, n4 = (tid & 7) * 4;
      const float4 v = *(const float4*)(src + (size_t)(k0 + k) * N + n0 + n4);
      ts[k * 33 + n4 + 0] = v.x; ts[k * 33 + n4 + 1] = v.y; ts[k * 33 + n4 + 2] = v.z; ts[k * 33 + n4 + 3] = v.w;
    }
    __syncthreads();
    const int n = tid >> 3, k8 = (tid & 7) * 8;
    float f[8];
#pragma unroll
    for (int e = 0; e < 8; ++e) f[e] = ts[(k8 + e) * 33 + n];
    *(uint4*)(dst + (size_t)(n0 + n) * K + k0 + k8) = f16out ? pack8h(f) : pack8(f);
  }
}
__device__ __forceinline__ void phase_wconv(const Params& p, char* smem) {
  for (int m = 0; m < 8; ++m) conv_matrix(p.rw_proj + (size_t)m * DM * DI, DM, DI, g_wt + OFF_PROJ + (size_t)m * DI * DM, smem, true);
  for (int j = 0; j < 2; ++j) conv_matrix(p.rw_wo + (size_t)j * DI * DM, DI, DM, g_wt + OFF_RWO + (size_t)j * DM * DI, smem);
  for (int m = 0; m < 4; ++m) {
    conv_matrix(p.rw_w1 + (size_t)m * DM * 64, DM, 64, g_wt + OFF_W1 + (size_t)m * 64 * DM, smem, true);
    conv_matrix(p.rw_a1 + (size_t)m * DM * 64, DM, 64, g_wt + OFF_A1 + (size_t)m * 64 * DM, smem, true);
  }
  conv_matrix(p.rw_v1, DM, 32, g_wt + OFF_V1, smem, true);
  for (int m = 0; m < 4; ++m) {
    conv_matrix(p.rw_w2 + (size_t)m * 64 * DI, 64, DI, g_wt + OFF_W2 + (size_t)m * DI * 64, smem);
    conv_matrix(p.rw_a2 + (size_t)m * 64 * DI, 64, DI, g_wt + OFF_A2 + (size_t)m * DI * 64, smem);
  }
  for (int j = 0; j < 2; ++j) conv_matrix(p.hg_win + (size_t)j * DM * 5 * DI, DM, 5 * DI, g_wt + OFF_HWIN + (size_t)j * 5 * DI * DM, smem);
  for (int j = 0; j < 2; ++j) conv_matrix(p.hg_wo + (size_t)j * DI * DM, DI, DM, g_wt + OFF_HWO + (size_t)j * DM * DI, smem);
  for (int idx = blockIdx.x * 256 + opaque_tid(); idx < DI * 32; idx += gridDim.x * 256) {
    const int n = idx >> 5, k = idx & 31;
    g_wt[OFF_V2 + idx] = f2bf(p.rw_v2[(size_t)k * DI + n]);
  }
}

__device__ __forceinline__ void phase_resnorm(const Params& p, int g, int lu, int ln) {
  const int tid = opaque_tid();
  const int lane = tid & 63;
  const int wv = blockIdx.x * 4 + (tid >> 6), nw = gridDim.x * 4;
  for (int tg = wv; tg < NTG; tg += nw) {
    const int bl = tg / TT, t = tg % TT, b = g * GB + bl;
    const bool isctx = t < CTX;
    const int mrow = isctx ? 8 : b;
    float xv[16];
    const float* src = (lu <= 0) ? row_in(p, b, t) : row_cur(p, b, t);
#pragma unroll
    for (int j = 0; j < 4; ++j) {
      const float4 v4 = *(const float4*)(src + j * 256 + lane * 4);
      xv[j * 4 + 0] = v4.x; xv[j * 4 + 1] = v4.y; xv[j * 4 + 2] = v4.z; xv[j * 4 + 3] = v4.w;
    }
    if (lu >= 0 && !(isctx && lu == 3)) {
      float ov[16], ss = 0.f;
      const float* orow = p.O + (size_t)tg * DM;
#pragma unroll
      for (int j = 0; j < 4; ++j) {
        const float4 v4 = *(const float4*)(orow + j * 256 + lane * 4);
        ov[j * 4 + 0] = v4.x; ov[j * 4 + 1] = v4.y; ov[j * 4 + 2] = v4.z; ov[j * 4 + 3] = v4.w;
      }
#pragma unroll
      for (int e = 0; e < 16; ++e) ss += ov[e] * ov[e];
      ss = red64(ss);
      const float rstd = rsqrtf(ss * (1.f / DM) + EPS);
      const float* gate = p.MODV + ((size_t)lu * 9 + mrow) * 3 * DM + 2 * DM;
      const float* pg = p.post_g + lu * DM;
      float* dst = row_cur(p, b, t);
#pragma unroll
      for (int j = 0; j < 4; ++j) {
        const int cc = j * 256 + lane * 4;
        const float4 g4 = *(const float4*)(gate + cc);
        const float4 p4 = *(const float4*)(pg + cc);
        xv[j * 4 + 0] += g4.x * (ov[j * 4 + 0] * rstd * p4.x);
        xv[j * 4 + 1] += g4.y * (ov[j * 4 + 1] * rstd * p4.y);
        xv[j * 4 + 2] += g4.z * (ov[j * 4 + 2] * rstd * p4.z);
        xv[j * 4 + 3] += g4.w * (ov[j * 4 + 3] * rstd * p4.w);
        *(float4*)(dst + cc) = make_float4(xv[j * 4 + 0], xv[j * 4 + 1], xv[j * 4 + 2], xv[j * 4 + 3]);
      }
    }
    if (ln >= 0) {
      for (int pass = 0; pass < (ln == 2 ? 2 : 1); ++pass) {
        const int lp = pass == 0 ? ln : 0;
        bf16_t* hdst = (pass == 0 ? ((ln & 1) == 0 ? p.HR : p.H) : p.HR0) + (size_t)tg * DM;
        if (pass == 1) {
          const float* s0 = row_in(p, b, t);
#pragma unroll
          for (int j = 0; j < 4; ++j) {
            const float4 v4 = *(const float4*)(s0 + j * 256 + lane * 4);
            xv[j * 4 + 0] = v4.x; xv[j * 4 + 1] = v4.y; xv[j * 4 + 2] = v4.z; xv[j * 4 + 3] = v4.w;
          }
        }
        float ss = 0.f;
#pragma unroll
        for (int e = 0; e < 16; ++e) ss += xv[e] * xv[e];
        ss = red64(ss);
        const float rstd = rsqrtf(ss * (1.f / DM) + EPS);
        const float* mv = p.MODV + ((size_t)lp * 9 + mrow) * 3 * DM;
        const float* pg = p.pre_g + lp * DM;
#pragma unroll
        for (int j = 0; j < 4; ++j) {
          const int cc = j * 256 + lane * 4;
          const float4 sh = *(const float4*)(mv + cc);
          const float4 sc = *(const float4*)(mv + DM + cc);
          const float4 p4 = *(const float4*)(pg + cc);
          const float h0 = xv[j * 4 + 0] * rstd * p4.x * (1.f + sc.x) + sh.x;
          const float h1 = xv[j * 4 + 1] * rstd * p4.y * (1.f + sc.y) + sh.y;
          const float h2 = xv[j * 4 + 2] * rstd * p4.z * (1.f + sc.z) + sh.z;
          const float h3 = xv[j * 4 + 3] * rstd * p4.w * (1.f + sc.w) + sh.w;
          uint2 u;
          if ((ln & 1) == 0) {
            const float L = 60000.f;
            u.x = pack2h(fminf(fmaxf(h0, -L), L), fminf(fmaxf(h1, -L), L));
            u.y = pack2h(fminf(fmaxf(h2, -L), L), fminf(fmaxf(h3, -L), L));
          } else {
            u.x = pack2(h0, h1); u.y = pack2(h2, h3);
          }
          *(uint2*)(hdst + cc) = u;
        }
      }
    }
  }
}

constexpr int LDK = 72;
constexpr int TM = 128;

template <int AMODE, class Epi>
__device__ __forceinline__ void gemm_tile(const bf16_t* __restrict__ A, int lda, const float* __restrict__ mix, int m0,
                                          int K, const bf16_t* __restrict__ Bt, int nvalid, char* smem, Epi epi) {
  bf16_t* As = (bf16_t*)smem;
  bf16_t* Bs = As + 2 * TM * LDK;
  float* mixs = (float*)(Bs + 2 * 128 * LDK);
  const int tid = opaque_tid(), lane = tid & 63, w = tid >> 6, wm = w >> 1, wn = w & 1;
  const int lr = lane >> 3, ch = (lane & 7) * 8;
  const int row0 = w * 32 + lr;
  const bf16_t* Ap = A + (size_t)(m0 + row0) * lda + ch;
  const bf16_t* Bp = Bt + (size_t)row0 * K + ch;
  const size_t astep = (size_t)8 * lda, bstep = (size_t)8 * K;
  const int KT = (K + 63) >> 6;
  const int tbase = m0 % TT;
  const bool isctx = tbase < CTX;
  unsigned vmask = 0;
  if (AMODE == 1) {
#pragma unroll
    for (int i = 0; i < 4; ++i) {
      const int t = tbase + row0 + i * 8;
      unsigned m;
      if (isctx) {
        m = (t >= 1 ? 3u : 0u) | (t + 1 < CTX ? 12u : 0u);
      } else {
        const int tl = t - CTX, row = tl >> 6, col = tl & 63;
        m = (col > 0 ? 1u : 0u) | (col < 63 ? 2u : 0u) | (row > 0 ? 4u : 0u) | (row < 63 ? 8u : 0u);
      }
      vmask |= m << (4 * i);
    }
  }

  __syncthreads();
  if (AMODE == 1) {
    const float4 m4 = *(const float4*)(mix + tid * 4);
    ((uint2*)mixs)[tid] = make_uint2(pack2h(m4.x, m4.y), pack2h(m4.z, m4.w));
  }

  f32x16 acc[2][2];
#pragma unroll
  for (int i = 0; i < 2; ++i)
#pragma unroll
    for (int j = 0; j < 2; ++j)
#pragma unroll
      for (int r = 0; r < 16; ++r) acc[i][j][r] = 0.f;

  uint4 a0, a1, a2, a3, n0, n1, n2, n3, b0, b1, b2, b3;
  auto load_regs = [&](int kt) {
    const int k0 = kt * 64;
    const uint4 z4 = make_uint4(0, 0, 0, 0);
    const bool kval = (k0 + ch) < K;
    const bf16_t* ap = Ap + k0;
    const bf16_t* bp = Bp + k0;
    a0 = z4; if (kval) a0 = *(const uint4*)(ap + 0 * astep);
    a1 = z4; if (kval) a1 = *(const uint4*)(ap + 1 * astep);
    a2 = z4; if (kval) a2 = *(const uint4*)(ap + 2 * astep);
    a3 = z4; if (kval) a3 = *(const uint4*)(ap + 3 * astep);
    b0 = z4; if (kval && (row0 + 0) < nvalid) b0 = *(const uint4*)(bp + 0 * bstep);
    b1 = z4; if (kval && (row0 + 8) < nvalid) b1 = *(const uint4*)(bp + 1 * bstep);
    b2 = z4; if (kval && (row0 + 16) < nvalid) b2 = *(const uint4*)(bp + 2 * bstep);
    b3 = z4; if (kval && (row0 + 24) < nvalid) b3 = *(const uint4*)(bp + 3 * bstep);
    if (AMODE == 1) {
      const int q = k0 >> 8;
      const int nb = isctx ? (q < 2 ? -1 : 1) : (q == 0 ? -1 : (q == 1 ? 1 : (q == 2 ? -64 : 64)));
      const bf16_t* np = ap + (ptrdiff_t)nb * lda;
      const unsigned vm = vmask >> q;
      n0 = z4; if ((vm >> 0) & 1u) n0 = *(const uint4*)(np + 0 * astep);
      n1 = z4; if ((vm >> 4) & 1u) n1 = *(const uint4*)(np + 1 * astep);
      n2 = z4; if ((vm >> 8) & 1u) n2 = *(const uint4*)(np + 2 * astep);
      n3 = z4; if ((vm >> 12) & 1u) n3 = *(const uint4*)(np + 3 * astep);
    }
  };
  auto mix8 = [&](const uint4& hv, const uint4& nv, const uint4& mv) -> uint4 {
    uint4 o;
    o.x = mixh2(hv.x, nv.x, mv.x); o.y = mixh2(hv.y, nv.y, mv.y); o.z = mixh2(hv.z, nv.z, mv.z); o.w = mixh2(hv.w, nv.w, mv.w);
    return o;
  };
  auto store_lds = [&](int kt, int buf) {
    bf16_t* ad = As + (buf * TM + row0) * LDK + ch;
    bf16_t* bd = Bs + (buf * 128 + row0) * LDK + ch;
    if (AMODE == 1) {
      const uint4 mv = *(const uint4*)((const bf16_t*)mixs + kt * 64 + ch);
      *(uint4*)(ad + 0 * LDK) = mix8(a0, n0, mv);
      *(uint4*)(ad + 8 * LDK) = mix8(a1, n1, mv);
      *(uint4*)(ad + 16 * LDK) = mix8(a2, n2, mv);
      *(uint4*)(ad + 24 * LDK) = mix8(a3, n3, mv);
    } else {
      *(uint4*)(ad + 0 * LDK) = a0;
      *(uint4*)(ad + 8 * LDK) = a1;
      *(uint4*)(ad + 16 * LDK) = a2;
      *(uint4*)(ad + 24 * LDK) = a3;
    }
    *(uint4*)(bd + 0 * LDK) = b0;
    *(uint4*)(bd + 8 * LDK) = b1;
    *(uint4*)(bd + 16 * LDK) = b2;
    *(uint4*)(bd + 24 * LDK) = b3;
  };
  auto compute = [&](int buf) {
    const bf16_t* ab = As + (buf * TM + wm * 64 + (lane & 31)) * LDK + (lane >> 5) * 8;
    const bf16_t* bb = Bs + (buf * 128 + wn * 64 + (lane & 31)) * LDK + (lane >> 5) * 8;
#pragma unroll
    for (int kk = 0; kk < 4; ++kk) {
      const bf16x8 af0 = *(const bf16x8*)(ab + kk * 16), af1 = *(const bf16x8*)(ab + 32 * LDK + kk * 16);
      const bf16x8 bf0 = *(const bf16x8*)(bb + kk * 16), bf1 = *(const bf16x8*)(bb + 32 * LDK + kk * 16);
      if (AMODE == 1) {
        const f16x8 ha0 = __builtin_bit_cast(f16x8, af0), ha1 = __builtin_bit_cast(f16x8, af1);
        const f16x8 hb0 = __builtin_bit_cast(f16x8, bf0), hb1 = __builtin_bit_cast(f16x8, bf1);
        acc[0][0] = __builtin_amdgcn_mfma_f32_32x32x16_f16(ha0, hb0, acc[0][0], 0, 0, 0);
        acc[0][1] = __builtin_amdgcn_mfma_f32_32x32x16_f16(ha0, hb1, acc[0][1], 0, 0, 0);
        acc[1][0] = __builtin_amdgcn_mfma_f32_32x32x16_f16(ha1, hb0, acc[1][0], 0, 0, 0);
        acc[1][1] = __builtin_amdgcn_mfma_f32_32x32x16_f16(ha1, hb1, acc[1][1], 0, 0, 0);
      } else {
        acc[0][0] = __builtin_amdgcn_mfma_f32_32x32x16_bf16(af0, bf0, acc[0][0], 0, 0, 0);
        acc[0][1] = __builtin_amdgcn_mfma_f32_32x32x16_bf16(af0, bf1, acc[0][1], 0, 0, 0);
        acc[1][0] = __builtin_amdgcn_mfma_f32_32x32x16_bf16(af1, bf0, acc[1][0], 0, 0, 0);
        acc[1][1] = __builtin_amdgcn_mfma_f32_32x32x16_bf16(af1, bf1, acc[1][1], 0, 0, 0);
      }
    }
  };
  load_regs(0);
  lds_barrier();
  store_lds(0, 0);
  if (KT > 1) load_regs(1);
  lds_barrier();
  for (int kt = 0; kt < KT; ++kt) {
    compute(kt & 1);
    if (kt + 1 < KT) store_lds(kt + 1, (kt + 1) & 1);
    if (kt + 2 < KT) load_regs(kt + 2);
    lds_barrier();
  }
  float* Cs = (float*)smem;
#pragma unroll
  for (int i = 0; i < 2; ++i)
#pragma unroll
    for (int j = 0; j < 2; ++j)
#pragma unroll
      for (int r = 0; r < 16; ++r)
        Cs[(wm * 64 + i * 32 + (r & 3) + 8 * (r >> 2) + 4 * (lane >> 5)) * 132 + wn * 64 + j * 32 + (lane & 31)] = acc[i][j][r];
  lds_barrier();
#pragma unroll 2
  for (int it = 0; it < 8; ++it) {
    const int idx = it * 256 + tid, row = idx >> 4, c8 = (idx & 15) * 8;
    const float4 v0 = *(const float4*)(Cs + row * 132 + c8), v1 = *(const float4*)(Cs + row * 132 + c8 + 4);
    float v[8] = {v0.x, v0.y, v0.z, v0.w, v1.x, v1.y, v1.z, v1.w};
    epi(m0 + row, c8, v);
  }
}

__device__ __forceinline__ void phase_rw_proj(const Params& p, int j, char* smem, int zonly, int bid, int nb) {
  const int ntn = zonly ? 16 : (j == 0 ? 50 : 67);
  const float* mixb = p.rw_mix + (size_t)j * 6 * DM;
  const bool xaware = (nb & 7) == 0;
  const int xcd = xaware ? (bid & 7) : 0, slot = xaware ? (bid >> 3) : bid, nslots = xaware ? (nb >> 3) : nb;
  const int ntx = xaware ? (ntn - xcd + 7) / 8 : ntn;
  for (int li = slot; li < MT * ntx; li += nslots) {
    const int mt = li / ntx, ntl = xaware ? xcd + 8 * (li % ntx) : (li % ntx), m0 = mt * 128;
    const int nt = zonly ? 48 + ntl : (ntl < 48 ? ntl : ntl + 16);
    if (nt < 64) {
      const int pi = nt >> 4, n0 = (nt & 15) * 128;
      const int mi = pi == 0 ? 0 : (pi == 1 ? 2 : (pi == 2 ? 3 : 5));
      const bf16_t* Bw = g_wt + OFF_PROJ + ((size_t)(j * 4 + pi) * DI + n0) * DM;
      bf16_t* dst = pi == 0 ? p.R : (pi == 1 ? p.K : (pi == 2 ? p.V : p.Z));
      if (pi == 3) {
        gemm_tile<1>(p.HR, DM, mixb + mi * DM, m0, DM, Bw, 128, smem,
                     [&](int row, int col, float* v) {
#pragma unroll
        for (int e = 0; e < 8; ++e) v[e] = siluf_(v[e]);
        *(uint4*)(dst + (size_t)row * DI + n0 + col) = pack8(v); });
      } else {
        gemm_tile<1>(p.HR, DM, mixb + mi * DM, m0, DM, Bw, 128, smem,
                     [&](int row, int col, float* v) { *(uint4*)(dst + (size_t)row * DI + n0 + col) = pack8(v); });
      }
    } else if (nt == 64) {
      gemm_tile<1>(p.HR, DM, mixb + 1 * DM, m0, DM, g_wt + OFF_W1 + (size_t)j * 128 * DM, 128, smem,
                   [&](int row, int col, float* v) {
#pragma unroll
        for (int e = 0; e < 8; ++e) v[e] = tanhf_(v[e]);
        *(uint4*)(p.LRW + (size_t)row * 128 + col) = pack8(v); });
    } else if (nt == 65) {
      gemm_tile<1>(p.HR, DM, mixb + 4 * DM, m0, DM, g_wt + OFF_A1 + (size_t)j * 128 * DM, 128, smem,
                   [&](int row, int col, float* v) { *(uint4*)(p.LRA + (size_t)row * 128 + col) = pack8(v); });
    } else if (nt == 66) {
      gemm_tile<1>(p.HR, DM, mixb + 3 * DM, m0, DM, g_wt + OFF_V1, 32, smem, [&](int row, int col, float* v) {
        if (col < 32) *(uint4*)(p.LRV + (size_t)row * 32 + col) = pack8(v);
      });
    } else {
      const int n0 = (nt - 67) * 128;
      const bf16_t* Bw = g_wt + OFF_PROJ + ((size_t)2 * DI + n0) * DM;
      gemm_tile<1>(p.HR0, DM, p.rw_mix + 3 * DM, m0, DM, Bw, 128, smem,
                   [&](int row, int col, float* v) { *(uint4*)(p.VF + (size_t)row * DI + n0 + col) = pack8(v); });
    }
  }
}

__device__ __forceinline__ void phase_rw_lr2(const Params& p, int j, char* smem) {
  for (int tile = blockIdx.x; tile < MT * 16; tile += gridDim.x) {
    const int mt = tile / 16, nt = tile % 16, m0 = mt * 128;
    const int n0 = nt * 128;
    const bf16_t* Bw = g_wt + OFF_V2 + (size_t)n0 * 32;
    const float* v0 = p.rw_v0 + n0;
    gemm_tile<0>(p.LRV, 32, nullptr, m0, 32, Bw, 128, smem, [&](int row, int col, float* v) {
      const size_t idx = (size_t)row * DI + n0 + col;
      float vv[8], vf[8];
      unpack8(*(const uint4*)(p.V + idx), vv); unpack8(*(const uint4*)(p.VF + idx), vf);
#pragma unroll
      for (int e = 0; e < 8; ++e) vv[e] += (vf[e] - vv[e]) * sigmoidf_(v[e] + v0[col + e]);
      *(uint4*)(p.V + idx) = pack8(vv);
    });
  }
}

constexpr int RCH = 32;
__device__ __forceinline__ int scan_pos(int dir, int s) { return dir == 0 ? s : (s < CTX ? CTX - 1 - s : TT + CTX - 1 - s); }

__device__ __forceinline__ void phase_rw_scan(const Params& p, int j, char* smem) {
  float* op = (float*)smem;
  float* vv = op + RCH * 4 * 64;
  float* sc = vv + RCH * 64;
  float* LWs = sc + RCH * 2;
  float* AAs = LWs + RCH * 64;
  float* yb = AAs;
  bf16_t* LRs = (bf16_t*)(AAs + RCH * 64);
  const int tid = opaque_tid(), lane = tid & 63, w = tid >> 6;
  const int ptau = tid >> 3, pc8 = (tid & 7) * 8;
  const int r2 = lane >> 3, ko = (lane & 7) * 8;
  const int row0 = w * 16 + r2, row1 = row0 + 8;
  for (int unit = blockIdx.x; unit < GB * 64; unit += gridDim.x) {
    const int bl = unit >> 6, h = (unit >> 1) & 31, dir = unit & 1;
    bf16_t* Y = dir == 0 ? p.YF : p.YB;
    float pkk[8], pka[8], prk[8];
#pragma unroll
    for (int e = 0; e < 8; ++e) {
      const int cc = j * DI + h * 64 + pc8 + e;
      pkk[e] = p.rw_kk[cc]; pka[e] = p.rw_ka[cc]; prk[e] = p.rw_rk[cc];
    }
    __syncthreads();
    const int mm = w >> 1, nh = w & 1;
    const float bias = (mm == 0 ? p.rw_w0 : p.rw_a0)[((size_t)j * 2 + dir) * DI + h * 64 + nh * 32 + (lane & 31)];
    bf16x8 wfr[4];
    {
      const bf16_t* w2g = g_wt + (mm == 0 ? OFF_W2 : OFF_A2) + (((size_t)j * 2 + dir) * DI + h * 64 + nh * 32 + (lane & 31)) * 64 + (lane >> 5) * 8;
#pragma unroll
      for (int kk = 0; kk < 4; ++kk) wfr[kk] = *(const bf16x8*)(w2g + kk * 16);
    }
    f2_t S0[4], S1[4];
#pragma unroll
    for (int e = 0; e < 4; ++e) { S0[e] = f2_t{0.f, 0.f}; S1[e] = f2_t{0.f, 0.f}; }
    uint4 gr, gk, gv, gl0, gl1;
    const int lmat = (tid & 7) >> 2, lcol = (tid & 3) * 16;
    const size_t ubase = (size_t)bl * TT * DI + h * 64 + pc8;
    const bf16_t* const rp = p.R + ubase;
    const bf16_t* const kp = p.K + ubase;
    const bf16_t* const vp_ = p.V + ubase;
    const bf16_t* const lrp = (lmat == 0 ? p.LRW : p.LRA) + (size_t)bl * TT * 128 + dir * 64 + lcol;
    auto gload = [&](int chunk) {
      const int pos = scan_pos(dir, chunk * RCH + ptau);
      const size_t o = (size_t)pos * DI;
      gr = *(const uint4*)(rp + o); gk = *(const uint4*)(kp + o); gv = *(const uint4*)(vp_ + o);
      const bf16_t* lr = lrp + (size_t)pos * 128;
      gl0 = *(const uint4*)(lr); gl1 = *(const uint4*)(lr + 8);
    };
    gload(0);
    for (int chunk = 0; chunk < TT / RCH; ++chunk) {
      *(uint4*)(LRs + (lmat * RCH + ptau) * 72 + lcol) = gl0;
      *(uint4*)(LRs + (lmat * RCH + ptau) * 72 + lcol + 8) = gl1;
      lds_barrier();
      {
        f32x16 acc;
#pragma unroll
        for (int r = 0; r < 16; ++r) acc[r] = 0.f;
#pragma unroll
        for (int kk = 0; kk < 4; ++kk) {
          const bf16x8 af = *(const bf16x8*)(LRs + (mm * RCH + (lane & 31)) * 72 + kk * 16 + (lane >> 5) * 8);
          acc = __builtin_amdgcn_mfma_f32_32x32x16_bf16(af, wfr[kk], acc, 0, 0, 0);
        }
        const int chn = nh * 32 + (lane & 31), hh = lane >> 5;
        if (mm == 0) {
          float lwv[16], pf[16], own[4], oth[4];
#pragma unroll
          for (int r = 0; r < 16; ++r) lwv[r] = -0.60653066f * sigmoidf_(acc[r] + bias);
#pragma unroll
          for (int g = 0; g < 4; ++g) {
            pf[g * 4] = lwv[g * 4];
            pf[g * 4 + 1] = pf[g * 4] + lwv[g * 4 + 1];
            pf[g * 4 + 2] = pf[g * 4 + 1] + lwv[g * 4 + 2];
            pf[g * 4 + 3] = pf[g * 4 + 2] + lwv[g * 4 + 3];
            own[g] = pf[g * 4 + 3];
            oth[g] = __shfl_xor(own[g], 32);
          }
          float base = 0.f;
#pragma unroll
          for (int g = 0; g < 4; ++g) {
            const float off = base + (hh ? oth[g] : 0.f);
#pragma unroll
            for (int q = 0; q < 4; ++q) {
              const int t = q + 8 * g + 4 * hh;
              const float c = off + pf[g * 4 + q];
              LWs[t * 64 + chn] = c;
            }
            base += own[g] + oth[g];
          }
        } else {
#pragma unroll
          for (int r = 0; r < 16; ++r) {
            const int t = (r & 3) + 8 * (r >> 2) + 4 * hh;
            AAs[t * 64 + chn] = sigmoidf_(acc[r] + bias);
          }
        }
      }
      lds_barrier();
      {
        float r[8], k[8], v[8], cm[8], cp[8], a[8];
        unpack8(gr, r); unpack8(gk, k); unpack8(gv, v);
#pragma unroll
        for (int e = 0; e < 8; ++e) {
          cm[e] = LWs[ptau * 64 + pc8 + e]; cp[e] = ptau > 0 ? LWs[(ptau - 1) * 64 + pc8 + e] : 0.f; a[e] = AAs[ptau * 64 + pc8 + e];
        }
        float kkv[8], ss = 0.f;
#pragma unroll
        for (int e = 0; e < 8; ++e) { kkv[e] = k[e] * pkk[e]; ss += kkv[e] * kkv[e]; }
        ss = red8(ss);
        const float inv = rsqrtf(fmaxf(ss, 1e-24f));
        float br = 0.f, kr = 0.f, bon = 0.f;
        float o0[8], o1[8], o2[8], o3[8];
#pragma unroll
        for (int e = 0; e < 8; ++e) {
          const float kkn = kkv[e] * inv;
          const float P = __expf(cm[e]), Pp = __expf(cp[e]);
          const float iP = rcpf_(P);
          const float kd = k[e] * (1.f + (a[e] - 1.f) * pka[e]);
          const float bb = kkn * a[e];
          o0[e] = -kkn * Pp; o1[e] = r[e] * P; o2[e] = bb * iP; o3[e] = kd * iP;
          br += bb * r[e]; kr += kd * r[e]; bon += r[e] * kd * prk[e];
        }
        br = red8(br); kr = red8(kr); bon = red8(bon);
        float* od = op + ptau * 256 + pc8;
        *(float4*)(od) = make_float4(o0[0], o0[1], o0[2], o0[3]); *(float4*)(od + 4) = make_float4(o0[4], o0[5], o0[6], o0[7]);
        *(float4*)(od + 64) = make_float4(o1[0], o1[1], o1[2], o1[3]); *(float4*)(od + 68) = make_float4(o1[4], o1[5], o1[6], o1[7]);
        *(float4*)(od + 128) = make_float4(o2[0], o2[1], o2[2], o2[3]); *(float4*)(od + 132) = make_float4(o2[4], o2[5], o2[6], o2[7]);
        *(float4*)(od + 192) = make_float4(o3[0], o3[1], o3[2], o3[3]); *(float4*)(od + 196) = make_float4(o3[4], o3[5], o3[6], o3[7]);
        float* vd = vv + ptau * 64 + pc8;
        *(float4*)(vd) = make_float4(v[0], v[1], v[2], v[3]); *(float4*)(vd + 4) = make_float4(v[4], v[5], v[6], v[7]);
        if ((tid & 7) == 0) {
          sc[ptau * 2] = br; sc[ptau * 2 + 1] = kr;
          const int pos = scan_pos(dir, chunk * RCH + ptau);
          p.BN[((size_t)dir * NTG + (size_t)bl * TT + pos) * 32 + h] = bon;
        }
      }
      lds_barrier();
      if (chunk + 1 < TT / RCH) gload(chunk + 1);
      {
        struct StepOps { float4 n0, n1, q0, q1, b0, b1, k0, k1; float v0, v1; float2 s; };
        auto ldops = [&](StepOps& o, int tau) {
          const float* ob = op + tau * 256 + ko;
          o.n0 = *(const float4*)(ob); o.n1 = *(const float4*)(ob + 4);
          o.q0 = *(const float4*)(ob + 64); o.q1 = *(const float4*)(ob + 68);
          o.b0 = *(const float4*)(ob + 128); o.b1 = *(const float4*)(ob + 132);
          o.k0 = *(const float4*)(ob + 192); o.k1 = *(const float4*)(ob + 196);
          o.v0 = vv[tau * 64 + row0]; o.v1 = vv[tau * 64 + row1];
          o.s = *(const float2*)(sc + tau * 2);
        };
        auto dostep = [&](const StepOps& o, int tau) {
          const float nk[8] = {o.n0.x, o.n0.y, o.n0.z, o.n0.w, o.n1.x, o.n1.y, o.n1.z, o.n1.w};
          const float rr[8] = {o.q0.x, o.q0.y, o.q0.z, o.q0.w, o.q1.x, o.q1.y, o.q1.z, o.q1.w};
          const float bb[8] = {o.b0.x, o.b0.y, o.b0.z, o.b0.w, o.b1.x, o.b1.y, o.b1.z, o.b1.w};
          const float kd[8] = {o.k0.x, o.k0.y, o.k0.z, o.k0.w, o.k1.x, o.k1.y, o.k1.z, o.k1.w};
          f2_t a10 = {0.f, 0.f}, a11 = {0.f, 0.f}, a20 = {0.f, 0.f}, a21 = {0.f, 0.f};
#pragma unroll
          for (int e = 0; e < 4; ++e) {
            const f2_t nk2 = {nk[2 * e], nk[2 * e + 1]}, rr2 = {rr[2 * e], rr[2 * e + 1]};
            a10 = __builtin_elementwise_fma(S0[e], nk2, a10); a11 = __builtin_elementwise_fma(S1[e], nk2, a11);
            a20 = __builtin_elementwise_fma(S0[e], rr2, a20); a21 = __builtin_elementwise_fma(S1[e], rr2, a21);
          }
          float d10 = a10.x + a10.y, d11 = a11.x + a11.y, d20 = a20.x + a20.y, d21 = a21.x + a21.y;
          d10 = red8(d10); d11 = red8(d11); d20 = red8(d20); d21 = red8(d21);
          const float y0 = d20 + d10 * o.s.x + o.v0 * o.s.y;
          const float y1 = d21 + d11 * o.s.x + o.v1 * o.s.y;
          const f2_t sa0 = {d10, d10}, sa1 = {d11, d11}, vv0 = {o.v0, o.v0}, vv1 = {o.v1, o.v1};
#pragma unroll
          for (int e = 0; e < 4; ++e) {
            const f2_t bb2 = {bb[2 * e], bb[2 * e + 1]}, kd2 = {kd[2 * e], kd[2 * e + 1]};
            S0[e] = __builtin_elementwise_fma(sa0, bb2, __builtin_elementwise_fma(vv0, kd2, S0[e]));
            S1[e] = __builtin_elementwise_fma(sa1, bb2, __builtin_elementwise_fma(vv1, kd2, S1[e]));
          }
          if ((lane & 7) == 0) { yb[tau * 64 + row0] = y0; yb[tau * 64 + row1] = y1; }
        };
        StepOps oa, ob2;
        ldops(oa, 0);
#pragma unroll 1
        for (int tau = 0; tau < RCH; tau += 2) {
          ldops(ob2, tau + 1);
          dostep(oa, tau);
          ldops(oa, tau + 2);
          dostep(ob2, tau + 1);
        }
#pragma unroll
        for (int e = 0; e < 4; ++e) {
          const f2_t pc = {__expf(LWs[(RCH - 1) * 64 + ko + 2 * e]), __expf(LWs[(RCH - 1) * 64 + ko + 2 * e + 1])};
          S0[e] *= pc; S1[e] *= pc;
        }
      }
      lds_barrier();
      {
        const int pos = scan_pos(dir, chunk * RCH + ptau);
        const float* ys = yb + ptau * 64 + pc8;
        float yv[8];
#pragma unroll
        for (int e = 0; e < 8; ++e) yv[e] = ys[e];
        *(uint4*)(Y + ((size_t)bl * TT + pos) * DI + h * 64 + pc8) = pack8(yv);
      }
    }
    lds_barrier();
  }
}

__device__ __forceinline__ void phase_rw_gate(const Params& p, int j) {
  const int tid = opaque_tid(), h = tid >> 3;
  const int c0 = tid * 8;
  float lnw[8], lnb[8];
#pragma unroll
  for (int e = 0; e < 8; ++e) { lnw[e] = p.rw_lnw[j * DI + c0 + e]; lnb[e] = p.rw_lnb[j * DI + c0 + e]; }
  for (int tg = blockIdx.x; tg < NTG; tg += gridDim.x) {
    const size_t base = (size_t)tg * DI + c0;
    float yf[8], yb[8], v[8], z[8];
    unpack8(*(const uint4*)(p.YF + base), yf); unpack8(*(const uint4*)(p.YB + base), yb);
    unpack8(*(const uint4*)(p.V + base), v); unpack8(*(const uint4*)(p.Z + base), z);
    const float bon = p.BN[(size_t)tg * 32 + h] + p.BN[((size_t)NTG + tg) * 32 + h];
    float y[8], s = 0.f;
#pragma unroll
    for (int e = 0; e < 8; ++e) { y[e] = yf[e] + yb[e]; s += y[e]; }
    const float mu = red8(s) * (1.f / 64.f);
    float s2 = 0.f;
#pragma unroll
    for (int e = 0; e < 8; ++e) { y[e] -= mu; s2 += y[e] * y[e]; }
    const float rstd = rsqrtf(red8(s2) * (1.f / 64.f) + 64e-5f);
#pragma unroll
    for (int e = 0; e < 8; ++e) y[e] = (y[e] * rstd * lnw[e] + lnb[e] + bon * v[e]) * z[e];
    *(uint4*)(p.YF + base) = pack8(y);
  }
}

__device__ __forceinline__ void phase_out(const Params& p, const bf16_t* wo, char* smem, bool skipctx = false) {
  const int mtn = skipctx ? GB * (SEQ / 128) : MT;
  for (int tile = blockIdx.x; tile < mtn * 8; tile += gridDim.x) {
    const int mtl = tile / 8, nt = tile % 8;
    const int mt = skipctx ? (mtl / (SEQ / 128)) * (TT / 128) + CTX / 128 + mtl % (SEQ / 128) : mtl;
    const int m0 = mt * 128, n0 = nt * 128;
    const bf16_t* Bw = wo + (size_t)n0 * DI;
    gemm_tile<0>(p.YF, DI, nullptr, m0, DI, Bw, 128, smem,
                 [&](int row, int col, float* v) {
      float* o = p.O + (size_t)row * DM + n0 + col;
      *(float4*)o = make_float4(v[0], v[1], v[2], v[3]); *(float4*)(o + 4) = make_float4(v[4], v[5], v[6], v[7]); });
  }
}

__device__ __forceinline__ void phase_hg_proj(const Params& p, int j, char* smem) {
  const int layer = 2 * j + 1;
  for (int tile = blockIdx.x; tile < MT * 80; tile += gridDim.x) {
    const int mt = tile / 80, nt = tile % 80, m0 = mt * 128;
    const int seg = nt >> 4, n0 = (nt & 15) * 128;
    if (layer == 3 && (mt % (TT / 128)) < CTX / 128 && (seg == 0 || seg == 4)) continue;
    const bf16_t* Bw = g_wt + OFF_HWIN + ((size_t)j * 5 * DI + (size_t)seg * DI + n0) * DM;
    bf16_t* dst = seg == 0 ? p.R : (seg == 1 ? p.K : (seg == 2 ? p.WF : (seg == 3 ? p.V : p.Z)));
    if (seg == 0 || seg == 4) {
      gemm_tile<0>(p.H, DM, nullptr, m0, DM, Bw, 128, smem, [&](int row, int col, float* v) {
#pragma unroll
        for (int e = 0; e < 8; ++e) v[e] = siluf_(v[e]);
        *(uint4*)(dst + (size_t)row * DI + n0 + col) = pack8(v); });
    } else if (seg == 3) {
      gemm_tile<0>(p.H, DM, nullptr, m0, DM, Bw, 128, smem,
                   [&](int row, int col, float* v) { *(uint4*)(dst + (size_t)row * DI + n0 + col) = pack8(v); });
    } else {
      const float* lbp = p.LB + layer * DI + n0;
      gemm_tile<0>(p.H, DM, nullptr, m0, DM, Bw, 128, smem, [&](int row, int col, float* v) {
        const float4 l0 = *(const float4*)(lbp + col), l1 = *(const float4*)(lbp + col + 4);
        const float lb[8] = {l0.x, l0.y, l0.z, l0.w, l1.x, l1.y, l1.z, l1.w};
#pragma unroll
        for (int e = 0; e < 8; ++e) v[e] = __logf(lb[e] + (1.f - lb[e]) * sigmoidf_(v[e]));
        *(uint4*)(dst + (size_t)row * DI + n0 + col) = pack8(v); });
    }
  }
}

constexpr int HC = 32;
constexpr int QS = 136;
constexpr int SS = 40;
__device__ __forceinline__ void phase_hg_scan(const Params& p, int layer, char* smem) {
  bf16_t* qe = (bf16_t*)smem;
  bf16_t* ke = qe + HC * QS;
  bf16_t* kdT = ke + HC * QS;
  bf16_t* vT = kdT + 128 * SS;
  bf16_t* att = vT + 64 * SS;
  bf16_t* ST = att + HC * SS;
  float* dC = (float*)(ST + 64 * QS);
  const int tid = opaque_tid(), lane = tid & 63, w = tid >> 6;
  for (int unit = blockIdx.x; unit < GB * 64; unit += gridDim.x) {
    const int vs = unit & 1, dir = (unit >> 1) & 1, h = (unit >> 2) & 15, bl = unit >> 6;
    const bf16_t* FL = dir == 0 ? p.K : p.WF;
    bf16_t* Y = dir == 0 ? p.YF : p.YB;
    const int st = lane & 31, cg = w * 2 + (lane >> 5), kb = cg * 16, vb = cg * 8;
    f32x16 sacc[2];
#pragma unroll
    for (int r = 0; r < 16; ++r) { sacc[0][r] = 0.f; sacc[1][r] = 0.f; }
    __syncthreads();
    for (int idx = tid; idx < 64 * QS / 2; idx += 256) ((unsigned*)ST)[idx] = 0u;
    uint4 gq0, gq1, gf0, gf1, gvv;
    const size_t ubase = (size_t)bl * TT * DI + h * 128;
    const bf16_t* const qp = p.R + ubase + kb;
    const bf16_t* const fp_ = FL + ubase + kb;
    const bf16_t* const ip = p.V + ubase + vs * 64 + vb;
    auto gload = [&](int chunk) {
      const int pos = scan_pos(dir, chunk * HC + st);
      const size_t o = (size_t)pos * DI;
      gq0 = *(const uint4*)(qp + o); gq1 = *(const uint4*)(qp + o + 8);
      gf0 = *(const uint4*)(fp_ + o); gf1 = *(const uint4*)(fp_ + o + 8);
      gvv = *(const uint4*)(ip + o);
    };
    gload(0);
    for (int chunk = 0; chunk < TT / HC; ++chunk) {
      float q[16], cum[16], one[16];
      {
        unpack8(gq0, q); unpack8(gq1, q + 8); unpack8(gf0, cum); unpack8(gf1, cum + 8);
#pragma unroll
        for (int e = 0; e < 16; ++e) {
          float c = cum[e];
          one[e] = 1.f - __expf(c);
          c += __int_as_float(__builtin_amdgcn_update_dpp(0, __float_as_int(c), 0x111, 0xf, 0xf, false));
          c += __int_as_float(__builtin_amdgcn_update_dpp(0, __float_as_int(c), 0x112, 0xf, 0xf, false));
          c += __int_as_float(__builtin_amdgcn_update_dpp(0, __float_as_int(c), 0x114, 0xf, 0xf, false));
          c += __int_as_float(__builtin_amdgcn_update_dpp(0, __float_as_int(c), 0x118, 0xf, 0xf, false));
          c += __int_as_float(__builtin_amdgcn_update_dpp(0, __float_as_int(c), 0x142, 0xa, 0xf, false));
          cum[e] = c;
        }
      }
      const uint4 vreg = gvv;
      lds_barrier();
      {
        float qo[16], ko[16];
#pragma unroll
        for (int e = 0; e < 16; ++e) {
          const float c31 = __int_as_float(__builtin_amdgcn_readlane(__float_as_int(cum[e]), 31));
          const float c63 = __int_as_float(__builtin_amdgcn_readlane(__float_as_int(cum[e]), 63));
          const float cC = (lane >> 5) ? c63 : c31;
          const float ec = __expf(fmaxf(cum[e], -80.f));
          const float inv = rcpf_(ec);
          const float eC = __expf(cC);
          qo[e] = q[e] * ec;
          ko[e] = one[e] * inv;
          kdT[(kb + e) * SS + st] = f2bf(one[e] * inv * eC);
          if (st == 31) dC[kb + e] = eC;
        }
        *(uint4*)(qe + st * QS + kb) = pack8(qo); *(uint4*)(qe + st * QS + kb + 8) = pack8(qo + 8);
        *(uint4*)(ke + st * QS + kb) = pack8(ko); *(uint4*)(ke + st * QS + kb + 8) = pack8(ko + 8);
        const bf16_t* vp = (const bf16_t*)&vreg;
#pragma unroll
        for (int e = 0; e < 8; ++e) vT[(vb + e) * SS + st] = vp[e];
      }
      lds_barrier();
      if (chunk + 1 < TT / HC) gload(chunk + 1);
      {
        const int mi = w >> 1, ni = w & 1;
        f32x4 a4 = {0.f, 0.f, 0.f, 0.f};
#pragma unroll
        for (int kk = 0; kk < 4; ++kk) {
          const bf16x8 af = *(const bf16x8*)(qe + (mi * 16 + (lane & 15)) * QS + kk * 32 + (lane >> 4) * 8);
          const bf16x8 bf = *(const bf16x8*)(ke + (ni * 16 + (lane & 15)) * QS + kk * 32 + (lane >> 4) * 8);
          a4 = __builtin_amdgcn_mfma_f32_16x16x32_bf16(af, bf, a4, 0, 0, 0);
        }
        const int s = ni * 16 + (lane & 15);
#pragma unroll
        for (int r = 0; r < 4; ++r) {
          const int t = mi * 16 + (lane >> 4) * 4 + r;
          att[t * SS + s] = f2bf(s <= t ? a4[r] : 0.f);
        }
      }
      lds_barrier();
      {
#pragma unroll
        for (int mh = 0; mh < 2; ++mh) {
          f32x4 y4 = {0.f, 0.f, 0.f, 0.f};
          {
            const bf16x8 af = *(const bf16x8*)(att + (mh * 16 + (lane & 15)) * SS + (lane >> 4) * 8);
            const bf16x8 bf = *(const bf16x8*)(vT + (w * 16 + (lane & 15)) * SS + (lane >> 4) * 8);
            y4 = __builtin_amdgcn_mfma_f32_16x16x32_bf16(af, bf, y4, 0, 0, 0);
          }
#pragma unroll
          for (int kk = 0; kk < 4; ++kk) {
            const bf16x8 af = *(const bf16x8*)(qe + (mh * 16 + (lane & 15)) * QS + kk * 32 + (lane >> 4) * 8);
            const bf16x8 bf = *(const bf16x8*)(ST + (w * 16 + (lane & 15)) * QS + kk * 32 + (lane >> 4) * 8);
            y4 = __builtin_amdgcn_mfma_f32_16x16x32_bf16(af, bf, y4, 0, 0, 0);
          }
#pragma unroll
          for (int r = 0; r < 4; ++r) {
            const int t = mh * 16 + (lane >> 4) * 4 + r;
            const int pos = scan_pos(dir, chunk * HC + t);
            Y[((size_t)bl * TT + pos) * DI + h * 128 + vs * 64 + w * 16 + (lane & 15)] = f2bf(y4[r]);
          }
        }
      }
      lds_barrier();
      {
        float dk[16];
#pragma unroll
        for (int r = 0; r < 16; ++r) dk[r] = dC[w * 32 + (r & 3) + 8 * (r >> 2) + 4 * (lane >> 5)];
#pragma unroll
        for (int nt = 0; nt < 2; ++nt) {
#pragma unroll
          for (int r = 0; r < 16; ++r) sacc[nt][r] *= dk[r];
#pragma unroll
          for (int ks = 0; ks < 2; ++ks) {
            const bf16x8 af = *(const bf16x8*)(kdT + (w * 32 + (lane & 31)) * SS + ks * 16 + (lane >> 5) * 8);
            const bf16x8 bf = *(const bf16x8*)(vT + (nt * 32 + (lane & 31)) * SS + ks * 16 + (lane >> 5) * 8);
            sacc[nt] = __builtin_amdgcn_mfma_f32_32x32x16_bf16(af, bf, sacc[nt], 0, 0, 0);
          }
#pragma unroll
          for (int gq = 0; gq < 4; ++gq) {
            uint2 u;
            u.x = pack2(sacc[nt][gq * 4 + 0], sacc[nt][gq * 4 + 1]);
            u.y = pack2(sacc[nt][gq * 4 + 2], sacc[nt][gq * 4 + 3]);
            *(uint2*)(ST + (nt * 32 + (lane & 31)) * QS + w * 32 + gq * 8 + (lane >> 5) * 4) = u;
          }
        }
      }
    }
    lds_barrier();
  }
}

__device__ __forceinline__ void phase_hg_gate(const Params& p, int j, bool skipctx = false) {
  const int tid = opaque_tid();
  const int c0 = tid * 8;
  float gn[8];
#pragma unroll
  for (int e = 0; e < 8; ++e) gn[e] = p.hg_gn[j * 128 + ((c0 + e) & 127)];
  for (int tg = blockIdx.x; tg < NTG; tg += gridDim.x) {
    if (skipctx && (tg % TT) < CTX) continue;
    const size_t base = (size_t)tg * DI + c0;
    float yf[8], yb[8], z[8];
    unpack8(*(const uint4*)(p.YF + base), yf); unpack8(*(const uint4*)(p.YB + base), yb);
    unpack8(*(const uint4*)(p.Z + base), z);
    float y[8], s2 = 0.f;
#pragma unroll
    for (int e = 0; e < 8; ++e) { y[e] = yf[e] + yb[e]; s2 += y[e] * y[e]; }
    const float rstd = rsqrtf(red16(s2) * (1.f / 128.f) + EPS);
#pragma unroll
    for (int e = 0; e < 8; ++e) y[e] = y[e] * rstd * gn[e] * z[e];
    *(uint4*)(p.YF + base) = pack8(y);
  }
}

__global__ void __launch_bounds__(256, 2) fwd_megakernel(Params p) {
  cg::grid_group grid = cg::this_grid();
  __shared__ __attribute__((aligned(16))) char smem[78 * 1024];
  __shared__ uint4 xb_words;
  if (threadIdx.x == 0) xb_words = make_uint4(0u, 0u, 0u, 0u);
  __syncthreads();
  XcdBarrier xb = xcd_barrier_post(p.bar, (volatile LAS unsigned*)&xb_words);
  phase_mod(p, smem);
  phase_wconv(p, smem);
  grid.sync();
  for (int g = 0; g < NG; ++g) {
    for (int layer = 0; layer < 4; ++layer) {
      phase_resnorm(p, g, layer - 1, layer);
      xcd_barrier(xb);
      const int j = layer >> 1;
      if ((layer & 1) == 0) {
        phase_rw_proj(p, j, smem, 0, blockIdx.x, gridDim.x);
        xcd_barrier(xb);
        if (j == 1) { phase_rw_lr2(p, j, smem); xcd_barrier(xb); }
        if (gridDim.x >= 2 * GB * 64) {
          if (blockIdx.x < GB * 64) phase_rw_scan(p, j, smem);
          else phase_rw_proj(p, j, smem, 1, blockIdx.x - GB * 64, gridDim.x - GB * 64);
        } else {
          phase_rw_scan(p, j, smem);
          phase_rw_proj(p, j, smem, 1, blockIdx.x, gridDim.x);
        }
        xcd_barrier(xb);
        phase_rw_gate(p, j);
        xcd_barrier(xb);
        phase_out(p, g_wt + OFF_RWO + (size_t)j * DM * DI, smem);
        xcd_barrier(xb);
      } else {
        phase_hg_proj(p, j, smem);
        xcd_barrier(xb);
        phase_hg_scan(p, layer, smem);
        xcd_barrier(xb);
        phase_hg_gate(p, j, layer == 3);
        xcd_barrier(xb);
        phase_out(p, g_wt + OFF_HWO + (size_t)j * DM * DI, smem, layer == 3);
        xcd_barrier(xb);
      }
    }
    phase_resnorm(p, g, 3, -1);
    xcd_barrier(xb);
  }
}

extern "C" void kernel_launch(void* const* d_in, const int* in_sizes, int n_in, void* d_out, int out_size, void* d_ws,
                              size_t ws_size, hipStream_t stream) {
  static int grid_blocks = 0;
  if (!grid_blocks) {
    int dev = 0, cus = 0, per_cu = 0;
    hipGetDevice(&dev);
    hipDeviceGetAttribute(&cus, hipDeviceAttributeMultiprocessorCount, dev);
    hipOccupancyMaxActiveBlocksPerMultiprocessor(&per_cu, fwd_megakernel, 256, 0);
    if (per_cu > 2) per_cu = 2;
    grid_blocks = cus * per_cu;
  }
  Params p{};
  const float** fp = (const float**)&p;
  for (int i = 0; i < 29; ++i) fp[i] = (const float*)d_in[i];
  p.out = (float*)d_out;
  char* w = (char*)d_ws;
  size_t off = 0;
  auto take = [&](size_t bytes) { char* r = w + off; off += (bytes + 255) & ~(size_t)255; return r; };
  const size_t DIW = (size_t)NTG * DI * 2;
  p.R = (bf16_t*)take(DIW); p.K = (bf16_t*)take(DIW); p.V = (bf16_t*)take(DIW); p.Z = (bf16_t*)take(DIW);
  p.WF = (bf16_t*)take(DIW); p.YF = (bf16_t*)take(DIW); p.YB = (bf16_t*)take(DIW);
  p.VF = p.YF;
  p.H = p.YB;
  p.HR = p.WF; p.HR0 = p.WF + (size_t)NTG * DM;
  p.LRW = (bf16_t*)take((size_t)NTG * 128 * 2); p.LRA = (bf16_t*)take((size_t)NTG * 128 * 2);
  p.LRV = (bf16_t*)take((size_t)NTG * 32 * 2);
  p.O = (float*)p.R;
  p.BN = (float*)take((size_t)2 * NTG * 32 * 4);
  p.CTXB = (float*)take((size_t)NB * CTX * DM * 4);
  p.MODV = (float*)take((size_t)4 * 9 * 3 * DM * 4);
  p.LB = (float*)take((size_t)4 * DI * 4);
  p.bar = (unsigned*)take((size_t)XCD_BAR_WORDS * 4);
  if (off > ws_size) { fprintf(stderr, "workspace too small: need %zu have %zu\n", off, ws_size); return; }
  hipMemsetAsync(p.bar, 0, (size_t)XCD_BAR_WORDS * 4, stream);
  void* args[] = {&p};
  hipError_t e = hipLaunchCooperativeKernel((void*)fwd_megakernel, dim3(grid_blocks), dim3(256), args, 0, stream);
  if (e != hipSuccess) fprintf(stderr, "cooperative launch failed: %s (grid %d)\n", hipGetErrorString(e), grid_blocks);
}
```
